# Optimizing an MI355X kernel written in HIP

```python
import jax, jax.numpy as jnp
from jax import lax
import numpy as np


D_MODEL = 1024
BATCH = 8
SEQ = 4096
DEPTH = 4

CHUNK = 64
N_MIXERS = 4
EPS = 1e-6

RET_HEADS = 4
RET_DK = D_MODEL // RET_HEADS
RET_DV = 2 * D_MODEL // RET_HEADS
ROPE_BASE = 10000.0

ATT_HEADS = 16
ATT_DH = D_MODEL // ATT_HEADS
ATT_LEFT_CHUNKS = 8
ATT_LEFT = ATT_LEFT_CHUNKS * CHUNK
ATT_BAND = ATT_LEFT + CHUNK
ATT_MAX_REL = 256
ATT_N_REL = CHUNK + ATT_MAX_REL

GLA_HEADS = 4
GLA_DK = D_MODEL // 2 // GLA_HEADS
GLA_DV = D_MODEL // GLA_HEADS
GLA_GATE_RANK = 16
GLA_GATE_NORM = 16.0

MLSTM_HEADS = 4
MLSTM_INNER = 2 * D_MODEL
MLSTM_DH = MLSTM_INNER // MLSTM_HEADS
MLSTM_CONV = 4
MLSTM_QKV_BLOCK = 4
MLSTM_N_BLOCKS = MLSTM_INNER // MLSTM_QKV_BLOCK

N_EXPERTS = 32
TOP_K = 4
D_EXPERT = D_MODEL
SWIGLU_LIMIT = 7.0
SWIGLU_ALPHA = 1.702

kernel_name = 'hybrid_streaming_encoder_trunk'


def _layers_of(kind):
    return len(range(kind, DEPTH, N_MIXERS))


def rms_norm(x, g):
    xf = x.astype(jnp.float32)
    y = xf * lax.rsqrt(jnp.mean(xf * xf, axis=-1, keepdims=True) + EPS)
    return (y * g).astype(x.dtype)


def head_norm(x, g, center):
    xf = x.astype(jnp.float32)
    if center:
        xf = xf - jnp.mean(xf, axis=-1, keepdims=True)
    y = xf * lax.rsqrt(jnp.mean(xf * xf, axis=-1, keepdims=True) + EPS)
    return (y * g[None, :, None, :]).astype(x.dtype)


def to_heads(t, n_heads):
    b, s, _ = t.shape
    return t.reshape(b, s, n_heads, -1).transpose(0, 2, 1, 3)


def from_heads(t):
    b, h, s, d = t.shape
    return t.transpose(0, 2, 1, 3).reshape(b, s, h * d)


def rope(t, pos):
    half = t.shape[-1] // 2
    inv = ROPE_BASE ** (-jnp.arange(half, dtype=jnp.float32) / half)
    ang = pos.astype(jnp.float32)[:, None] * inv[None, :]
    cos = jnp.cos(ang)[None, :, None, :]
    sin = jnp.sin(ang)[None, :, None, :]
    t1, t2 = t[..., :half], t[..., half:]
    return jnp.concatenate([t1 * cos - t2 * sin, t1 * sin + t2 * cos], axis=-1).astype(t.dtype)


def chunk_linear_attention(q, k, v, log_a):
    b_, h_, s_, _ = q.shape
    dv = v.shape[-1]
    nc = s_ // CHUNK

    def chunks(t):
        return t.reshape(t.shape[0], t.shape[1], nc, CHUNK, t.shape[3])

    qc, kc, vc = chunks(q), chunks(k), chunks(v)
    b = jnp.cumsum(chunks(log_a.astype(jnp.float32)), axis=3)
    b_last = b[:, :, :, -1:, :]
    q_in = qc * jnp.exp(b)
    k_in = kc * jnp.exp(-b)
    k_st = kc * jnp.exp(b_last - b)
    causal = jnp.tril(jnp.ones((CHUNK, CHUNK), dtype=bool))
    scores = jnp.where(causal, jnp.einsum('bhcld,bhcmd->bhclm', q_in, k_in), 0.0)
    o_intra = jnp.einsum('bhclm,bhcme->bhcle', scores, vc)
    decay = jnp.exp(b_last[:, :, :, 0, :])

    def step(state, xs):
        q_c, k_c, v_c, d_c = xs
        o = jnp.einsum('bhld,bhde->bhle', q_c, state)
        state = d_c[..., None] * state + jnp.einsum('bhld,bhle->bhde', k_c, v_c)
        return state, o

    mv = lambda t: jnp.moveaxis(t, 2, 0)
    dt = jnp.result_type(q_in, k_st, vc)
    init = jnp.zeros((b_, h_, q.shape[-1], dv), dt)
    _, o_inter = lax.scan(step, init, (mv(q_in), mv(k_st), mv(vc), mv(decay)))
    o = o_intra + jnp.moveaxis(o_inter, 0, 2)
    return o.reshape(b_, h_, s_, dv)


def retention_mixer(h, w_in, gn_g, w_out):
    b_, s_, _ = h.shape
    dq = RET_HEADS * RET_DK
    dvv = RET_HEADS * RET_DV
    q, k, v, g = jnp.split(h @ w_in, [dq, 2 * dq, 2 * dq + dvv], axis=-1)
    pos = jnp.arange(s_)
    q = rope(q.reshape(b_, s_, RET_HEADS, RET_DK), pos)
    k = rope(k.reshape(b_, s_, RET_HEADS, RET_DK), pos) * RET_DK ** -0.5
    q, k = q.transpose(0, 2, 1, 3), k.transpose(0, 2, 1, 3)
    v = to_heads(v, RET_HEADS)
    log_gamma = jnp.log1p(-jnp.exp2(-5.0 - jnp.arange(RET_HEADS, dtype=jnp.float32)))
    log_a = jnp.broadcast_to(log_gamma[None, :, None, None], (1, RET_HEADS, s_, 1))
    o = head_norm(chunk_linear_attention(q, k, v, log_a), gn_g, center=True)
    return (from_heads(o) * jax.nn.silu(g)) @ w_out


def chunked_attention_mixer(h, w_in, rel_bias, w_out):
    b_, s_, d_ = h.shape
    nc = s_ // CHUNK
    q, k, v = jnp.split(h @ w_in, 3, axis=-1)
    q = q.reshape(b_, s_, ATT_HEADS, ATT_DH) * ATT_DH ** -0.5
    pad = ((0, 0), (ATT_LEFT, 0), (0, 0), (0, 0))
    k = jnp.pad(k.reshape(b_, s_, ATT_HEADS, ATT_DH), pad)
    v = jnp.pad(v.reshape(b_, s_, ATT_HEADS, ATT_DH), pad)
    qi = jnp.arange(CHUNK)[:, None]
    kj = jnp.arange(ATT_BAND)[None, :]
    dist = qi - kj + ATT_LEFT
    idx = jnp.clip(dist, -(CHUNK - 1), ATT_MAX_REL) + (CHUNK - 1)
    bias = rel_bias[:, idx].astype(jnp.float32)
    qc = jnp.moveaxis(q.reshape(b_, nc, CHUNK, ATT_HEADS, ATT_DH), 1, 0)

    def one_chunk(args):
        ci, q_c = args
        start = ci * CHUNK
        k_b = lax.dynamic_slice_in_dim(k, start, ATT_BAND, axis=1)
        v_b = lax.dynamic_slice_in_dim(v, start, ATT_BAND, axis=1)
        s = jnp.einsum('blhd,bmhd->bhlm', q_c, k_b).astype(jnp.float32) + bias
        valid = kj >= ATT_LEFT - start
        p = jax.nn.softmax(jnp.where(valid, s, -jnp.inf), axis=-1).astype(v.dtype)
        return jnp.einsum('bhlm,bmhd->blhd', p, v_b)

    o = lax.map(one_chunk, (jnp.arange(nc), qc))
    o = jnp.moveaxis(o, 0, 1).reshape(b_, s_, d_)
    return o @ w_out


def gla_mixer(h, w_in, w_gate, b_gate, gn_g, w_out):
    dq = GLA_HEADS * GLA_DK
    dvv = GLA_HEADS * GLA_DV
    q, k, v, g_low, r = jnp.split(h @ w_in, [dq, 2 * dq, 2 * dq + dvv, 2 * dq + dvv + GLA_GATE_RANK], axis=-1)
    log_a = jax.nn.log_sigmoid((g_low @ w_gate + b_gate).astype(jnp.float32)) / GLA_GATE_NORM
    q = to_heads(q, GLA_HEADS) * GLA_DK ** -0.5
    o = chunk_linear_attention(q, to_heads(k, GLA_HEADS), to_heads(v, GLA_HEADS), to_heads(log_a, GLA_HEADS))
    o = head_norm(o, gn_g, center=False)
    return (from_heads(o) * jax.nn.silu(r)) @ w_out


def causal_depthwise_conv(x, w, b):
    ch = x.shape[-1]
    y = lax.conv_general_dilated(x, w[:, None, :].astype(x.dtype), window_strides=(1,),
                                 padding=[(MLSTM_CONV - 1, 0)],
                                 dimension_numbers=('NWC', 'WIO', 'NWC'),
                                 feature_group_count=ch)
    return y + b


def mlstm_chunkwise(q, k, v, ig, log_f):
    b_, h_, s_, dh = q.shape
    nc = s_ // CHUNK
    f32 = jnp.float32

    def chunks(t):
        return jnp.moveaxis(t.astype(f32).reshape((b_, h_, nc, CHUNK) + t.shape[3:]), 2, 0)

    causal = jnp.tril(jnp.ones((CHUNK, CHUNK), dtype=bool))

    def step(carry, xs):
        cmat, nvec, m = carry
        q_c, k_c, v_c, i_c, f_c = xs
        b = jnp.cumsum(f_c, axis=-1)
        log_intra = jnp.where(causal, b[..., :, None] - b[..., None, :] + i_c[..., None, :], -jnp.inf)
        log_inter = b + m[..., None]
        m_row = jnp.maximum(log_inter, jnp.max(log_intra, axis=-1))
        w_intra = jnp.exp(log_intra - m_row[..., None])
        w_inter = jnp.exp(log_inter - m_row)
        s = jnp.einsum('bhld,bhmd->bhlm', q_c, k_c) * w_intra
        num = w_inter[..., None] * jnp.einsum('bhld,bhde->bhle', q_c, cmat) + jnp.einsum('bhlm,bhme->bhle', s, v_c)
        den = w_inter * jnp.einsum('bhld,bhd->bhl', q_c, nvec) + jnp.sum(s, axis=-1)
        h_c = num / jnp.maximum(jnp.abs(den), jnp.exp(-m_row))[..., None]
        b_last = b[..., -1]
        log_keep = b_last + m
        log_w = b_last[..., None] - b + i_c
        m_new = jnp.maximum(log_keep, jnp.max(log_w, axis=-1))
        keep = jnp.exp(log_keep - m_new)
        w = jnp.exp(log_w - m_new[..., None])
        cmat = keep[..., None, None] * cmat + jnp.einsum('bhl,bhld,bhle->bhde', w, k_c, v_c)
        nvec = keep[..., None] * nvec + jnp.einsum('bhl,bhld->bhd', w, k_c)
        return (cmat, nvec, m_new), h_c

    init = (jnp.zeros((b_, h_, dh, dh), f32), jnp.zeros((b_, h_, dh), f32), jnp.zeros((b_, h_), f32))
    _, hs = lax.scan(step, init, (chunks(q), chunks(k), chunks(v), chunks(ig), chunks(log_f)))
    return jnp.moveaxis(hs, 0, 2).reshape(b_, h_, s_, dh)


def mlstm_mixer(h, w_in, conv_w, conv_b, w_q, w_k, w_v, w_gates, b_gates, gn_g, skip, w_out):
    b_, s_, _ = h.shape
    xm, z = jnp.split(h @ w_in, 2, axis=-1)
    xc = jax.nn.silu(causal_depthwise_conv(xm, conv_w, conv_b))

    def blockdiag(t, w):
        t = t.reshape(b_, s_, MLSTM_N_BLOCKS, MLSTM_QKV_BLOCK)
        return jnp.einsum('bsnc,ncd->bsnd', t, w).reshape(b_, s_, MLSTM_INNER)

    q = blockdiag(xc, w_q)
    k = blockdiag(xc, w_k) * MLSTM_DH ** -0.5
    v = blockdiag(xm, w_v)
    gates = (jnp.concatenate([q, k, v], axis=-1) @ w_gates + b_gates).astype(jnp.float32)
    ig, fg = jnp.split(gates.transpose(0, 2, 1), 2, axis=1)
    hh = mlstm_chunkwise(to_heads(q, MLSTM_HEADS), to_heads(k, MLSTM_HEADS), to_heads(v, MLSTM_HEADS),
                         ig, jax.nn.log_sigmoid(fg))
    hh = head_norm(hh.astype(h.dtype), gn_g, center=True)
    out = (from_heads(hh) + skip * xc) * jax.nn.silu(z)
    return out @ w_out


def moe_ffn(h, router_w, router_b, w1, b1, w2, b2):
    b_, s_, d_ = h.shape
    t = h.reshape(b_ * s_, d_)
    logits = (t @ router_w + router_b).astype(jnp.float32)
    top_v, top_i = lax.top_k(logits, TOP_K)
    top_w = jax.nn.softmax(top_v, axis=-1)
    combine = jnp.sum(jax.nn.one_hot(top_i, N_EXPERTS, dtype=jnp.float32) * top_w[..., None], axis=1)
    out = jnp.zeros((b_ * s_, d_), jnp.float32)
    for e in range(N_EXPERTS):
        hid = t @ w1[e] + b1[e]
        gate = jnp.minimum(hid[:, :D_EXPERT], SWIGLU_LIMIT)
        lin = jnp.clip(hid[:, D_EXPERT:], -SWIGLU_LIMIT, SWIGLU_LIMIT)
        act = gate * jax.nn.sigmoid(SWIGLU_ALPHA * gate) * (lin + 1.0)
        out = out + combine[:, e:e + 1] * (act @ w2[e] + b2[e])
    return out.reshape(b_, s_, d_).astype(h.dtype)


def setup_inputs(seed: int = 0) -> dict:
    key = jax.random.key(seed)
    keys = jax.random.split(key, 64)
    counter = iter(range(64))

    def nxt():
        return keys[next(counter)]

    def dense(shape, fan_in, scale=1.0):
        return jax.random.normal(nxt(), shape, jnp.float32) * (scale * fan_in ** -0.5)

    def gain(shape):
        return 1.0 + 0.02 * jax.random.normal(nxt(), shape, jnp.float32)

    def small(shape, s=0.02):
        return s * jax.random.normal(nxt(), shape, jnp.float32)

    D = D_MODEL
    nA, nB, nC, nD = (_layers_of(m) for m in range(N_MIXERS))
    ret_cols = 2 * RET_HEADS * RET_DK + 2 * RET_HEADS * RET_DV
    gla_cols = 2 * GLA_HEADS * GLA_DK + 2 * GLA_HEADS * GLA_DV + GLA_GATE_RANK
    f_bias = jnp.linspace(3.0, 6.0, MLSTM_HEADS, dtype=jnp.float32)
    mlstm_b_gates = jnp.concatenate([small((nD, MLSTM_HEADS), 0.1),
                                     f_bias + small((nD, MLSTM_HEADS), 0.1)], axis=-1)
    return {
        'x': jax.random.normal(nxt(), (BATCH, SEQ, D), jnp.float32),
        'c': jax.random.normal(nxt(), (BATCH, D), jnp.float32),
        'ada_w': dense((DEPTH, D, 6 * D), D, 0.5),
        'ada_b': small((DEPTH, 6 * D)),
        'norm_mix_g': gain((DEPTH, D)),
        'norm_ffn_g': gain((DEPTH, D)),
        'norm_final_g': gain((D,)),
        'ret_w_in': dense((nA, D, ret_cols), D),
        'ret_gn_g': gain((nA, RET_HEADS, RET_DV)),
        'ret_w_out': dense((nA, RET_HEADS * RET_DV, D), RET_HEADS * RET_DV),
        'att_w_in': dense((nB, D, 3 * D), D),
        'att_rel_bias': small((nB, ATT_HEADS, ATT_N_REL), 0.5),
        'att_w_out': dense((nB, D, D), D),
        'gla_w_in': dense((nC, D, gla_cols), D),
        'gla_w_gate': dense((nC, GLA_GATE_RANK, GLA_HEADS * GLA_DK), GLA_GATE_RANK),
        'gla_b_gate': small((nC, GLA_HEADS * GLA_DK), 0.1),
        'gla_gn_g': gain((nC, GLA_HEADS, GLA_DV)),
        'gla_w_out': dense((nC, GLA_HEADS * GLA_DV, D), GLA_HEADS * GLA_DV),
        'mlstm_w_in': dense((nD, D, 2 * MLSTM_INNER), D),
        'mlstm_conv_w': dense((nD, MLSTM_CONV, MLSTM_INNER), MLSTM_CONV),
        'mlstm_conv_b': small((nD, MLSTM_INNER)),
        'mlstm_w_q': dense((nD, MLSTM_N_BLOCKS, MLSTM_QKV_BLOCK, MLSTM_QKV_BLOCK), MLSTM_QKV_BLOCK),
        'mlstm_w_k': dense((nD, MLSTM_N_BLOCKS, MLSTM_QKV_BLOCK, MLSTM_QKV_BLOCK), MLSTM_QKV_BLOCK),
        'mlstm_w_v': dense((nD, MLSTM_N_BLOCKS, MLSTM_QKV_BLOCK, MLSTM_QKV_BLOCK), MLSTM_QKV_BLOCK),
        'mlstm_w_gates': dense((nD, 3 * MLSTM_INNER, 2 * MLSTM_HEADS), 3 * MLSTM_INNER, 0.5),
        'mlstm_b_gates': mlstm_b_gates,
        'mlstm_gn_g': gain((nD, MLSTM_HEADS, MLSTM_DH)),
        'mlstm_skip': gain((nD, MLSTM_INNER)),
        'mlstm_w_out': dense((nD, MLSTM_INNER, D), MLSTM_INNER),
        'router_w': dense((DEPTH, D, N_EXPERTS), D),
        'router_b': small((DEPTH, N_EXPERTS), 0.01),
        'moe_w1': dense((DEPTH, N_EXPERTS, D, 2 * D_EXPERT), D),
        'moe_b1': small((DEPTH, N_EXPERTS, 2 * D_EXPERT)),
        'moe_w2': dense((DEPTH, N_EXPERTS, D_EXPERT, D), D_EXPERT),
        'moe_b2': small((DEPTH, N_EXPERTS, D)),
    }


def reference(x, c, ada_w, ada_b, norm_mix_g, norm_ffn_g, norm_final_g,
              ret_w_in, ret_gn_g, ret_w_out,
              att_w_in, att_rel_bias, att_w_out,
              gla_w_in, gla_w_gate, gla_b_gate, gla_gn_g, gla_w_out,
              mlstm_w_in, mlstm_conv_w, mlstm_conv_b, mlstm_w_q, mlstm_w_k, mlstm_w_v,
              mlstm_w_gates, mlstm_b_gates, mlstm_gn_g, mlstm_skip, mlstm_w_out,
              router_w, router_b, moe_w1, moe_b1, moe_w2, moe_b2):
    cond = jax.nn.silu(c)
    for i in range(DEPTH):
        kind, j = i % N_MIXERS, i // N_MIXERS
        mod = (cond @ ada_w[i] + ada_b[i])[:, None, :]
        sh_a, sc_a, g_a, sh_f, sc_f, g_f = jnp.split(mod, 6, axis=-1)
        h = rms_norm(x, norm_mix_g[i]) * (1.0 + sc_a) + sh_a
        if kind == 0:
            y = retention_mixer(h, ret_w_in[j], ret_gn_g[j], ret_w_out[j])
        elif kind == 1:
            y = chunked_attention_mixer(h, att_w_in[j], att_rel_bias[j], att_w_out[j])
        elif kind == 2:
            y = gla_mixer(h, gla_w_in[j], gla_w_gate[j], gla_b_gate[j], gla_gn_g[j], gla_w_out[j])
        else:
            y = mlstm_mixer(h, mlstm_w_in[j], mlstm_conv_w[j], mlstm_conv_b[j], mlstm_w_q[j], mlstm_w_k[j],
                            mlstm_w_v[j], mlstm_w_gates[j], mlstm_b_gates[j], mlstm_gn_g[j], mlstm_skip[j],
                            mlstm_w_out[j])
        x = x + g_a * y
        h = rms_norm(x, norm_ffn_g[i]) * (1.0 + sc_f) + sh_f
        x = x + g_f * moe_ffn(h, router_w[i], router_b[i], moe_w1[i], moe_b1[i], moe_w2[i], moe_b2[i])
    return rms_norm(x, norm_final_g)
```

```cpp
#include <hip/hip_runtime.h>
#include <stdint.h>
#include <stdio.h>

#define GAS __attribute__((address_space(1)))
#define LAS __attribute__((address_space(3)))
typedef unsigned short bf16_t;
typedef short bf16x8 __attribute__((ext_vector_type(8)));
typedef float f32x4 __attribute__((ext_vector_type(4)));
typedef float f32x2 __attribute__((ext_vector_type(2)));
typedef unsigned u32x4 __attribute__((ext_vector_type(4)));
typedef unsigned u32x2 __attribute__((ext_vector_type(2)));
typedef short s16x4 __attribute__((ext_vector_type(4)));
typedef int i32x8 __attribute__((ext_vector_type(8)));
typedef int i32x4 __attribute__((ext_vector_type(4)));

constexpr int NB = 8, SEQ = 4096, DM = 1024, T = NB * SEQ;
constexpr int NCHUNK = SEQ / 64;
constexpr int NEXP = 32, TOPK = 4;
constexpr int NWAVES = 8, NTHR = NWAVES * 64;
constexpr float EPS = 1e-6f;

constexpr size_t MiB = 1u << 20;
constexpr size_t WS_CTL = 0, CTL_ZERO_BYTES = 1 * MiB;
constexpr size_t WS_MOD = 1 * MiB;
constexpr size_t WS_ROPE = 2 * MiB;
constexpr size_t WS_WRT = 6 * MiB;
constexpr size_t WS_WGL = 7 * MiB;
constexpr size_t WS_WMG = 7 * MiB + 131072;
constexpr size_t WS_W_RET_IN = 8 * MiB, WS_W_RET_OUT = 20 * MiB, WS_W_ATT_IN = 24 * MiB, WS_W_ATT_OUT = 30 * MiB;
constexpr size_t WS_W_GLA_IN = 32 * MiB, WS_W_GLA_OUT = 38 * MiB, WS_W_MLS_IN = 40 * MiB, WS_W_MLS_OUT = 48 * MiB;
constexpr size_t WS_W1T = 64 * MiB;
constexpr size_t WS_W2T = 576 * MiB;
constexpr size_t WS_XRES = 832 * MiB;
constexpr size_t WS_H = 960 * MiB;
constexpr size_t WS_PROJ = 1024 * MiB;
constexpr size_t WS_MIX = 1408 * MiB;
constexpr size_t WS_AMIX = 1536 * MiB;
constexpr size_t WS_PT = 1664 * MiB;
constexpr size_t WS_KT = 1680 * MiB;
constexpr size_t WS_VT = 1808 * MiB;
constexpr size_t WS_QS = 1936 * MiB;
constexpr size_t WS_REC = 1968 * MiB;
constexpr size_t WS_MQ = WS_PROJ + 256 * MiB;
constexpr size_t WS_MK = 1984 * MiB, WS_MV = 2112 * MiB, WS_MXC = 2240 * MiB;
constexpr size_t WS_ACT = 2368 * MiB;
constexpr size_t WS_YP = 2640 * MiB;
constexpr size_t WS_TOKES = 2912 * MiB;
constexpr size_t WS_TOKW = 2913 * MiB;
constexpr size_t WS_LIST = 2914 * MiB;
constexpr size_t WS_GLOW = 2918 * MiB;
constexpr size_t WS_GATES = 2920 * MiB;
constexpr size_t WS_H8 = 2928 * MiB;
constexpr size_t WS_END = 2960 * MiB;
constexpr int CW_BAR = 4096;
constexpr int CW_CNT = 16384;

constexpr int LDS_BYTES = 163840;
constexpr int LDS_MISC = 163840 - 1536;
constexpr int LDS_IDX = 131072;

#define LDS_WAIT() asm volatile("s_waitcnt lgkmcnt(0)" ::: "memory")
#define VM_WAIT() asm volatile("s_waitcnt vmcnt(0)" ::: "memory")
#define WG_SYNC_LDS() do { asm volatile("s_waitcnt lgkmcnt(0)" ::: "memory"); __builtin_amdgcn_s_barrier(); asm volatile("" ::: "memory"); } while (0)
typedef __bf16 bf16n2 __attribute__((ext_vector_type(2)));
__device__ __forceinline__ unsigned pk2(float lo, float hi) { const f32x2 v = {lo, hi}; return __builtin_bit_cast(unsigned, __builtin_convertvector(v, bf16n2)); }
__device__ __forceinline__ unsigned f2bf(float f) { return pk2(f, 0.f) & 0xffffu; }
__device__ __forceinline__ float bf2f(unsigned short b) { return __builtin_bit_cast(float, ((unsigned)b) << 16); }
__device__ __forceinline__ float bflo(unsigned u) { return __builtin_bit_cast(float, u << 16); }
__device__ __forceinline__ float bfhi(unsigned u) { return __builtin_bit_cast(float, u & 0xffff0000u); }
__device__ __forceinline__ unsigned cvt_pk_bf16(float lo, float hi) { return pk2(lo, hi); }
__device__ __forceinline__ unsigned pk4_fp8(float a, float b, float c, float d) { int r = 0; r = __builtin_amdgcn_cvt_pk_fp8_f32(a, b, r, false); r = __builtin_amdgcn_cvt_pk_fp8_f32(c, d, r, true); return (unsigned)r; }
__device__ __forceinline__ float wave_sum(float v) {
#pragma unroll
    for (int o = 1; o < 64; o <<= 1) v += __shfl_xor(v, o);
    return v;
}
__device__ __forceinline__ float wave_max(float v) {
#pragma unroll
    for (int o = 1; o < 64; o <<= 1) v = fmaxf(v, __shfl_xor(v, o));
    return v;
}
__device__ __forceinline__ float sigmoidf_(float x) { return __builtin_amdgcn_rcpf(1.0f + __builtin_amdgcn_exp2f(-1.4426950408889634f * x)); }
__device__ __forceinline__ float siluf_(float x) { return x * __builtin_amdgcn_rcpf(1.0f + __builtin_amdgcn_exp2f(-1.4426950408889634f * x)); }
__device__ __forceinline__ float logsigmoidf_(float x) { return fminf(x, 0.f) - log1pf(__expf(-fabsf(x))); }

#define XB_TMO      128
#define XB_XCNT(j)  (256  + 64 * (j))
#define XB_XSUB(j)  (1280 + 64 * (j))
#define XB_XGEN(j)  (2304 + 64 * (j))
#define XB_TOP      3328
#define XB_TOPGEN   3392
#define XCD_BAR_WORDS 3456
#define XB_SPIN_CAP (1u << 20)

__device__ __forceinline__ unsigned xb_ld(unsigned* p)              { return __hip_atomic_load(p, __ATOMIC_RELAXED, __HIP_MEMORY_SCOPE_AGENT); }
__device__ __forceinline__ unsigned xb_add(unsigned* p, unsigned v) { return __hip_atomic_fetch_add(p, v, __ATOMIC_RELAXED, __HIP_MEMORY_SCOPE_AGENT); }
__device__ __forceinline__ unsigned xb_xcc_id() { return (unsigned)__builtin_amdgcn_s_getreg((3 << 11) | 20) & 0xFu; }
#define XB_SPIN(cond, bar) do { unsigned _sp = 0; while (cond) { __builtin_amdgcn_s_sleep(1); \
    if ((++_sp & 255u) == 0u) { if (xb_ld(&(bar)[XB_TMO])) break; if (_sp > XB_SPIN_CAP) { atomicAdd(&(bar)[XB_TMO], 1u); break; } } } } while (0)

struct XcdBarrier { unsigned* bar; unsigned x; volatile LAS unsigned* st; };

__device__ __forceinline__ XcdBarrier xcd_barrier_post(unsigned* bar, volatile LAS unsigned* st) {
    XcdBarrier b; b.bar = bar; b.x = xb_xcc_id(); b.st = st;
    if (threadIdx.x == 0) (void)xb_add(&bar[XB_XCNT(b.x)], 1u);
    return b;
}
__device__ __forceinline__ void xcd_barrier_complete(unsigned* bar, unsigned x, unsigned& nloc, unsigned& nx) {
    const unsigned G = gridDim.x * gridDim.y * gridDim.z;
    unsigned sum, cnt, mine, sp = 0u;
    for (;;) {
        sum = 0u; cnt = 0u; mine = 0u;
#pragma unroll
        for (unsigned j = 0; j < 16; ++j) { const unsigned c = xb_ld(&bar[XB_XCNT(j)]); sum += c; cnt += (c > 0u) ? 1u : 0u; mine = (j == x) ? c : mine; }
        if (sum == G) break;
        __builtin_amdgcn_s_sleep(1);
        if ((++sp & 255u) == 0u) { if (xb_ld(&bar[XB_TMO])) break; if (sp > XB_SPIN_CAP) { atomicAdd(&bar[XB_TMO], 1u); break; } }
    }
    nloc = mine > 0u ? mine : 1u; nx = cnt > 0u ? cnt : 1u;
}
__device__ __forceinline__ void xcd_barrier(const XcdBarrier& b) {
    asm volatile("s_waitcnt vmcnt(0)" ::: "memory");
    __syncthreads();
    if (threadIdx.x == 0) {
        unsigned* bar = b.bar;
        __builtin_amdgcn_s_waitcnt(0);
        unsigned nloc = b.st[0], nx = b.st[1];
        if (nloc == 0u) { xcd_barrier_complete(bar, b.x, nloc, nx); b.st[0] = nloc; b.st[1] = nx; }
        const unsigned old = xb_add(&bar[XB_XSUB(b.x)], 1u);
        const unsigned gen = old / nloc;
        if (old + 1u == (gen + 1u) * nloc) {
            __builtin_amdgcn_fence(__ATOMIC_RELEASE, "agent");
            asm volatile("s_waitcnt vmcnt(0)" ::: "memory");
            const unsigned og = xb_add(&bar[XB_TOP], 1u);
            const unsigned tg = og / nx;
            if (og + 1u == (tg + 1u) * nx) xb_add(&bar[XB_TOPGEN], 1u);
            else XB_SPIN(xb_ld(&bar[XB_TOPGEN]) == tg, bar);
            __builtin_amdgcn_fence(__ATOMIC_ACQUIRE, "agent");
            xb_add(&bar[XB_XGEN(b.x)], 1u);
            asm volatile("s_waitcnt vmcnt(0)" ::: "memory");
        } else {
            XB_SPIN(xb_ld(&bar[XB_XGEN(b.x)]) == gen, bar);
            __builtin_amdgcn_fence(__ATOMIC_ACQUIRE, "agent");
            asm volatile("s_waitcnt vmcnt(0)" ::: "memory");
        }
    }
    __syncthreads();
}
#define N_LAUNCH_MODE 0
#define ENABLE_RET 1
#define ENABLE_ATT 1
#define ENABLE_GLA 1
#define ENABLE_MLS 1
#define ENABLE_MOE 1
#define MOE_FP8 1
#define S2_ABL 0
#define OUT_FP8 1
#define YP_FP8 1
#define MOE_NULL 0
#define MOE_WHICH 3
#define MOE_HOT 0
#define WNT 1
#define CVT_HOST 2
#define S2X 1
#define S2M 1
#define GFP8_RET 0
#define GFP8_GLA 0
#define GFP8_MLS 0
#define MOE_PRO_LAYERS 1
#define MLS_S2MODE 2
#define IFP8_RET 0
#define IFP8_GLA 0
#define IFP8_MLS 0
#define IFP8_ATT 1
#define REP_PRO 1
#define REP_MOE 1
#define REP_INPROJ 1
#define REP_S1 1
#define REP_S2 1
#define REP_S2M 1
#define REP_S2R 1
#define REP_PRE 1
#define REP_HN 1
#define REP_ATT 1
#define REP_NORM 1
#define REP_OUT 1
#define REP_BAR 1
struct CvtJob { const float* wp; unsigned char* op; int ld; int lane; };
namespace pg8 {
constexpr int BM = 256, BK = 64, HALF = 128, HTB = HALF * BK * 2, STAGE_BYTES = 8 * HTB, NXCD = 8, WGM = 8;
__host__ __device__ __forceinline__ int lds_byte(int r, int c) { const int st = (r >> 4) * 2 + (c >> 5), rr = r & 15, cc = c & 31, ob = rr * 64 + cc * 2; return st * 1024 + (ob ^ (((ob >> 9) & 1) << 5)); }
__host__ __device__ __forceinline__ void stage_rc(int b, int& R, int& C) { const int st = b / 1024, sb = b % 1024, swz = sb ^ (((sb >> 9) & 1) << 5); R = (st >> 1) * 16 + swz / 64; C = (st & 1) * 32 + (swz % 64) / 2; }
__host__ __device__ __forceinline__ int perm32(int rho) { const int n = rho >> 4, i = rho & 15; return 8 * (i >> 2) + 4 * n + (i & 3); }

struct Unit { int pm, pn; };
struct Gemm { const bf16_t* A; const bf16_t* Bt; int M, N, K; };

struct StaticOrder {
    int nM, nN, nwg, G, c;
    __device__ void init(int M, int N, int G_, int c_) { nM = M / BM; nN = N / BM; nwg = nM * nN; G = G_; c = c_; }
    __device__ bool next(int i, Unit& u) const {
        const long L = (long)i * G + c; if (L >= nwg) return false;
        int wgid = (int)L; { const int q = nwg / NXCD, r = nwg % NXCD, xcd = wgid % NXCD, off = wgid / NXCD; wgid = (xcd < r ? xcd * (q + 1) : r * (q + 1) + (xcd - r) * q) + off; }
        const int nig = WGM * nN, gid = wgid / nig, fm = gid * WGM, gsz = (nM - fm) < WGM ? (nM - fm) : WGM;
        u.pm = fm + ((wgid % nig) % gsz); u.pn = (wgid % nig) / gsz; return true;
    }
    __device__ __forceinline__ unsigned rowtok(int, int) const { return 0u; }
};
struct MoeOrder {
    const LAS int* utab;
    const LAS unsigned short* idx;
    int nmy;
    __device__ __forceinline__ bool next(int i, Unit& u) const { if (i >= nmy) return false; u.pm = utab[2 * i]; u.pn = utab[2 * i + 1]; return true; }
    __device__ __forceinline__ unsigned rowtok(int i, int r) const { return (unsigned)idx[i * 256 + r]; }
};

struct NoBg { static constexpr bool ON = false; };
template <class Epi, class Sched, bool GATHER, bool FP8, class Bg>
__device__ __forceinline__ void gemm_phase_bg(LAS unsigned char* lds, const Gemm g, const Sched& S, const Epi& E, Bg& bg) {
    const int tid = threadIdx.x, wid = __builtin_amdgcn_readfirstlane(tid >> 6), lane = tid & 63, wr = wid >> 2, wc = wid & 3, fr = lane & 15, fq = lane >> 4;
    const int K = g.K, nt = K / BK;
    unsigned voffA[2], voffB[2]; int rowA[2];
#pragma unroll
    for (int i = 0; i < 2; ++i) { int R, C; stage_rc(tid * 16 + i * 8192, R, C); const int Rb = Epi::PERM ? ((R & ~31) + perm32(R & 31)) : R;
        rowA[i] = R; voffA[i] = GATHER ? (unsigned)(C * 2) : (unsigned)(R * K + C) * 2u; voffB[i] = (unsigned)(Rb * K + C) * 2u; }
    const size_t kstep = (size_t)(BK * 2);
    const size_t hstep = (size_t)HALF * K * 2;
    const size_t tstep = 2 * hstep;
    const unsigned ldsw = (unsigned)wid * 1024u;
    const int aoff = FP8 ? lds_byte(wr * 64 + fr, fq * 16) : lds_byte(wr * 64 + fr, fq * 8), boff = FP8 ? lds_byte(wc * 32 + fr, fq * 16) : lds_byte(wc * 32 + fr, fq * 8);
    const int fo1 = (fq & 1) ? 16 : 0, fo2 = 16 - fo1;
    const int aoff1 = aoff + fo1, aoff2 = aoff + fo2, boff1 = boff + fo1, boff2 = boff + fo2;
    const unsigned rowbytes = (unsigned)K * 2u;
#define PG8_SA(b, h) (((b) * 2 + (h)) * HTB)
#define PG8_SB(b, h) ((4 + (b) * 2 + (h)) * HTB)
#define PG8_STAGE(bufoff, gbase, voff) do { _Pragma("unroll") for (int _i = 0; _i < 2; ++_i) \
        __builtin_amdgcn_global_load_lds((const unsigned*)((const char*)(gbase) + (voff)[_i]), (LAS unsigned*)(lds + (bufoff) + ldsw + _i * 8192), 16, 0, 0); } while (0)
#define PG8_STAGE_A(bufoff, tptr, half, vg) do { if constexpr (GATHER) { PG8_STAGE(bufoff, tptr, (vg)[half]); } else { PG8_STAGE(bufoff, (tptr) + (half) * hstep, voffA); } } while (0)
#define PG8_LDA8(dst, b, h) do { _Pragma("unroll") for (int m = 0; m < 4; ++m) { const i32x4 lo_ = *(const LAS i32x4*)(lds + PG8_SA(b, h) + aoff1 + m * 2048), hi_ = *(const LAS i32x4*)(lds + PG8_SA(b, h) + aoff2 + m * 2048); \
        dst[m] = (i32x8){lo_.x, lo_.y, lo_.z, lo_.w, hi_.x, hi_.y, hi_.z, hi_.w}; } } while (0)
#define PG8_LDB8(dst, b, h) do { _Pragma("unroll") for (int n = 0; n < 2; ++n) { const i32x4 lo_ = *(const LAS i32x4*)(lds + PG8_SB(b, h) + boff1 + n * 2048), hi_ = *(const LAS i32x4*)(lds + PG8_SB(b, h) + boff2 + n * 2048); \
        dst[n] = (i32x8){lo_.x, lo_.y, lo_.z, lo_.w, hi_.x, hi_.y, hi_.z, hi_.w}; } } while (0)
#define PG8_MMA8(ai, bj, At, Bt) do { __builtin_amdgcn_s_setprio(1); _Pragma("unroll") for (int m = 0; m < 4; ++m) _Pragma("unroll") for (int n = 0; n < 2; ++n) \
        asm volatile("v_mfma_scale_f32_16x16x128_f8f6f4 %0, %1, %2, %0, %3, %3 op_sel_hi:[0,0,0]" : "+v"(acc[ai][bj][m][n]) : "v"(Bt[n]), "v"(At[m]), "v"(sc7f)); __builtin_amdgcn_s_setprio(0); } while (0)
#define PG8_LDA(dst, b, h) do { _Pragma("unroll") for (int m = 0; m < 4; ++m) _Pragma("unroll") for (int k = 0; k < 2; ++k) dst[m][k] = *(const LAS bf16x8*)(lds + PG8_SA(b, h) + aoff + m * 2048 + k * 1024); } while (0)
#define PG8_LDB(dst, b, h) do { _Pragma("unroll") for (int n = 0; n < 2; ++n) _Pragma("unroll") for (int k = 0; k < 2; ++k) dst[n][k] = *(const LAS bf16x8*)(lds + PG8_SB(b, h) + boff + n * 2048 + k * 1024); } while (0)
#define PG8_MMA(ai, bj, At, Bt) do { __builtin_amdgcn_s_setprio(1); _Pragma("unroll") for (int m = 0; m < 4; ++m) _Pragma("unroll") for (int n = 0; n < 2; ++n) _Pragma("unroll") for (int k = 0; k < 2; ++k) \
        acc[ai][bj][m][n] = __builtin_amdgcn_mfma_f32_16x16x32_bf16(Bt[n][k], At[m][k], acc[ai][bj][m][n], 0, 0, 0); __builtin_amdgcn_s_setprio(0); } while (0)
#define PG8_WAIT_V(n) asm volatile("s_waitcnt vmcnt(" #n ")" ::: "memory")
#define PG8_WAIT_L(n) asm volatile("s_waitcnt lgkmcnt(" #n ")" ::: "memory")
#define PG8_BAR __builtin_amdgcn_s_barrier()
#define PG8_SCHED __builtin_amdgcn_sched_barrier(0)
#define XLDA(b, h) do { if constexpr (FP8) { PG8_LDA8(At8, b, h); } else { PG8_LDA(At, b, h); } } while (0)
#define XLDB(w_, b, h) do { if constexpr (FP8) { if (w_) { PG8_LDB8(B18, b, h); } else { PG8_LDB8(B08, b, h); } } else { if (w_) { PG8_LDB(B1, b, h); } else { PG8_LDB(B0, b, h); } } } while (0)
#define XMMA(ai, bj, w_) do { if constexpr (FP8) { if (w_) { PG8_MMA8(ai, bj, At8, B18); } else { PG8_MMA8(ai, bj, At8, B08); } } else { if (w_) { PG8_MMA(ai, bj, At, B1); } else { PG8_MMA(ai, bj, At, B0); } } } while (0)
    Unit cur, nxt; int ui = 0;
    if (!S.next(0, cur)) return;
    f32x4 acc[2][2][4][2];
#pragma unroll
    for (int a = 0; a < 2; ++a)
#pragma unroll
        for (int b = 0; b < 2; ++b)
#pragma unroll
            for (int m = 0; m < 4; ++m)
#pragma unroll
                for (int n = 0; n < 2; ++n) acc[a][b][m][n] = (f32x4){0.f, 0.f, 0.f, 0.f};
    bf16x8 At[4][2], B0[2][2], B1[2][2];
    i32x8 At8[4], B08[2], B18[2]; const int sc7f = 0x7f7f7f7f;
    unsigned vgc[2][2], vgn[2][2];
    if constexpr (GATHER) {
#pragma unroll
        for (int h = 0; h < 2; ++h)
#pragma unroll
            for (int i = 0; i < 2; ++i) { vgc[h][i] = S.rowtok(0, h * HALF + rowA[i]) * rowbytes + voffA[i]; vgn[h][i] = vgc[h][i]; }
    }
    const char* cA = GATHER ? (const char*)g.A : (const char*)g.A + (size_t)cur.pm * tstep; const char* cB = (const char*)g.Bt + (size_t)cur.pn * tstep;
    PG8_STAGE(PG8_SB(0, 0), cB, voffB); PG8_STAGE_A(PG8_SA(0, 0), cA, 0, vgc); PG8_STAGE(PG8_SB(0, 1), cB + hstep, voffB); PG8_STAGE_A(PG8_SA(0, 1), cA, 1, vgc);
    if (wr == 1) PG8_BAR;
    PG8_WAIT_V(4); PG8_BAR;
    PG8_STAGE(PG8_SB(1, 0), cB + kstep, voffB); PG8_STAGE_A(PG8_SA(1, 0), cA + kstep, 0, vgc); PG8_STAGE(PG8_SB(1, 1), cB + hstep + kstep, voffB);
    PG8_WAIT_V(6); PG8_BAR;
    for (;;) {
        const bool has_next = S.next(ui + 1, nxt);
        if constexpr (GATHER) {
            if (has_next) {
#pragma unroll
                for (int h = 0; h < 2; ++h)
#pragma unroll
                    for (int i = 0; i < 2; ++i) vgn[h][i] = S.rowtok(ui + 1, h * HALF + rowA[i]) * rowbytes + voffA[i];
            } else {
#pragma unroll
                for (int h = 0; h < 2; ++h)
#pragma unroll
                    for (int i = 0; i < 2; ++i) vgn[h][i] = vgc[h][i];
            }
        }
        const char* nA = GATHER ? cA : (has_next ? (const char*)g.A + (size_t)nxt.pm * tstep : cA); const char* nB = has_next ? (const char*)g.Bt + (size_t)nxt.pn * tstep : cB;
        for (int t = 0; t < nt; t += 2) {
            const bool last = (t == nt - 2);
            const char* a1 = cA + (size_t)(t + 1) * kstep;
            const char* a2 = last ? nA : cA + (size_t)(t + 2) * kstep; const char* b2 = last ? nB : cB + (size_t)(t + 2) * kstep;
            const char* a3 = a2 + kstep; const char* b3 = b2 + kstep;
            unsigned vg2[2][2];
            if constexpr (GATHER) {
#pragma unroll
                for (int h = 0; h < 2; ++h)
#pragma unroll
                    for (int i = 0; i < 2; ++i) vg2[h][i] = last ? vgn[h][i] : vgc[h][i];
            }
            XLDB(0, 0, 0); PG8_SCHED; XLDA(0, 0); PG8_STAGE_A(PG8_SA(1, 1), a1, 1, vgc);
            PG8_WAIT_L(8); PG8_BAR; PG8_WAIT_L(0); XMMA(0, 0, 0); PG8_BAR; PG8_SCHED;
            XLDB(1, 0, 1); PG8_STAGE(PG8_SB(0, 0), b2, voffB);
            PG8_BAR; PG8_WAIT_L(0); XMMA(0, 1, 1); PG8_BAR;
            XLDA(0, 1); PG8_STAGE_A(PG8_SA(0, 0), a2, 0, vg2);
            PG8_BAR; PG8_WAIT_L(0); XMMA(1, 0, 0); PG8_BAR; PG8_SCHED;
            PG8_STAGE(PG8_SB(0, 1), b2 + hstep, voffB);
            PG8_WAIT_V(6); PG8_BAR; XMMA(1, 1, 1); PG8_BAR;
            XLDB(0, 1, 0); PG8_SCHED; XLDA(1, 0); PG8_STAGE_A(PG8_SA(0, 1), a2, 1, vg2);
            PG8_WAIT_L(8); PG8_BAR; PG8_WAIT_L(0); XMMA(0, 0, 0); PG8_BAR; PG8_SCHED;
            XLDB(1, 1, 1); PG8_STAGE(PG8_SB(1, 0), b3, voffB);
            PG8_BAR; PG8_WAIT_L(0); XMMA(0, 1, 1); PG8_BAR;
            XLDA(1, 1); PG8_STAGE_A(PG8_SA(1, 0), a3, 0, vg2);
            PG8_BAR; PG8_WAIT_L(0); XMMA(1, 0, 0); PG8_BAR; PG8_SCHED;
            PG8_STAGE(PG8_SB(1, 1), b3 + hstep, voffB);
            PG8_WAIT_V(6); PG8_BAR; XMMA(1, 1, 1); PG8_BAR;
        }
        if constexpr (FP8) { asm volatile("s_nop 15\n\ts_nop 15" ::: "memory"); }
        if constexpr (Bg::ON) E.run(acc, cur, wr, wc, fr, fq, bg); else E(acc, cur, wr, wc, fr, fq);
        if (!has_next) break;
#pragma unroll
        for (int a = 0; a < 2; ++a)
#pragma unroll
            for (int b = 0; b < 2; ++b)
#pragma unroll
                for (int m = 0; m < 4; ++m)
#pragma unroll
                    for (int n = 0; n < 2; ++n) acc[a][b][m][n] = (f32x4){0.f, 0.f, 0.f, 0.f};
        cur = nxt; cA = nA; cB = nB; ++ui;
        if constexpr (GATHER) {
#pragma unroll
            for (int h = 0; h < 2; ++h)
#pragma unroll
                for (int i = 0; i < 2; ++i) vgc[h][i] = vgn[h][i];
        }
    }
    PG8_WAIT_V(0);
    if (wr == 0) PG8_BAR;
    PG8_BAR;
#undef PG8_SA
#undef PG8_SB
#undef PG8_STAGE
#undef PG8_STAGE_A
#undef PG8_LDA
#undef PG8_LDA8
#undef PG8_LDB8
#undef PG8_MMA8
#undef XLDA
#undef XLDB
#undef XMMA
#undef PG8_LDB
#undef PG8_MMA
#undef PG8_WAIT_V
#undef PG8_WAIT_L
#undef PG8_BAR
#undef PG8_SCHED
}
template <class Epi, class Sched, bool GATHER, bool FP8 = false>
__device__ __forceinline__ void gemm_phase(LAS unsigned char* lds, const Gemm g, const Sched& S, const Epi& E) { NoBg nb; gemm_phase_bg<Epi, Sched, GATHER, FP8, NoBg>(lds, g, S, E, nb); }


template <bool XBF> struct EpiResid {
    static constexpr bool PERM = true;
    const void* xin; bf16_t* xout; const float* gate; float gs;
    __device__ __forceinline__ void operator()(const f32x4 (&acc)[2][2][4][2], const Unit& u, int wr, int wc, int fr, int fq) const {
        const int row0 = u.pm * BM + wr * 64 + fr, col0 = u.pn * BM + wc * 32 + 8 * fq;
        const int b = (u.pm * BM) >> 12;
        f32x4 gv[2][2];
#pragma unroll
        for (int bj = 0; bj < 2; ++bj)
#pragma unroll
            for (int n = 0; n < 2; ++n) gv[bj][n] = *(const f32x4*)(gate + (size_t)b * 6144 + col0 + bj * HALF + 4 * n) * gs;
#pragma unroll
        for (int ai = 0; ai < 2; ++ai)
#pragma unroll
            for (int m = 0; m < 4; ++m) { const size_t ro = (size_t)(row0 + ai * HALF + m * 16) * DM + col0;
#pragma unroll
                for (int bj = 0; bj < 2; ++bj) { f32x4 x0, x1;
                    if (XBF) { const u32x4 p = *(const u32x4*)((const bf16_t*)xin + ro + bj * HALF); x0 = (f32x4){bflo(p.x), bfhi(p.x), bflo(p.y), bfhi(p.y)}; x1 = (f32x4){bflo(p.z), bfhi(p.z), bflo(p.w), bfhi(p.w)}; }
                    else { x0 = *(const f32x4*)((const float*)xin + ro + bj * HALF); x1 = *(const f32x4*)((const float*)xin + ro + bj * HALF + 4); }
                    const f32x4 o0 = x0 + gv[bj][0] * acc[ai][bj][m][0], o1 = x1 + gv[bj][1] * acc[ai][bj][m][1];
                    u32x4 q; q.x = pk2(o0[0], o0[1]); q.y = pk2(o0[2], o0[3]); q.z = pk2(o1[0], o1[1]); q.w = pk2(o1[2], o1[3]);
                    *(u32x4*)(xout + ro + bj * HALF) = q; } }
    }
};
struct EpiBf16S {
    static constexpr bool PERM = true;
    bf16_t* O; int ldc; int nscaled; float scale; float gs;
    __device__ __forceinline__ void operator()(const f32x4 (&acc)[2][2][4][2], const Unit& u, int wr, int wc, int fr, int fq) const {
        const int row0 = u.pm * BM + wr * 64 + fr; const int col0 = u.pn * BM + wc * 32 + 8 * fq;
        const float sc = ((u.pn < nscaled) ? scale : 1.0f) * gs;
#pragma unroll
        for (int ai = 0; ai < 2; ++ai)
#pragma unroll
            for (int m = 0; m < 4; ++m) { bf16_t* rowp = O + (size_t)(row0 + ai * HALF + m * 16) * ldc + col0;
#pragma unroll
                for (int bj = 0; bj < 2; ++bj) { const f32x4 v0 = acc[ai][bj][m][0] * sc, v1 = acc[ai][bj][m][1] * sc;
                    u32x4 w; w.x = cvt_pk_bf16(v0[0], v0[1]); w.y = cvt_pk_bf16(v0[2], v0[3]); w.z = cvt_pk_bf16(v1[0], v1[1]); w.w = cvt_pk_bf16(v1[2], v1[3]);
                    *(u32x4*)(rowp + bj * HALF) = w; } }
    }
};
struct EpiRet {
    static constexpr bool PERM = true;
    bf16_t* O; const f32x2* rope; float gs;
    __device__ __forceinline__ void operator()(const f32x4 (&acc)[2][2][4][2], const Unit& u, int wr, int wc, int fr, int fq) const { NoBg nb; run(acc, u, wr, wc, fr, fq, nb); }
    template <class Bg> __device__ __forceinline__ void run(const f32x4 (&acc)[2][2][4][2], const Unit& u, int wr, int wc, int fr, int fq, Bg& hook) const {
        const int row0 = u.pm * BM + wr * 64 + fr; const int col0 = u.pn * BM + wc * 32 + 8 * fq;
        const float sc = ((u.pn >= 4 && u.pn < 8) ? 0.0625f : 1.0f) * gs;
        if (u.pn < 8) { NoBg nb; rows<true>(acc, row0, col0, sc, wc, fq, nb); } else rows<false>(acc, row0, col0, sc, wc, fq, hook);
    }
    template <bool ROT, class Bg> __device__ __forceinline__ void rows(const f32x4 (&acc)[2][2][4][2], int row0, int col0, float sc, int wc, int fq, Bg& hook) const {
        float cv[64]; CvtJob cj; bool cp = false;
        if constexpr (Bg::ON) { cp = hook.begin(cj); if (cp) Bg::load1(cj, cv); __builtin_amdgcn_sched_barrier(0); }
#pragma unroll
        for (int ai = 0; ai < 2; ++ai)
#pragma unroll
            for (int m = 0; m < 4; ++m) { const int row = row0 + ai * HALF + m * 16; bf16_t* rowp = O + (size_t)row * 6144 + col0;
                f32x4 a0 = acc[ai][0][m][0], a1 = acc[ai][0][m][1], b0 = acc[ai][1][m][0], b1 = acc[ai][1][m][1];
                if constexpr (!ROT) { a0 = a0 * gs; a1 = a1 * gs; b0 = b0 * gs; b1 = b1 * gs; }
                else {
                    const f32x2* cs = rope + (size_t)(row & (SEQ - 1)) * 128 + wc * 32 + 8 * fq;
                    f32x4 o0, o1, p0, p1;
#pragma unroll
                    for (int j = 0; j < 4; ++j) { const f32x2 c0 = cs[j], c1 = cs[4 + j];
                        o0[j] = (a0[j] * c0.x - b0[j] * c0.y) * sc; p0[j] = (a0[j] * c0.y + b0[j] * c0.x) * sc;
                        o1[j] = (a1[j] * c1.x - b1[j] * c1.y) * sc; p1[j] = (a1[j] * c1.y + b1[j] * c1.x) * sc; }
                    a0 = o0; a1 = o1; b0 = p0; b1 = p1;
                }
                u32x4 w; w.x = cvt_pk_bf16(a0[0], a0[1]); w.y = cvt_pk_bf16(a0[2], a0[3]); w.z = cvt_pk_bf16(a1[0], a1[1]); w.w = cvt_pk_bf16(a1[2], a1[3]);
                *(u32x4*)(rowp) = w;
                w.x = cvt_pk_bf16(b0[0], b0[1]); w.y = cvt_pk_bf16(b0[2], b0[3]); w.z = cvt_pk_bf16(b1[0], b1[1]); w.w = cvt_pk_bf16(b1[2], b1[3]);
                *(u32x4*)(rowp + HALF) = w;
                if constexpr (Bg::ON) { if (ai == 0 && m == 3) { __builtin_amdgcn_sched_barrier(0); if (cp) Bg::load2(cj, cv); } } }
        if constexpr (Bg::ON) { __builtin_amdgcn_sched_barrier(0); if (cp) Bg::store(cj, cv); }
    }
};
struct EpiSwiglu {
    static constexpr bool PERM = true;
    bf16_t* O; const float* b1;
    __device__ __forceinline__ void operator()(const f32x4 (&acc)[2][2][4][2], const Unit& u, int wr, int wc, int fr, int fq) const {
        const int e = u.pn >> 3, pl = u.pn & 7;
        const int row0 = u.pm * BM + wr * 64 + fr; const int c0 = pl * 128 + wc * 32 + 8 * fq;
        const float* bg = b1 + (size_t)e * 2048 + c0; const float* bl = bg + 1024;
        const f32x4 bg0 = *(const f32x4*)bg, bg1 = *(const f32x4*)(bg + 4), bl0 = *(const f32x4*)bl, bl1 = *(const f32x4*)(bl + 4);
#pragma unroll
        for (int ai = 0; ai < 2; ++ai)
#pragma unroll
            for (int m = 0; m < 4; ++m) { bf16_t* rowp = O + (size_t)(row0 + ai * HALF + m * 16) * 1024 + c0;
                const f32x4 g0 = acc[ai][0][m][0] + bg0, g1 = acc[ai][0][m][1] + bg1, l0 = acc[ai][1][m][0] + bl0, l1 = acc[ai][1][m][1] + bl1;
                float r[8];
#pragma unroll
                for (int j = 0; j < 4; ++j) {
                    const float ga = fminf(g0[j], 7.0f), la = fminf(fmaxf(l0[j], -7.0f), 7.0f);
                    r[j] = ga * __builtin_amdgcn_rcpf(1.0f + __builtin_amdgcn_exp2f(-2.4554669595930157f * ga)) * (la + 1.0f);
                    const float gb = fminf(g1[j], 7.0f), lb = fminf(fmaxf(l1[j], -7.0f), 7.0f);
                    r[4 + j] = gb * __builtin_amdgcn_rcpf(1.0f + __builtin_amdgcn_exp2f(-2.4554669595930157f * gb)) * (lb + 1.0f); }
                u32x4 w; w.x = cvt_pk_bf16(r[0], r[1]); w.y = cvt_pk_bf16(r[2], r[3]); w.z = cvt_pk_bf16(r[4], r[5]); w.w = cvt_pk_bf16(r[6], r[7]);
                *(u32x4*)(rowp) = w; }
    }
};
struct EpiSwiglu8 {
    static constexpr bool PERM = true;
    unsigned char* O; const float* b1;
    static __device__ __forceinline__ f32x2 act2(f32x2 accg, f32x2 accl, f32x2 bg, f32x2 bl) {
        const f32x2 ws2 = {0.03125f, 0.03125f};
        f32x2 gg = accg * ws2 + bg, ll = accl * ws2 + bl;
        gg.x = fminf(gg.x, 7.0f); gg.y = fminf(gg.y, 7.0f);
        ll.x = fminf(fmaxf(ll.x, -7.0f), 7.0f); ll.y = fminf(fmaxf(ll.y, -7.0f), 7.0f);
        const f32x2 ea = gg * (f32x2){-2.4554669595930157f, -2.4554669595930157f};
        f32x2 den; den.x = __builtin_amdgcn_exp2f(ea.x); den.y = __builtin_amdgcn_exp2f(ea.y);
        den = den + (f32x2){1.0f, 1.0f};
        f32x2 rc; rc.x = __builtin_amdgcn_rcpf(den.x); rc.y = __builtin_amdgcn_rcpf(den.y);
        return (gg * rc) * (ll + (f32x2){1.0f, 1.0f});
    }
    __device__ __forceinline__ void operator()(const f32x4 (&acc)[2][2][4][2], const Unit& u, int wr, int wc, int fr, int fq) const { NoBg nb; run(acc, u, wr, wc, fr, fq, nb); }
    template <class Bg> __device__ __forceinline__ void run(const f32x4 (&acc)[2][2][4][2], const Unit& u, int wr, int wc, int fr, int fq, Bg& hook) const {
        const int e = u.pn >> 3, pl = u.pn & 7;
        const int row0 = u.pm * BM + wr * 64 + fr; const int c0 = pl * 128 + wc * 32 + 8 * fq;
        const float* bg = b1 + (size_t)e * 2048 + c0; const float* bl = bg + 1024;
        const f32x4 bg0 = *(const f32x4*)bg, bg1 = *(const f32x4*)(bg + 4), bl0 = *(const f32x4*)bl, bl1 = *(const f32x4*)(bl + 4);
        float cv[64]; CvtJob cj; bool cp = false;
        if constexpr (Bg::ON) { __builtin_amdgcn_sched_barrier(0); cp = hook.begin(cj); if (cp) Bg::load1(cj, cv); __builtin_amdgcn_sched_barrier(0); }
#pragma unroll
        for (int ai = 0; ai < 2; ++ai)
#pragma unroll
            for (int m = 0; m < 4; ++m) { __builtin_amdgcn_sched_barrier(0); unsigned char* rowp = O + (size_t)(row0 + ai * HALF + m * 16) * 1024 + c0;
                const f32x4 g0 = acc[ai][0][m][0], g1 = acc[ai][0][m][1], l0 = acc[ai][1][m][0], l1 = acc[ai][1][m][1];
                const f32x2 r0 = act2((f32x2){g0[0], g0[1]}, (f32x2){l0[0], l0[1]}, (f32x2){bg0[0], bg0[1]}, (f32x2){bl0[0], bl0[1]});
                const f32x2 r1 = act2((f32x2){g0[2], g0[3]}, (f32x2){l0[2], l0[3]}, (f32x2){bg0[2], bg0[3]}, (f32x2){bl0[2], bl0[3]});
                const f32x2 r2 = act2((f32x2){g1[0], g1[1]}, (f32x2){l1[0], l1[1]}, (f32x2){bg1[0], bg1[1]}, (f32x2){bl1[0], bl1[1]});
                const f32x2 r3 = act2((f32x2){g1[2], g1[3]}, (f32x2){l1[2], l1[3]}, (f32x2){bg1[2], bg1[3]}, (f32x2){bl1[2], bl1[3]});
                u32x2 w; w.x = pk4_fp8(r0.x, r0.y, r1.x, r1.y); w.y = pk4_fp8(r2.x, r2.y, r3.x, r3.y);
                *(u32x2*)(rowp) = w;
                if constexpr (Bg::ON) { if (ai == 0 && m == 3) { __builtin_amdgcn_sched_barrier(0); if (cp) Bg::load2(cj, cv); } } }
        if constexpr (Bg::ON) { __builtin_amdgcn_sched_barrier(0); if (cp) Bg::store(cj, cv); }
    }
};
struct EpiNull {
    static constexpr bool PERM = true;
    float* sink;
    __device__ __forceinline__ void operator()(const f32x4 (&acc)[2][2][4][2], const Unit& u, int wr, int wc, int fr, int fq) const {
        float s = 0.f;
#pragma unroll
        for (int ai = 0; ai < 2; ++ai)
#pragma unroll
            for (int bj = 0; bj < 2; ++bj)
#pragma unroll
                for (int m = 0; m < 4; ++m)
#pragma unroll
                    for (int n = 0; n < 2; ++n) s += acc[ai][bj][m][n][0];
        if (s == 123.456f) sink[0] = s;
    }
};
struct EpiMoe2 {
    static constexpr bool PERM = true;
    bf16_t* O; const float* b2; float ws_;
    __device__ __forceinline__ void operator()(const f32x4 (&acc)[2][2][4][2], const Unit& u, int wr, int wc, int fr, int fq) const {
        const int e = u.pn >> 2, pl = u.pn & 3;
        const int row0 = u.pm * BM + wr * 64 + fr; const int c0 = pl * 256 + wc * 32 + 8 * fq;
        const float* bp = b2 + (size_t)e * 1024 + c0;
        f32x4 bv[2][2];
#pragma unroll
        for (int bj = 0; bj < 2; ++bj)
#pragma unroll
            for (int n = 0; n < 2; ++n) bv[bj][n] = *(const f32x4*)(bp + bj * HALF + 4 * n);
#pragma unroll
        for (int ai = 0; ai < 2; ++ai)
#pragma unroll
            for (int m = 0; m < 4; ++m) { __builtin_amdgcn_sched_barrier(0); bf16_t* rowp = O + (size_t)(row0 + ai * HALF + m * 16) * 1024 + c0;
#pragma unroll
                for (int bj = 0; bj < 2; ++bj) { const f32x4 v0 = acc[ai][bj][m][0] * ws_ + bv[bj][0], v1 = acc[ai][bj][m][1] * ws_ + bv[bj][1];
                    if (YP_FP8) { u32x2 w; w.x = pk4_fp8(v0[0], v0[1], v0[2], v0[3]); w.y = pk4_fp8(v1[0], v1[1], v1[2], v1[3]);
                        *(u32x2*)((unsigned char*)O + (size_t)(row0 + ai * HALF + m * 16) * 1024 + c0 + bj * HALF) = w; }
                    else { u32x4 w; w.x = cvt_pk_bf16(v0[0], v0[1]); w.y = cvt_pk_bf16(v0[2], v0[3]); w.z = cvt_pk_bf16(v1[0], v1[1]); w.w = cvt_pk_bf16(v1[2], v1[3]);
                    *(u32x4*)(rowp + bj * HALF) = w; } } }
    }
};
}
struct Frame {
    LAS unsigned char* lds;
    unsigned* ctl;
    unsigned char* ws;
    const float* const* in;
    float* out;
    int tid, lane, wave, G, bid;
};

__device__ __forceinline__ void transpose_item(const float* W, int ld, int K, bf16_t* WT, int drow0, LAS float* scr, int k0, int n0, int lane) {
    f32x4 v[16];
#pragma unroll
    for (int i = 0; i < 16; ++i) v[i] = *(const f32x4*)(W + (size_t)(k0 + 4 * i + (lane >> 4)) * ld + n0 + 4 * (lane & 15));
#pragma unroll
    for (int i = 0; i < 16; ++i) { LAS float* s = scr + (4 * i + (lane >> 4)) * 65 + 4 * (lane & 15); s[0] = v[i].x; s[1] = v[i].y; s[2] = v[i].z; s[3] = v[i].w; }
    LDS_WAIT(); asm volatile("" ::: "memory");
    const int c = lane & 7;
#pragma unroll
    for (int j = 0; j < 8; ++j) { const int n = (lane >> 3) + 8 * j; const LAS float* s = scr + (8 * c) * 65 + n;
        u32x4 o; o.x = pk2(s[0 * 65], s[1 * 65]); o.y = pk2(s[2 * 65], s[3 * 65]); o.z = pk2(s[4 * 65], s[5 * 65]); o.w = pk2(s[6 * 65], s[7 * 65]);
        *(u32x4*)(WT + (size_t)(drow0 + n) * K + k0 + 8 * c) = o; }
    LDS_WAIT(); asm volatile("" ::: "memory");
}
__device__ __forceinline__ void transpose_item8(const float* W, int ld, int K, unsigned char* WT, int drow0, LAS float* scr, int k0, int n0, int lane) {
    f32x4 v[16];
#pragma unroll
    for (int i = 0; i < 16; ++i) v[i] = *(const f32x4*)(W + (size_t)(k0 + 4 * i + (lane >> 4)) * ld + n0 + 4 * (lane & 15));
#pragma unroll
    for (int i = 0; i < 16; ++i) { LAS float* s = scr + (4 * i + (lane >> 4)) * 65 + 4 * (lane & 15); s[0] = v[i].x * 32.0f; s[1] = v[i].y * 32.0f; s[2] = v[i].z * 32.0f; s[3] = v[i].w * 32.0f; }
    LDS_WAIT(); asm volatile("" ::: "memory");
    const int c = lane & 3;
#pragma unroll
    for (int j = 0; j < 4; ++j) { const int n = (lane >> 2) + 16 * j; const LAS float* s = scr + (16 * c) * 65 + n;
        u32x4 o; o.x = pk4_fp8(s[0 * 65], s[1 * 65], s[2 * 65], s[3 * 65]); o.y = pk4_fp8(s[4 * 65], s[5 * 65], s[6 * 65], s[7 * 65]);
        o.z = pk4_fp8(s[8 * 65], s[9 * 65], s[10 * 65], s[11 * 65]); o.w = pk4_fp8(s[12 * 65], s[13 * 65], s[14 * 65], s[15 * 65]);
        *(u32x4*)(WT + (size_t)(drow0 + n) * K + k0 + 16 * c) = o; }
    LDS_WAIT(); asm volatile("" ::: "memory");
}
__device__ __forceinline__ void cvt_item_regs(const float* W, int ld, int K, unsigned char* WT, int drow0, int k0, int n0, int lane) {
    const float* wp = W + (size_t)k0 * ld + n0 + lane;
    float v[64];
#pragma unroll
    for (int i = 0; i < 64; ++i) v[i] = WNT ? __builtin_nontemporal_load(wp + (size_t)i * ld) : wp[(size_t)i * ld];
    unsigned char* op = WT + (size_t)(drow0 + lane) * K + k0;
#pragma unroll
    for (int c = 0; c < 4; ++c) { u32x4 o;
        o.x = pk4_fp8(v[16 * c + 0] * 32.0f, v[16 * c + 1] * 32.0f, v[16 * c + 2] * 32.0f, v[16 * c + 3] * 32.0f);
        o.y = pk4_fp8(v[16 * c + 4] * 32.0f, v[16 * c + 5] * 32.0f, v[16 * c + 6] * 32.0f, v[16 * c + 7] * 32.0f);
        o.z = pk4_fp8(v[16 * c + 8] * 32.0f, v[16 * c + 9] * 32.0f, v[16 * c + 10] * 32.0f, v[16 * c + 11] * 32.0f);
        o.w = pk4_fp8(v[16 * c + 12] * 32.0f, v[16 * c + 13] * 32.0f, v[16 * c + 14] * 32.0f, v[16 * c + 15] * 32.0f);
        *(u32x4*)(op + 16 * c) = o; }
}
__device__ __forceinline__ float cvt_ld(const CvtJob& j, __amdgpu_buffer_rsrc_t r, int i) { return __builtin_bit_cast(float, __builtin_amdgcn_raw_buffer_load_b32(r, j.lane * 4, i * j.ld * 4, 0)); }
__device__ __forceinline__ __amdgpu_buffer_rsrc_t cvt_rsrc(const CvtJob& j) { return __builtin_amdgcn_make_buffer_rsrc((void*)j.wp, 0, 0x7fffffff, 0x00020000); }
__device__ __forceinline__ CvtJob moe_cvt_job(const float* const* in, unsigned char* ws, int l, int gi_, int lane) {
    CvtJob j; j.lane = lane;
    const int gi = __builtin_amdgcn_readfirstlane(gi_);
    if (gi < 32 * 512) { const int e = gi >> 9, q = gi & 511, kb = q >> 5, n0 = (q & 31) * 64, mat = l * 32 + e;
        const int drow = (n0 < 1024) ? ((n0 >> 7) * 256 + (n0 & 127)) : (((n0 - 1024) >> 7) * 256 + 128 + ((n0 - 1024) & 127));
        j.ld = 2048; j.wp = in[31] + (size_t)mat * 1024 * 2048 + (size_t)(kb * 64) * 2048 + n0; j.op = ws + WS_W1T + (size_t)mat * 2048 * 1024 + (size_t)drow * 1024 + kb * 64; }
    else { const int r = gi - 32 * 512, e = r >> 8, q = r & 255, kb = q >> 4, n0 = (q & 15) * 64, mat = l * 32 + e;
        j.ld = 1024; j.wp = in[33] + (size_t)mat * 1024 * 1024 + (size_t)(kb * 64) * 1024 + n0; j.op = ws + WS_W2T + (size_t)mat * 1024 * 1024 + (size_t)n0 * 1024 + kb * 64; }
    return j;
}
__device__ __forceinline__ void cvt_job_load(const CvtJob& j, float (&v)[64]) {
    const __amdgpu_buffer_rsrc_t r = cvt_rsrc(j);
#pragma unroll
    for (int i = 0; i < 64; ++i) v[i] = cvt_ld(j, r, i);
}
__device__ __forceinline__ void cvt_job_store(const CvtJob& j, const float (&v)[64]) {
    unsigned char* op = j.op + (unsigned)j.lane * 1024u;
#pragma unroll
    for (int c = 0; c < 4; ++c) { u32x4 o;
        o.x = pk4_fp8(v[16 * c + 0] * 32.0f, v[16 * c + 1] * 32.0f, v[16 * c + 2] * 32.0f, v[16 * c + 3] * 32.0f);
        o.y = pk4_fp8(v[16 * c + 4] * 32.0f, v[16 * c + 5] * 32.0f, v[16 * c + 6] * 32.0f, v[16 * c + 7] * 32.0f);
        o.z = pk4_fp8(v[16 * c + 8] * 32.0f, v[16 * c + 9] * 32.0f, v[16 * c + 10] * 32.0f, v[16 * c + 11] * 32.0f);
        o.w = pk4_fp8(v[16 * c + 12] * 32.0f, v[16 * c + 13] * 32.0f, v[16 * c + 14] * 32.0f, v[16 * c + 15] * 32.0f);
        *(u32x4*)(op + 16 * c) = o; }
}
__device__ __forceinline__ void cvt_half_load(const CvtJob& j, int hf, float (&v)[32]) {
#pragma unroll
    for (int i = 0; i < 32; ++i) v[i] = j.wp[(size_t)(32 * hf + i) * j.ld + j.lane];
}
__device__ __forceinline__ void cvt_half_store(const CvtJob& j, int hf, const float (&v)[32]) {
    unsigned char* op = j.op + (unsigned)j.lane * 1024u;
#pragma unroll
    for (int c = 0; c < 2; ++c) { u32x4 o;
        o.x = pk4_fp8(v[16 * c + 0] * 32.0f, v[16 * c + 1] * 32.0f, v[16 * c + 2] * 32.0f, v[16 * c + 3] * 32.0f);
        o.y = pk4_fp8(v[16 * c + 4] * 32.0f, v[16 * c + 5] * 32.0f, v[16 * c + 6] * 32.0f, v[16 * c + 7] * 32.0f);
        o.z = pk4_fp8(v[16 * c + 8] * 32.0f, v[16 * c + 9] * 32.0f, v[16 * c + 10] * 32.0f, v[16 * c + 11] * 32.0f);
        o.w = pk4_fp8(v[16 * c + 12] * 32.0f, v[16 * c + 13] * 32.0f, v[16 * c + 14] * 32.0f, v[16 * c + 15] * 32.0f);
        *(u32x4*)(op + 32 * hf + 16 * c) = o; }
}
__device__ __forceinline__ void bg_convert(const float* const* in, unsigned char* ws, int layer, int slot0, int count, int gw, int NGW, int lane) {
    for (int s = 0; s < count; s += 2) {
        const int ga = (slot0 + s) * NGW + gw, gb = (slot0 + s + 1) * NGW + gw;
        const bool va = ga < 24576, vb = (s + 1 < count) && gb < 24576;
        float xa[64], xb[64]; CvtJob ja, jb;
        if (va) { ja = moe_cvt_job(in, ws, layer, ga, lane); cvt_job_load(ja, xa); }
        if (vb) { jb = moe_cvt_job(in, ws, layer, gb, lane); cvt_job_load(jb, xb); }
        if (va) cvt_job_store(ja, xa);
        if (vb) cvt_job_store(jb, xb);
    }
}
template <int NB1> struct BgCvtT {
    static constexpr bool ON = true;
    const float* const* in; unsigned char* ws; int layerA, giA, limA, nA, layerB, limB, slot, nslot, gw, NGW, lane;
    __device__ __forceinline__ void init(const float* const* in_, unsigned char* ws_, int gw_, int NGW_, int lane_, int layerA_, int giA_, int limA_, int layerB_, int limB_) {
        in = in_; ws = ws_; gw = gw_; NGW = NGW_; lane = lane_; layerA = layerA_; giA = giA_; limA = limA_; layerB = layerB_; limB = limB_;
        nA = layerA_ >= 0 ? (limA_ - giA_ + NGW_ - 1) / NGW_ : 0; nslot = nA + (layerB_ >= 0 ? (limB_ + NGW_ - 1) / NGW_ : 0); slot = 0; }
    __device__ __forceinline__ bool sel(int s, int& layer, int& gi) const {
        if (s >= nslot) return false;
        if (s < nA) { layer = layerA; gi = giA + s * NGW + gw; return gi < limA; }
        layer = layerB; gi = (s - nA) * NGW + gw; return gi < limB; }
    __device__ __forceinline__ bool begin(CvtJob& j) { int layer = 0, gi = 0; const bool ok = sel(slot, layer, gi); ++slot; if (ok) j = moe_cvt_job(in, ws, layer, gi, lane); return ok; }
    static __device__ __forceinline__ void load1(const CvtJob& j, float (&v)[64]) { const __amdgpu_buffer_rsrc_t r = cvt_rsrc(j);
#pragma unroll
        for (int i = 0; i < NB1; ++i) v[i] = cvt_ld(j, r, i); }
    static __device__ __forceinline__ void load2(const CvtJob& j, float (&v)[64]) { const __amdgpu_buffer_rsrc_t r = cvt_rsrc(j);
#pragma unroll
        for (int i = NB1; i < 64; ++i) v[i] = cvt_ld(j, r, i); }
    static __device__ __forceinline__ void store(const CvtJob& j, const float (&v)[64]) { cvt_job_store(j, v); }
    __device__ __forceinline__ void finish() {
        for (; slot < nslot; ++slot) { int layer = 0, gi = 0; if (sel(slot, layer, gi)) { const CvtJob jj = moe_cvt_job(in, ws, layer, gi, lane); float x[64]; cvt_job_load(jj, x); cvt_job_store(jj, x); } } }
};
typedef BgCvtT<48> BgCvt;
typedef BgCvtT<40> BgCvtR;
__device__ __forceinline__ void moe_cvt_item(const float* const* in, unsigned char* ws, int l, int gi, int lane) {
    if (gi < 32 * 512) { const int e = gi >> 9, q = gi & 511, kb = q >> 5, n0 = (q & 31) * 64, mat = l * 32 + e;
        const int drow = (n0 < 1024) ? ((n0 >> 7) * 256 + (n0 & 127)) : (((n0 - 1024) >> 7) * 256 + 128 + ((n0 - 1024) & 127));
        cvt_item_regs(in[31] + (size_t)mat * 1024 * 2048, 2048, 1024, ws + WS_W1T + (size_t)mat * 2048 * 1024, drow, kb * 64, n0, lane); }
    else { const int r = gi - 32 * 512, e = r >> 8, q = r & 255, kb = q >> 4, n0 = (q & 15) * 64, mat = l * 32 + e;
        cvt_item_regs(in[33] + (size_t)mat * 1024 * 1024, 1024, 1024, ws + WS_W2T + (size_t)mat * 1024 * 1024, n0, kb * 64, n0, lane); }
}
__device__ __forceinline__ bool tr_job(int& r, const float* W, int ld, int K, int N, bf16_t* WT, LAS float* scr, int lane) {
    const int nb = N / 64, items = (K / 64) * nb;
    if (r >= items) { r -= items; return false; }
    const int kb = r / nb, nn = r % nb;
    transpose_item(W, ld, K, WT, nn * 64, scr, kb * 64, nn * 64, lane);
    return true;
}

__device__ __forceinline__ bool tr_job8(int& r, const float* W, int ld, int K, int N, unsigned char* WT, LAS float* scr, int lane) {
    const int nb = N / 64, items = (K / 64) * nb;
    if (r >= items) { r -= items; return false; }
    const int kb = r / nb, nn = r % nb;
    transpose_item8(W, ld, K, WT, nn * 64, scr, kb * 64, nn * 64, lane);
    return true;
}
__device__ __forceinline__ void prologue_phase(Frame& F) {
    const float* const* in = F.in; unsigned char* ws = F.ws;
    {
        LAS float* sc = (LAS float*)F.lds;
        LAS float* red = (LAS float*)(F.lds + 32768);
        const float* c = in[1];
        for (int i = F.tid; i < NB * DM; i += NTHR) sc[i] = siluf_(c[i]);
        __syncthreads();
        float* mod = (float*)(ws + WS_MOD);
        for (int it = F.bid; it < 4 * 96; it += F.G) {
            const int l = it / 96, cb = it % 96, col = cb * 64 + F.lane;
            const __amdgpu_buffer_rsrc_t wr = __builtin_amdgcn_make_buffer_rsrc((void*)(in[2] + (size_t)l * DM * 6144), 0, 0x7fffffff, 0x00020000);
            float acc[8];
#pragma unroll
            for (int b = 0; b < 8; ++b) acc[b] = 0.f;
            const int k0 = F.wave * 128;
            const LAS float* scp = sc + k0;
#pragma unroll 1
            for (int kk = 0; kk < 128; kk += 64) {
                float wv[64];
#pragma unroll
                for (int j = 0; j < 64; ++j) wv[j] = __builtin_bit_cast(float, __builtin_amdgcn_raw_buffer_load_b32(wr, col * 4, (k0 + kk + j) * 6144 * 4, 0));
#pragma unroll
                for (int j = 0; j < 64; j += 4)
#pragma unroll
                    for (int b = 0; b < 8; ++b) { const f32x4 s4 = *(const LAS f32x4*)(scp + b * DM + kk + j);
                        acc[b] += s4.x * wv[j] + s4.y * wv[j + 1] + s4.z * wv[j + 2] + s4.w * wv[j + 3]; }
            }
#pragma unroll
            for (int b = 0; b < 8; ++b) red[(F.wave * 8 + b) * 64 + F.lane] = acc[b];
            __syncthreads();
            {
                float s = 0.f;
#pragma unroll
                for (int w8 = 0; w8 < 8; ++w8) s += red[(w8 * 8 + F.wave) * 64 + F.lane];
                mod[((size_t)l * NB + F.wave) * 6144 + col] = s + in[3][(size_t)l * 6144 + col];
            }
            __syncthreads();
        }
    }
    const int gw = F.bid * NWAVES + F.wave, NGW = F.G * NWAVES, gt = F.bid * NTHR + F.tid, NGT = F.G * NTHR;
    {
        f32x2* rope = (f32x2*)(ws + WS_ROPE);
        const float inv_t = (float)exp(-(double)(gt & 127) * (9.210340371976184 / 128.0));
        const bool inv_same = (NGT & 127) == 0;
        for (int i = gt; i < SEQ * 128; i += NGT) {
            const int pos = i >> 7, j = i & 127;
            const float inv = inv_same ? inv_t : (float)exp(-(double)j * (9.210340371976184 / 128.0));
            const float ang = (float)pos * inv;
            const double rev = (double)ang * 0.15915494309189535;
            const float fr = (float)(rev - floor(rev));
            rope[i] = (f32x2){__builtin_amdgcn_cosf(fr), __builtin_amdgcn_sinf(fr)};
        }
    }
    {
        bf16_t* wrt = (bf16_t*)(ws + WS_WRT);
        for (int i = gt; i < 4 * 32 * 1024; i += NGT) {
            const int l = i >> 15, e = (i >> 10) & 31, k = i & 1023;
            const float w = in[29][((size_t)l * 1024 + k) * 32 + e];
            const unsigned hi = f2bf(w); const float lo = w - bf2f((unsigned short)hi);
            wrt[((size_t)(l * 2 + 0) * 32 + e) * 1024 + k] = (bf16_t)hi; wrt[((size_t)(l * 2 + 1) * 32 + e) * 1024 + k] = (bf16_t)f2bf(lo);
        }
        bf16_t* wgl = (bf16_t*)(ws + WS_WGL);
        for (int i = gt; i < 16 * 1024; i += NGT) {
            const int e = i >> 10, k = i & 1023;
            const float w = in[13][(size_t)k * 3088 + 2048 + e];
            const unsigned hi = f2bf(w); const float lo = w - bf2f((unsigned short)hi);
            wgl[(size_t)(0 * 16 + e) * 1024 + k] = (bf16_t)hi; wgl[(size_t)(1 * 16 + e) * 1024 + k] = (bf16_t)f2bf(lo);
        }
    }
    {
        bf16_t* wmg = (bf16_t*)(ws + WS_WMG);
        for (int i = gt; i < 16 * 6144; i += NGT) {
            const int e = i / 6144, k = i % 6144;
            const float w = (e < 8) ? in[24][(size_t)k * 8 + e] : 0.f;
            const unsigned hi = f2bf(w); const float lo = w - bf2f((unsigned short)hi);
            wmg[(size_t)e * 6144 + k] = (bf16_t)hi; wmg[(size_t)(16 + e) * 6144 + k] = (bf16_t)f2bf(lo);
        }
    }
    {
        LAS float* scr = (LAS float*)(F.lds + F.wave * 16640);
        constexpr int I_RET_IN = 16 * 96, I_RET_OUT = 32 * 16, I_ATT_IN = 16 * 48, I_ATT_OUT = 16 * 16, I_GLA_A = 16 * 32, I_GLA_B = 16 * 16, I_GLA_OUT = 16 * 16,
                      I_MLS_IN = 16 * 64, I_MLS_OUT = 32 * 16;
        constexpr int I_DENSE = I_RET_IN + I_RET_OUT + I_ATT_IN + I_ATT_OUT + I_GLA_A + I_GLA_B + I_GLA_OUT + I_MLS_IN + I_MLS_OUT;
        constexpr int I_W1 = 16 * 32, I_W2 = 16 * 16;
        constexpr int NITEMS = I_DENSE + (MOE_FP8 ? (CVT_HOST == 2 ? 0 : MOE_PRO_LAYERS) * 24576 : 128 * I_W1 + 128 * I_W2);
        for (int it = gw; it < NITEMS; it += NGW) {
            int r = it;
            if (r < I_DENSE) {
                if (GFP8_RET) { if (tr_job(r, in[7], 6144, 1024, 4096, (bf16_t*)(ws + WS_W_RET_IN), scr, F.lane)) continue;
                    if (tr_job8(r, in[7] + 4096, 6144, 1024, 2048, (unsigned char*)(ws + WS_W_RET_IN + 8 * MiB), scr, F.lane)) continue; }
                else if (IFP8_RET ? tr_job8(r, in[7], 6144, 1024, 6144, (unsigned char*)(ws + WS_W_RET_IN), scr, F.lane) : tr_job(r, in[7], 6144, 1024, 6144, (bf16_t*)(ws + WS_W_RET_IN), scr, F.lane)) continue;
                if (OUT_FP8 ? tr_job8(r, in[9], 1024, 2048, 1024, (unsigned char*)(ws + WS_W_RET_OUT), scr, F.lane) : tr_job(r, in[9], 1024, 2048, 1024, (bf16_t*)(ws + WS_W_RET_OUT), scr, F.lane)) continue;
                if (IFP8_ATT ? tr_job8(r, in[10], 3072, 1024, 3072, (unsigned char*)(ws + WS_W_ATT_IN), scr, F.lane) : tr_job(r, in[10], 3072, 1024, 3072, (bf16_t*)(ws + WS_W_ATT_IN), scr, F.lane)) continue;
                if (OUT_FP8 ? tr_job8(r, in[12], 1024, 1024, 1024, (unsigned char*)(ws + WS_W_ATT_OUT), scr, F.lane) : tr_job(r, in[12], 1024, 1024, 1024, (bf16_t*)(ws + WS_W_ATT_OUT), scr, F.lane)) continue;
                if (IFP8_GLA ? tr_job8(r, in[13], 3088, 1024, 2048, (unsigned char*)(ws + WS_W_GLA_IN), scr, F.lane) : tr_job(r, in[13], 3088, 1024, 2048, (bf16_t*)(ws + WS_W_GLA_IN), scr, F.lane)) continue;
                if (GFP8_GLA) { if (tr_job8(r, in[13] + 2064, 3088, 1024, 1024, (unsigned char*)(ws + WS_W_GLA_IN + 4 * MiB), scr, F.lane)) continue; }
                else if (IFP8_GLA ? tr_job8(r, in[13] + 2064, 3088, 1024, 1024, (unsigned char*)(ws + WS_W_GLA_IN) + (size_t)2048 * 1024, scr, F.lane) : tr_job(r, in[13] + 2064, 3088, 1024, 1024, (bf16_t*)(ws + WS_W_GLA_IN) + (size_t)2048 * 1024, scr, F.lane)) continue;
                if (OUT_FP8 ? tr_job8(r, in[17], 1024, 1024, 1024, (unsigned char*)(ws + WS_W_GLA_OUT), scr, F.lane) : tr_job(r, in[17], 1024, 1024, 1024, (bf16_t*)(ws + WS_W_GLA_OUT), scr, F.lane)) continue;
                if (GFP8_MLS) { if (tr_job(r, in[18], 4096, 1024, 2048, (bf16_t*)(ws + WS_W_MLS_IN), scr, F.lane)) continue;
                    if (tr_job8(r, in[18] + 2048, 4096, 1024, 2048, (unsigned char*)(ws + WS_W_MLS_IN + 4 * MiB), scr, F.lane)) continue; }
                else if (IFP8_MLS ? tr_job8(r, in[18], 4096, 1024, 4096, (unsigned char*)(ws + WS_W_MLS_IN), scr, F.lane) : tr_job(r, in[18], 4096, 1024, 4096, (bf16_t*)(ws + WS_W_MLS_IN), scr, F.lane)) continue;
                if (OUT_FP8) tr_job8(r, in[28], 1024, 2048, 1024, (unsigned char*)(ws + WS_W_MLS_OUT), scr, F.lane); else tr_job(r, in[28], 1024, 2048, 1024, (bf16_t*)(ws + WS_W_MLS_OUT), scr, F.lane);
                continue;
            }
            r -= I_DENSE;
            if (MOE_FP8) { moe_cvt_item(in, ws, r / 24576, r % 24576, F.lane); continue; }
            if (r < 128 * I_W1) {
                const int mat = r / I_W1, q = r % I_W1, kb = q / 32, nn = q % 32, n0 = nn * 64;
                const int drow = (n0 < 1024) ? ((n0 >> 7) * 256 + (n0 & 127)) : (((n0 - 1024) >> 7) * 256 + 128 + ((n0 - 1024) & 127));
                transpose_item(in[31] + (size_t)mat * 1024 * 2048, 2048, 1024, (bf16_t*)(ws + WS_W1T) + (size_t)mat * 2048 * 1024, drow, scr, kb * 64, n0, F.lane);
                continue;
            }
            r -= 128 * I_W1;
            { const int mat = r / I_W2, q = r % I_W2, kb = q / 16, nn = q % 16;
              transpose_item(in[33] + (size_t)mat * 1024 * 1024, 1024, 1024, (bf16_t*)(ws + WS_W2T) + (size_t)mat * 1024 * 1024, nn * 64, scr, kb * 64, nn * 64, F.lane); }
        }
    }
}

struct NormArgs {
    const void* xin; bf16_t* xout;
    const float* gain;
    const float* sc; const float* sh;
    bf16_t* h;
    unsigned char* h8;
    const bf16_t* yp; const int* tokes_c; const float* tokw_c; const float* gf; const unsigned* cnt_prev;
    const bf16_t* wt;
    const float* rb;
    unsigned* cnt; unsigned short* list; int* tokes; float* tokw;
    float* glow;
    float* out;
};
template <bool COMBINE, int PROJ  , bool FINAL, bool XBF = true, int HOUT = 3>
__device__ __forceinline__ void norm_phase(Frame& F, const NormArgs& a) {
    constexpr bool WANT_H8 = !FINAL && (HOUT & 2), WANT_H16 = !FINAL && ((HOUT & 1) || PROJ != 0);
    LAS unsigned* sbase = (LAS unsigned*)(F.lds + LDS_MISC + 256);
    LAS float* lg = (LAS float*)(F.lds + F.wave * 2176);
    if (COMBINE) {
        if (F.wave == 0) {
            const unsigned t = F.lane < NEXP ? ((a.cnt_prev[F.lane * 64] + 255u) >> 8) << 8 : 0u;
            unsigned incl = t;
#pragma unroll
            for (int d = 1; d < NEXP; d <<= 1) { const unsigned v = __shfl_up(incl, d); if (F.lane >= d) incl += v; }
            if (F.lane < NEXP) sbase[F.lane] = incl - t;
        }
        LDS_WAIT();
        __syncthreads();
    }
    const int gw = F.bid * NWAVES + F.wave, NGW = F.G * NWAVES, lane = F.lane;
    LAS unsigned* hist = (LAS unsigned*)(F.lds + LDS_MISC + 1024);
    LAS unsigned* gbase = (LAS unsigned*)(F.lds + LDS_MISC + 1280);
    if (PROJ == 1) { if (F.tid < 32) hist[F.tid] = 0u; __syncthreads(); }
    const int niter = (T / 16 + NGW - 1) / NGW;
    for (int it = 0; it < niter; ++it) {
        const int tile_ = it * NGW + gw; const bool active = tile_ < T / 16; const int tile = active ? tile_ : 0;
        const int t0 = tile * 16, b = t0 >> 12;
        f32x4 gm[4], shv[4], gfv[4];
        if (active) {
#pragma unroll
        for (int j = 0; j < 4; ++j) {
            const int d = 512 * (j >> 1) + 8 * lane + 4 * (j & 1);
            const f32x4 g = *(const f32x4*)(a.gain + d);
            if (!FINAL) { const f32x4 s = *(const f32x4*)(a.sc + (size_t)b * 6144 + d); gm[j] = g * (s + 1.0f); shv[j] = *(const f32x4*)(a.sh + (size_t)b * 6144 + d); }
            else { gm[j] = g; shv[j] = (f32x4){0.f, 0.f, 0.f, 0.f}; }
            if (COMBINE) gfv[j] = *(const f32x4*)(a.gf + (size_t)b * 6144 + d);
        }
        int es_all = 0; float w_all = 0.f;
        if (COMBINE) { es_all = a.tokes_c[t0 * 4 + lane]; w_all = a.tokw_c[t0 * 4 + lane]; }
        f32x4 xa[4], xb[4]; u32x2 ya[4][4], yb[4][4];
#define NP_LOAD(r, X, Y) do { const int t_ = t0 + (r); \
            _Pragma("unroll") for (int jj = 0; jj < 2; ++jj) { if (XBF) { const u32x4 p_ = *(const u32x4*)((const bf16_t*)a.xin + (size_t)t_ * DM + 512 * jj + 8 * lane); \
                    X[2 * jj] = (f32x4){bflo(p_.x), bfhi(p_.x), bflo(p_.y), bfhi(p_.y)}; X[2 * jj + 1] = (f32x4){bflo(p_.z), bfhi(p_.z), bflo(p_.w), bfhi(p_.w)}; } \
                else { X[2 * jj] = *(const f32x4*)((const float*)a.xin + (size_t)t_ * DM + 512 * jj + 8 * lane); X[2 * jj + 1] = *(const f32x4*)((const float*)a.xin + (size_t)t_ * DM + 512 * jj + 8 * lane + 4); } } \
            if (COMBINE) { _Pragma("unroll") for (int k = 0; k < TOPK; ++k) { const int es = __builtin_amdgcn_readlane(es_all, 4 * (r) + k); \
                const size_t row = (size_t)sbase[es >> 16] + (unsigned)(es & 0xffff); \
                _Pragma("unroll") for (int jj = 0; jj < 2; ++jj) { if (YP_FP8) { const u32x2 y_ = *(const u32x2*)((const unsigned char*)a.yp + row * 1024 + 512 * jj + 8 * lane); Y[k][2 * jj].x = y_.x; Y[k][2 * jj + 1].x = y_.y; } \
                    else { const u32x4 y_ = *(const u32x4*)(a.yp + row * 1024 + 512 * jj + 8 * lane); Y[k][2 * jj] = (u32x2){y_.x, y_.y}; Y[k][2 * jj + 1] = (u32x2){y_.z, y_.w}; } } } } } while (0)
#define NP_PROC(r, X, Y) do { const int t_ = t0 + (r); f32x4 v[4]; \
            _Pragma("unroll") for (int j = 0; j < 4; ++j) v[j] = X[j]; \
            if (COMBINE) { f32x4 y[4]; \
                _Pragma("unroll") for (int j = 0; j < 4; ++j) y[j] = (f32x4){0.f, 0.f, 0.f, 0.f}; \
                _Pragma("unroll") for (int k = 0; k < TOPK; ++k) { const float w = __builtin_bit_cast(float, __builtin_amdgcn_readlane(__builtin_bit_cast(int, w_all), 4 * (r) + k)); \
                    _Pragma("unroll") for (int j = 0; j < 4; ++j) { const u32x2 p = Y[k][j]; \
                        if (YP_FP8) { const f32x2 lo_ = __builtin_amdgcn_cvt_pk_f32_fp8((int)p.x, false), hi_ = __builtin_amdgcn_cvt_pk_f32_fp8((int)p.x, true); y[j] += (f32x4){lo_.x, lo_.y, hi_.x, hi_.y} * w; } \
                        else y[j] += (f32x4){bflo(p.x), bfhi(p.x), bflo(p.y), bfhi(p.y)} * w; } } \
                _Pragma("unroll") for (int j = 0; j < 4; ++j) v[j] += gfv[j] * y[j]; \
                _Pragma("unroll") for (int jj = 0; jj < 2; ++jj) { u32x4 q_; q_.x = pk2(v[2 * jj].x, v[2 * jj].y); q_.y = pk2(v[2 * jj].z, v[2 * jj].w); q_.z = pk2(v[2 * jj + 1].x, v[2 * jj + 1].y); q_.w = pk2(v[2 * jj + 1].z, v[2 * jj + 1].w); \
                    *(u32x4*)(a.xout + (size_t)t_ * DM + 512 * jj + 8 * lane) = q_; } } \
            float ss = 0.f; \
            _Pragma("unroll") for (int j = 0; j < 4; ++j) ss += (v[j].x * v[j].x + v[j].y * v[j].y) + (v[j].z * v[j].z + v[j].w * v[j].w); \
            const float rstd = rsqrtf(wave_sum(ss) * (1.0f / DM) + EPS); \
            _Pragma("unroll") for (int jj = 0; jj < 2; ++jj) { const f32x4 h0 = v[2 * jj] * rstd * gm[2 * jj] + shv[2 * jj], h1 = v[2 * jj + 1] * rstd * gm[2 * jj + 1] + shv[2 * jj + 1]; \
                if (FINAL) { *(f32x4*)(a.out + (size_t)t_ * DM + 512 * jj + 8 * lane) = h0; *(f32x4*)(a.out + (size_t)t_ * DM + 512 * jj + 8 * lane + 4) = h1; } \
                else { if (WANT_H16) { u32x4 p; p.x = pk2(h0.x, h0.y); p.y = pk2(h0.z, h0.w); p.z = pk2(h1.x, h1.y); p.w = pk2(h1.z, h1.w); *(u32x4*)(a.h + (size_t)t_ * DM + 512 * jj + 8 * lane) = p; } \
                    if (WANT_H8) { u32x2 p8; p8.x = pk4_fp8(h0.x, h0.y, h0.z, h0.w); p8.y = pk4_fp8(h1.x, h1.y, h1.z, h1.w); *(u32x2*)(a.h8 + (size_t)t_ * DM + 512 * jj + 8 * lane) = p8; } } } } while (0)
        f32x4 xc[4]; u32x2 yc[4][4];
        NP_LOAD(0, xa, ya); NP_LOAD(1, xb, yb);
#pragma unroll 1
        for (int r = 0; r < 15; r += 3) {
            NP_LOAD(r + 2, xc, yc);
            NP_PROC(r, xa, ya);
            NP_LOAD(r + 3, xa, ya);
            NP_PROC(r + 1, xb, yb);
            if (r + 4 < 16) NP_LOAD(r + 4, xb, yb);
            NP_PROC(r + 2, xc, yc);
        }
        NP_PROC(15, xa, ya);
#undef NP_LOAD
#undef NP_PROC
        }
        if (PROJ != 0) {
            constexpr int NT = (PROJ == 1) ? 2 : 1;
            VM_WAIT();
            f32x4 acc[NT];
#pragma unroll
            for (int n = 0; n < NT; ++n) acc[n] = (f32x4){0.f, 0.f, 0.f, 0.f};
            const bf16_t* ap = a.h + (size_t)(t0 + (lane & 15)) * DM + 8 * (lane >> 4);
            const bf16_t* bp = a.wt + (size_t)(lane & 15) * DM + 8 * (lane >> 4);
#pragma unroll 4
            for (int ks = 0; ks < 32; ++ks) {
                const bf16x8 av = *(const bf16x8*)(ap + 32 * ks);
#pragma unroll
                for (int n = 0; n < NT; ++n) {
                    const bf16x8 bh = *(const bf16x8*)(bp + (size_t)(16 * n) * DM + 32 * ks);
                    const bf16x8 bl = *(const bf16x8*)(bp + (size_t)(NT * 16 + 16 * n) * DM + 32 * ks);
                    acc[n] = __builtin_amdgcn_mfma_f32_16x16x32_bf16(av, bh, acc[n], 0, 0, 0);
                    acc[n] = __builtin_amdgcn_mfma_f32_16x16x32_bf16(av, bl, acc[n], 0, 0, 0);
                }
            }
            if (PROJ == 2) {
                if (active)
#pragma unroll
                for (int i = 0; i < 4; ++i) a.glow[(size_t)(t0 + 4 * (lane >> 4) + i) * 16 + (lane & 15)] = acc[0][i];
            } else {
#pragma unroll
                for (int n = 0; n < NT; ++n)
#pragma unroll
                    for (int i = 0; i < 4; ++i) lg[(4 * (lane >> 4) + i) * 34 + 16 * n + (lane & 15)] = acc[n][i];
                LDS_WAIT(); asm volatile("" ::: "memory");
                float tv[4]; int ti[4]; unsigned lr[4];
                const bool picker = active && lane < 16;
#pragma unroll
                for (int k = 0; k < 4; ++k) { tv[k] = 0.f; ti[k] = 0; lr[k] = 0u; }
                if (picker) {
                    float v[32];
#pragma unroll
                    for (int e = 0; e < 32; ++e) v[e] = lg[lane * 34 + e] + a.rb[e];
#pragma unroll
                    for (int k = 0; k < 4; ++k) {
                        float best = -3.0e38f; int bi = 0;
#pragma unroll
                        for (int e = 0; e < 32; ++e) { const bool gt = v[e] > best; best = gt ? v[e] : best; bi = gt ? e : bi; }
#pragma unroll
                        for (int e = 0; e < 32; ++e) v[e] = (e == bi) ? -3.0e38f : v[e];
                        tv[k] = best; ti[k] = bi;
                    }
#pragma unroll
                    for (int k = 0; k < 4; ++k) lr[k] = __hip_atomic_fetch_add(hist + ti[k], 1u, __ATOMIC_RELAXED, __HIP_MEMORY_SCOPE_WORKGROUP);
                }
                LDS_WAIT();
                __syncthreads();
                if (F.tid < 32) { const unsigned hc = hist[F.tid]; gbase[F.tid] = hc ? atomicAdd(a.cnt + F.tid * 64, hc) : 0u; hist[F.tid] = 0u; }
                LDS_WAIT();
                __syncthreads();
                if (picker) {
                    const int t = t0 + lane;
                    const float e1 = __expf(tv[1] - tv[0]), e2 = __expf(tv[2] - tv[0]), e3 = __expf(tv[3] - tv[0]);
                    const float inv = 1.0f / (1.0f + e1 + e2 + e3);
                    const float wk[4] = {inv, e1 * inv, e2 * inv, e3 * inv};
#pragma unroll
                    for (int k = 0; k < 4; ++k) {
                        const unsigned slot = gbase[ti[k]] + lr[k];
                        a.list[(size_t)ti[k] * T + slot] = (unsigned short)t;
                        a.tokes[t * 4 + k] = (ti[k] << 16) | (int)slot;
                        a.tokw[t * 4 + k] = wk[k];
                    }
                }
                LDS_WAIT();
                __syncthreads();
            }
        }
    }
}

template <int NPN, bool GATHER, bool FP8, class Epi, bool HOT = false, bool HOSTCVT = false>
__device__ __forceinline__ void moe_gemm_phase(Frame& F, const bf16_t* A, const bf16_t* Bt, const unsigned* cnt, const unsigned short* list, const Epi& E, const float* const* in = nullptr, unsigned char* ws = nullptr, int cvt_layer = -1, int w2_layer = -1) {
    BgCvt bgc; if constexpr (HOSTCVT) bgc.init(in, ws, F.bid * NWAVES + F.wave, F.G * NWAVES, F.lane, w2_layer, 16384, 24576, cvt_layer, 24576);
    LAS int* tb = (LAS int*)(F.lds + LDS_MISC + 512);
    LAS int* cn = (LAS int*)(F.lds + LDS_MISC + 768);
    LAS unsigned short* idx = (LAS unsigned short*)(F.lds + LDS_IDX);
    LAS int* utab = (LAS int*)(F.lds + LDS_IDX + 18 * 512);
    if (F.wave == 0) {
        const int c = F.lane < NEXP ? (int)cnt[F.lane * 64] : 0, t = (c + 255) >> 8;
        int incl = t;
#pragma unroll
        for (int d = 1; d < NEXP; d <<= 1) { const int v = __shfl_up(incl, d); if (F.lane >= d) incl += v; }
        if (F.lane < NEXP) { cn[F.lane] = c; tb[F.lane] = incl - t; }
        if (F.lane == NEXP - 1) tb[NEXP] = incl;
    }
    LDS_WAIT();
    __syncthreads();
    const int NT = tb[NEXP];
    const bool xcd_deal = (F.G % 8 == 0);
    const int ncls = xcd_deal ? 8 : 1, cls = xcd_deal ? (F.bid & 7) : 0, rank = xcd_deal ? (F.bid >> 3) : F.bid, W = F.G / ncls;
    const int r0 = (int)(((long)cls * NT) / ncls), r1 = (int)(((long)(cls + 1) * NT) / ncls);
    const int U = (r1 - r0) * NPN;
    int e = GATHER ? 0 : NEXP - 1;
    for (int i0 = 0; i0 * W + rank < U; i0 += 18) {
        if (i0 > 0) __syncthreads();
        int nmy = 0;
        int goff[18];
#pragma unroll
        for (int i = 0; i < 18; ++i) {
            goff[i] = 0;
            const int L = (i0 + i) * W + rank;
            if (L < U) {
                const int rt = GATHER ? (r0 + L / NPN) : (r1 - 1 - L / NPN), pl = L % NPN;
                if (GATHER) { while (e < NEXP - 1 && rt >= tb[e + 1]) ++e; } else { while (e > 0 && rt < tb[e]) --e; }
                if (F.tid == 0) { utab[2 * i] = HOT ? 0 : rt; utab[2 * i + 1] = HOT ? 0 : (e * NPN + pl); }
                if (GATHER) { int j = (rt - tb[e]) * 256 + (F.tid & 255); const int c = cn[e]; j = j < c ? j : c - 1; goff[i] = e * T + j; }
                nmy = i + 1;
            }
        }
        if (GATHER && F.tid < 256) {
            unsigned short lv[18];
#pragma unroll
            for (int i = 0; i < 18; ++i) lv[i] = (i < nmy) ? list[goff[i]] : (unsigned short)0;
#pragma unroll
            for (int i = 0; i < 18; ++i) if (i < nmy) idx[i * 256 + F.tid] = HOT ? (unsigned short)F.tid : lv[i];
        }
        VM_WAIT(); LDS_WAIT();
        __syncthreads();
        pg8::MoeOrder S; S.utab = utab; S.idx = idx; S.nmy = nmy;
        pg8::Gemm g{A, Bt, 0, 0, FP8 ? 512 : 1024};
        if constexpr (HOSTCVT) pg8::gemm_phase_bg<Epi, pg8::MoeOrder, GATHER, FP8, BgCvt>(F.lds, g, S, E, bgc);
        else pg8::gemm_phase<Epi, pg8::MoeOrder, GATHER, FP8>(F.lds, g, S, E);
    }
    if constexpr (HOSTCVT) bgc.finish();
}
template <int MODE, int ABL = 0>
__device__ __forceinline__ void s2_phase(Frame& F, const bf16_t* Q, const bf16_t* PT, const bf16_t* KT, const bf16_t* VT, const float* REC, bf16_t* mix,
                                         const float* const* in = nullptr, unsigned char* ws = nullptr, int cvt_layer = -1) {
    constexpr bool ML = (MODE == 2 || MODE == 3);
    constexpr int DK = MODE == 0 ? 256 : (MODE == 1 ? 128 : 512);
    constexpr int NER = (MODE == 1 || MODE == 3) ? 2 : 4;
    constexpr int NE = ML ? NER + 1 : NER;
    constexpr int NEB = (MODE == 3) ? 16 : 8;
    constexpr int EW = 16 * NER, MT = DK / 128, KS = DK / 32, NJ = (NE + 1) / 2;
    constexpr int KSE = (MODE == 2) ? KS / 2 : KS;
    constexpr int LDQ = MODE == 0 ? 6144 : (MODE == 1 ? 512 : 2048);
    constexpr int QH = MODE == 0 ? 256 : (MODE == 1 ? 128 : 512);
    constexpr int VH = MODE == 1 ? 256 : 512;
    constexpr int LDM = MODE == 1 ? 1024 : 2048;
    constexpr int LDS_ST = DK * 2 + 16, LDO = EW * 2 + 16;
    constexpr int VCOLS = ML ? EW + 16 : EW, LDV = VCOLS * 2 + 16;
    constexpr int LDVS = MODE == 0 ? 6144 : (MODE == 1 ? 3072 : 2048);
    constexpr int NROWS = ML ? EW + 2 : EW;
    constexpr int ST_BYTES = NROWS * LDS_ST, VT_BYTES = 64 * LDV;
    constexpr bool QLDS = (MODE == 2);
    constexpr int LDQL = 528;
    LAS unsigned char* ST = F.lds;
    LAS unsigned char* VTs = F.lds + ST_BYTES;
    LAS unsigned char* Os = VTs + 2 * VT_BYTES;
    LAS float* QN = (LAS float*)(Os + 64 * LDO);
    LAS float* RS = QN + 64;
    LAS float* NL = RS + 64;
    LAS float* BLA = NL + 512;
    LAS unsigned char* QL = (LAS unsigned char*)(BLA + 256);
    const int lane = F.lane, l15 = lane & 15, g = lane >> 4, w = F.wave, lt = w >> 1, eh = w & 1;
    const int nrow = EW + (l15 == 0 ? 0 : 1);
    constexpr int VPR = EW / 8;
    const int se = F.tid / VPR, sq = F.tid % VPR;
    const int tq = l15 >> 2, tp = l15 & 3;
    const bool stager = F.tid < 64 * VPR;
    const unsigned qs_lo = (unsigned)((F.tid >> 5) * LDQ + 8 * (F.tid & 31)) * 2u;
    const unsigned q_lo = (unsigned)((16 * lt + l15) * LDQ + 8 * g) * 2u, p_lo = (unsigned)((16 * lt + l15) * 64 + 8 * g) * 2u, v_lo = (unsigned)(se * LDVS + 8 * sq) * 2u, k_lo = (unsigned)lane * 16u;
    constexpr bool BG = (MODE == 0 || MODE == 1) && ABL == 0;
    const int gw_ = F.bid * NWAVES + F.wave, NGW_ = F.G * NWAVES;
    const int bg_n = (BG && cvt_layer >= 0) ? 2 * ((24576 + NGW_ - 1) / NGW_) : 0;
    const int bg_period = bg_n > 0 ? ((NCHUNK / bg_n) > 2 ? (NCHUNK / bg_n) : 2) : 1;
    int bg_done = 0;
    float bgx[32]; CvtJob bgj; bgj.wp = nullptr; bgj.op = nullptr; bgj.ld = 0; bool bg_pending = false;
    for (int u0 = F.bid; u0 < NB * 4 * NEB; u0 += F.G) {
        int eb, bh;
        if (F.G == 256) { const int x = u0 & 7, j = (u0 >> 3) & 31, r = u0 >> 8; bh = x * 4 + (j >> 3); eb = (j & 7) + 8 * r; }
        else { eb = u0 % NEB; bh = u0 / NEB; }
        const int h = bh & 3, b = bh >> 2;
        const size_t ubase = ((size_t)(b * 4 + h)) * NCHUNK;
        f32x4 S[MT][NER];
#pragma unroll
        for (int mt = 0; mt < MT; ++mt)
#pragma unroll
            for (int nt = 0; nt < NER; ++nt) S[mt][nt] = (f32x4){0.f, 0.f, 0.f, 0.f};
        if (ML) { NL[F.tid] = 0.f; }
        for (int i = F.tid; i < ST_BYTES / 4; i += NTHR) ((LAS unsigned*)ST)[i] = 0u;
        float vsc[8], rsi[4], rso[4], dec64 = 1.f;
        if (MODE == 0) {
            const float lg = log1pf(-exp2f(-5.0f - (float)h));
#pragma unroll
            for (int j = 0; j < 8; ++j) vsc[j] = __expf((float)(63 - se) * lg);
#pragma unroll
            for (int r = 0; r < 4; ++r) { const int l = 16 * lt + 4 * g + r; rsi[r] = __expf((float)(l - 63) * lg); rso[r] = __expf((float)(l + 1) * lg); }
            dec64 = __expf(64.0f * lg);
        }
        float m_prev = 0.f;
        bf16x8 qf[KS] = {}, pf[2] = {}, kf[MT][2] = {}; u32x4 qst[4] = {}; float recv = 0.f; u32x4 vraw = (u32x4){0u, 0u, 0u, 0u}; f32x4 z0 = (f32x4){0.f, 0.f, 0.f, 0.f}, z1 = z0, blv = z0, alv = z0, dcv = z0; float Amax = 0.f, blast = 0.f;
#define S2_PREFETCH(cc) do { const size_t uidx_ = ubase + (cc); const size_t t0_ = (size_t)b * SEQ + (size_t)(cc) * 64; \
          \
        if (stager) vraw = *(const u32x4*)((const char*)(VT + t0_ * LDVS + VH * h + EW * eb) + v_lo); \
        if (MODE == 1) dcv = *(const f32x4*)(REC + uidx_ * 128 + 16 * w + 4 * g); \
        if (ML) { const float* rec_ = REC + uidx_ * 192; z0.x = rec_[64 + (se & 63)]; \
            Amax = rec_[128 + 63]; blast = rec_[63]; if (F.tid < 128) recv = rec_[(F.tid < 64) ? F.tid : (64 + F.tid)]; } \
        _Pragma("unroll") for (int ks = 0; ks < 2; ++ks) pf[ks] = *(const bf16x8*)((const char*)(PT + uidx_ * 4096 + 32 * ks) + p_lo); \
        if (QLDS) { _Pragma("unroll") for (int i = 0; i < 4; ++i) qst[i] = *(const u32x4*)((const char*)(Q + (t0_ + 16 * i) * LDQ + QH * h) + qs_lo); } \
        if (ABL < 2 && !QLDS) { _Pragma("unroll") for (int ks = 0; ks < KSE; ++ks) qf[ks] = *(const bf16x8*)((const char*)(Q + t0_ * LDQ + QH * h + 32 * ks) + q_lo); } } while (0)
        S2_PREFETCH(0);
#define S2_VFRAG(dst, c0_, ks_) do { const LAS unsigned char* a_ = vt + (32 * (ks_) + 8 * g + tq) * LDV + 2 * ((c0_) + 4 * tp); \
        const s16x4 lo_ = __builtin_amdgcn_ds_read_tr16_b64_v4i16((LAS s16x4*)a_), hi_ = __builtin_amdgcn_ds_read_tr16_b64_v4i16((LAS s16x4*)(a_ + 4 * LDV)); \
        dst = (bf16x8){lo_.x, lo_.y, lo_.z, lo_.w, hi_.x, hi_.y, hi_.z, hi_.w}; } while (0)
        for (int c = 0; c < NCHUNK; ++c) {
            const size_t t0 = (size_t)b * SEQ + (size_t)c * 64;
            const size_t uidx = ubase + c;
            LAS unsigned char* vt = VTs + (c & 1) * VT_BYTES;
            const float Mx = fmaxf(m_prev, Amax), keep = ML ? __expf(m_prev - Mx) : 1.f, bl_c = blast;
            f32x4 blc = blv, alc = alv; const f32x4 dcc = dcv;
            if (stager) {
                u32x4 o = vraw;
                if (MODE != 1) {
                    float wrow = 1.f;
                    if (MODE == 0) wrow = vsc[0];
                    if (ML) wrow = __expf(z0.x - Mx);
                    o.x = pk2(bflo(vraw.x) * wrow, bfhi(vraw.x) * wrow); o.y = pk2(bflo(vraw.y) * wrow, bfhi(vraw.y) * wrow);
                    o.z = pk2(bflo(vraw.z) * wrow, bfhi(vraw.z) * wrow); o.w = pk2(bflo(vraw.w) * wrow, bfhi(vraw.w) * wrow);
                    if (ML && sq == 0) {
                        *(LAS u32x4*)(vt + se * LDV + 2 * EW) = (u32x4){pk2(wrow, 0.f), 0u, 0u, 0u};
                        *(LAS u32x4*)(vt + se * LDV + 2 * EW + 16) = (u32x4){0u, 0u, 0u, 0u}; }
                }
                *(LAS u32x4*)(vt + se * LDV + 16 * sq) = o;
            }
            asm volatile("" ::: "memory");
            if (QLDS) {
#pragma unroll
                for (int i = 0; i < 4; ++i) { const int p_ = F.tid + i * NTHR; *(LAS u32x4*)(QL + (p_ >> 5) * LDQL + 16 * (p_ & 31)) = qst[i]; }
                asm volatile("" ::: "memory");
#pragma unroll
                for (int ks = KS - KSE; ks < KS; ++ks) { if (ABL < 2) qf[ks] = *(const bf16x8*)((const char*)(Q + t0 * LDQ + QH * h + 32 * ks) + q_lo); }
            }
            if (ML) { if (F.tid < 128) BLA[(c & 1) * 128 + F.tid] = recv; }
            if (MODE != 2) {
#pragma unroll
                for (int mt = 0; mt < MT; ++mt)
#pragma unroll
                    for (int ks = 0; ks < 2; ++ks) if (ABL < 3) kf[mt][ks] = *(const bf16x8*)((const char*)(KT + uidx * (DK * 64) + ((((MT * w + mt) * 2 + ks) * 64) << 3)) + k_lo);
            }
            WG_SYNC_LDS();
            if (c > 0) {
                if (EW == 64) { const int r = F.tid >> 3, q = F.tid & 7; *(u32x4*)(mix + (t0 - 64 + r) * LDM + VH * h + EW * eb + 8 * q) = *(const LAS u32x4*)(Os + r * LDO + 16 * q); }
                else if (F.tid < 256) { const int r = F.tid >> 2, q = F.tid & 3; *(u32x4*)(mix + (t0 - 64 + r) * LDM + VH * h + EW * eb + 8 * q) = *(const LAS u32x4*)(Os + r * LDO + 16 * q); }
            }
            f32x4 oi[NJ], oo[NJ];
#pragma unroll
            for (int j = 0; j < NJ; ++j) { oi[j] = (f32x4){0.f, 0.f, 0.f, 0.f}; oo[j] = (f32x4){0.f, 0.f, 0.f, 0.f}; }
#pragma unroll
            for (int j = 0; j < NJ; ++j) { const int nt = eh + 2 * j;
                if (2 * j + 1 < NE || eh == 0) {
#pragma unroll
                    for (int ks = 0; ks < 2; ++ks) { bf16x8 vf; S2_VFRAG(vf, 16 * nt, ks);
                        if (ABL == 0) oi[j] = __builtin_amdgcn_mfma_f32_16x16x32_bf16(pf[ks], vf, oi[j], 0, 0, 0); else asm volatile("" :: "v"(vf), "v"(pf[ks])); } } }
#pragma unroll
            for (int ks = 0; ks < KS; ++ks) {
                bf16x8 qa;
                if (QLDS && ks < KS - KSE) qa = *(const LAS bf16x8*)(QL + (16 * lt + l15) * LDQL + 64 * ks + 16 * g); else qa = qf[ks];
#pragma unroll
                for (int j = 0; j < NJ; ++j) { const int nt = eh + 2 * j;
                    if ((2 * j + 1 < NE || eh == 0) && ABL < 4) { const bf16x8 sf = *(const LAS bf16x8*)(ST + ((ML && nt == NER) ? nrow : (16 * nt + l15)) * LDS_ST + 64 * ks + 16 * g);
                        if (ABL == 0) oo[j] = __builtin_amdgcn_mfma_f32_16x16x32_bf16(qa, sf, oo[j], 0, 0, 0); else asm volatile("" :: "v"(sf), "v"(qa)); } }
                if (MODE == 2 && (ks & 3) == 3) __builtin_amdgcn_sched_barrier(0);
            }
            if (ML) { if (((NE - 1) & 1) == eh && l15 == 0) {
#pragma unroll
                    for (int r = 0; r < 4; ++r) { QN[16 * lt + 4 * g + r] = oo[NJ - 1][r]; RS[16 * lt + 4 * g + r] = oi[NJ - 1][r]; } } }
            if (MODE == 2) {
#pragma unroll
                for (int mt = 0; mt < MT; ++mt)
#pragma unroll
                    for (int ks = 0; ks < 2; ++ks) if (ABL < 3) kf[mt][ks] = *(const bf16x8*)((const char*)(KT + uidx * (DK * 64) + ((((MT * w + mt) * 2 + ks) * 64) << 3)) + k_lo);
            }
            { const int cn = (c + 1 < NCHUNK) ? c + 1 : c; S2_PREFETCH(cn); }
            WG_SYNC_LDS();
            if (ML) { blc = *(const LAS f32x4*)(BLA + (c & 1) * 128 + 16 * lt + 4 * g); alc = *(const LAS f32x4*)(BLA + (c & 1) * 128 + 64 + 16 * lt + 4 * g); }
#pragma unroll
            for (int r = 0; r < 4; ++r) { const int l = 16 * lt + 4 * g + r;
                float ci = 1.f, co = 1.f;
                if (MODE == 0) { ci = rsi[r]; co = rso[r]; }
                if (ML) { const float Ml = fmaxf(m_prev, alc[r]), rho = __expf(Mx - Ml), wi = __expf(m_prev - Ml);
                    const float den = wi * QN[l] + rho * RS[l];
                    const float inv = 1.0f / fmaxf(fabsf(den), __expf(-(blc[r] + Ml)));
                    ci = rho * inv; co = wi * inv; }
#pragma unroll
                for (int j = 0; j < NER / 2; ++j) { const int nt = eh + 2 * j;
                    *(LAS unsigned short*)(Os + l * LDO + 2 * (16 * nt + l15)) = (unsigned short)f2bf(ci * oi[j][r] + co * oo[j][r]); } }
#pragma unroll
            for (int nt = 0; nt < NER; ++nt) {
                bf16x8 vf[2];
#pragma unroll
                for (int ks = 0; ks < 2; ++ks) S2_VFRAG(vf[ks], 16 * nt, ks);
#pragma unroll
                for (int mt = 0; mt < MT; ++mt) {
                    if (MODE == 0) S[mt][nt] = S[mt][nt] * dec64;
                    if (MODE == 1) S[mt][nt] = S[mt][nt] * dcc;
                    if (ML) S[mt][nt] = S[mt][nt] * keep;
#pragma unroll
                    for (int ks = 0; ks < 2; ++ks) { if (ABL == 0) S[mt][nt] = __builtin_amdgcn_mfma_f32_16x16x32_bf16(kf[mt][ks], vf[ks], S[mt][nt], 0, 0, 0); else asm volatile("" :: "v"(vf[ks]), "v"(kf[mt][ks])); }
                    u32x2 o; o.x = pk2(S[mt][nt][0], S[mt][nt][1]); o.y = pk2(S[mt][nt][2], S[mt][nt][3]);
                    if (ABL < 4) *(LAS u32x2*)(ST + (16 * nt + l15) * LDS_ST + 2 * (DK / 8 * w + 16 * mt + 4 * g)) = o; }
            }
            if (ML) {
                bf16x8 vf[2];
#pragma unroll
                for (int ks = 0; ks < 2; ++ks) S2_VFRAG(vf[ks], EW, ks);
#pragma unroll
                for (int mt = 0; mt < MT; ++mt) { const int d0 = DK / 8 * w + 16 * mt + 4 * g;
                    f32x4 na = (f32x4){0.f, 0.f, 0.f, 0.f};
                    if (l15 == 0) na = *(const LAS f32x4*)(NL + d0) * keep;
#pragma unroll
                    for (int ks = 0; ks < 2; ++ks) { if (ABL == 0) na = __builtin_amdgcn_mfma_f32_16x16x32_bf16(kf[mt][ks], vf[ks], na, 0, 0, 0); else asm volatile("" :: "v"(vf[ks]), "v"(kf[mt][ks])); }
                    if (l15 == 0) { *(LAS f32x4*)(NL + d0) = na; u32x2 o; o.x = pk2(na[0], na[1]); o.y = pk2(na[2], na[3]); *(LAS u32x2*)(ST + EW * LDS_ST + 2 * d0) = o; } }
            }
            if (ML) m_prev = bl_c + Mx;
            if (BG) {
                if (bg_pending) { cvt_half_store(bgj, bg_done & 1, bgx); bg_pending = false; ++bg_done; }
                else if (bg_done < bg_n && (c % bg_period) == 0) { const int gi = (bg_done >> 1) * NGW_ + gw_;
                    if (gi < 24576) { bgj = moe_cvt_job(in, ws, cvt_layer, gi, lane); cvt_half_load(bgj, bg_done & 1, bgx); bg_pending = true; } else ++bg_done; }
            }
        }
#undef S2_PREFETCH
#undef S2_VFRAG
        LDS_WAIT();
        __syncthreads();
        { const size_t t0 = (size_t)b * SEQ + (size_t)(NCHUNK - 1) * 64;
          if (EW == 64) { const int r = F.tid >> 3, q = F.tid & 7; *(u32x4*)(mix + (t0 + r) * LDM + VH * h + EW * eb + 8 * q) = *(const LAS u32x4*)(Os + r * LDO + 16 * q); }
          else if (F.tid < 256) { const int r = F.tid >> 2, q = F.tid & 3; *(u32x4*)(mix + (t0 + r) * LDM + VH * h + EW * eb + 8 * q) = *(const LAS u32x4*)(Os + r * LDO + 16 * q); } }
        LDS_WAIT();
        __syncthreads();
    }
    if (BG) {
        if (bg_pending) { cvt_half_store(bgj, bg_done & 1, bgx); ++bg_done; }
        for (; bg_done < bg_n; ++bg_done) { const int gi = (bg_done >> 1) * NGW_ + gw_;
            if (gi < 24576) { bgj = moe_cvt_job(in, ws, cvt_layer, gi, lane); cvt_half_load(bgj, bg_done & 1, bgx); cvt_half_store(bgj, bg_done & 1, bgx); } }
    }
}

template <int MODE>
__device__ __forceinline__ void s2x_phase(Frame& F, const bf16_t* Q, const bf16_t* PT, const bf16_t* KT, const bf16_t* VT, const float* REC, bf16_t* mix) {
    constexpr int DK = MODE == 0 ? 256 : 128, NER = MODE == 0 ? 4 : 2, EW = 16 * NER, KS = DK / 32, MTY = DK / 64, NEB = 8;
    constexpr int LDQ = MODE == 0 ? 6144 : 512, QH = MODE == 0 ? 256 : 128, VH = MODE == 1 ? 256 : 512, LDM = MODE == 1 ? 1024 : 2048;
    constexpr int LDS_ST = DK * 2 + 16, LDV = EW * 2 + 16, LDVS = MODE == 0 ? 6144 : 3072;
    constexpr int ST_BYTES = EW * LDS_ST, VT_BYTES = 64 * LDV, VPR = EW / 8;
    LAS unsigned char* ST = F.lds;
    LAS unsigned char* VTs = F.lds + 2 * ST_BYTES;
    const int lane = F.lane, l15 = lane & 15, g = lane >> 4, w = F.wave, lt = w & 3, yw = w & 3;
    const bool isX = w < 4;
    const int se = F.tid / VPR, sq = F.tid % VPR, tq = l15 >> 2, tp = l15 & 3;
    const bool stager = F.tid < 64 * VPR;
    unsigned q_lo = (unsigned)((16 * lt + l15) * LDQ + 8 * g) * 2u, p_lo = (unsigned)((16 * lt + l15) * 64 + 8 * g) * 2u, v_lo = (unsigned)(se * LDVS + 8 * sq) * 2u, k_lo = (unsigned)lane * 16u;
    unsigned o_lo = (unsigned)((16 * lt + l15) * LDM + 4 * g) * 2u;
    for (int u0 = F.bid; u0 < NB * 4 * NEB; u0 += F.G) {
        int eb, bh;
        if (F.G == 256) { const int x = u0 & 7, j = (u0 >> 3) & 31, r = u0 >> 8; bh = x * 4 + (j >> 3); eb = (j & 7) + 8 * r; }
        else { eb = u0 % NEB; bh = u0 / NEB; }
        const int h = bh & 3, b = bh >> 2;
        const size_t ubase = ((size_t)(b * 4 + h)) * NCHUNK;
        for (int i = F.tid; i < 2 * ST_BYTES / 4; i += NTHR) ((LAS unsigned*)ST)[i] = 0u;
        float vsc = 1.f, rsi = 1.f, rso = 1.f, dec64 = 1.f;
        if (MODE == 0) {
            const float lg = log1pf(-exp2f(-5.0f - (float)h));
            vsc = __expf((float)(63 - se) * lg);
            { const int l = 16 * lt + l15; rsi = __expf((float)(l - 63) * lg); rso = __expf((float)(l + 1) * lg); }
            dec64 = __expf(64.0f * lg);
        }
#define S2X_CL(cc) ((cc) < NCHUNK ? (cc) : NCHUNK - 1)
#define S2X_LOADX(QF, PF, cc) do { const size_t uidx_ = ubase + (cc); const size_t t0_ = (size_t)b * SEQ + (size_t)(cc) * 64; \
        _Pragma("unroll") for (int ks = 0; ks < 2; ++ks) PF[ks] = *(const bf16x8*)((const char*)(PT + uidx_ * 4096 + 32 * ks) + p_lo); \
        _Pragma("unroll") for (int ks = 0; ks < KS; ++ks) QF[ks] = *(const bf16x8*)((const char*)(Q + t0_ * LDQ + QH * h + 32 * ks) + q_lo); } while (0)
#define S2X_LOADY(KF, DC, cc) do { const size_t uidx_ = ubase + (cc); \
        _Pragma("unroll") for (int mt = 0; mt < MTY; ++mt) { \
            _Pragma("unroll") for (int ks = 0; ks < 2; ++ks) KF[mt][ks] = *(const bf16x8*)((const char*)(KT + uidx_ * (DK * 64) + ((((MTY * yw + mt) * 2 + ks) * 64) << 3)) + k_lo); \
            if (MODE == 1) DC[mt] = *(const f32x4*)(REC + uidx_ * 128 + 16 * (MTY * yw + mt) + 4 * g); } } while (0)
#define S2X_LOADV(VR, cc) do { const size_t t0_ = (size_t)b * SEQ + (size_t)(cc) * 64; if (stager) VR = *(const u32x4*)((const char*)(VT + t0_ * LDVS + VH * h + EW * eb) + v_lo); } while (0)
#define S2X_STAGE(VR, vt_) do { if (stager) { u32x4 o = VR; \
            if (MODE == 0) { o.x = pk2(bflo(VR.x) * vsc, bfhi(VR.x) * vsc); o.y = pk2(bflo(VR.y) * vsc, bfhi(VR.y) * vsc); o.z = pk2(bflo(VR.z) * vsc, bfhi(VR.z) * vsc); o.w = pk2(bflo(VR.w) * vsc, bfhi(VR.w) * vsc); } \
            *(LAS u32x4*)((vt_) + se * LDV + 16 * sq) = o; } } while (0)
#define S2X_VFRAG(dst, c0_, ks_) do { const LAS unsigned char* a_ = vt + (32 * (ks_) + 8 * g + tq) * LDV + 2 * ((c0_) + 4 * tp); \
        const s16x4 lo_ = __builtin_amdgcn_ds_read_tr16_b64_v4i16((LAS s16x4*)a_), hi_ = __builtin_amdgcn_ds_read_tr16_b64_v4i16((LAS s16x4*)(a_ + 4 * LDV)); \
        dst = (bf16x8){lo_.x, lo_.y, lo_.z, lo_.w, hi_.x, hi_.y, hi_.z, hi_.w}; } while (0)
        u32x4 vrA = (u32x4){0u, 0u, 0u, 0u}, vrB = vrA;
        S2X_LOADV(vrA, 0);
        if (isX) {
            bf16x8 qfA[KS], pfA[2], qfB[KS], pfB[2];
            S2X_LOADX(qfA, pfA, 0); S2X_LOADV(vrB, 1); S2X_LOADX(qfB, pfB, 1);
            S2X_STAGE(vrA, VTs);
            S2X_LOADV(vrA, 2);
            WG_SYNC_LDS();
#define S2X_XBODY(QF, PF, VRN, c) do { \
                asm volatile("" : "+v"(q_lo), "+v"(p_lo), "+v"(v_lo), "+v"(o_lo)); \
                const size_t t0 = (size_t)b * SEQ + (size_t)(c) * 64; \
                LAS unsigned char* vt = VTs + ((c) & 1) * VT_BYTES; \
                const LAS unsigned char* STr = ST + (((c) + 1) & 1) * ST_BYTES;           \
                f32x4 oi[NER], oo[NER]; \
                _Pragma("unroll") for (int nt = 0; nt < NER; ++nt) { oi[nt] = (f32x4){0.f, 0.f, 0.f, 0.f}; oo[nt] = (f32x4){0.f, 0.f, 0.f, 0.f}; } \
                _Pragma("unroll") for (int nt = 0; nt < NER; ++nt) _Pragma("unroll") for (int ks = 0; ks < 2; ++ks) { bf16x8 vf; S2X_VFRAG(vf, 16 * nt, ks); oi[nt] = __builtin_amdgcn_mfma_f32_16x16x32_bf16(vf, PF[ks], oi[nt], 0, 0, 0); } \
                _Pragma("unroll") for (int ks = 0; ks < KS; ++ks) _Pragma("unroll") for (int nt = 0; nt < NER; ++nt) { const bf16x8 sf = *(const LAS bf16x8*)(STr + (16 * nt + l15) * LDS_ST + 64 * ks + 16 * g); \
                        oo[nt] = __builtin_amdgcn_mfma_f32_16x16x32_bf16(sf, QF[ks], oo[nt], 0, 0, 0); } \
                S2X_LOADX(QF, PF, S2X_CL((c) + 2)); \
                  \
                _Pragma("unroll") for (int nt = 0; nt < NER; ++nt) { const f32x4 ov = oi[nt] * rsi + oo[nt] * rso; \
                    u32x2 o; o.x = pk2(ov[0], ov[1]); o.y = pk2(ov[2], ov[3]); \
                    *(u32x2*)((char*)(mix + t0 * LDM + VH * h + EW * eb + 16 * nt) + o_lo) = o; } \
                S2X_STAGE(VRN, VTs + (((c) + 1) & 1) * VT_BYTES); \
                S2X_LOADV(VRN, S2X_CL((c) + 3)); \
                WG_SYNC_LDS(); } while (0)
            for (int c = 0; c < NCHUNK; c += 2) { S2X_XBODY(qfA, pfA, vrB, c); S2X_XBODY(qfB, pfB, vrA, c + 1); }
#undef S2X_XBODY
        } else {
            bf16x8 kfA[MTY][2], kfB[MTY][2]; f32x4 dcA[MTY], dcB[MTY]; f32x4 S[MTY][NER];
#pragma unroll
            for (int mt = 0; mt < MTY; ++mt) { dcA[mt] = (f32x4){1.f, 1.f, 1.f, 1.f}; dcB[mt] = dcA[mt];
#pragma unroll
                for (int nt = 0; nt < NER; ++nt) S[mt][nt] = (f32x4){0.f, 0.f, 0.f, 0.f}; }
            S2X_LOADY(kfA, dcA, 0); S2X_LOADV(vrB, 1); S2X_LOADY(kfB, dcB, 1);
            S2X_STAGE(vrA, VTs);
            S2X_LOADV(vrA, 2);
            WG_SYNC_LDS();
#define S2X_YBODY(KF, DC, VRN, c) do { \
                asm volatile("" : "+v"(k_lo), "+v"(v_lo)); \
                LAS unsigned char* vt = VTs + ((c) & 1) * VT_BYTES; \
                LAS unsigned char* STw = ST + ((c) & 1) * ST_BYTES; \
                _Pragma("unroll") for (int nt = 0; nt < NER; ++nt) { \
                    bf16x8 vf[2]; \
                    _Pragma("unroll") for (int ks = 0; ks < 2; ++ks) S2X_VFRAG(vf[ks], 16 * nt, ks); \
                    _Pragma("unroll") for (int mt = 0; mt < MTY; ++mt) { \
                        if (MODE == 0) S[mt][nt] = S[mt][nt] * dec64; else S[mt][nt] = S[mt][nt] * DC[mt]; \
                        _Pragma("unroll") for (int ks = 0; ks < 2; ++ks) S[mt][nt] = __builtin_amdgcn_mfma_f32_16x16x32_bf16(KF[mt][ks], vf[ks], S[mt][nt], 0, 0, 0); \
                        u32x2 o; o.x = pk2(S[mt][nt][0], S[mt][nt][1]); o.y = pk2(S[mt][nt][2], S[mt][nt][3]); \
                        *(LAS u32x2*)(STw + (16 * nt + l15) * LDS_ST + 2 * (16 * (MTY * yw + mt) + 4 * g)) = o; } } \
                S2X_LOADY(KF, DC, S2X_CL((c) + 2)); \
                S2X_STAGE(VRN, VTs + (((c) + 1) & 1) * VT_BYTES); \
                S2X_LOADV(VRN, S2X_CL((c) + 3)); \
                WG_SYNC_LDS(); } while (0)
            for (int c = 0; c < NCHUNK; c += 2) { S2X_YBODY(kfA, dcA, vrB, c); S2X_YBODY(kfB, dcB, vrA, c + 1); }
#undef S2X_YBODY
        }
#undef S2X_CL
#undef S2X_LOADX
#undef S2X_LOADY
#undef S2X_LOADV
#undef S2X_STAGE
#undef S2X_VFRAG
    }
}

__device__ __forceinline__ void s2m_phase(Frame& F, const bf16_t* Q, const bf16_t* PT, const bf16_t* KT, const bf16_t* VT, const float* REC, bf16_t* mix) {
    constexpr int DK = 512, NER = 4, NE = 5, EW = 64, KS = 16, MTY = 8, NEB = 8;
    constexpr int LDQ = 2048, QH = 512, VH = 512, LDM = 2048, LDVS = 2048;
    constexpr int LDS_ST = DK * 2 + 16, VCOLS = EW + 16, LDV = VCOLS * 2 + 16, NROWS = EW + 2;
    constexpr int ST_BYTES = NROWS * LDS_ST, VT_BYTES = 64 * LDV;
    LAS unsigned char* ST = F.lds;
    LAS unsigned char* VTs = F.lds + 2 * ST_BYTES;
    LAS float* NL = (LAS float*)(VTs + 2 * VT_BYTES);
    static_assert(2 * ST_BYTES + 2 * VT_BYTES + 2048 <= LDS_MISC, "s2m LDS");
    const int lane = F.lane, l15 = lane & 15, g = lane >> 4, w = F.wave, lt = w & 3, yw = w & 3;
    const bool isX = w < 4;
    const int se = (F.tid & 255) >> 2, sq = 2 * (F.tid & 3), tq = l15 >> 2, tp = l15 & 3;
    const int nrow = EW + (l15 == 0 ? 0 : 1);
    unsigned q_lo = (unsigned)((16 * lt + l15) * LDQ + 8 * g) * 2u, p_lo = (unsigned)((16 * lt + l15) * 64 + 8 * g) * 2u, v_lo = (unsigned)(se * LDVS + 8 * sq) * 2u, k_lo = (unsigned)lane * 16u;
    unsigned o_lo = (unsigned)((16 * lt + l15) * LDM + 4 * g) * 2u;
    unsigned rb_lo = (unsigned)(16 * lt + l15) * 4u, rz_lo = (unsigned)(64 + se) * 4u;
    unsigned st_lo = (unsigned)(l15 * LDS_ST + 2 * (16 * MTY * yw + 4 * g)), nl_lo = (unsigned)(4 * (16 * MTY * yw + 4 * g)), sn_lo = (unsigned)(EW * LDS_ST + 2 * (16 * MTY * yw + 4 * g));
    for (int u0 = F.bid; u0 < NB * 4 * NEB; u0 += F.G) {
        int eb, bh;
        if (F.G == 256) { const int x = u0 & 7, j = (u0 >> 3) & 31, r = u0 >> 8; bh = x * 4 + (j >> 3); eb = (j & 7) + 8 * r; }
        else { eb = u0 % NEB; bh = u0 / NEB; }
        const int h = bh & 3, b = bh >> 2;
        const size_t ubase = ((size_t)(b * 4 + h)) * NCHUNK;
        for (int i = F.tid; i < 2 * ST_BYTES / 4; i += NTHR) ((LAS unsigned*)ST)[i] = 0u;
        NL[F.tid] = 0.f;
        u32x4 vraw[2] = {(u32x4){0u, 0u, 0u, 0u}, (u32x4){0u, 0u, 0u, 0u}}; float z_s = 0.f, Amax_s = 0.f, blast_s = 0.f;
#define S2M_RFL(x) __builtin_bit_cast(float, __builtin_amdgcn_readfirstlane(__builtin_bit_cast(int, (float)(x))))
#define S2M_LOADS(cc) do { const float* rec_ = REC + (ubase + (cc)) * 192; Amax_s = rec_[128 + 63]; blast_s = rec_[63]; } while (0)
#define S2M_LOADV(cc) do { const size_t t0_ = (size_t)b * SEQ + (size_t)(cc) * 64; const float* rec_ = REC + (ubase + (cc)) * 192; \
        vraw[0] = *(const u32x4*)((const char*)(VT + t0_ * LDVS + VH * h + EW * eb) + v_lo); vraw[1] = *(const u32x4*)((const char*)(VT + t0_ * LDVS + VH * h + EW * eb + 8) + v_lo); \
        z_s = *(const float*)((const char*)rec_ + rz_lo); Amax_s = rec_[128 + 63]; blast_s = rec_[63]; } while (0)
#define S2M_STAGE(vt_, Mx_) do { const float wrow = __expf(z_s - (Mx_)); \
        _Pragma("unroll") for (int i_ = 0; i_ < 2; ++i_) { u32x4 o; const u32x4 vr_ = vraw[i_]; \
            o.x = pk2(bflo(vr_.x) * wrow, bfhi(vr_.x) * wrow); o.y = pk2(bflo(vr_.y) * wrow, bfhi(vr_.y) * wrow); o.z = pk2(bflo(vr_.z) * wrow, bfhi(vr_.z) * wrow); o.w = pk2(bflo(vr_.w) * wrow, bfhi(vr_.w) * wrow); \
            *(LAS u32x4*)((vt_) + se * LDV + 16 * (sq + i_)) = o; } \
        if (sq == 0) { *(LAS u32x4*)((vt_) + se * LDV + 2 * EW) = (u32x4){pk2(wrow, 0.f), 0u, 0u, 0u}; *(LAS u32x4*)((vt_) + se * LDV + 2 * EW + 16) = (u32x4){0u, 0u, 0u, 0u}; } } while (0)
#define S2M_VFRAG(dst, c0_, ks_) do { const LAS unsigned char* a_ = vt + (32 * (ks_) + 8 * g + tq) * LDV + 2 * ((c0_) + 4 * tp); \
        const s16x4 lo_ = __builtin_amdgcn_ds_read_tr16_b64_v4i16((LAS s16x4*)a_), hi_ = __builtin_amdgcn_ds_read_tr16_b64_v4i16((LAS s16x4*)(a_ + 4 * LDV)); \
        dst = (bf16x8){lo_.x, lo_.y, lo_.z, lo_.w, hi_.x, hi_.y, hi_.z, hi_.w}; } while (0)
        float m_prev = 0.f, Mx, keep, bl_c;
        if (isX) { S2M_LOADV(0); } else { S2M_LOADS(0); }
        Mx = S2M_RFL(fmaxf(m_prev, Amax_s)); keep = S2M_RFL(__expf(m_prev - Mx)); bl_c = S2M_RFL(blast_s);
        if (isX) { S2M_STAGE(VTs, Mx); S2M_LOADV(1); } else { S2M_LOADS(1); }
#define S2M_ADVANCE(XR) do { const float m_next = S2M_RFL(bl_c + Mx), Mx_next = S2M_RFL(fmaxf(m_next, Amax_s)), bl_next = S2M_RFL(blast_s); \
        if (XR) { S2M_STAGE(VTs + ((c + 1) & 1) * VT_BYTES, Mx_next); S2M_LOADV(cn2); } else { S2M_LOADS(cn2); } \
        m_prev = m_next; Mx = Mx_next; keep = S2M_RFL(__expf(m_prev - Mx)); bl_c = bl_next; } while (0)
        if (isX) {
            bf16x8 qf[KS], pf[2]; float b_l, a_l;
#define S2M_LOADX(cc) do { const size_t uidx_ = ubase + (cc); const size_t t0_ = (size_t)b * SEQ + (size_t)(cc) * 64; const float* rec_ = REC + uidx_ * 192; \
            _Pragma("unroll") for (int ks = 0; ks < 2; ++ks) pf[ks] = *(const bf16x8*)((const char*)(PT + uidx_ * 4096 + 32 * ks) + p_lo); \
            _Pragma("unroll") for (int ks = 0; ks < KS; ++ks) qf[ks] = *(const bf16x8*)((const char*)(Q + t0_ * LDQ + QH * h + 32 * ks) + q_lo); \
            b_l = *(const float*)((const char*)rec_ + rb_lo); a_l = *(const float*)((const char*)(rec_ + 128) + rb_lo); } while (0)
            S2M_LOADX(0);
            WG_SYNC_LDS();
            for (int c = 0; c < NCHUNK; ++c) {
                asm volatile("" : "+v"(q_lo), "+v"(p_lo), "+v"(v_lo), "+v"(rb_lo), "+v"(rz_lo), "+v"(o_lo));
                const size_t t0 = (size_t)b * SEQ + (size_t)c * 64;
                const int cn = (c + 1 < NCHUNK) ? c + 1 : c, cn2 = (c + 2 < NCHUNK) ? c + 2 : NCHUNK - 1;
                LAS unsigned char* vt = VTs + (c & 1) * VT_BYTES;
                const LAS unsigned char* STr = ST + ((c + 1) & 1) * ST_BYTES;
                f32x4 oi[NE], oo[NE];
#pragma unroll
                for (int nt = 0; nt < NE; ++nt) { oi[nt] = (f32x4){0.f, 0.f, 0.f, 0.f}; oo[nt] = (f32x4){0.f, 0.f, 0.f, 0.f}; }
#pragma unroll
                for (int nt = 0; nt < NE; ++nt)
#pragma unroll
                    for (int ks = 0; ks < 2; ++ks) { bf16x8 vf; S2M_VFRAG(vf, 16 * nt, ks); oi[nt] = __builtin_amdgcn_mfma_f32_16x16x32_bf16(vf, pf[ks], oi[nt], 0, 0, 0); }
#pragma unroll
                for (int ks = 0; ks < KS; ++ks) {
#pragma unroll
                    for (int nt = 0; nt < NE; ++nt) { const bf16x8 sf = *(const LAS bf16x8*)(STr + ((nt == NER) ? nrow : (16 * nt + l15)) * LDS_ST + 64 * ks + 16 * g);
                        oo[nt] = __builtin_amdgcn_mfma_f32_16x16x32_bf16(sf, qf[ks], oo[nt], 0, 0, 0); }
                    if ((ks & 3) == 3) __builtin_amdgcn_sched_barrier(0);
                }
                const float QNl = __shfl(oo[NER][0], l15), RSl = __shfl(oi[NER][0], l15);
                const float Ml = fmaxf(m_prev, a_l), rho = __expf(Mx - Ml), wi = __expf(m_prev - Ml);
                const float den = wi * QNl + rho * RSl;
                const float inv = 1.0f / fmaxf(fabsf(den), __expf(-(b_l + Ml)));
                const float ci = rho * inv, co = wi * inv;
#pragma unroll
                for (int nt = 0; nt < NER; ++nt) { const f32x4 ov = oi[nt] * ci + oo[nt] * co;
                    u32x2 o; o.x = pk2(ov[0], ov[1]); o.y = pk2(ov[2], ov[3]);
                    *(u32x2*)((char*)(mix + t0 * LDM + VH * h + EW * eb + 16 * nt) + o_lo) = o; }
                S2M_LOADX(cn);
                S2M_ADVANCE(true);
                WG_SYNC_LDS();
            }
#undef S2M_LOADX
        } else {
            bf16x8 kf[MTY][2]; f32x4 S[MTY][NER];
#pragma unroll
            for (int mt = 0; mt < MTY; ++mt)
#pragma unroll
                for (int nt = 0; nt < NER; ++nt) S[mt][nt] = (f32x4){0.f, 0.f, 0.f, 0.f};
#define S2M_LOADY(cc) do { const size_t uidx_ = ubase + (cc); \
            _Pragma("unroll") for (int mt = 0; mt < MTY; ++mt) _Pragma("unroll") for (int ks = 0; ks < 2; ++ks) \
                kf[mt][ks] = *(const bf16x8*)((const char*)(KT + uidx_ * (DK * 64) + ((((MTY * yw + mt) * 2 + ks) * 64) << 3)) + k_lo); } while (0)
            S2M_LOADY(0);
            WG_SYNC_LDS();
            for (int c = 0; c < NCHUNK; ++c) {
                asm volatile("" : "+v"(k_lo), "+v"(st_lo), "+v"(nl_lo), "+v"(sn_lo));
                const int cn = (c + 1 < NCHUNK) ? c + 1 : c, cn2 = (c + 2 < NCHUNK) ? c + 2 : NCHUNK - 1;
                LAS unsigned char* vt = VTs + (c & 1) * VT_BYTES;
                LAS unsigned char* STw = ST + (c & 1) * ST_BYTES;
#pragma unroll
                for (int nt = 0; nt < NER; ++nt) {
                    bf16x8 vf[2];
#pragma unroll
                    for (int ks = 0; ks < 2; ++ks) S2M_VFRAG(vf[ks], 16 * nt, ks);
#pragma unroll
                    for (int mt = 0; mt < MTY; ++mt) {
                        S[mt][nt] = S[mt][nt] * keep;
#pragma unroll
                        for (int ks = 0; ks < 2; ++ks) S[mt][nt] = __builtin_amdgcn_mfma_f32_16x16x32_bf16(kf[mt][ks], vf[ks], S[mt][nt], 0, 0, 0);
                        u32x2 o; o.x = pk2(S[mt][nt][0], S[mt][nt][1]); o.y = pk2(S[mt][nt][2], S[mt][nt][3]);
                        *(LAS u32x2*)(STw + st_lo + (16 * nt * LDS_ST + 32 * mt)) = o; }
                }
                {
                    bf16x8 vf[2];
#pragma unroll
                    for (int ks = 0; ks < 2; ++ks) S2M_VFRAG(vf[ks], EW, ks);
#pragma unroll
                    for (int mt = 0; mt < MTY; ++mt) {
                        f32x4 na = (f32x4){0.f, 0.f, 0.f, 0.f};
                        if (l15 == 0) na = *(const LAS f32x4*)((LAS unsigned char*)NL + nl_lo + 64 * mt) * keep;
#pragma unroll
                        for (int ks = 0; ks < 2; ++ks) na = __builtin_amdgcn_mfma_f32_16x16x32_bf16(kf[mt][ks], vf[ks], na, 0, 0, 0);
                        if (l15 == 0) { *(LAS f32x4*)((LAS unsigned char*)NL + nl_lo + 64 * mt) = na; u32x2 o; o.x = pk2(na[0], na[1]); o.y = pk2(na[2], na[3]); *(LAS u32x2*)(STw + sn_lo + 32 * mt) = o; } }
                }
                S2M_LOADY(cn);
                S2M_ADVANCE(false);
                WG_SYNC_LDS();
            }
#undef S2M_LOADY
        }
#undef S2M_ADVANCE
#undef S2M_LOADV
#undef S2M_LOADS
#undef S2M_RFL
#undef S2M_STAGE
#undef S2M_VFRAG
    }
}
template <int MODE>
__device__ __forceinline__ void hn_phase(Frame& F, const bf16_t* mix, const bf16_t* gate, const bf16_t* xc, const float* gn, const float* skip, bf16_t* amix) {
    constexpr int HD = MODE == 1 ? 256 : 512, NV = HD / 64;
    constexpr int LDM = 4 * HD;
    constexpr int LDG = MODE == 0 ? 6144 : (MODE == 1 ? 3072 : 4096), GOFF = MODE == 0 ? 4096 : 2048;
    const int gw = F.bid * NWAVES + F.wave, NGW = F.G * NWAVES, lane = F.lane;
    for (int t = gw; t < T; t += NGW) {
        float v[4][NV], gv[4][NV], xv[4][NV];
#pragma unroll
        for (int h = 0; h < 4; ++h) {
            if (NV == 8) {
                const u32x4 a = *(const u32x4*)(mix + (size_t)t * LDM + HD * h + 8 * lane), b = *(const u32x4*)(gate + (size_t)t * LDG + GOFF + HD * h + 8 * lane);
                v[h][0] = bflo(a.x); v[h][1] = bfhi(a.x); v[h][2] = bflo(a.y); v[h][3] = bfhi(a.y); v[h][4 % NV] = bflo(a.z); v[h][5 % NV] = bfhi(a.z); v[h][6 % NV] = bflo(a.w); v[h][7 % NV] = bfhi(a.w);
                gv[h][0] = bflo(b.x); gv[h][1] = bfhi(b.x); gv[h][2] = bflo(b.y); gv[h][3] = bfhi(b.y); gv[h][4 % NV] = bflo(b.z); gv[h][5 % NV] = bfhi(b.z); gv[h][6 % NV] = bflo(b.w); gv[h][7 % NV] = bfhi(b.w);
                if (MODE == 2) { const u32x4 c = *(const u32x4*)(xc + (size_t)t * LDM + HD * h + 8 * lane);
                    xv[h][0] = bflo(c.x); xv[h][1] = bfhi(c.x); xv[h][2] = bflo(c.y); xv[h][3] = bfhi(c.y); xv[h][4 % NV] = bflo(c.z); xv[h][5 % NV] = bfhi(c.z); xv[h][6 % NV] = bflo(c.w); xv[h][7 % NV] = bfhi(c.w); }
            } else {
                const u32x2 a = *(const u32x2*)(mix + (size_t)t * LDM + HD * h + 4 * lane), b = *(const u32x2*)(gate + (size_t)t * LDG + GOFF + HD * h + 4 * lane);
                v[h][0] = bflo(a.x); v[h][1] = bfhi(a.x); v[h][2] = bflo(a.y); v[h][3] = bfhi(a.y);
                gv[h][0] = bflo(b.x); gv[h][1] = bfhi(b.x); gv[h][2] = bflo(b.y); gv[h][3] = bfhi(b.y);
            }
        }
#pragma unroll
        for (int h = 0; h < 4; ++h) {
            if (MODE != 1) { float s = 0.f;
#pragma unroll
                for (int j = 0; j < NV; ++j) s += v[h][j];
                const float mean = wave_sum(s) * (1.0f / HD);
#pragma unroll
                for (int j = 0; j < NV; ++j) v[h][j] -= mean; }
            float q = 0.f;
#pragma unroll
            for (int j = 0; j < NV; ++j) q += v[h][j] * v[h][j];
            const float rstd = rsqrtf(wave_sum(q) * (1.0f / HD) + EPS);
            float o[NV];
#pragma unroll
            for (int j = 0; j < NV; ++j) { const int ch = HD * h + NV * lane + j;
                float y = v[h][j] * rstd * gn[ch];
                if (MODE == 2) y += skip[ch] * xv[h][j];
                o[j] = y * siluf_(gv[h][j]); }
            if (OUT_FP8) { unsigned char* a8 = (unsigned char*)amix;
                if (NV == 8) { u32x2 ow; ow.x = pk4_fp8(o[0], o[1], o[2], o[3]); ow.y = pk4_fp8(o[4 % NV], o[5 % NV], o[6 % NV], o[7 % NV]); *(u32x2*)(a8 + (size_t)t * LDM + HD * h + 8 * lane) = ow; }
                else *(unsigned*)(a8 + (size_t)t * LDM + HD * h + 4 * lane) = pk4_fp8(o[0], o[1], o[2], o[3]); }
            else if (NV == 8) { u32x4 ow; ow.x = pk2(o[0], o[1]); ow.y = pk2(o[2], o[3]); ow.z = pk2(o[4 % NV], o[5 % NV]); ow.w = pk2(o[6 % NV], o[7 % NV]);
                *(u32x4*)(amix + (size_t)t * LDM + HD * h + 8 * lane) = ow; }
            else { u32x2 ow; ow.x = pk2(o[0], o[1]); ow.y = pk2(o[2], o[3]); *(u32x2*)(amix + (size_t)t * LDM + HD * h + 4 * lane) = ow; }
        }
    }
}
__device__ __forceinline__ int kt_off(int d, int m) { return ((((d >> 4) * 2 + (m >> 5)) * 64 + 16 * ((m >> 3) & 3) + (d & 15)) << 3) + (m & 7); }

template <int NC, bool FRAG>
__device__ __forceinline__ void s1_write_transposed(const LAS unsigned char* src, int ldb, bf16_t* dst, int tid) {
    for (int p = tid; p < NC * 8; p += NTHR) {
        const int col = p % NC, mc = p / NC;
        unsigned short v[8];
#pragma unroll
        for (int e = 0; e < 8; ++e) v[e] = *(const LAS unsigned short*)(src + (size_t)(8 * mc + e) * ldb + 2 * col);
        u32x4 w; w.x = v[0] | ((unsigned)v[1] << 16); w.y = v[2] | ((unsigned)v[3] << 16); w.z = v[4] | ((unsigned)v[5] << 16); w.w = v[6] | ((unsigned)v[7] << 16);
        const int off = FRAG ? kt_off(col, 8 * mc) : (col * 64 + 8 * mc);
        *(u32x4*)(dst + off) = w;
    }
}
template <int DK>
__device__ __forceinline__ void s1_write_kt_tr(const LAS unsigned char* src, int ldb, bf16_t* dst, int wave, int lane) {
    const int l15 = lane & 15, g = lane >> 4, q = l15 >> 2, p = l15 & 3;
#pragma unroll
    for (int f = wave; f < (DK / 16) * 2; f += NWAVES) {
        const int dt = f >> 1, ks = f & 1;
        const LAS unsigned char* a = src + (32 * ks + 8 * g + q) * ldb + 2 * (16 * dt + 4 * p);
        const s16x4 lo = __builtin_amdgcn_ds_read_tr16_b64_v4i16((LAS s16x4*)a), hi = __builtin_amdgcn_ds_read_tr16_b64_v4i16((LAS s16x4*)(a + 4 * ldb));
        const bf16x8 v = (bf16x8){lo.x, lo.y, lo.z, lo.w, hi.x, hi.y, hi.z, hi.w};
        *(bf16x8*)(dst + ((size_t)f * 64 + lane) * 8) = v;
    }
}
template <int NC>
__device__ __forceinline__ void s1_load_tile(const bf16_t* src, int ld, LAS unsigned char* dst, int ldb, int tid) {
    constexpr int PPR = NC / 8;
    for (int p = tid; p < 64 * PPR; p += NTHR) { const int r = p / PPR, q = p % PPR;
        *(LAS u32x4*)(dst + (size_t)r * ldb + 16 * q) = *(const u32x4*)(src + (size_t)r * ld + 8 * q); }
}

template <int NC>
__device__ __forceinline__ void s1_gload(const bf16_t* src, int ld, u32x4 (&r)[64 * NC / 8 / NTHR], int tid) {
    constexpr int PPR = NC / 8;
#pragma unroll
    for (int i = 0; i < 64 * NC / 8 / NTHR; ++i) { const int p = tid + i * NTHR, row = p / PPR, q = p % PPR; r[i] = *(const u32x4*)(src + (size_t)row * ld + 8 * q); }
}
template <int NC>
__device__ __forceinline__ void s1_lstore(const u32x4 (&r)[64 * NC / 8 / NTHR], LAS unsigned char* dst, int ldb, int tid) {
    constexpr int PPR = NC / 8;
#pragma unroll
    for (int i = 0; i < 64 * NC / 8 / NTHR; ++i) { const int p = tid + i * NTHR, row = p / PPR, q = p % PPR; *(LAS u32x4*)(dst + (size_t)row * ldb + 16 * q) = r[i]; }
}
__device__ __forceinline__ void ret_s1_phase(Frame& F, const bf16_t* proj, bf16_t* PT, bf16_t* KT, bf16_t* VT) {
    constexpr int LDK = 528, LDV = 1040, LDP = 144;
    LAS unsigned char* Ks = F.lds;
    LAS unsigned char* Vs = F.lds + 33792;
    LAS unsigned char* Ps = F.lds + 33792 + 66560;
    const int lane = F.lane, l15 = lane & 15, g = lane >> 4, w = F.wave, lt = w >> 1, mh = w & 1;
    u32x4 kr[4]; bf16x8 qf[8];
#define RS1_LOAD(uu) do { const int c_ = (uu) % NCHUNK, h_ = ((uu) / NCHUNK) % 4, b_ = (uu) / (NCHUNK * 4); const size_t t0_ = (size_t)b_ * SEQ + (size_t)c_ * 64; \
        s1_gload<256>(proj + t0_ * 6144 + 1024 + 256 * h_, 6144, kr, F.tid); \
        _Pragma("unroll") for (int ks = 0; ks < 8; ++ks) qf[ks] = *(const bf16x8*)(proj + (t0_ + 16 * lt + l15) * 6144 + 256 * h_ + 32 * ks + 8 * g); } while (0)
    if (F.bid < NB * 4 * NCHUNK) RS1_LOAD(F.bid);
    for (int u = F.bid; u < NB * 4 * NCHUNK; u += F.G) {
        s1_lstore<256>(kr, Ks, LDK, F.tid);
        WG_SYNC_LDS();
        f32x4 acc[2];
#pragma unroll
        for (int nt = 0; nt < 2; ++nt) { acc[nt] = (f32x4){0.f, 0.f, 0.f, 0.f};
#pragma unroll
            for (int ks = 0; ks < 8; ++ks) { const bf16x8 kf = *(const LAS bf16x8*)(Ks + (size_t)(32 * mh + 16 * nt + l15) * LDK + 64 * ks + 16 * g);
                acc[nt] = __builtin_amdgcn_mfma_f32_16x16x32_bf16(qf[ks], kf, acc[nt], 0, 0, 0); } }
#pragma unroll
        for (int nt = 0; nt < 2; ++nt)
#pragma unroll
            for (int r = 0; r < 4; ++r) { const int l = 16 * lt + 4 * g + r, m = 32 * mh + 16 * nt + l15;
                *(LAS unsigned short*)(Ps + l * LDP + 2 * m) = (unsigned short)f2bf(m <= l ? acc[nt][r] : 0.f); }
        { const int un = u + F.G; if (un < NB * 4 * NCHUNK) RS1_LOAD(un); }
        WG_SYNC_LDS();
        { const int r = F.tid >> 3, q = F.tid & 7; *(u32x4*)(PT + (size_t)u * 4096 + r * 64 + 8 * q) = *(const LAS u32x4*)(Ps + r * LDP + 16 * q); }
        s1_write_kt_tr<256>(Ks, LDK, KT + (size_t)u * 256 * 64, F.wave, lane);
        WG_SYNC_LDS();
    }
#undef RS1_LOAD
}

__device__ __forceinline__ void ret_s2_phase(Frame& F, const bf16_t* proj, const bf16_t* PT, const bf16_t* KT, const bf16_t* VT, bf16_t* mix) {
    constexpr int LDS_ST = 528, LDV = 144, LDO = 144;
    LAS unsigned char* ST = F.lds;
    LAS unsigned char* VTs = F.lds + 33792;
    LAS unsigned char* Os = F.lds + 33792 + 18432;
    const int lane = F.lane, l15 = lane & 15, g = lane >> 4, w = F.wave, lt = w >> 1, eh = w & 1;
    for (int u = F.bid; u < NB * 4 * 8; u += F.G) {
        const int eb = u & 7, h = (u >> 3) & 3, b = u >> 5;
        const float lg = log1pf(-exp2f(-5.0f - (float)h));
        f32x4 S[2][4];
#pragma unroll
        for (int mt = 0; mt < 2; ++mt)
#pragma unroll
            for (int nt = 0; nt < 4; ++nt) S[mt][nt] = (f32x4){0.f, 0.f, 0.f, 0.f};
        for (int i = F.tid; i < 33792 / 4; i += NTHR) ((LAS unsigned*)ST)[i] = 0u;
        const float dec64 = __expf(64.0f * lg);
        for (int c = 0; c < NCHUNK; ++c) {
            const size_t t0 = (size_t)b * SEQ + (size_t)c * 64;
            const size_t uidx = ((size_t)(b * 4 + h)) * NCHUNK + c;
            LAS unsigned char* vt = VTs + (c & 1) * 9216;
            bf16x8 kf[2][2], qf[8], pf[2];
#pragma unroll
            for (int mt = 0; mt < 2; ++mt)
#pragma unroll
                for (int ks = 0; ks < 2; ++ks) kf[mt][ks] = *(const bf16x8*)(KT + uidx * (256 * 64) + ((((2 * w + mt) * 2 + ks) * 64 + lane) << 3));
#pragma unroll
            for (int ks = 0; ks < 8; ++ks) qf[ks] = *(const bf16x8*)(proj + (t0 + 16 * lt + l15) * 6144 + 256 * h + 32 * ks + 8 * g);
#pragma unroll
            for (int ks = 0; ks < 2; ++ks) pf[ks] = *(const bf16x8*)(PT + uidx * 4096 + (16 * lt + l15) * 64 + 32 * ks + 8 * g);
            {
                const int e = F.tid >> 3, q = F.tid & 7;
                const u32x4 raw = *(const u32x4*)(VT + uidx * (512 * 64) + (size_t)(64 * eb + e) * 64 + 8 * q);
                float f[8] = {bflo(raw.x), bfhi(raw.x), bflo(raw.y), bfhi(raw.y), bflo(raw.z), bfhi(raw.z), bflo(raw.w), bfhi(raw.w)};
#pragma unroll
                for (int j = 0; j < 8; ++j) f[j] *= __expf((float)(63 - (8 * q + j)) * lg);
                u32x4 o; o.x = pk2(f[0], f[1]); o.y = pk2(f[2], f[3]); o.z = pk2(f[4], f[5]); o.w = pk2(f[6], f[7]);
                *(LAS u32x4*)(vt + e * LDV + 16 * q) = o;
            }
            LDS_WAIT();
            __syncthreads();
            f32x4 oi[2], oo[2];
#pragma unroll
            for (int nt = 0; nt < 2; ++nt) {
                const int e = 32 * eh + 16 * nt + l15;
                oi[nt] = (f32x4){0.f, 0.f, 0.f, 0.f}; oo[nt] = (f32x4){0.f, 0.f, 0.f, 0.f};
#pragma unroll
                for (int ks = 0; ks < 2; ++ks) { const bf16x8 vf = *(const LAS bf16x8*)(vt + e * LDV + 64 * ks + 16 * g);
                    oi[nt] = __builtin_amdgcn_mfma_f32_16x16x32_bf16(pf[ks], vf, oi[nt], 0, 0, 0); }
#pragma unroll
                for (int ks = 0; ks < 8; ++ks) { const bf16x8 sf = *(const LAS bf16x8*)(ST + e * LDS_ST + 64 * ks + 16 * g);
                    oo[nt] = __builtin_amdgcn_mfma_f32_16x16x32_bf16(qf[ks], sf, oo[nt], 0, 0, 0); }
            }
#pragma unroll
            for (int r = 0; r < 4; ++r) { const int l = 16 * lt + 4 * g + r;
                const float si = __expf((float)(l - 63) * lg), so = __expf((float)(l + 1) * lg);
#pragma unroll
                for (int nt = 0; nt < 2; ++nt) *(LAS unsigned short*)(Os + l * LDO + 2 * (32 * eh + 16 * nt + l15)) = (unsigned short)f2bf(si * oi[nt][r] + so * oo[nt][r]); }
            LDS_WAIT();
            __syncthreads();
            { const int r = F.tid >> 3, q = F.tid & 7; *(u32x4*)(mix + (t0 + r) * 2048 + 512 * h + 64 * eb + 8 * q) = *(const LAS u32x4*)(Os + r * LDO + 16 * q); }
#pragma unroll
            for (int mt = 0; mt < 2; ++mt)
#pragma unroll
                for (int nt = 0; nt < 4; ++nt) { S[mt][nt] = S[mt][nt] * dec64;
#pragma unroll
                    for (int ks = 0; ks < 2; ++ks) { const bf16x8 vf = *(const LAS bf16x8*)(vt + (16 * nt + l15) * LDV + 64 * ks + 16 * g);
                        S[mt][nt] = __builtin_amdgcn_mfma_f32_16x16x32_bf16(kf[mt][ks], vf, S[mt][nt], 0, 0, 0); }
                    u32x2 o; o.x = pk2(S[mt][nt][0], S[mt][nt][1]); o.y = pk2(S[mt][nt][2], S[mt][nt][3]);
                    *(LAS u32x2*)(ST + (16 * nt + l15) * LDS_ST + 2 * (32 * w + 16 * mt + 4 * g)) = o; }
        }
        LDS_WAIT();
        __syncthreads();
    }
}

__device__ __forceinline__ void ret_norm_phase(Frame& F, const bf16_t* mix, const bf16_t* proj, const float* gn, bf16_t* amix) {
    const int gw = F.bid * NWAVES + F.wave, NGW = F.G * NWAVES, lane = F.lane;
    for (int i = gw; i < T * 4; i += NGW) {
        const int t = i >> 2, h = i & 3;
        const u32x4 raw = *(const u32x4*)(mix + (size_t)t * 2048 + 512 * h + 8 * lane);
        const u32x4 gr = *(const u32x4*)(proj + (size_t)t * 6144 + 4096 + 512 * h + 8 * lane);
        float v[8] = {bflo(raw.x), bfhi(raw.x), bflo(raw.y), bfhi(raw.y), bflo(raw.z), bfhi(raw.z), bflo(raw.w), bfhi(raw.w)};
        const float gv[8] = {bflo(gr.x), bfhi(gr.x), bflo(gr.y), bfhi(gr.y), bflo(gr.z), bfhi(gr.z), bflo(gr.w), bfhi(gr.w)};
        float s = 0.f;
#pragma unroll
        for (int j = 0; j < 8; ++j) s += v[j];
        const float mean = wave_sum(s) * (1.0f / 512.0f);
        float q = 0.f;
#pragma unroll
        for (int j = 0; j < 8; ++j) { v[j] -= mean; q += v[j] * v[j]; }
        const float rstd = rsqrtf(wave_sum(q) * (1.0f / 512.0f) + EPS);
        const f32x4 g0 = *(const f32x4*)(gn + 512 * h + 8 * lane), g1 = *(const f32x4*)(gn + 512 * h + 8 * lane + 4);
        const float gg[8] = {g0.x, g0.y, g0.z, g0.w, g1.x, g1.y, g1.z, g1.w};
        float o[8];
#pragma unroll
        for (int j = 0; j < 8; ++j) o[j] = v[j] * rstd * gg[j] * siluf_(gv[j]);
        u32x4 ow; ow.x = pk2(o[0], o[1]); ow.y = pk2(o[2], o[3]); ow.z = pk2(o[4], o[5]); ow.w = pk2(o[6], o[7]);
        *(u32x4*)(amix + (size_t)t * 2048 + 512 * h + 8 * lane) = ow;
    }
}
#define NPH_RET 5
#define LAYER_RET() do { \
        { pg8::Gemm g{IFP8_RET ? (const bf16_t*)(ws + WS_H8) : hbuf, (const bf16_t*)(ws + WS_W_RET_IN), T, GFP8_RET ? 4096 : 6144, IFP8_RET ? 512 : 1024}; pg8::EpiRet E{proj, (const f32x2*)(ws + WS_ROPE), IFP8_RET ? 0.03125f : 1.0f}; \
          pg8::Gemm g2{(const bf16_t*)(ws + WS_H8), (const bf16_t*)(ws + WS_W_RET_IN + 8 * MiB), T, 2048, 512}; pg8::EpiBf16S E2{proj + 4096, 6144, 0, 1.0f, 0.03125f}; \
          RUN_PHASE({ pg8::StaticOrder S; S.init(T, GFP8_RET ? 4096 : 6144, F.G, F.bid); \
            if (CVT_HOST == 2 && MOE_FP8) { BgCvtR bgc; bgc.init(in, ws, F.bid * NWAVES + F.wave, F.G * NWAVES, F.lane, -1, 0, 0, 0, 16384);       \
              pg8::gemm_phase_bg<pg8::EpiRet, pg8::StaticOrder, false, (IFP8_RET != 0), BgCvtR>(F.lds, g, S, E, bgc); bgc.finish(); } \
            else pg8::gemm_phase<pg8::EpiRet, pg8::StaticOrder, false, (IFP8_RET != 0)>(F.lds, g, S, E); \
            if (GFP8_RET) { pg8::StaticOrder S2; S2.init(T, 2048, F.G, F.bid); pg8::gemm_phase<pg8::EpiBf16S, pg8::StaticOrder, false, true>(F.lds, g2, S2, E2); } }); } \
        RUN_PHASE_N(REP_S1, ret_s1_phase(F, proj, (bf16_t*)(ws + WS_PT), (bf16_t*)(ws + WS_KT), (bf16_t*)(ws + WS_VT))); \
        RUN_PHASE({ if (S2X) s2x_phase<0>(F, proj, (const bf16_t*)(ws + WS_PT), (const bf16_t*)(ws + WS_KT), proj + 2048, nullptr, (bf16_t*)(ws + WS_MIX)); else s2_phase<0>(F, proj, (const bf16_t*)(ws + WS_PT), (const bf16_t*)(ws + WS_KT), proj + 2048, nullptr, (bf16_t*)(ws + WS_MIX), in, ws, -1); \
            if (REP_S2R > 1) { VM_WAIT(); __syncthreads(); s2_phase<0, S2_ABL>(F, proj, (const bf16_t*)(ws + WS_PT), (const bf16_t*)(ws + WS_KT), proj + 2048, nullptr, (bf16_t*)(ws + WS_AMIX)); } }); \
        RUN_PHASE_N(REP_HN, hn_phase<0>(F, (const bf16_t*)(ws + WS_MIX), proj, nullptr, in[8], nullptr, amix)); \
        OUTPROJ(0, WS_W_RET_OUT, 2048); \
    } while (0)
__device__ __forceinline__ void attn_phase(Frame& F, const bf16_t* qkv, const float* relb, bf16_t* o, const float* const* in, unsigned char* ws) {
    const int gw_ = F.bid * NWAVES + F.wave, NGW_ = F.G * NWAVES;
    const int n_it = 2 * ((NB * NCHUNK + F.G - 1) / F.G);
    constexpr int NLY = CVT_HOST ? 0 : 4 - MOE_PRO_LAYERS;
    const int per_ly = (MOE_FP8 && NLY > 0) ? ((24576 + NGW_ * n_it - 1) / (NGW_ * n_it)) : 0, per_it = per_ly * NLY;
    int it_ = 0;
    LAS unsigned char* wl = F.lds + F.wave * 8192;
    LAS float* rb = (LAS float*)(wl + 5120);
    const int lane = F.lane, l15 = lane & 15, g = lane >> 4;
    const __amdgpu_buffer_rsrc_t qrs = __builtin_amdgcn_make_buffer_rsrc((void*)qkv, 0, 0x7fffffff, 0x00020000);
    const unsigned kofs = (unsigned)(l15 * 3072 + 8 * g) * 2u, vofs = (unsigned)((lane >> 3) * 3072 + 8 * (lane & 7)) * 2u;
    for (int u0 = F.bid; u0 < NB * NCHUNK; u0 += F.G) {
        int u = u0;
        if (F.G == 256) { const int x = u0 & 7, j = (u0 >> 3) & 31, r = u0 >> 8; u = x * NCHUNK + r * 32 + j; }
        const int b = u / NCHUNK, c = u % NCHUNK;
        const size_t t0 = (size_t)b * SEQ + (size_t)c * 64;
        for (int hh = 0; hh < 2; ++hh) {
            const int h = F.wave * 2 + hh;
            if (per_it) { for (int ly = 0; ly < NLY; ++ly) bg_convert(in, ws, MOE_PRO_LAYERS + ly, it_ * per_ly, per_ly, gw_, NGW_, lane); }
            ++it_;
            for (int i = lane; i < 320; i += 64) rb[i] = relb[h * 320 + i] * 1.4426950408889634f;
            bf16x8 qf[4][2];
#pragma unroll
            for (int nt = 0; nt < 4; ++nt)
#pragma unroll
                for (int ks = 0; ks < 2; ++ks) qf[nt][ks] = *(const bf16x8*)(qkv + (t0 + 16 * nt + l15) * 3072 + 64 * h + 32 * ks + 8 * g);
            f32x4 oacc[4][4];
#pragma unroll
            for (int dt = 0; dt < 4; ++dt)
#pragma unroll
                for (int nt = 0; nt < 4; ++nt) oacc[dt][nt] = (f32x4){0.f, 0.f, 0.f, 0.f};
            float mrun[4], lsum[4];
#pragma unroll
            for (int nt = 0; nt < 4; ++nt) { mrun[nt] = -1.0e30f; lsum[nt] = 0.f; }
            const int kt0 = (16 - 2 * c) > 0 ? (16 - 2 * c) : 0;
            bf16x8 kf[2][2]; u32x4 vv[4];
#define ATT_GLOAD(KF, VV, kt_) do { const unsigned sb_ = (unsigned)((t0 - 512 + 32 * (kt_)) * 3072 + 64 * h) * 2u;        \
                _Pragma("unroll") for (int mt = 0; mt < 2; ++mt) _Pragma("unroll") for (int ks = 0; ks < 2; ++ks) \
                    KF[mt][ks] = __builtin_bit_cast(bf16x8, __builtin_amdgcn_raw_buffer_load_b128(qrs, kofs, sb_ + (unsigned)((16 * mt * 3072 + 1024 + 32 * ks) * 2), 0)); \
                _Pragma("unroll") for (int i = 0; i < 4; ++i) VV[i] = __builtin_bit_cast(u32x4, __builtin_amdgcn_raw_buffer_load_b128(qrs, vofs, sb_ + (unsigned)((8 * i * 3072 + 2048) * 2), 0)); } while (0)
            ATT_GLOAD(kf, vv, kt0);
            for (int kt = kt0; kt < 18; ++kt) {
                bf16x8 kfn[2][2]; u32x4 vvn[4];
                { const int ktn = kt + 1 < 18 ? kt + 1 : kt; ATT_GLOAD(kfn, vvn, ktn); }
                f32x4 sacc[2][4];
#pragma unroll
                for (int mt = 0; mt < 2; ++mt)
#pragma unroll
                    for (int nt = 0; nt < 4; ++nt) { sacc[mt][nt] = (f32x4){0.f, 0.f, 0.f, 0.f};
#pragma unroll
                        for (int ks = 0; ks < 2; ++ks) sacc[mt][nt] = __builtin_amdgcn_mfma_f32_16x16x32_bf16(kf[mt][ks], qf[nt][ks], sacc[mt][nt], 0, 0, 0); }
#pragma unroll
                for (int i = 0; i < 4; ++i) *(LAS u32x4*)(wl + ((lane >> 3) + 8 * i) * 144 + 16 * (lane & 7)) = vv[i];
                bf16x8 pf[4];
#pragma unroll
                for (int nt = 0; nt < 4; ++nt) {
                    float tmax = -1.0e30f;
                    if (kt <= 7) {
                        const float cb = rb[256 + 63];
#pragma unroll
                        for (int mt = 0; mt < 2; ++mt)
#pragma unroll
                            for (int r = 0; r < 4; ++r) { const float s = sacc[mt][nt][r] + cb; sacc[mt][nt][r] = s; tmax = fmaxf(tmax, s); }
                    } else {
#pragma unroll
                        for (int mt = 0; mt < 2; ++mt)
#pragma unroll
                            for (int r = 0; r < 4; ++r) {
                                int dist = (16 * nt + l15) - (32 * kt + 16 * mt + 4 * g + r) + 512;
                                dist = dist < -63 ? -63 : (dist > 256 ? 256 : dist);
                                const float s = sacc[mt][nt][r] + rb[dist + 63];
                                sacc[mt][nt][r] = s; tmax = fmaxf(tmax, s);
                            }
                    }
                    tmax = fmaxf(tmax, __shfl_xor(tmax, 16)); tmax = fmaxf(tmax, __shfl_xor(tmax, 32));
                    const float mnew = fmaxf(mrun[nt], tmax);
                    const float alpha = __builtin_amdgcn_exp2f(mrun[nt] - mnew);
                    mrun[nt] = mnew;
                    float ps = 0.f; float p[8];
#pragma unroll
                    for (int mt = 0; mt < 2; ++mt)
#pragma unroll
                        for (int r = 0; r < 4; ++r) { const float e = __builtin_amdgcn_exp2f(sacc[mt][nt][r] - mnew); p[4 * mt + r] = e; ps += e; }
                    lsum[nt] = lsum[nt] * alpha + ps;
                    if (__builtin_amdgcn_ballot_w64(alpha != 1.0f) != 0) {
#pragma unroll
                        for (int dt = 0; dt < 4; ++dt) oacc[dt][nt] = oacc[dt][nt] * alpha; }
                    u32x4 pw; pw.x = cvt_pk_bf16(p[0], p[1]); pw.y = cvt_pk_bf16(p[2], p[3]); pw.z = cvt_pk_bf16(p[4], p[5]); pw.w = cvt_pk_bf16(p[6], p[7]);
                    pf[nt] = __builtin_bit_cast(bf16x8, pw);
                }
#pragma unroll
                for (int dt = 0; dt < 4; ++dt) {
                    const LAS unsigned char* ta = wl + (4 * g + (l15 >> 2)) * 144 + 2 * (16 * dt + 4 * (l15 & 3));
                    const s16x4 lo = __builtin_amdgcn_ds_read_tr16_b64_v4i16((LAS s16x4*)ta), hi = __builtin_amdgcn_ds_read_tr16_b64_v4i16((LAS s16x4*)(ta + 16 * 144));
                    const bf16x8 vf = (bf16x8){lo.x, lo.y, lo.z, lo.w, hi.x, hi.y, hi.z, hi.w};
#pragma unroll
                    for (int nt = 0; nt < 4; ++nt) oacc[dt][nt] = __builtin_amdgcn_mfma_f32_16x16x32_bf16(vf, pf[nt], oacc[dt][nt], 0, 0, 0);
                }
#pragma unroll
                for (int mt = 0; mt < 2; ++mt)
#pragma unroll
                    for (int ks = 0; ks < 2; ++ks) kf[mt][ks] = kfn[mt][ks];
#pragma unroll
                for (int i = 0; i < 4; ++i) vv[i] = vvn[i];
            }
#undef ATT_GLOAD
#pragma unroll
            for (int nt = 0; nt < 4; ++nt) {
                float l = lsum[nt]; l += __shfl_xor(l, 16); l += __shfl_xor(l, 32);
                const float inv = 1.0f / l;
#pragma unroll
                for (int dt = 0; dt < 4; ++dt) { const f32x4 v = oacc[dt][nt] * inv;
                    if (OUT_FP8) *(unsigned*)((unsigned char*)o + (t0 + 16 * nt + l15) * 1024 + 64 * h + 16 * dt + 4 * g) = pk4_fp8(v[0], v[1], v[2], v[3]);
                    else { u32x2 w; w.x = cvt_pk_bf16(v[0], v[1]); w.y = cvt_pk_bf16(v[2], v[3]);
                    *(u32x2*)(o + (t0 + 16 * nt + l15) * 1024 + 64 * h + 16 * dt + 4 * g) = w; } }
            }
        }
    }
    for (; it_ < n_it; ++it_) { if (per_it) for (int ly = 0; ly < NLY; ++ly) bg_convert(in, ws, MOE_PRO_LAYERS + ly, it_ * per_ly, per_ly, gw_, NGW_, lane); }
}
#define NPH_ATT 3
#define LAYER_ATT() do { \
        { pg8::Gemm g{IFP8_ATT ? (const bf16_t*)(ws + WS_H8) : hbuf, (const bf16_t*)(ws + WS_W_ATT_IN), T, 3072, IFP8_ATT ? 512 : 1024}; pg8::EpiBf16S E{proj, 3072, 4, 0.125f * 1.4426950408889634f, IFP8_ATT ? 0.03125f : 1.0f};       \
          RUN_PHASE_DUP(REP_INPROJ, { pg8::StaticOrder S; S.init(T, 3072, F.G, F.bid); pg8::gemm_phase<pg8::EpiBf16S, pg8::StaticOrder, false, (IFP8_ATT != 0)>(F.lds, g, S, E); }); } \
        RUN_PHASE_N(REP_ATT, attn_phase(F, proj, in[11], amix, in, ws)); \
        OUTPROJ(1, WS_W_ATT_OUT, 1024); \
    } while (0)
__device__ __forceinline__ void gla_s1_phase(Frame& F, const bf16_t* proj, const float* glow, const float* wgate, const float* bgate,
                                             bf16_t* PT, bf16_t* KT, bf16_t* VT, bf16_t* QS, float* REC) {
    constexpr int LDQ = 272, LDV = 528, LDP = 144;
    LAS float* Bc = (LAS float*)F.lds;
    LAS float* Gl = (LAS float*)(F.lds + 32768);
    LAS float* Wg = (LAS float*)(F.lds + 36864);
    LAS unsigned char* Qi = F.lds + 45056;
    LAS unsigned char* Ki = F.lds + 45056 + 17408;
    LAS unsigned char* Kst = F.lds + 45056 + 2 * 17408;
    LAS unsigned char* Vs = F.lds + 45056 + 3 * 17408;
    LAS unsigned char* Ps = F.lds + 45056 + 3 * 17408 + 33792;
    const int lane = F.lane, l15 = lane & 15, g = lane >> 4, w = F.wave, lt = w >> 1, mh = w & 1;
    float glr[2], wgr[4], bgr = 0.f; u32x4 qrr[2], krr[2];
#define GS1_LOAD(uu) do { const int c_ = (uu) % NCHUNK, h_ = ((uu) / NCHUNK) % 4, b_ = (uu) / (NCHUNK * 4); const size_t t0_ = (size_t)b_ * SEQ + (size_t)c_ * 64; \
        _Pragma("unroll") for (int i = 0; i < 2; ++i) glr[i] = glow[t0_ * 16 + F.tid + NTHR * i]; \
        _Pragma("unroll") for (int i = 0; i < 4; ++i) { const int x_ = F.tid + NTHR * i; wgr[i] = wgate[(size_t)(x_ >> 7) * 512 + 128 * h_ + (x_ & 127)]; } \
        bgr = bgate[128 * h_ + (F.tid & 127)]; \
        _Pragma("unroll") for (int i = 0; i < 2; ++i) { const int p_ = F.tid + NTHR * i, l_ = p_ >> 4, q8_ = p_ & 15; \
            qrr[i] = *(const u32x4*)(proj + (t0_ + l_) * 3072 + 128 * h_ + 8 * q8_); krr[i] = *(const u32x4*)(proj + (t0_ + l_) * 3072 + 512 + 128 * h_ + 8 * q8_); } } while (0)
    if (F.bid < NB * 4 * NCHUNK) GS1_LOAD(F.bid);
    for (int u = F.bid; u < NB * 4 * NCHUNK; u += F.G) {
        const int c = u % NCHUNK, h = (u / NCHUNK) % 4, b = u / (NCHUNK * 4);
        const size_t t0 = (size_t)b * SEQ + (size_t)c * 64;
#pragma unroll
        for (int i = 0; i < 2; ++i) Gl[F.tid + NTHR * i] = glr[i];
#pragma unroll
        for (int i = 0; i < 4; ++i) Wg[F.tid + NTHR * i] = wgr[i];
        const float bg_cur = bgr; const u32x4 qc[2] = {qrr[0], qrr[1]}, kc[2] = {krr[0], krr[1]};
        if (u + F.G < NB * 4 * NCHUNK) GS1_LOAD(u + F.G);
        WG_SYNC_LDS();
        { const int d = F.tid & 127; const float bg = bg_cur;
          float wg[16];
#pragma unroll
          for (int k = 0; k < 16; ++k) wg[k] = Wg[k * 128 + d];
          for (int i = 0; i < 16; ++i) { const int l = (F.tid >> 7) + 4 * i; float z = bg;
#pragma unroll
              for (int k = 0; k < 16; ++k) z += Gl[l * 16 + k] * wg[k];
              Bc[l * 128 + d] = logsigmoidf_(z) * (1.0f / 16.0f); } }
        WG_SYNC_LDS();
        if (F.tid < 128) { float a = 0.f; for (int l = 0; l < 64; ++l) { a += Bc[l * 128 + F.tid]; Bc[l * 128 + F.tid] = a; } REC[(size_t)u * 128 + F.tid] = __expf(a); }
        WG_SYNC_LDS();
#pragma unroll
        for (int pi = 0; pi < 2; ++pi) { const int p = F.tid + NTHR * pi;
            const int l = p >> 4, q8 = p & 15;
            const u32x4 qr = qc[pi], kr = kc[pi];
            const float qv[8] = {bflo(qr.x), bfhi(qr.x), bflo(qr.y), bfhi(qr.y), bflo(qr.z), bfhi(qr.z), bflo(qr.w), bfhi(qr.w)};
            const float kv[8] = {bflo(kr.x), bfhi(kr.x), bflo(kr.y), bfhi(kr.y), bflo(kr.z), bfhi(kr.z), bflo(kr.w), bfhi(kr.w)};
            float qi[8], ki[8], ks[8];
#pragma unroll
            for (int j = 0; j < 8; ++j) { const float bb = Bc[l * 128 + 8 * q8 + j], bl = Bc[63 * 128 + 8 * q8 + j];
                qi[j] = qv[j] * __expf(bb); ki[j] = kv[j] * __expf(-bb); ks[j] = kv[j] * __expf(bl - bb); }
            u32x4 o; o.x = pk2(qi[0], qi[1]); o.y = pk2(qi[2], qi[3]); o.z = pk2(qi[4], qi[5]); o.w = pk2(qi[6], qi[7]);
            *(LAS u32x4*)(Qi + l * LDQ + 16 * q8) = o; *(u32x4*)(QS + (t0 + l) * 512 + 128 * h + 8 * q8) = o;
            o.x = pk2(ki[0], ki[1]); o.y = pk2(ki[2], ki[3]); o.z = pk2(ki[4], ki[5]); o.w = pk2(ki[6], ki[7]);
            *(LAS u32x4*)(Ki + l * LDQ + 16 * q8) = o;
            o.x = pk2(ks[0], ks[1]); o.y = pk2(ks[2], ks[3]); o.z = pk2(ks[4], ks[5]); o.w = pk2(ks[6], ks[7]);
            *(LAS u32x4*)(Kst + l * LDQ + 16 * q8) = o;
        }
        WG_SYNC_LDS();
        f32x4 acc[2];
#pragma unroll
        for (int nt = 0; nt < 2; ++nt) { acc[nt] = (f32x4){0.f, 0.f, 0.f, 0.f};
#pragma unroll
            for (int ks = 0; ks < 4; ++ks) { const bf16x8 qf = *(const LAS bf16x8*)(Qi + (16 * lt + l15) * LDQ + 64 * ks + 16 * g);
                const bf16x8 kf = *(const LAS bf16x8*)(Ki + (32 * mh + 16 * nt + l15) * LDQ + 64 * ks + 16 * g);
                acc[nt] = __builtin_amdgcn_mfma_f32_16x16x32_bf16(qf, kf, acc[nt], 0, 0, 0); } }
#pragma unroll
        for (int nt = 0; nt < 2; ++nt)
#pragma unroll
            for (int r = 0; r < 4; ++r) { const int l = 16 * lt + 4 * g + r, m = 32 * mh + 16 * nt + l15;
                *(LAS unsigned short*)(Ps + l * LDP + 2 * m) = (unsigned short)f2bf(m <= l ? acc[nt][r] : 0.f); }
        WG_SYNC_LDS();
        { const int r = F.tid >> 3, q = F.tid & 7; *(u32x4*)(PT + (size_t)u * 4096 + r * 64 + 8 * q) = *(const LAS u32x4*)(Ps + r * LDP + 16 * q); }
        s1_write_kt_tr<128>(Kst, LDQ, KT + (size_t)u * 128 * 64, F.wave, lane);
        WG_SYNC_LDS();
    }
#undef GS1_LOAD
}

__device__ __forceinline__ void gla_s2_phase(Frame& F, const bf16_t* QS, const bf16_t* PT, const bf16_t* KT, const bf16_t* VT, const float* REC, bf16_t* mix) {
    constexpr int LDS_ST = 272, LDV = 144, LDO = 80;
    LAS unsigned char* ST = F.lds;
    LAS unsigned char* VTs = F.lds + 8704;
    LAS unsigned char* Os = F.lds + 8704 + 9216;
    const int lane = F.lane, l15 = lane & 15, g = lane >> 4, w = F.wave, lt = w >> 1, eh = w & 1;
    for (int u = F.bid; u < NB * 4 * 8; u += F.G) {
        const int eb = u & 7, h = (u >> 3) & 3, b = u >> 5;
        f32x4 S[2];
#pragma unroll
        for (int nt = 0; nt < 2; ++nt) S[nt] = (f32x4){0.f, 0.f, 0.f, 0.f};
        for (int i = F.tid; i < 8704 / 4; i += NTHR) ((LAS unsigned*)ST)[i] = 0u;
        for (int c = 0; c < NCHUNK; ++c) {
            const size_t t0 = (size_t)b * SEQ + (size_t)c * 64;
            const size_t uidx = ((size_t)(b * 4 + h)) * NCHUNK + c;
            LAS unsigned char* vt = VTs + (c & 1) * 4608;
            bf16x8 kf[2], qf[4], pf[2];
#pragma unroll
            for (int ks = 0; ks < 2; ++ks) kf[ks] = *(const bf16x8*)(KT + uidx * (128 * 64) + (((w * 2 + ks) * 64 + lane) << 3));
#pragma unroll
            for (int ks = 0; ks < 4; ++ks) qf[ks] = *(const bf16x8*)(QS + (t0 + 16 * lt + l15) * 512 + 128 * h + 32 * ks + 8 * g);
#pragma unroll
            for (int ks = 0; ks < 2; ++ks) pf[ks] = *(const bf16x8*)(PT + uidx * 4096 + (16 * lt + l15) * 64 + 32 * ks + 8 * g);
            f32x4 dec;
#pragma unroll
            for (int r = 0; r < 4; ++r) dec[r] = REC[uidx * 128 + 16 * w + 4 * g + r];
            if (F.tid < 256) { const int e = F.tid >> 3, q = F.tid & 7;
                *(LAS u32x4*)(vt + e * LDV + 16 * q) = *(const u32x4*)(VT + uidx * (256 * 64) + (size_t)(32 * eb + e) * 64 + 8 * q); }
            LDS_WAIT();
            __syncthreads();
            f32x4 oo = (f32x4){0.f, 0.f, 0.f, 0.f};
            { const int e = 16 * eh + l15;
#pragma unroll
              for (int ks = 0; ks < 2; ++ks) { const bf16x8 vf = *(const LAS bf16x8*)(vt + e * LDV + 64 * ks + 16 * g);
                  oo = __builtin_amdgcn_mfma_f32_16x16x32_bf16(pf[ks], vf, oo, 0, 0, 0); }
#pragma unroll
              for (int ks = 0; ks < 4; ++ks) { const bf16x8 sf = *(const LAS bf16x8*)(ST + e * LDS_ST + 64 * ks + 16 * g);
                  oo = __builtin_amdgcn_mfma_f32_16x16x32_bf16(qf[ks], sf, oo, 0, 0, 0); } }
#pragma unroll
            for (int r = 0; r < 4; ++r) *(LAS unsigned short*)(Os + (16 * lt + 4 * g + r) * LDO + 2 * (16 * eh + l15)) = (unsigned short)f2bf(oo[r]);
            LDS_WAIT();
            __syncthreads();
            if (F.tid < 256) { const int r = F.tid >> 2, q = F.tid & 3; *(u32x4*)(mix + (t0 + r) * 1024 + 256 * h + 32 * eb + 8 * q) = *(const LAS u32x4*)(Os + r * LDO + 16 * q); }
#pragma unroll
            for (int nt = 0; nt < 2; ++nt) { S[nt] = S[nt] * dec;
#pragma unroll
                for (int ks = 0; ks < 2; ++ks) { const bf16x8 vf = *(const LAS bf16x8*)(vt + (16 * nt + l15) * LDV + 64 * ks + 16 * g);
                    S[nt] = __builtin_amdgcn_mfma_f32_16x16x32_bf16(kf[ks], vf, S[nt], 0, 0, 0); }
                u32x2 o; o.x = pk2(S[nt][0], S[nt][1]); o.y = pk2(S[nt][2], S[nt][3]);
                *(LAS u32x2*)(ST + (16 * nt + l15) * LDS_ST + 2 * (16 * w + 4 * g)) = o; }
        }
        LDS_WAIT();
        __syncthreads();
    }
}

__device__ __forceinline__ void gla_norm_phase(Frame& F, const bf16_t* mix, const bf16_t* proj, const float* gn, bf16_t* amix) {
    const int gw = F.bid * NWAVES + F.wave, NGW = F.G * NWAVES, lane = F.lane;
    for (int i = gw; i < T * 4; i += NGW) {
        const int t = i >> 2, h = i & 3;
        const u32x2 raw = *(const u32x2*)(mix + (size_t)t * 1024 + 256 * h + 4 * lane);
        const u32x2 rr = *(const u32x2*)(proj + (size_t)t * 3072 + 2048 + 256 * h + 4 * lane);
        const float v[4] = {bflo(raw.x), bfhi(raw.x), bflo(raw.y), bfhi(raw.y)};
        const float rv[4] = {bflo(rr.x), bfhi(rr.x), bflo(rr.y), bfhi(rr.y)};
        float q = 0.f;
#pragma unroll
        for (int j = 0; j < 4; ++j) q += v[j] * v[j];
        const float rstd = rsqrtf(wave_sum(q) * (1.0f / 256.0f) + EPS);
        const f32x4 g0 = *(const f32x4*)(gn + 256 * h + 4 * lane);
        const float gg[4] = {g0.x, g0.y, g0.z, g0.w};
        float o[4];
#pragma unroll
        for (int j = 0; j < 4; ++j) o[j] = v[j] * rstd * gg[j] * siluf_(rv[j]);
        u32x2 ow; ow.x = pk2(o[0], o[1]); ow.y = pk2(o[2], o[3]);
        *(u32x2*)(amix + (size_t)t * 1024 + 256 * h + 4 * lane) = ow;
    }
}
#define NPH_GLA 5
#define LAYER_GLA() do { \
        { pg8::Gemm g{IFP8_GLA ? (const bf16_t*)(ws + WS_H8) : hbuf, (const bf16_t*)(ws + WS_W_GLA_IN), T, GFP8_GLA ? 2048 : 3072, IFP8_GLA ? 512 : 1024}; pg8::EpiBf16S E{proj, 3072, 2, 0.08838834764831845f, IFP8_GLA ? 0.03125f : 1.0f}; \
          pg8::Gemm g2{(const bf16_t*)(ws + WS_H8), (const bf16_t*)(ws + WS_W_GLA_IN + 4 * MiB), T, 1024, 512}; pg8::EpiBf16S E2{proj + 2048, 3072, 0, 1.0f, 0.03125f}; \
          RUN_PHASE({ pg8::StaticOrder S; S.init(T, GFP8_GLA ? 2048 : 3072, F.G, F.bid); pg8::gemm_phase<pg8::EpiBf16S, pg8::StaticOrder, false, (IFP8_GLA != 0)>(F.lds, g, S, E); \
            if (GFP8_GLA) { pg8::StaticOrder S2; S2.init(T, 1024, F.G, F.bid); pg8::gemm_phase<pg8::EpiBf16S, pg8::StaticOrder, false, true>(F.lds, g2, S2, E2); } }); } \
        RUN_PHASE_N(REP_S1, gla_s1_phase(F, proj, (const float*)(ws + WS_GLOW), in[14], in[15], (bf16_t*)(ws + WS_PT), (bf16_t*)(ws + WS_KT), (bf16_t*)(ws + WS_VT), (bf16_t*)(ws + WS_QS), (float*)(ws + WS_REC))); \
        RUN_PHASE_N(REP_S2, { if (S2X) s2x_phase<1>(F, (const bf16_t*)(ws + WS_QS), (const bf16_t*)(ws + WS_PT), (const bf16_t*)(ws + WS_KT), proj + 1024, (const float*)(ws + WS_REC), (bf16_t*)(ws + WS_MIX)); else s2_phase<1>(F, (const bf16_t*)(ws + WS_QS), (const bf16_t*)(ws + WS_PT), (const bf16_t*)(ws + WS_KT), proj + 1024, (const float*)(ws + WS_REC), (bf16_t*)(ws + WS_MIX), in, ws, -1); }); \
        RUN_PHASE_N(REP_HN, hn_phase<1>(F, (const bf16_t*)(ws + WS_MIX), proj, nullptr, in[16], nullptr, amix)); \
        OUTPROJ(2, WS_W_GLA_OUT, 1024); \
    } while (0)
__device__ __forceinline__ void mls_pre_phase(Frame& F, const bf16_t* proj, const float* conv_w, const float* conv_b, const float* w_q, const float* w_k, const float* w_v,
                                              const bf16_t* wmg, const float* b_gates, bf16_t* MQ, bf16_t* MK, bf16_t* MV, bf16_t* MXC, float* GATES) {
    LAS float* red = (LAS float*)F.lds;
    const int n = F.tid, lane = F.lane, l15 = lane & 15, g = lane >> 4, w = F.wave;
    f32x2 cw2[4][2], cb2[2], wq2[4][2], wk2[4][2], wv2[4][2];
#pragma unroll
    for (int j = 0; j < 4; ++j) { const f32x4 t4 = *(const f32x4*)(conv_w + (size_t)j * 2048 + 4 * n); cw2[j][0] = (f32x2){t4.x, t4.y}; cw2[j][1] = (f32x2){t4.z, t4.w}; }
    { const f32x4 t4 = *(const f32x4*)(conv_b + 4 * n); cb2[0] = (f32x2){t4.x, t4.y}; cb2[1] = (f32x2){t4.z, t4.w}; }
    const float kscale = 0.044194173824159216f;
#pragma unroll
    for (int c4 = 0; c4 < 4; ++c4) { const f32x4 a = *(const f32x4*)(w_q + (size_t)n * 16 + 4 * c4), bb = *(const f32x4*)(w_k + (size_t)n * 16 + 4 * c4), cc = *(const f32x4*)(w_v + (size_t)n * 16 + 4 * c4);
        wq2[c4][0] = (f32x2){a.x, a.y}; wq2[c4][1] = (f32x2){a.z, a.w};
        wk2[c4][0] = (f32x2){bb.x, bb.y} * kscale; wk2[c4][1] = (f32x2){bb.z, bb.w} * kscale;
        wv2[c4][0] = (f32x2){cc.x, cc.y}; wv2[c4][1] = (f32x2){cc.z, cc.w}; }
    for (int u = F.bid; u < NB * NCHUNK; u += F.G) {
        const int b = u / NCHUNK, c = u % NCHUNK;
        const size_t t0 = (size_t)b * SEQ + (size_t)c * 64;
        f32x2 x3[2], x2[2], x1[2];
        if (c > 0) {
            const u32x2 r3 = *(const u32x2*)(proj + (t0 - 3) * 4096 + 4 * n), r2 = *(const u32x2*)(proj + (t0 - 2) * 4096 + 4 * n), r1 = *(const u32x2*)(proj + (t0 - 1) * 4096 + 4 * n);
            x3[0] = (f32x2){bflo(r3.x), bfhi(r3.x)}; x3[1] = (f32x2){bflo(r3.y), bfhi(r3.y)};
            x2[0] = (f32x2){bflo(r2.x), bfhi(r2.x)}; x2[1] = (f32x2){bflo(r2.y), bfhi(r2.y)};
            x1[0] = (f32x2){bflo(r1.x), bfhi(r1.x)}; x1[1] = (f32x2){bflo(r1.y), bfhi(r1.y)};
        } else {
#pragma unroll
            for (int p = 0; p < 2; ++p) { x3[p] = (f32x2){0.f, 0.f}; x2[p] = x3[p]; x1[p] = x3[p]; }
        }
        for (int l0 = 0; l0 < 64; l0 += 8) {
            u32x2 xr[8];
#pragma unroll
            for (int j = 0; j < 8; ++j) xr[j] = *(const u32x2*)(proj + (t0 + l0 + j) * 4096 + 4 * n);
#pragma unroll
            for (int j = 0; j < 8; ++j) {
                const f32x2 x0[2] = {(f32x2){bflo(xr[j].x), bfhi(xr[j].x)}, (f32x2){bflo(xr[j].y), bfhi(xr[j].y)}};
                f32x2 xc[2];
#pragma unroll
                for (int p = 0; p < 2; ++p) { const f32x2 cv = cb2[p] + cw2[0][p] * x3[p] + cw2[1][p] * x2[p] + cw2[2][p] * x1[p] + cw2[3][p] * x0[p];
                    xc[p] = (f32x2){siluf_(cv.x), siluf_(cv.y)}; }
                const float xcs[4] = {xc[0].x, xc[0].y, xc[1].x, xc[1].y}, x0s[4] = {x0[0].x, x0[0].y, x0[1].x, x0[1].y};
                f32x2 q[2], k[2], v[2];
#pragma unroll
                for (int p = 0; p < 2; ++p) {
                    q[p] = wq2[0][p] * xcs[0] + wq2[1][p] * xcs[1] + wq2[2][p] * xcs[2] + wq2[3][p] * xcs[3];
                    k[p] = wk2[0][p] * xcs[0] + wk2[1][p] * xcs[1] + wk2[2][p] * xcs[2] + wk2[3][p] * xcs[3];
                    v[p] = wv2[0][p] * x0s[0] + wv2[1][p] * x0s[1] + wv2[2][p] * x0s[2] + wv2[3][p] * x0s[3];
                }
                const size_t o = (t0 + l0 + j) * 2048 + 4 * n;
                u32x2 pq; pq.x = pk2(q[0].x, q[0].y); pq.y = pk2(q[1].x, q[1].y); *(u32x2*)(MQ + o) = pq;
                pq.x = pk2(k[0].x, k[0].y); pq.y = pk2(k[1].x, k[1].y); *(u32x2*)(MK + o) = pq;
                pq.x = pk2(v[0].x, v[0].y); pq.y = pk2(v[1].x, v[1].y); *(u32x2*)(MV + o) = pq;
                pq.x = pk2(xc[0].x, xc[0].y); pq.y = pk2(xc[1].x, xc[1].y); *(u32x2*)(MXC + o) = pq;
#pragma unroll
                for (int p = 0; p < 2; ++p) { x3[p] = x2[p]; x2[p] = x1[p]; x1[p] = x0[p]; }
            }
        }
        VM_WAIT();
        __syncthreads();
        f32x4 acc[4];
#pragma unroll
        for (int mt = 0; mt < 4; ++mt) acc[mt] = (f32x4){0.f, 0.f, 0.f, 0.f};
        for (int ks0 = 0; ks0 < 24; ks0 += 4) {
            bf16x8 bh[4], bl[4], af[4][4];
#pragma unroll
            for (int u4 = 0; u4 < 4; ++u4) {
                const int kk = 768 * w + 32 * (ks0 + u4), buf = kk >> 11, col = kk & 2047;
                const bf16_t* src = buf == 0 ? MQ : (buf == 1 ? MK : MV);
                bh[u4] = *(const bf16x8*)(wmg + (size_t)l15 * 6144 + kk + 8 * g);
                bl[u4] = *(const bf16x8*)(wmg + (size_t)(16 + l15) * 6144 + kk + 8 * g);
#pragma unroll
                for (int mt = 0; mt < 4; ++mt) af[u4][mt] = *(const bf16x8*)(src + (t0 + 16 * mt + l15) * 2048 + col + 8 * g);
            }
#pragma unroll
            for (int u4 = 0; u4 < 4; ++u4)
#pragma unroll
                for (int mt = 0; mt < 4; ++mt) {
                    acc[mt] = __builtin_amdgcn_mfma_f32_16x16x32_bf16(af[u4][mt], bh[u4], acc[mt], 0, 0, 0);
                    acc[mt] = __builtin_amdgcn_mfma_f32_16x16x32_bf16(af[u4][mt], bl[u4], acc[mt], 0, 0, 0); }
        }
#pragma unroll
        for (int mt = 0; mt < 4; ++mt)
#pragma unroll
            for (int r = 0; r < 4; ++r) red[(w * 64 + 16 * mt + 4 * g + r) * 16 + l15] = acc[mt][r];
        LDS_WAIT();
        __syncthreads();
        { const int tok = F.tid >> 3, j = F.tid & 7; float s = b_gates[j];
#pragma unroll
          for (int ww = 0; ww < 8; ++ww) s += red[(ww * 64 + tok) * 16 + j];
          GATES[(t0 + tok) * 8 + j] = (j < 4) ? s : logsigmoidf_(s); }
        LDS_WAIT();
        __syncthreads();
    }
}

__device__ __forceinline__ void mls_s1_phase(Frame& F, const bf16_t* MQ, const bf16_t* MK, const bf16_t* MV, const float* GATES, bf16_t* PT, bf16_t* KT, bf16_t* VT, float* REC) {
    constexpr int LDK = 1040, LDP = 144;
    LAS unsigned char* Ks = F.lds;
    LAS unsigned char* Vs = F.lds + 66560;
    LAS unsigned char* Ps = F.lds + 133120;
    const int lane = F.lane, l15 = lane & 15, g = lane >> 4, w = F.wave, lt = w >> 1, mh = w & 1;
    u32x4 kr[8]; bf16x8 qf[16]; float g_f = 0.f, g_i = 0.f;
#define MS1_LOAD(uu) do { const int c_ = (uu) % NCHUNK, h_ = ((uu) / NCHUNK) % 4, b_ = (uu) / (NCHUNK * 4); const size_t t0_ = (size_t)b_ * SEQ + (size_t)c_ * 64; \
        s1_gload<512>(MK + t0_ * 2048 + 512 * h_, 2048, kr, F.tid); \
        if (w == 0) { g_f = GATES[(t0_ + lane) * 8 + 4 + h_]; g_i = GATES[(t0_ + lane) * 8 + h_]; } \
        _Pragma("unroll") for (int ks = 0; ks < 16; ++ks) qf[ks] = *(const bf16x8*)(MQ + (t0_ + 16 * lt + l15) * 2048 + 512 * h_ + 32 * ks + 8 * g); } while (0)
    if (F.bid < NB * 4 * NCHUNK) MS1_LOAD(F.bid);
    for (int u = F.bid; u < NB * 4 * NCHUNK; u += F.G) {
        const int c = u % NCHUNK, h = (u / NCHUNK) % 4, b = u / (NCHUNK * 4);
        const size_t t0 = (size_t)b * SEQ + (size_t)c * 64;
        s1_lstore<512>(kr, Ks, LDK, F.tid);
        if (w == 0) {
            float bsum = g_f;
#pragma unroll
            for (int o = 1; o < 64; o <<= 1) { const float t = __shfl_up(bsum, o); if (lane >= o) bsum += t; }
            const float z = g_i - bsum;
            float a = z;
#pragma unroll
            for (int o = 1; o < 64; o <<= 1) { const float t = __shfl_up(a, o); if (lane >= o) a = fmaxf(a, t); }
            REC[(size_t)u * 192 + lane] = bsum; REC[(size_t)u * 192 + 64 + lane] = z; REC[(size_t)u * 192 + 128 + lane] = a;
        }
        WG_SYNC_LDS();
        f32x4 acc[2];
#pragma unroll
        for (int nt = 0; nt < 2; ++nt) acc[nt] = (f32x4){0.f, 0.f, 0.f, 0.f};
#pragma unroll
        for (int ks = 0; ks < 16; ++ks) {
#pragma unroll
            for (int nt = 0; nt < 2; ++nt) { const bf16x8 kf = *(const LAS bf16x8*)(Ks + (size_t)(32 * mh + 16 * nt + l15) * LDK + 64 * ks + 16 * g);
                acc[nt] = __builtin_amdgcn_mfma_f32_16x16x32_bf16(qf[ks], kf, acc[nt], 0, 0, 0); }
        }
#pragma unroll
        for (int nt = 0; nt < 2; ++nt)
#pragma unroll
            for (int r = 0; r < 4; ++r) { const int l = 16 * lt + 4 * g + r, m = 32 * mh + 16 * nt + l15;
                *(LAS unsigned short*)(Ps + l * LDP + 2 * m) = (unsigned short)f2bf(m <= l ? acc[nt][r] : 0.f); }
        { const int un = u + F.G; if (un < NB * 4 * NCHUNK) MS1_LOAD(un); }
        WG_SYNC_LDS();
        { const int r = F.tid >> 3, q = F.tid & 7; *(u32x4*)(PT + (size_t)u * 4096 + r * 64 + 8 * q) = *(const LAS u32x4*)(Ps + r * LDP + 16 * q); }
        s1_write_kt_tr<512>(Ks, LDK, KT + (size_t)u * 512 * 64, F.wave, lane);
        WG_SYNC_LDS();
    }
#undef MS1_LOAD
}

__device__ __forceinline__ void mls_s2_phase(Frame& F, const bf16_t* MQ, const bf16_t* PT, const bf16_t* KT, const bf16_t* VT, const float* REC, bf16_t* mix) {
    constexpr int LDS_ST = 1040, LDV = 144, LDO = 144;
    LAS unsigned char* ST = F.lds;
    LAS unsigned char* VTs = F.lds + 83200;
    LAS unsigned char* Os = F.lds + 83200 + 23040;
    LAS float* QN = (LAS float*)(F.lds + 83200 + 23040 + 9216);
    LAS float* RS = QN + 64;
    const int lane = F.lane, l15 = lane & 15, g = lane >> 4, w = F.wave, lt = w >> 1, eh = w & 1;
    for (int u = F.bid; u < NB * 4 * 8; u += F.G) {
        const int eb = u & 7, h = (u >> 3) & 3, b = u >> 5;
        f32x4 S[4][5];
#pragma unroll
        for (int mt = 0; mt < 4; ++mt)
#pragma unroll
            for (int nt = 0; nt < 5; ++nt) S[mt][nt] = (f32x4){0.f, 0.f, 0.f, 0.f};
        for (int i = F.tid; i < 83200 / 4; i += NTHR) ((LAS unsigned*)ST)[i] = 0u;
        float m_prev = 0.f;
        for (int c = 0; c < NCHUNK; ++c) {
            const size_t t0 = (size_t)b * SEQ + (size_t)c * 64;
            const size_t uidx = ((size_t)(b * 4 + h)) * NCHUNK + c;
            const float* rec = REC + uidx * 192;
            LAS unsigned char* vt = VTs + (c & 1) * 11520;
            const float Amax = rec[128 + 63], blast = rec[63];
            const float Mx = fmaxf(m_prev, Amax), keep = __expf(m_prev - Mx);
            {
                const int e = F.tid >> 3, q = F.tid & 7;
                const f32x4 z0 = *(const f32x4*)(rec + 64 + 8 * q), z1 = *(const f32x4*)(rec + 64 + 8 * q + 4);
                const float wm[8] = {__expf(z0.x - Mx), __expf(z0.y - Mx), __expf(z0.z - Mx), __expf(z0.w - Mx), __expf(z1.x - Mx), __expf(z1.y - Mx), __expf(z1.z - Mx), __expf(z1.w - Mx)};
                const u32x4 raw = *(const u32x4*)(VT + uidx * (512 * 64) + (size_t)(64 * eb + e) * 64 + 8 * q);
                const float f[8] = {bflo(raw.x) * wm[0], bfhi(raw.x) * wm[1], bflo(raw.y) * wm[2], bfhi(raw.y) * wm[3], bflo(raw.z) * wm[4], bfhi(raw.z) * wm[5], bflo(raw.w) * wm[6], bfhi(raw.w) * wm[7]};
                u32x4 o; o.x = pk2(f[0], f[1]); o.y = pk2(f[2], f[3]); o.z = pk2(f[4], f[5]); o.w = pk2(f[6], f[7]);
                *(LAS u32x4*)(vt + e * LDV + 16 * q) = o;
                if (F.tid < 128) { u32x4 o2 = (u32x4){0u, 0u, 0u, 0u};
                    if (e == 0) { o2.x = pk2(wm[0], wm[1]); o2.y = pk2(wm[2], wm[3]); o2.z = pk2(wm[4], wm[5]); o2.w = pk2(wm[6], wm[7]); }
                    *(LAS u32x4*)(vt + (64 + e) * LDV + 16 * q) = o2; }
            }
            bf16x8 pf[2];
#pragma unroll
            for (int ks = 0; ks < 2; ++ks) pf[ks] = *(const bf16x8*)(PT + uidx * 4096 + (16 * lt + l15) * 64 + 32 * ks + 8 * g);
            LDS_WAIT();
            __syncthreads();
            if (c > 0) { const int r = F.tid >> 3, q = F.tid & 7; *(u32x4*)(mix + (t0 - 64 + r) * 2048 + 512 * h + 64 * eb + 8 * q) = *(const LAS u32x4*)(Os + r * LDO + 16 * q); }
            f32x4 oi[3], oo[3];
#pragma unroll
            for (int j = 0; j < 3; ++j) { oi[j] = (f32x4){0.f, 0.f, 0.f, 0.f}; oo[j] = (f32x4){0.f, 0.f, 0.f, 0.f}; }
#pragma unroll
            for (int j = 0; j < 3; ++j) { const int nt = eh + 2 * j;
                if (nt < 5) {
#pragma unroll
                    for (int ks = 0; ks < 2; ++ks) { const bf16x8 vf = *(const LAS bf16x8*)(vt + (16 * nt + l15) * LDV + 64 * ks + 16 * g);
                        oi[j] = __builtin_amdgcn_mfma_f32_16x16x32_bf16(pf[ks], vf, oi[j], 0, 0, 0); } } }
#pragma unroll 4
            for (int ks = 0; ks < 16; ++ks) {
                const bf16x8 qf = *(const bf16x8*)(MQ + (t0 + 16 * lt + l15) * 2048 + 512 * h + 32 * ks + 8 * g);
#pragma unroll
                for (int j = 0; j < 3; ++j) { const int nt = eh + 2 * j;
                    if (nt < 5) { const bf16x8 sf = *(const LAS bf16x8*)(ST + (16 * nt + l15) * LDS_ST + 64 * ks + 16 * g);
                        oo[j] = __builtin_amdgcn_mfma_f32_16x16x32_bf16(qf, sf, oo[j], 0, 0, 0); } }
            }
            if (eh == 0 && l15 == 0) {
#pragma unroll
                for (int r = 0; r < 4; ++r) { QN[16 * lt + 4 * g + r] = oo[2][r]; RS[16 * lt + 4 * g + r] = oi[2][r]; }
            }
            LDS_WAIT();
            __syncthreads();
#pragma unroll
            for (int r = 0; r < 4; ++r) { const int l = 16 * lt + 4 * g + r;
                const float bl = rec[l], al = rec[128 + l];
                const float Ml = fmaxf(m_prev, al), rho = __expf(Mx - Ml), wi = __expf(m_prev - Ml);
                const float den = wi * QN[l] + rho * RS[l];
                const float dn = fmaxf(fabsf(den), __expf(-(bl + Ml)));
                const float inv = 1.0f / dn;
#pragma unroll
                for (int j = 0; j < 2; ++j) { const int nt = eh + 2 * j;
                    *(LAS unsigned short*)(Os + l * LDO + 2 * (16 * nt + l15)) = (unsigned short)f2bf((wi * oo[j][r] + rho * oi[j][r]) * inv); } }
            bf16x8 kf[4][2];
#pragma unroll
            for (int mt = 0; mt < 4; ++mt)
#pragma unroll
                for (int ks = 0; ks < 2; ++ks) kf[mt][ks] = *(const bf16x8*)(KT + uidx * (512 * 64) + ((((4 * w + mt) * 2 + ks) * 64 + lane) << 3));
#pragma unroll
            for (int nt = 0; nt < 5; ++nt) {
                bf16x8 vf[2];
#pragma unroll
                for (int ks = 0; ks < 2; ++ks) vf[ks] = *(const LAS bf16x8*)(vt + (16 * nt + l15) * LDV + 64 * ks + 16 * g);
#pragma unroll
                for (int mt = 0; mt < 4; ++mt) { S[mt][nt] = S[mt][nt] * keep;
#pragma unroll
                    for (int ks = 0; ks < 2; ++ks) S[mt][nt] = __builtin_amdgcn_mfma_f32_16x16x32_bf16(kf[mt][ks], vf[ks], S[mt][nt], 0, 0, 0);
                    u32x2 o; o.x = pk2(S[mt][nt][0], S[mt][nt][1]); o.y = pk2(S[mt][nt][2], S[mt][nt][3]);
                    *(LAS u32x2*)(ST + (16 * nt + l15) * LDS_ST + 2 * (64 * w + 16 * mt + 4 * g)) = o; }
            }
            m_prev = blast + Mx;
        }
        LDS_WAIT();
        __syncthreads();
        { const size_t t0 = (size_t)b * SEQ + (size_t)(NCHUNK - 1) * 64; const int r = F.tid >> 3, q = F.tid & 7;
          *(u32x4*)(mix + (t0 + r) * 2048 + 512 * h + 64 * eb + 8 * q) = *(const LAS u32x4*)(Os + r * LDO + 16 * q); }
        LDS_WAIT();
        __syncthreads();
    }
}

__device__ __forceinline__ void mls_norm_phase(Frame& F, const bf16_t* mix, const bf16_t* proj, const bf16_t* MXC, const float* gn, const float* skip, bf16_t* amix) {
    const int gw = F.bid * NWAVES + F.wave, NGW = F.G * NWAVES, lane = F.lane;
    for (int i = gw; i < T * 4; i += NGW) {
        const int t = i >> 2, h = i & 3, ch = 512 * h + 8 * lane;
        const u32x4 raw = *(const u32x4*)(mix + (size_t)t * 2048 + ch);
        const u32x4 zr = *(const u32x4*)(proj + (size_t)t * 4096 + 2048 + ch);
        const u32x4 xr = *(const u32x4*)(MXC + (size_t)t * 2048 + ch);
        float v[8] = {bflo(raw.x), bfhi(raw.x), bflo(raw.y), bfhi(raw.y), bflo(raw.z), bfhi(raw.z), bflo(raw.w), bfhi(raw.w)};
        const float zv[8] = {bflo(zr.x), bfhi(zr.x), bflo(zr.y), bfhi(zr.y), bflo(zr.z), bfhi(zr.z), bflo(zr.w), bfhi(zr.w)};
        const float xv[8] = {bflo(xr.x), bfhi(xr.x), bflo(xr.y), bfhi(xr.y), bflo(xr.z), bfhi(xr.z), bflo(xr.w), bfhi(xr.w)};
        float s = 0.f;
#pragma unroll
        for (int j = 0; j < 8; ++j) s += v[j];
        const float mean = wave_sum(s) * (1.0f / 512.0f);
        float q = 0.f;
#pragma unroll
        for (int j = 0; j < 8; ++j) { v[j] -= mean; q += v[j] * v[j]; }
        const float rstd = rsqrtf(wave_sum(q) * (1.0f / 512.0f) + EPS);
        const f32x4 g0 = *(const f32x4*)(gn + ch), g1 = *(const f32x4*)(gn + ch + 4), s0 = *(const f32x4*)(skip + ch), s1 = *(const f32x4*)(skip + ch + 4);
        const float gg[8] = {g0.x, g0.y, g0.z, g0.w, g1.x, g1.y, g1.z, g1.w};
        const float sk[8] = {s0.x, s0.y, s0.z, s0.w, s1.x, s1.y, s1.z, s1.w};
        float o[8];
#pragma unroll
        for (int j = 0; j < 8; ++j) o[j] = (v[j] * rstd * gg[j] + sk[j] * xv[j]) * siluf_(zv[j]);
        u32x4 ow; ow.x = pk2(o[0], o[1]); ow.y = pk2(o[2], o[3]); ow.z = pk2(o[4], o[5]); ow.w = pk2(o[6], o[7]);
        *(u32x4*)(amix + (size_t)t * 2048 + ch) = ow;
    }
}
#define NPH_MLS 6
#define LAYER_MLS() do { \
        { pg8::Gemm g{IFP8_MLS ? (const bf16_t*)(ws + WS_H8) : hbuf, (const bf16_t*)(ws + WS_W_MLS_IN), T, GFP8_MLS ? 2048 : 4096, IFP8_MLS ? 512 : 1024}; pg8::EpiBf16S E{proj, 4096, 0, 1.0f, IFP8_MLS ? 0.03125f : 1.0f}; \
          pg8::Gemm g2{(const bf16_t*)(ws + WS_H8), (const bf16_t*)(ws + WS_W_MLS_IN + 4 * MiB), T, 2048, 512}; pg8::EpiBf16S E2{proj + 2048, 4096, 0, 1.0f, 0.03125f}; \
          RUN_PHASE({ pg8::StaticOrder S; S.init(T, GFP8_MLS ? 2048 : 4096, F.G, F.bid); pg8::gemm_phase<pg8::EpiBf16S, pg8::StaticOrder, false, (IFP8_MLS != 0)>(F.lds, g, S, E); \
            if (GFP8_MLS) { pg8::StaticOrder S2; S2.init(T, 2048, F.G, F.bid); pg8::gemm_phase<pg8::EpiBf16S, pg8::StaticOrder, false, true>(F.lds, g2, S2, E2); } }); } \
        RUN_PHASE_N(REP_PRE, mls_pre_phase(F, proj, in[19], in[20], in[21], in[22], in[23], (const bf16_t*)(ws + WS_WMG), in[25], (bf16_t*)(ws + WS_MQ), (bf16_t*)(ws + WS_MK), (bf16_t*)(ws + WS_MV), (bf16_t*)(ws + WS_MXC), (float*)(ws + WS_GATES))); \
        RUN_PHASE_N(REP_S1, mls_s1_phase(F, (const bf16_t*)(ws + WS_MQ), (const bf16_t*)(ws + WS_MK), (const bf16_t*)(ws + WS_MV), (const float*)(ws + WS_GATES), (bf16_t*)(ws + WS_PT), (bf16_t*)(ws + WS_KT), (bf16_t*)(ws + WS_VT), (float*)(ws + WS_REC))); \
        RUN_PHASE({ if (S2M) s2m_phase(F, (const bf16_t*)(ws + WS_MQ), (const bf16_t*)(ws + WS_PT), (const bf16_t*)(ws + WS_KT), (const bf16_t*)(ws + WS_MV), (const float*)(ws + WS_REC), (bf16_t*)(ws + WS_MIX)); else s2_phase<MLS_S2MODE>(F, (const bf16_t*)(ws + WS_MQ), (const bf16_t*)(ws + WS_PT), (const bf16_t*)(ws + WS_KT), (const bf16_t*)(ws + WS_MV), (const float*)(ws + WS_REC), (bf16_t*)(ws + WS_MIX)); \
            if (REP_S2M > 1) { VM_WAIT(); __syncthreads(); if (S2M) s2m_phase(F, (const bf16_t*)(ws + WS_MQ), (const bf16_t*)(ws + WS_PT), (const bf16_t*)(ws + WS_KT), (const bf16_t*)(ws + WS_MV), (const float*)(ws + WS_REC), (bf16_t*)(ws + WS_AMIX)); else s2_phase<2, S2_ABL>(F, (const bf16_t*)(ws + WS_MQ), (const bf16_t*)(ws + WS_PT), (const bf16_t*)(ws + WS_KT), (const bf16_t*)(ws + WS_MV), (const float*)(ws + WS_REC), (bf16_t*)(ws + WS_AMIX)); } }); \
        RUN_PHASE_N(REP_HN, hn_phase<2>(F, (const bf16_t*)(ws + WS_MIX), proj, (const bf16_t*)(ws + WS_MXC), in[26], in[27], amix)); \
        OUTPROJ(3, WS_W_MLS_OUT, 2048); \
    } while (0)
#ifndef N_LAUNCH_MODE
#define N_LAUNCH_MODE 0
#endif
struct Args { const float* in[35]; float* out; unsigned char* ws; int ph_lo, ph_hi; };

__global__ void __launch_bounds__(NTHR, 2) trunk_fwd(Args args) {
    extern __shared__ __attribute__((aligned(16))) unsigned char lds_raw[];
    Frame F;
    F.lds = (LAS unsigned char*)lds_raw;
    F.tid = threadIdx.x; F.lane = F.tid & 63; F.wave = __builtin_amdgcn_readfirstlane(F.tid >> 6);
    F.G = gridDim.x; F.bid = blockIdx.x;
    F.ws = args.ws; F.in = args.in; F.out = args.out; F.ctl = (unsigned*)(args.ws + WS_CTL);
    unsigned char* ws = args.ws; const float* const* in = args.in;
    const int lo = args.ph_lo, hi = args.ph_hi;
    volatile LAS unsigned* xbw = (volatile LAS unsigned*)(F.lds + LDS_MISC);
    if (F.tid < 4) xbw[F.tid] = 0u;
    __syncthreads();
    XcdBarrier bar; bar.bar = F.ctl + CW_BAR; bar.x = 0; bar.st = xbw;
    if (hi - lo > 1) bar = xcd_barrier_post(F.ctl + CW_BAR, xbw);
    int ph = 0;
#define RUN_PHASE(...) do { if (ph >= lo && ph < hi) { __VA_ARGS__; if (ph + 1 < hi) { xcd_barrier(bar); if (REP_BAR > 1) xcd_barrier(bar); } } ++ph; } while (0)
#define RUN_PHASE_DUP(NREP, ...) do { if (ph >= lo && ph < hi) { __VA_ARGS__; if ((NREP) > 1) { VM_WAIT(); __syncthreads(); __VA_ARGS__; } if (ph + 1 < hi) xcd_barrier(bar); } ++ph; } while (0)
#define RUN_PHASE_N(NREP, ...) do { if (ph >= lo && ph < hi) { for (int rep_ = 0; rep_ < (NREP); ++rep_) { if (rep_) { VM_WAIT(); __syncthreads(); } __VA_ARGS__; } if (ph + 1 < hi) xcd_barrier(bar); } ++ph; } while (0)

    float* mod = (float*)(ws + WS_MOD);
    bf16_t* xres = (bf16_t*)(ws + WS_XRES);
    bf16_t* hbuf = (bf16_t*)(ws + WS_H);
    bf16_t* proj = (bf16_t*)(ws + WS_PROJ);
    bf16_t* amix = (bf16_t*)(ws + WS_AMIX);
    bf16_t* act = (bf16_t*)(ws + WS_ACT);
    bf16_t* yp = (bf16_t*)(ws + WS_YP);
    int* tokes = (int*)(ws + WS_TOKES); float* tokw = (float*)(ws + WS_TOKW);
    unsigned short* list = (unsigned short*)(ws + WS_LIST);
    const void* xcur = in[0];

    RUN_PHASE_N(REP_PRO, prologue_phase(F));

#define MOD(l, k) (mod + (size_t)(l) * NB * 6144 + (k) * 1024)
#define CNT(l) (F.ctl + CW_CNT + (l) * 32 * 64)
#define NORM1(l, PROJ) do { constexpr bool CMB = ((l) > 0) && ENABLE_MOE; NormArgs a{}; a.xin = xcur; a.xout = xres; a.gain = in[4] + (l) * 1024; a.sc = MOD(l, 1); a.sh = MOD(l, 0); a.h = hbuf; \
        if (CMB) { a.yp = yp; a.tokes_c = tokes; a.tokw_c = tokw; a.gf = MOD((l) - 1, 5); a.cnt_prev = CNT((l) - 1); } \
        a.wt = (const bf16_t*)(ws + WS_WGL); a.glow = (float*)(ws + WS_GLOW); a.h8 = (unsigned char*)(ws + WS_H8); \
        constexpr int IF8 = (l) == 0 ? IFP8_RET : ((l) == 1 ? IFP8_ATT : ((l) == 2 ? IFP8_GLA : IFP8_MLS)); \
        constexpr int GF8 = (l) == 0 ? GFP8_RET : ((l) == 2 ? GFP8_GLA : ((l) == 3 ? GFP8_MLS : 0)); \
        RUN_PHASE({ norm_phase<CMB, PROJ, false, ((l) > 0), (IF8 ? 2 : (GF8 ? 3 : 1))>(F, a); \
            if (REP_NORM > 1) { VM_WAIT(); __syncthreads(); NormArgs a2 = a; a2.xout = (bf16_t*)(ws + WS_PT); a2.h = (bf16_t*)(ws + WS_MIX); a2.h8 = (unsigned char*)(ws + WS_AMIX); norm_phase<CMB, 0, false, ((l) > 0), (IF8 ? 2 : (GF8 ? 3 : 1))>(F, a2); } }); if (CMB) xcur = xres; } while (0)
#define OUTPROJ(l, WOFF, KK) do { pg8::Gemm g{amix, (const bf16_t*)(ws + (WOFF)), T, DM, OUT_FP8 ? (KK) / 2 : (KK)}; pg8::EpiResid<((l) > 0)> E{xcur, xres, MOD(l, 2), OUT_FP8 ? 0.03125f : 1.0f}; \
        RUN_PHASE({ pg8::StaticOrder S; S.init(T, DM, F.G, F.bid); pg8::gemm_phase<pg8::EpiResid<((l) > 0)>, pg8::StaticOrder, false, (OUT_FP8 != 0)>(F.lds, g, S, E); \
            if (REP_OUT > 1) { VM_WAIT(); __syncthreads(); pg8::EpiResid<((l) > 0)> E2{(l) > 0 ? (const void*)(ws + WS_PT) : xcur, (bf16_t*)(ws + WS_PT), MOD(l, 2), 1.0f}; pg8::gemm_phase<pg8::EpiResid<((l) > 0)>, pg8::StaticOrder, false, (OUT_FP8 != 0)>(F.lds, g, S, E2); } }); xcur = xres; } while (0)
#define MOE(l) do { if (!ENABLE_MOE) break; \
        { NormArgs a{}; a.xin = xcur; a.gain = in[5] + (l) * 1024; a.sc = MOD(l, 4); a.sh = MOD(l, 3); a.h = hbuf; \
          a.wt = (const bf16_t*)(ws + WS_WRT) + (size_t)(l) * 2 * 32 * 1024; a.rb = in[30] + (l) * 32; a.cnt = CNT(l); a.list = list; a.tokes = tokes; a.tokw = tokw; a.h8 = (unsigned char*)(ws + WS_H8); \
          RUN_PHASE({ norm_phase<false, 1, false, true, (MOE_FP8 ? 3 : 1)>(F, a); \
            if (REP_NORM > 1) { VM_WAIT(); __syncthreads(); NormArgs a2 = a; a2.h = (bf16_t*)(ws + WS_MIX); a2.h8 = (unsigned char*)(ws + WS_AMIX); norm_phase<false, 0, false, true, (MOE_FP8 ? 3 : 1)>(F, a2); } }); } \
        if (MOE_FP8) { \
          { pg8::EpiSwiglu8 E{(unsigned char*)act, in[32] + (size_t)(l) * 32 * 2048}; pg8::EpiNull EN{(float*)(ws + WS_GLOW)}; \
            RUN_PHASE({ if (CVT_HOST && (l) >= MOE_PRO_LAYERS - 1 && (l) < 3) moe_gemm_phase<8, true, true, pg8::EpiSwiglu8, false, true>(F, (const bf16_t*)(ws + WS_H8), (const bf16_t*)(ws + WS_W1T + (size_t)(l) * 32 * 2048 * 1024), CNT(l), list, E, in, ws, (l) + 1, (CVT_HOST == 2 && (l) == 0) ? 0 : -1); \
              else moe_gemm_phase<8, true, true, pg8::EpiSwiglu8>(F, (const bf16_t*)(ws + WS_H8), (const bf16_t*)(ws + WS_W1T + (size_t)(l) * 32 * 2048 * 1024), CNT(l), list, E); \
              if (REP_MOE > 1 && (MOE_WHICH & 1)) { VM_WAIT(); __syncthreads(); if (MOE_NULL) moe_gemm_phase<8, true, true, pg8::EpiNull, (MOE_HOT != 0)>(F, (const bf16_t*)(ws + WS_H8), (const bf16_t*)(ws + WS_W1T + (size_t)(l) * 32 * 2048 * 1024), CNT(l), list, EN); \
                else moe_gemm_phase<8, true, true, pg8::EpiSwiglu8>(F, (const bf16_t*)(ws + WS_H8), (const bf16_t*)(ws + WS_W1T + (size_t)(l) * 32 * 2048 * 1024), CNT(l), list, E); } }); } \
          { pg8::EpiMoe2 E{yp, in[34] + (size_t)(l) * 32 * 1024, 0.03125f}; pg8::EpiNull EN{(float*)(ws + WS_GLOW)}; \
            RUN_PHASE({ moe_gemm_phase<4, false, true, pg8::EpiMoe2>(F, act, (const bf16_t*)(ws + WS_W2T + (size_t)(l) * 32 * 1024 * 1024), CNT(l), list, E); \
              if (REP_MOE > 1 && (MOE_WHICH & 2)) { VM_WAIT(); __syncthreads(); if (MOE_NULL) moe_gemm_phase<4, false, true, pg8::EpiNull, (MOE_HOT != 0)>(F, act, (const bf16_t*)(ws + WS_W2T + (size_t)(l) * 32 * 1024 * 1024), CNT(l), list, EN); \
                else moe_gemm_phase<4, false, true, pg8::EpiMoe2>(F, act, (const bf16_t*)(ws + WS_W2T + (size_t)(l) * 32 * 1024 * 1024), CNT(l), list, E); } }); } \
        } else { \
          { pg8::EpiSwiglu E{act, in[32] + (size_t)(l) * 32 * 2048}; \
            RUN_PHASE_N(REP_MOE, moe_gemm_phase<8, true, false, pg8::EpiSwiglu>(F, hbuf, (const bf16_t*)(ws + WS_W1T) + (size_t)(l) * 32 * 2048 * 1024, CNT(l), list, E)); } \
          { pg8::EpiMoe2 E{yp, in[34] + (size_t)(l) * 32 * 1024, 1.0f}; \
            RUN_PHASE_N(REP_MOE, moe_gemm_phase<4, false, false, pg8::EpiMoe2>(F, act, (const bf16_t*)(ws + WS_W2T) + (size_t)(l) * 32 * 1024 * 1024, CNT(l), list, E)); } \
        } \
    } while (0)

    NORM1(0, 0);
#if ENABLE_RET
    LAYER_RET();
#endif
    MOE(0);
    NORM1(1, 0);
#if ENABLE_ATT
    LAYER_ATT();
#endif
    MOE(1);
    NORM1(2, 2);
#if ENABLE_GLA
    LAYER_GLA();
#endif
    MOE(2);
    NORM1(3, 0);
#if ENABLE_MLS
    LAYER_MLS();
#endif
    MOE(3);
    { NormArgs a{}; a.xin = xcur; a.xout = xres; a.gain = in[6]; a.yp = yp; a.tokes_c = tokes; a.tokw_c = tokw; a.gf = MOD(3, 5); a.cnt_prev = CNT(3); a.out = F.out;
      RUN_PHASE({ norm_phase<(ENABLE_MOE != 0), 0, true, true>(F, a); if (REP_NORM > 1) { VM_WAIT(); __syncthreads(); NormArgs a2 = a; a2.xout = (bf16_t*)(ws + WS_PT); a2.out = (float*)(ws + WS_MIX); norm_phase<(ENABLE_MOE != 0), 0, true, true>(F, a2); } }); }
#undef RUN_PHASE
}

static int count_phases() {
    int n = 1;
    const int mixer[4] = {ENABLE_RET ? NPH_RET : 0, ENABLE_ATT ? NPH_ATT : 0, ENABLE_GLA ? NPH_GLA : 0, ENABLE_MLS ? NPH_MLS : 0};
    for (int l = 0; l < 4; ++l) n += 1 + mixer[l] + (ENABLE_MOE ? 3 : 0);
    return n + 1;
}

extern "C" void kernel_launch(void* const* d_in, const int* in_sizes, int n_in, void* d_out, int out_size, void* d_ws, size_t ws_size, hipStream_t stream) {
    static int grid = 0;
    if (grid == 0) {
        if (n_in != 35 || out_size != T * DM || ws_size < WS_END) { fprintf(stderr, "kernel_launch: unexpected shapes (n_in %d out %d ws %zu)\n", n_in, out_size, ws_size); grid = -1; return; }
        int dev = 0, cus = 0, per_cu = 0;
        if (hipGetDevice(&dev) != hipSuccess || hipDeviceGetAttribute(&cus, hipDeviceAttributeMultiprocessorCount, dev) != hipSuccess) { grid = -1; return; }
        if (hipFuncSetAttribute((const void*)trunk_fwd, hipFuncAttributeMaxDynamicSharedMemorySize, LDS_BYTES) != hipSuccess) { fprintf(stderr, "kernel_launch: hipFuncSetAttribute failed\n"); grid = -1; return; }
        if (hipOccupancyMaxActiveBlocksPerMultiprocessor(&per_cu, (const void*)trunk_fwd, NTHR, LDS_BYTES) != hipSuccess || per_cu < 1) { fprintf(stderr, "kernel_launch: occupancy query says %d\n", per_cu); grid = -1; return; }
        grid = cus;
    }
    if (grid <= 0) return;
    hipMemsetAsync((char*)d_ws + WS_CTL, 0, CTL_ZERO_BYTES, stream);
    Args a{};
    for (int i = 0; i < 35; ++i) a.in[i] = (const float*)d_in[i];
    a.out = (float*)d_out; a.ws = (unsigned char*)d_ws;
    const int nph = count_phases();
#if N_LAUNCH_MODE == 1
    for (int p = 0; p < nph; ++p) { a.ph_lo = p; a.ph_hi = p + 1; hipLaunchKernelGGL(trunk_fwd, dim3(grid), dim3(NTHR), LDS_BYTES, stream, a); }
#else
    a.ph_lo = 0; a.ph_hi = nph;
    hipLaunchKernelGGL(trunk_fwd, dim3(grid), dim3(NTHR), LDS_BYTES, stream, a);
#endif
    hipError_t le = hipGetLastError();
    if (le != hipSuccess) fprintf(stderr, "kernel_launch: launch failed: %s\n", hipGetErrorName(le));
}
```

```cpp
#include <hip/hip_runtime.h>
#include <stdint.h>
#include <stdio.h>

#define GAS __attribute__((address_space(1)))
#define LAS __attribute__((address_space(3)))
typedef unsigned short bf16_t;
typedef short bf16x8 __attribute__((ext_vector_type(8)));
typedef float f32x4 __attribute__((ext_vector_type(4)));
typedef float f32x2 __attribute__((ext_vector_type(2)));
typedef unsigned u32x4 __attribute__((ext_vector_type(4)));
typedef unsigned u32x2 __attribute__((ext_vector_type(2)));
typedef short s16x4 __attribute__((ext_vector_type(4)));
typedef int i32x8 __attribute__((ext_vector_type(8)));
typedef int i32x4 __attribute__((ext_vector_type(4)));

constexpr int NB = 8, SEQ = 4096, DM = 1024, T = NB * SEQ;
constexpr int NCHUNK = SEQ / 64;
constexpr int NEXP = 32, TOPK = 4;
constexpr int NWAVES = 8, NTHR = NWAVES * 64;
constexpr float EPS = 1e-6f;

constexpr size_t MiB = 1u << 20;
constexpr size_t WS_CTL = 0, CTL_ZERO_BYTES = 1 * MiB;
constexpr size_t WS_MOD = 1 * MiB;
constexpr size_t WS_ROPE = 2 * MiB;
constexpr size_t WS_WRT = 6 * MiB;
constexpr size_t WS_WGL = 7 * MiB;
constexpr size_t WS_WMG = 7 * MiB + 131072;
constexpr size_t WS_W_RET_IN = 8 * MiB, WS_W_RET_OUT = 20 * MiB, WS_W_ATT_IN = 24 * MiB, WS_W_ATT_OUT = 30 * MiB;
constexpr size_t WS_W_GLA_IN = 32 * MiB, WS_W_GLA_OUT = 38 * MiB, WS_W_MLS_IN = 40 * MiB, WS_W_MLS_OUT = 48 * MiB;
constexpr size_t WS_W1T = 64 * MiB;
constexpr size_t WS_W2T = 576 * MiB;
constexpr size_t WS_XRES = 832 * MiB;
constexpr size_t WS_H = 960 * MiB;
constexpr size_t WS_PROJ = 1024 * MiB;
constexpr size_t WS_MIX = 1408 * MiB;
constexpr size_t WS_AMIX = 1536 * MiB;
constexpr size_t WS_PT = 1664 * MiB;
constexpr size_t WS_KT = 1680 * MiB;
constexpr size_t WS_VT = 1808 * MiB;
constexpr size_t WS_QS = 1936 * MiB;
constexpr size_t WS_REC = 1968 * MiB;
constexpr size_t WS_MQ = WS_PROJ + 256 * MiB;
constexpr size_t WS_MK = 1984 * MiB, WS_MV = 2112 * MiB, WS_MXC = 2240 * MiB;
constexpr size_t WS_ACT = 2368 * MiB;
constexpr size_t WS_YP = 2640 * MiB;
constexpr size_t WS_TOKES = 2912 * MiB;
constexpr size_t WS_TOKW = 2913 * MiB;
constexpr size_t WS_LIST = 2914 * MiB;
constexpr size_t WS_GLOW = 2918 * MiB;
constexpr size_t WS_GATES = 2920 * MiB;
constexpr size_t WS_H8 = 2928 * MiB;
constexpr size_t WS_END = 2960 * MiB;
constexpr int CW_BAR = 4096;
constexpr int CW_CNT = 16384;

constexpr int LDS_BYTES = 163840;
constexpr int LDS_MISC = 163840 - 1536;
constexpr int LDS_IDX = 131072;

#define LDS_WAIT() asm volatile("s_waitcnt lgkmcnt(0)" ::: "memory")
#define VM_WAIT() asm volatile("s_waitcnt vmcnt(0)" ::: "memory")
#define WG_SYNC_LDS() do { asm volatile("s_waitcnt lgkmcnt(0)" ::: "memory"); __builtin_amdgcn_s_barrier(); asm volatile("" ::: "memory"); } while (0)
typedef __bf16 bf16n2 __attribute__((ext_vector_type(2)));
__device__ __forceinline__ unsigned pk2(float lo, float hi) { const f32x2 v = {lo, hi}; return __builtin_bit_cast(unsigned, __builtin_convertvector(v, bf16n2)); }
__device__ __forceinline__ unsigned f2bf(float f) { return pk2(f, 0.f) & 0xffffu; }
__device__ __forceinline__ float bf2f(unsigned short b) { return __builtin_bit_cast(float, ((unsigned)b) << 16); }
__device__ __forceinline__ float bflo(unsigned u) { return __builtin_bit_cast(float, u << 16); }
__device__ __forceinline__ float bfhi(unsigned u) { return __builtin_bit_cast(float, u & 0xffff0000u); }
__device__ __forceinline__ unsigned cvt_pk_bf16(float lo, float hi) { return pk2(lo, hi); }
__device__ __forceinline__ unsigned pk4_fp8(float a, float b, float c, float d) { int r = 0; r = __builtin_amdgcn_cvt_pk_fp8_f32(a, b, r, false); r = __builtin_amdgcn_cvt_pk_fp8_f32(c, d, r, true); return (unsigned)r; }
__device__ __forceinline__ float wave_sum(float v) {
#pragma unroll
    for (int o = 1; o < 64; o <<= 1) v += __shfl_xor(v, o);
    return v;
}
__device__ __forceinline__ float wave_max(float v) {
#pragma unroll
    for (int o = 1; o < 64; o <<= 1) v = fmaxf(v, __shfl_xor(v, o));
    return v;
}
__device__ __forceinline__ float sigmoidf_(float x) { return __builtin_amdgcn_rcpf(1.0f + __builtin_amdgcn_exp2f(-1.4426950408889634f * x)); }
__device__ __forceinline__ float siluf_(float x) { return x * __builtin_amdgcn_rcpf(1.0f + __builtin_amdgcn_exp2f(-1.4426950408889634f * x)); }
__device__ __forceinline__ float logsigmoidf_(float x) { return fminf(x, 0.f) - log1pf(__expf(-fabsf(x))); }

#define XB_TMO      128
#define XB_XCNT(j)  (256  + 64 * (j))
#define XB_XSUB(j)  (1280 + 64 * (j))
#define XB_XGEN(j)  (2304 + 64 * (j))
#define XB_TOP      3328
#define XB_TOPGEN   3392
#define XCD_BAR_WORDS 3456
#define XB_SPIN_CAP (1u << 20)

__device__ __forceinline__ unsigned xb_ld(unsigned* p)              { return __hip_atomic_load(p, __ATOMIC_RELAXED, __HIP_MEMORY_SCOPE_AGENT); }
__device__ __forceinline__ unsigned xb_add(unsigned* p, unsigned v) { return __hip_atomic_fetch_add(p, v, __ATOMIC_RELAXED, __HIP_MEMORY_SCOPE_AGENT); }
__device__ __forceinline__ unsigned xb_xcc_id() { return (unsigned)__builtin_amdgcn_s_getreg((3 << 11) | 20) & 0xFu; }
#define XB_SPIN(cond, bar) do { unsigned _sp = 0; while (cond) { __builtin_amdgcn_s_sleep(1); \
    if ((++_sp & 255u) == 0u) { if (xb_ld(&(bar)[XB_TMO])) break; if (_sp > XB_SPIN_CAP) { atomicAdd(&(bar)[XB_TMO], 1u); break; } } } } while (0)

struct XcdBarrier { unsigned* bar; unsigned x; volatile LAS unsigned* st; };

__device__ __forceinline__ XcdBarrier xcd_barrier_post(unsigned* bar, volatile LAS unsigned* st) {
    XcdBarrier b; b.bar = bar; b.x = xb_xcc_id(); b.st = st;
    if (threadIdx.x == 0) (void)xb_add(&bar[XB_XCNT(b.x)], 1u);
    return b;
}
__device__ __forceinline__ void xcd_barrier_complete(unsigned* bar, unsigned x, unsigned& nloc, unsigned& nx) {
    const unsigned G = gridDim.x * gridDim.y * gridDim.z;
    unsigned sum, cnt, mine, sp = 0u;
    for (;;) {
        sum = 0u; cnt = 0u; mine = 0u;
#pragma unroll
        for (unsigned j = 0; j < 16; ++j) { const unsigned c = xb_ld(&bar[XB_XCNT(j)]); sum += c; cnt += (c > 0u) ? 1u : 0u; mine = (j == x) ? c : mine; }
        if (sum == G) break;
        __builtin_amdgcn_s_sleep(1);
        if ((++sp & 255u) == 0u) { if (xb_ld(&bar[XB_TMO])) break; if (sp > XB_SPIN_CAP) { atomicAdd(&bar[XB_TMO], 1u); break; } }
    }
    nloc = mine > 0u ? mine : 1u; nx = cnt > 0u ? cnt : 1u;
}
__device__ __forceinline__ void xcd_barrier(const XcdBarrier& b) {
    asm volatile("s_waitcnt vmcnt(0)" ::: "memory");
    __syncthreads();
    if (threadIdx.x == 0) {
        unsigned* bar = b.bar;
        __builtin_amdgcn_s_waitcnt(0);
        unsigned nloc = b.st[0], nx = b.st[1];
        if (nloc == 0u) { xcd_barrier_complete(bar, b.x, nloc, nx); b.st[0] = nloc; b.st[1] = nx; }
        const unsigned old = xb_add(&bar[XB_XSUB(b.x)], 1u);
        const unsigned gen = old / nloc;
        if (old + 1u == (gen + 1u) * nloc) {
            __builtin_amdgcn_fence(__ATOMIC_RELEASE, "agent");
            asm volatile("s_waitcnt vmcnt(0)" ::: "memory");
            const unsigned og = xb_add(&bar[XB_TOP], 1u);
            const unsigned tg = og / nx;
            if (og + 1u == (tg + 1u) * nx) xb_add(&bar[XB_TOPGEN], 1u);
            else XB_SPIN(xb_ld(&bar[XB_TOPGEN]) == tg, bar);
            __builtin_amdgcn_fence(__ATOMIC_ACQUIRE, "agent");
            xb_add(&bar[XB_XGEN(b.x)], 1u);
            asm volatile("s_waitcnt vmcnt(0)" ::: "memory");
        } else {
            XB_SPIN(xb_ld(&bar[XB_XGEN(b.x)]) == gen, bar);
            __builtin_amdgcn_fence(__ATOMIC_ACQUIRE, "agent");
            asm volatile("s_waitcnt vmcnt(0)" ::: "memory");
        }
    }
    __syncthreads();
}
#define N_LAUNCH_MODE 0
#define ENABLE_RET 1
#define ENABLE_ATT 1
#define ENABLE_GLA 1
#define ENABLE_MLS 1
#define ENABLE_MOE 1
#define MOE_FP8 1
#define S2_ABL 0
#define OUT_FP8 1
#define YP_FP8 1
#define MOE_NULL 0
#define MOE_WHICH 3
#define MOE_HOT 0
#define WNT 1
#define CVT_HOST 2
#define S2X 1
#define S2M 1
#define GFP8_RET 0
#define GFP8_GLA 0
#define GFP8_MLS 0
#define MOE_PRO_LAYERS 1
#define MLS_S2MODE 2
#define IFP8_RET 0
#define IFP8_GLA 0
#define IFP8_MLS 0
#define IFP8_ATT 1
#define REP_PRO 1
#define REP_MOE 1
#define REP_INPROJ 1
#define REP_S1 1
#define REP_S2 1
#define REP_S2M 1
#define REP_S2R 1
#define REP_PRE 1
#define REP_HN 1
#define REP_ATT 1
#define REP_NORM 1
#define REP_OUT 1
#define REP_BAR 1
struct CvtJob { const float* wp; unsigned char* op; int ld; int lane; };
namespace pg8 {
constexpr int BM = 256, BK = 64, HALF = 128, HTB = HALF * BK * 2, STAGE_BYTES = 8 * HTB, NXCD = 8, WGM = 8;
__host__ __device__ __forceinline__ int lds_byte(int r, int c) { const int st = (r >> 4) * 2 + (c >> 5), rr = r & 15, cc = c & 31, ob = rr * 64 + cc * 2; return st * 1024 + (ob ^ (((ob >> 9) & 1) << 5)); }
__host__ __device__ __forceinline__ void stage_rc(int b, int& R, int& C) { const int st = b / 1024, sb = b % 1024, swz = sb ^ (((sb >> 9) & 1) << 5); R = (st >> 1) * 16 + swz / 64; C = (st & 1) * 32 + (swz % 64) / 2; }
__host__ __device__ __forceinline__ int perm32(int rho) { const int n = rho >> 4, i = rho & 15; return 8 * (i >> 2) + 4 * n + (i & 3); }

struct Unit { int pm, pn; };
struct Gemm { const bf16_t* A; const bf16_t* Bt; int M, N, K; };

struct StaticOrder {
    int nM, nN, nwg, G, c;
    __device__ void init(int M, int N, int G_, int c_) { nM = M / BM; nN = N / BM; nwg = nM * nN; G = G_; c = c_; }
    __device__ bool next(int i, Unit& u) const {
        const long L = (long)i * G + c; if (L >= nwg) return false;
        int wgid = (int)L; { const int q = nwg / NXCD, r = nwg % NXCD, xcd = wgid % NXCD, off = wgid / NXCD; wgid = (xcd < r ? xcd * (q + 1) : r * (q + 1) + (xcd - r) * q) + off; }
        const int nig = WGM * nN, gid = wgid / nig, fm = gid * WGM, gsz = (nM - fm) < WGM ? (nM - fm) : WGM;
        u.pm = fm + ((wgid % nig) % gsz); u.pn = (wgid % nig) / gsz; return true;
    }
    __device__ __forceinline__ unsigned rowtok(int, int) const { return 0u; }
};
struct MoeOrder {
    const LAS int* utab;
    const LAS unsigned short* idx;
    int nmy;
    __device__ __forceinline__ bool next(int i, Unit& u) const { if (i >= nmy) return false; u.pm = utab[2 * i]; u.pn = utab[2 * i + 1]; return true; }
    __device__ __forceinline__ unsigned rowtok(int i, int r) const { return (unsigned)idx[i * 256 + r]; }
};

struct NoBg { static constexpr bool ON = false; };
template <class Epi, class Sched, bool GATHER, bool FP8, class Bg>
__device__ __forceinline__ void gemm_phase_bg(LAS unsigned char* lds, const Gemm g, const Sched& S, const Epi& E, Bg& bg) {
    const int tid = threadIdx.x, wid = __builtin_amdgcn_readfirstlane(tid >> 6), lane = tid & 63, wr = wid >> 2, wc = wid & 3, fr = lane & 15, fq = lane >> 4;
    const int K = g.K, nt = K / BK;
    unsigned voffA[2], voffB[2]; int rowA[2];
#pragma unroll
    for (int i = 0; i < 2; ++i) { int R, C; stage_rc(tid * 16 + i * 8192, R, C); const int Rb = Epi::PERM2 ? ((R >> 5) * 64 + ((R >> 2) & 3) * 16 + ((R >> 4) & 1) * 4 + (R & 3)) : (Epi::PERM ? ((R & ~31) + perm32(R & 31)) : R);
        rowA[i] = R; voffA[i] = GATHER ? (unsigned)(C * 2) : (unsigned)(R * K + C) * 2u; voffB[i] = (unsigned)(Rb * K + C) * 2u; }
    const size_t kstep = (size_t)(BK * 2);
    const size_t hstep = (size_t)HALF * K * 2;
    const size_t bhstep = Epi::PERM2 ? (size_t)8 * K * 2 : hstep;
    const size_t tstep = 2 * hstep;
    const unsigned ldsw = (unsigned)wid * 1024u;
    const int aoff = FP8 ? lds_byte(wr * 64 + fr, fq * 16) : lds_byte(wr * 64 + fr, fq * 8), boff = FP8 ? lds_byte(wc * 32 + fr, fq * 16) : lds_byte(wc * 32 + fr, fq * 8);
    const int fo1 = (fq & 1) ? 16 : 0, fo2 = 16 - fo1;
    const int aoff1 = aoff + fo1, aoff2 = aoff + fo2, boff1 = boff + fo1, boff2 = boff + fo2;
    const unsigned rowbytes = (unsigned)K * 2u;
#define PG8_SA(b, h) (((b) * 2 + (h)) * HTB)
#define PG8_SB(b, h) ((4 + (b) * 2 + (h)) * HTB)
#define PG8_STAGE(bufoff, gbase, voff) do { _Pragma("unroll") for (int _i = 0; _i < 2; ++_i) \
        __builtin_amdgcn_global_load_lds((const unsigned*)((const char*)(gbase) + (voff)[_i]), (LAS unsigned*)(lds + (bufoff) + ldsw + _i * 8192), 16, 0, 0); } while (0)
#define PG8_STAGE_A(bufoff, tptr, half, vg) do { if constexpr (GATHER) { PG8_STAGE(bufoff, tptr, (vg)[half]); } else { PG8_STAGE(bufoff, (tptr) + (half) * hstep, voffA); } } while (0)
#define PG8_LDA8(dst, b, h) do { _Pragma("unroll") for (int m = 0; m < 4; ++m) { const i32x4 lo_ = *(const LAS i32x4*)(lds + PG8_SA(b, h) + aoff1 + m * 2048), hi_ = *(const LAS i32x4*)(lds + PG8_SA(b, h) + aoff2 + m * 2048); \
        dst[m] = (i32x8){lo_.x, lo_.y, lo_.z, lo_.w, hi_.x, hi_.y, hi_.z, hi_.w}; } } while (0)
#define PG8_LDB8(dst, b, h) do { _Pragma("unroll") for (int n = 0; n < 2; ++n) { const i32x4 lo_ = *(const LAS i32x4*)(lds + PG8_SB(b, h) + boff1 + n * 2048), hi_ = *(const LAS i32x4*)(lds + PG8_SB(b, h) + boff2 + n * 2048); \
        dst[n] = (i32x8){lo_.x, lo_.y, lo_.z, lo_.w, hi_.x, hi_.y, hi_.z, hi_.w}; } } while (0)
#define PG8_MMA8(ai, bj, At, Bt) do { __builtin_amdgcn_s_setprio(1); _Pragma("unroll") for (int m = 0; m < 4; ++m) _Pragma("unroll") for (int n = 0; n < 2; ++n) \
        asm volatile("v_mfma_scale_f32_16x16x128_f8f6f4 %0, %1, %2, %0, %3, %3 op_sel_hi:[0,0,0]" : "+v"(acc[ai][bj][m][n]) : "v"(Bt[n]), "v"(At[m]), "v"(sc7f)); __builtin_amdgcn_s_setprio(0); } while (0)
#define PG8_LDA(dst, b, h) do { _Pragma("unroll") for (int m = 0; m < 4; ++m) _Pragma("unroll") for (int k = 0; k < 2; ++k) dst[m][k] = *(const LAS bf16x8*)(lds + PG8_SA(b, h) + aoff + m * 2048 + k * 1024); } while (0)
#define PG8_LDB(dst, b, h) do { _Pragma("unroll") for (int n = 0; n < 2; ++n) _Pragma("unroll") for (int k = 0; k < 2; ++k) dst[n][k] = *(const LAS bf16x8*)(lds + PG8_SB(b, h) + boff + n * 2048 + k * 1024); } while (0)
#define PG8_MMA(ai, bj, At, Bt) do { __builtin_amdgcn_s_setprio(1); _Pragma("unroll") for (int m = 0; m < 4; ++m) _Pragma("unroll") for (int n = 0; n < 2; ++n) _Pragma("unroll") for (int k = 0; k < 2; ++k) \
        acc[ai][bj][m][n] = __builtin_amdgcn_mfma_f32_16x16x32_bf16(Bt[n][k], At[m][k], acc[ai][bj][m][n], 0, 0, 0); __builtin_amdgcn_s_setprio(0); } while (0)
#define PG8_WAIT_V(n) asm volatile("s_waitcnt vmcnt(" #n ")" ::: "memory")
#define PG8_WAIT_L(n) asm volatile("s_waitcnt lgkmcnt(" #n ")" ::: "memory")
#define PG8_BAR __builtin_amdgcn_s_barrier()
#define PG8_SCHED __builtin_amdgcn_sched_barrier(0)
#define XLDA(b, h) do { if constexpr (FP8) { PG8_LDA8(At8, b, h); } else { PG8_LDA(At, b, h); } } while (0)
#define XLDB(w_, b, h) do { if constexpr (FP8) { if (w_) { PG8_LDB8(B18, b, h); } else { PG8_LDB8(B08, b, h); } } else { if (w_) { PG8_LDB(B1, b, h); } else { PG8_LDB(B0, b, h); } } } while (0)
#define XMMA(ai, bj, w_) do { if constexpr (FP8) { if (w_) { PG8_MMA8(ai, bj, At8, B18); } else { PG8_MMA8(ai, bj, At8, B08); } } else { if (w_) { PG8_MMA(ai, bj, At, B1); } else { PG8_MMA(ai, bj, At, B0); } } } while (0)
    Unit cur, nxt; int ui = 0;
    if (!S.next(0, cur)) return;
    f32x4 acc[2][2][4][2];
#pragma unroll
    for (int a = 0; a < 2; ++a)
#pragma unroll
        for (int b = 0; b < 2; ++b)
#pragma unroll
            for (int m = 0; m < 4; ++m)
#pragma unroll
                for (int n = 0; n < 2; ++n) acc[a][b][m][n] = (f32x4){0.f, 0.f, 0.f, 0.f};
    bf16x8 At[4][2], B0[2][2], B1[2][2];
    i32x8 At8[4], B08[2], B18[2]; const int sc7f = 0x7f7f7f7f;
    unsigned vgc[2][2], vgn[2][2];
    if constexpr (GATHER) {
#pragma unroll
        for (int h = 0; h < 2; ++h)
#pragma unroll
            for (int i = 0; i < 2; ++i) { vgc[h][i] = S.rowtok(0, h * HALF + rowA[i]) * rowbytes + voffA[i]; vgn[h][i] = vgc[h][i]; }
    }
    const char* cA = GATHER ? (const char*)g.A : (const char*)g.A + (size_t)cur.pm * tstep; const char* cB = (const char*)g.Bt + (size_t)cur.pn * tstep;
    PG8_STAGE(PG8_SB(0, 0), cB, voffB); PG8_STAGE_A(PG8_SA(0, 0), cA, 0, vgc); PG8_STAGE(PG8_SB(0, 1), cB + bhstep, voffB); PG8_STAGE_A(PG8_SA(0, 1), cA, 1, vgc);
    if (wr == 1) PG8_BAR;
    PG8_WAIT_V(4); PG8_BAR;
    PG8_STAGE(PG8_SB(1, 0), cB + kstep, voffB); PG8_STAGE_A(PG8_SA(1, 0), cA + kstep, 0, vgc); PG8_STAGE(PG8_SB(1, 1), cB + bhstep + kstep, voffB);
    PG8_WAIT_V(6); PG8_BAR;
    for (;;) {
        const bool has_next = S.next(ui + 1, nxt);
        if constexpr (GATHER) {
            if (has_next) {
#pragma unroll
                for (int h = 0; h < 2; ++h)
#pragma unroll
                    for (int i = 0; i < 2; ++i) vgn[h][i] = S.rowtok(ui + 1, h * HALF + rowA[i]) * rowbytes + voffA[i];
            } else {
#pragma unroll
                for (int h = 0; h < 2; ++h)
#pragma unroll
                    for (int i = 0; i < 2; ++i) vgn[h][i] = vgc[h][i];
            }
        }
        const char* nA = GATHER ? cA : (has_next ? (const char*)g.A + (size_t)nxt.pm * tstep : cA); const char* nB = has_next ? (const char*)g.Bt + (size_t)nxt.pn * tstep : cB;
        for (int t = 0; t < nt; t += 2) {
            const bool last = (t == nt - 2);
            const char* a1 = cA + (size_t)(t + 1) * kstep;
            const char* a2 = last ? nA : cA + (size_t)(t + 2) * kstep; const char* b2 = last ? nB : cB + (size_t)(t + 2) * kstep;
            const char* a3 = a2 + kstep; const char* b3 = b2 + kstep;
            unsigned vg2[2][2];
            if constexpr (GATHER) {
#pragma unroll
                for (int h = 0; h < 2; ++h)
#pragma unroll
                    for (int i = 0; i < 2; ++i) vg2[h][i] = last ? vgn[h][i] : vgc[h][i];
            }
            XLDB(0, 0, 0); PG8_SCHED; XLDA(0, 0); PG8_STAGE_A(PG8_SA(1, 1), a1, 1, vgc);
            PG8_WAIT_L(8); PG8_BAR; PG8_WAIT_L(0); XMMA(0, 0, 0); PG8_BAR; PG8_SCHED;
            XLDB(1, 0, 1); PG8_STAGE(PG8_SB(0, 0), b2, voffB);
            PG8_BAR; PG8_WAIT_L(0); XMMA(0, 1, 1); PG8_BAR;
            XLDA(0, 1); PG8_STAGE_A(PG8_SA(0, 0), a2, 0, vg2);
            PG8_BAR; PG8_WAIT_L(0); XMMA(1, 0, 0); PG8_BAR; PG8_SCHED;
            PG8_STAGE(PG8_SB(0, 1), b2 + bhstep, voffB);
            PG8_WAIT_V(6); PG8_BAR; XMMA(1, 1, 1); PG8_BAR;
            XLDB(0, 1, 0); PG8_SCHED; XLDA(1, 0); PG8_STAGE_A(PG8_SA(0, 1), a2, 1, vg2);
            PG8_WAIT_L(8); PG8_BAR; PG8_WAIT_L(0); XMMA(0, 0, 0); PG8_BAR; PG8_SCHED;
            XLDB(1, 1, 1); PG8_STAGE(PG8_SB(1, 0), b3, voffB);
            PG8_BAR; PG8_WAIT_L(0); XMMA(0, 1, 1); PG8_BAR;
            XLDA(1, 1); PG8_STAGE_A(PG8_SA(1, 0), a3, 0, vg2);
            PG8_BAR; PG8_WAIT_L(0); XMMA(1, 0, 0); PG8_BAR; PG8_SCHED;
            PG8_STAGE(PG8_SB(1, 1), b3 + bhstep, voffB);
            PG8_WAIT_V(6); PG8_BAR; XMMA(1, 1, 1); PG8_BAR;
        }
        if constexpr (FP8) { asm volatile("s_nop 15\n\ts_nop 15" ::: "memory"); }
        if constexpr (Bg::ON) E.run(acc, cur, wr, wc, fr, fq, bg); else E(acc, cur, wr, wc, fr, fq);
        if (!has_next) break;
#pragma unroll
        for (int a = 0; a < 2; ++a)
#pragma unroll
            for (int b = 0; b < 2; ++b)
#pragma unroll
                for (int m = 0; m < 4; ++m)
#pragma unroll
                    for (int n = 0; n < 2; ++n) acc[a][b][m][n] = (f32x4){0.f, 0.f, 0.f, 0.f};
        cur = nxt; cA = nA; cB = nB; ++ui;
        if constexpr (GATHER) {
#pragma unroll
            for (int h = 0; h < 2; ++h)
#pragma unroll
                for (int i = 0; i < 2; ++i) vgc[h][i] = vgn[h][i];
        }
    }
    PG8_WAIT_V(0);
    if (wr == 0) PG8_BAR;
    PG8_BAR;
#undef PG8_SA
#undef PG8_SB
#undef PG8_STAGE
#undef PG8_STAGE_A
#undef PG8_LDA
#undef PG8_LDA8
#undef PG8_LDB8
#undef PG8_MMA8
#undef XLDA
#undef XLDB
#undef XMMA
#undef PG8_LDB
#undef PG8_MMA
#undef PG8_WAIT_V
#undef PG8_WAIT_L
#undef PG8_BAR
#undef PG8_SCHED
}
template <class Epi, class Sched, bool GATHER, bool FP8 = false>
__device__ __forceinline__ void gemm_phase(LAS unsigned char* lds, const Gemm g, const Sched& S, const Epi& E) { NoBg nb; gemm_phase_bg<Epi, Sched, GATHER, FP8, NoBg>(lds, g, S, E, nb); }


template <bool XBF> struct EpiResid {
    static constexpr bool PERM = true, PERM2 = false;
    const void* xin; bf16_t* xout; const float* gate; float gs;
    __device__ __forceinline__ void operator()(const f32x4 (&acc)[2][2][4][2], const Unit& u, int wr, int wc, int fr, int fq) const {
        const int row0 = u.pm * BM + wr * 64 + fr, col0 = u.pn * BM + wc * 32 + 8 * fq;
        const int b = (u.pm * BM) >> 12;
        f32x4 gv[2][2];
#pragma unroll
        for (int bj = 0; bj < 2; ++bj)
#pragma unroll
            for (int n = 0; n < 2; ++n) gv[bj][n] = *(const f32x4*)(gate + (size_t)b * 6144 + col0 + bj * HALF + 4 * n) * gs;
#pragma unroll
        for (int ai = 0; ai < 2; ++ai)
#pragma unroll
            for (int m = 0; m < 4; ++m) { const size_t ro = (size_t)(row0 + ai * HALF + m * 16) * DM + col0;
#pragma unroll
                for (int bj = 0; bj < 2; ++bj) { f32x4 x0, x1;
                    if (XBF) { const u32x4 p = *(const u32x4*)((const bf16_t*)xin + ro + bj * HALF); x0 = (f32x4){bflo(p.x), bfhi(p.x), bflo(p.y), bfhi(p.y)}; x1 = (f32x4){bflo(p.z), bfhi(p.z), bflo(p.w), bfhi(p.w)}; }
                    else { x0 = *(const f32x4*)((const float*)xin + ro + bj * HALF); x1 = *(const f32x4*)((const float*)xin + ro + bj * HALF + 4); }
                    const f32x4 o0 = x0 + gv[bj][0] * acc[ai][bj][m][0], o1 = x1 + gv[bj][1] * acc[ai][bj][m][1];
                    u32x4 q; q.x = pk2(o0[0], o0[1]); q.y = pk2(o0[2], o0[3]); q.z = pk2(o1[0], o1[1]); q.w = pk2(o1[2], o1[3]);
                    *(u32x4*)(xout + ro + bj * HALF) = q; } }
    }
};
struct EpiBf16S {
    static constexpr bool PERM = true, PERM2 = false;
    bf16_t* O; int ldc; int nscaled; float scale; float gs;
    __device__ __forceinline__ void operator()(const f32x4 (&acc)[2][2][4][2], const Unit& u, int wr, int wc, int fr, int fq) const {
        const int row0 = u.pm * BM + wr * 64 + fr; const int col0 = u.pn * BM + wc * 32 + 8 * fq;
        const float sc = ((u.pn < nscaled) ? scale : 1.0f) * gs;
#pragma unroll
        for (int ai = 0; ai < 2; ++ai)
#pragma unroll
            for (int m = 0; m < 4; ++m) { bf16_t* rowp = O + (size_t)(row0 + ai * HALF + m * 16) * ldc + col0;
#pragma unroll
                for (int bj = 0; bj < 2; ++bj) { const f32x4 v0 = acc[ai][bj][m][0] * sc, v1 = acc[ai][bj][m][1] * sc;
                    u32x4 w; w.x = cvt_pk_bf16(v0[0], v0[1]); w.y = cvt_pk_bf16(v0[2], v0[3]); w.z = cvt_pk_bf16(v1[0], v1[1]); w.w = cvt_pk_bf16(v1[2], v1[3]);
                    *(u32x4*)(rowp + bj * HALF) = w; } }
    }
};
struct EpiRet {
    static constexpr bool PERM = true, PERM2 = false;
    bf16_t* O; const f32x2* rope; float gs;
    __device__ __forceinline__ void operator()(const f32x4 (&acc)[2][2][4][2], const Unit& u, int wr, int wc, int fr, int fq) const { NoBg nb; run(acc, u, wr, wc, fr, fq, nb); }
    template <class Bg> __device__ __forceinline__ void run(const f32x4 (&acc)[2][2][4][2], const Unit& u, int wr, int wc, int fr, int fq, Bg& hook) const {
        const int row0 = u.pm * BM + wr * 64 + fr; const int col0 = u.pn * BM + wc * 32 + 8 * fq;
        const float sc = ((u.pn >= 4 && u.pn < 8) ? 0.0625f : 1.0f) * gs;
        if (u.pn < 8) { NoBg nb; rows<true>(acc, row0, col0, sc, wc, fq, nb); } else rows<false>(acc, row0, col0, sc, wc, fq, hook);
    }
    template <bool ROT, class Bg> __device__ __forceinline__ void rows(const f32x4 (&acc)[2][2][4][2], int row0, int col0, float sc, int wc, int fq, Bg& hook) const {
        float cv[64]; CvtJob cj; bool cp = false;
        if constexpr (Bg::ON) { cp = hook.begin(cj); if (cp) Bg::load1(cj, cv); __builtin_amdgcn_sched_barrier(0); }
#pragma unroll
        for (int ai = 0; ai < 2; ++ai)
#pragma unroll
            for (int m = 0; m < 4; ++m) { const int row = row0 + ai * HALF + m * 16; bf16_t* rowp = O + (size_t)row * 6144 + col0;
                f32x4 a0 = acc[ai][0][m][0], a1 = acc[ai][0][m][1], b0 = acc[ai][1][m][0], b1 = acc[ai][1][m][1];
                if constexpr (!ROT) { a0 = a0 * gs; a1 = a1 * gs; b0 = b0 * gs; b1 = b1 * gs; }
                else {
                    const f32x2* cs = rope + (size_t)(row & (SEQ - 1)) * 128 + wc * 32 + 8 * fq;
                    f32x4 o0, o1, p0, p1;
#pragma unroll
                    for (int j = 0; j < 4; ++j) { const f32x2 c0 = cs[j], c1 = cs[4 + j];
                        o0[j] = (a0[j] * c0.x - b0[j] * c0.y) * sc; p0[j] = (a0[j] * c0.y + b0[j] * c0.x) * sc;
                        o1[j] = (a1[j] * c1.x - b1[j] * c1.y) * sc; p1[j] = (a1[j] * c1.y + b1[j] * c1.x) * sc; }
                    a0 = o0; a1 = o1; b0 = p0; b1 = p1;
                }
                u32x4 w; w.x = cvt_pk_bf16(a0[0], a0[1]); w.y = cvt_pk_bf16(a0[2], a0[3]); w.z = cvt_pk_bf16(a1[0], a1[1]); w.w = cvt_pk_bf16(a1[2], a1[3]);
                *(u32x4*)(rowp) = w;
                w.x = cvt_pk_bf16(b0[0], b0[1]); w.y = cvt_pk_bf16(b0[2], b0[3]); w.z = cvt_pk_bf16(b1[0], b1[1]); w.w = cvt_pk_bf16(b1[2], b1[3]);
                *(u32x4*)(rowp + HALF) = w;
                if constexpr (Bg::ON) { if (ai == 0 && m == 3) { __builtin_amdgcn_sched_barrier(0); if (cp) Bg::load2(cj, cv); } } }
        if constexpr (Bg::ON) { __builtin_amdgcn_sched_barrier(0); if (cp) Bg::store(cj, cv); }
    }
};
struct EpiSwiglu {
    static constexpr bool PERM = true, PERM2 = false;
    bf16_t* O; const float* b1;
    __device__ __forceinline__ void operator()(const f32x4 (&acc)[2][2][4][2], const Unit& u, int wr, int wc, int fr, int fq) const {
        const int e = u.pn >> 3, pl = u.pn & 7;
        const int row0 = u.pm * BM + wr * 64 + fr; const int c0 = pl * 128 + wc * 32 + 8 * fq;
        const float* bg = b1 + (size_t)e * 2048 + c0; const float* bl = bg + 1024;
        const f32x4 bg0 = *(const f32x4*)bg, bg1 = *(const f32x4*)(bg + 4), bl0 = *(const f32x4*)bl, bl1 = *(const f32x4*)(bl + 4);
#pragma unroll
        for (int ai = 0; ai < 2; ++ai)
#pragma unroll
            for (int m = 0; m < 4; ++m) { bf16_t* rowp = O + (size_t)(row0 + ai * HALF + m * 16) * 1024 + c0;
                const f32x4 g0 = acc[ai][0][m][0] + bg0, g1 = acc[ai][0][m][1] + bg1, l0 = acc[ai][1][m][0] + bl0, l1 = acc[ai][1][m][1] + bl1;
                float r[8];
#pragma unroll
                for (int j = 0; j < 4; ++j) {
                    const float ga = fminf(g0[j], 7.0f), la = fminf(fmaxf(l0[j], -7.0f), 7.0f);
                    r[j] = ga * __builtin_amdgcn_rcpf(1.0f + __builtin_amdgcn_exp2f(-2.4554669595930157f * ga)) * (la + 1.0f);
                    const float gb = fminf(g1[j], 7.0f), lb = fminf(fmaxf(l1[j], -7.0f), 7.0f);
                    r[4 + j] = gb * __builtin_amdgcn_rcpf(1.0f + __builtin_amdgcn_exp2f(-2.4554669595930157f * gb)) * (lb + 1.0f); }
                u32x4 w; w.x = cvt_pk_bf16(r[0], r[1]); w.y = cvt_pk_bf16(r[2], r[3]); w.z = cvt_pk_bf16(r[4], r[5]); w.w = cvt_pk_bf16(r[6], r[7]);
                *(u32x4*)(rowp) = w; }
    }
};
struct EpiSwiglu8 {
    static constexpr bool PERM = true, PERM2 = false;
    unsigned char* O; const float* b1;
    static __device__ __forceinline__ f32x2 act2(f32x2 accg, f32x2 accl, f32x2 bg, f32x2 bl) {
        const f32x2 ws2 = {0.03125f, 0.03125f};
        f32x2 gg = accg * ws2 + bg, ll = accl * ws2 + bl;
        gg.x = fminf(gg.x, 7.0f); gg.y = fminf(gg.y, 7.0f);
        ll.x = fminf(fmaxf(ll.x, -7.0f), 7.0f); ll.y = fminf(fmaxf(ll.y, -7.0f), 7.0f);
        const f32x2 ea = gg * (f32x2){-2.4554669595930157f, -2.4554669595930157f};
        f32x2 den; den.x = __builtin_amdgcn_exp2f(ea.x); den.y = __builtin_amdgcn_exp2f(ea.y);
        den = den + (f32x2){1.0f, 1.0f};
        f32x2 rc; rc.x = __builtin_amdgcn_rcpf(den.x); rc.y = __builtin_amdgcn_rcpf(den.y);
        return (gg * rc) * (ll + (f32x2){1.0f, 1.0f});
    }
    __device__ __forceinline__ void operator()(const f32x4 (&acc)[2][2][4][2], const Unit& u, int wr, int wc, int fr, int fq) const { NoBg nb; run(acc, u, wr, wc, fr, fq, nb); }
    template <class Bg> __device__ __forceinline__ void run(const f32x4 (&acc)[2][2][4][2], const Unit& u, int wr, int wc, int fr, int fq, Bg& hook) const {
        const int e = u.pn >> 3, pl = u.pn & 7;
        const int row0 = u.pm * BM + wr * 64 + fr; const int c0 = pl * 128 + wc * 32 + 8 * fq;
        const float* bg = b1 + (size_t)e * 2048 + c0; const float* bl = bg + 1024;
        const f32x4 bg0 = *(const f32x4*)bg, bg1 = *(const f32x4*)(bg + 4), bl0 = *(const f32x4*)bl, bl1 = *(const f32x4*)(bl + 4);
        float cv[64]; CvtJob cj; bool cp = false;
        if constexpr (Bg::ON) { __builtin_amdgcn_sched_barrier(0); cp = hook.begin(cj); if (cp) Bg::load1(cj, cv); __builtin_amdgcn_sched_barrier(0); }
#pragma unroll
        for (int ai = 0; ai < 2; ++ai)
#pragma unroll
            for (int m = 0; m < 4; ++m) { __builtin_amdgcn_sched_barrier(0); unsigned char* rowp = O + (size_t)(row0 + ai * HALF + m * 16) * 1024 + c0;
                const f32x4 g0 = acc[ai][0][m][0], g1 = acc[ai][0][m][1], l0 = acc[ai][1][m][0], l1 = acc[ai][1][m][1];
                const f32x2 r0 = act2((f32x2){g0[0], g0[1]}, (f32x2){l0[0], l0[1]}, (f32x2){bg0[0], bg0[1]}, (f32x2){bl0[0], bl0[1]});
                const f32x2 r1 = act2((f32x2){g0[2], g0[3]}, (f32x2){l0[2], l0[3]}, (f32x2){bg0[2], bg0[3]}, (f32x2){bl0[2], bl0[3]});
                const f32x2 r2 = act2((f32x2){g1[0], g1[1]}, (f32x2){l1[0], l1[1]}, (f32x2){bg1[0], bg1[1]}, (f32x2){bl1[0], bl1[1]});
                const f32x2 r3 = act2((f32x2){g1[2], g1[3]}, (f32x2){l1[2], l1[3]}, (f32x2){bg1[2], bg1[3]}, (f32x2){bl1[2], bl1[3]});
                u32x2 w; w.x = pk4_fp8(r0.x, r0.y, r1.x, r1.y); w.y = pk4_fp8(r2.x, r2.y, r3.x, r3.y);
                *(u32x2*)(rowp) = w;
                if constexpr (Bg::ON) { if (ai == 0 && m == 3) { __builtin_amdgcn_sched_barrier(0); if (cp) Bg::load2(cj, cv); } } }
        if constexpr (Bg::ON) { __builtin_amdgcn_sched_barrier(0); if (cp) Bg::store(cj, cv); }
    }
};
struct EpiNull {
    static constexpr bool PERM = true, PERM2 = false;
    float* sink;
    __device__ __forceinline__ void operator()(const f32x4 (&acc)[2][2][4][2], const Unit& u, int wr, int wc, int fr, int fq) const {
        float s = 0.f;
#pragma unroll
        for (int ai = 0; ai < 2; ++ai)
#pragma unroll
            for (int bj = 0; bj < 2; ++bj)
#pragma unroll
                for (int m = 0; m < 4; ++m)
#pragma unroll
                    for (int n = 0; n < 2; ++n) s += acc[ai][bj][m][n][0];
        if (s == 123.456f) sink[0] = s;
    }
};
struct EpiMoe2 {
    static constexpr bool PERM = true, PERM2 = (YP_FP8 != 0);
    bf16_t* O; const float* b2; float ws_;
    __device__ __forceinline__ void operator()(const f32x4 (&acc)[2][2][4][2], const Unit& u, int wr, int wc, int fr, int fq) const {
        const int e = u.pn >> 2, pl = u.pn & 3;
        const int row0 = u.pm * BM + wr * 64 + fr;
        if constexpr (PERM2) {
            const int c0 = pl * 256 + wc * 64 + 16 * fq;
            const float* bp = b2 + (size_t)e * 1024 + c0;
            f32x4 bv[2][2];
#pragma unroll
            for (int bj = 0; bj < 2; ++bj)
#pragma unroll
                for (int n = 0; n < 2; ++n) bv[bj][n] = *(const f32x4*)(bp + 8 * bj + 4 * n);
#pragma unroll
            for (int ai = 0; ai < 2; ++ai)
#pragma unroll
                for (int m = 0; m < 4; ++m) { __builtin_amdgcn_sched_barrier(0);
                    const f32x4 v00 = acc[ai][0][m][0] * ws_ + bv[0][0], v01 = acc[ai][0][m][1] * ws_ + bv[0][1], v10 = acc[ai][1][m][0] * ws_ + bv[1][0], v11 = acc[ai][1][m][1] * ws_ + bv[1][1];
                    u32x4 w; w.x = pk4_fp8(v00[0], v00[1], v00[2], v00[3]); w.y = pk4_fp8(v01[0], v01[1], v01[2], v01[3]); w.z = pk4_fp8(v10[0], v10[1], v10[2], v10[3]); w.w = pk4_fp8(v11[0], v11[1], v11[2], v11[3]);
                    *(u32x4*)((unsigned char*)O + (size_t)(row0 + ai * HALF + m * 16) * 1024 + c0) = w; }
        } else {
            const int c0 = pl * 256 + wc * 32 + 8 * fq;
            const float* bp = b2 + (size_t)e * 1024 + c0;
            f32x4 bv[2][2];
#pragma unroll
            for (int bj = 0; bj < 2; ++bj)
#pragma unroll
                for (int n = 0; n < 2; ++n) bv[bj][n] = *(const f32x4*)(bp + bj * HALF + 4 * n);
#pragma unroll
            for (int ai = 0; ai < 2; ++ai)
#pragma unroll
                for (int m = 0; m < 4; ++m) { __builtin_amdgcn_sched_barrier(0); bf16_t* rowp = O + (size_t)(row0 + ai * HALF + m * 16) * 1024 + c0;
#pragma unroll
                    for (int bj = 0; bj < 2; ++bj) { const f32x4 v0 = acc[ai][bj][m][0] * ws_ + bv[bj][0], v1 = acc[ai][bj][m][1] * ws_ + bv[bj][1];
                        u32x4 w; w.x = cvt_pk_bf16(v0[0], v0[1]); w.y = cvt_pk_bf16(v0[2], v0[3]); w.z = cvt_pk_bf16(v1[0], v1[1]); w.w = cvt_pk_bf16(v1[2], v1[3]);
                        *(u32x4*)(rowp + bj * HALF) = w; } }
        }
    }
};
}
struct Frame {
    LAS unsigned char* lds;
    unsigned* ctl;
    unsigned char* ws;
    const float* const* in;
    float* out;
    int tid, lane, wave, G, bid;
};

__device__ __forceinline__ void transpose_item(const float* W, int ld, int K, bf16_t* WT, int drow0, LAS float* scr, int k0, int n0, int lane) {
    f32x4 v[16];
#pragma unroll
    for (int i = 0; i < 16; ++i) v[i] = *(const f32x4*)(W + (size_t)(k0 + 4 * i + (lane >> 4)) * ld + n0 + 4 * (lane & 15));
#pragma unroll
    for (int i = 0; i < 16; ++i) { LAS float* s = scr + (4 * i + (lane >> 4)) * 65 + 4 * (lane & 15); s[0] = v[i].x; s[1] = v[i].y; s[2] = v[i].z; s[3] = v[i].w; }
    LDS_WAIT(); asm volatile("" ::: "memory");
    const int c = lane & 7;
#pragma unroll
    for (int j = 0; j < 8; ++j) { const int n = (lane >> 3) + 8 * j; const LAS float* s = scr + (8 * c) * 65 + n;
        u32x4 o; o.x = pk2(s[0 * 65], s[1 * 65]); o.y = pk2(s[2 * 65], s[3 * 65]); o.z = pk2(s[4 * 65], s[5 * 65]); o.w = pk2(s[6 * 65], s[7 * 65]);
        *(u32x4*)(WT + (size_t)(drow0 + n) * K + k0 + 8 * c) = o; }
    LDS_WAIT(); asm volatile("" ::: "memory");
}
__device__ __forceinline__ void transpose_item8(const float* W, int ld, int K, unsigned char* WT, int drow0, LAS float* scr, int k0, int n0, int lane) {
    f32x4 v[16];
#pragma unroll
    for (int i = 0; i < 16; ++i) v[i] = *(const f32x4*)(W + (size_t)(k0 + 4 * i + (lane >> 4)) * ld + n0 + 4 * (lane & 15));
#pragma unroll
    for (int i = 0; i < 16; ++i) { LAS float* s = scr + (4 * i + (lane >> 4)) * 65 + 4 * (lane & 15); s[0] = v[i].x * 32.0f; s[1] = v[i].y * 32.0f; s[2] = v[i].z * 32.0f; s[3] = v[i].w * 32.0f; }
    LDS_WAIT(); asm volatile("" ::: "memory");
    const int c = lane & 3;
#pragma unroll
    for (int j = 0; j < 4; ++j) { const int n = (lane >> 2) + 16 * j; const LAS float* s = scr + (16 * c) * 65 + n;
        u32x4 o; o.x = pk4_fp8(s[0 * 65], s[1 * 65], s[2 * 65], s[3 * 65]); o.y = pk4_fp8(s[4 * 65], s[5 * 65], s[6 * 65], s[7 * 65]);
        o.z = pk4_fp8(s[8 * 65], s[9 * 65], s[10 * 65], s[11 * 65]); o.w = pk4_fp8(s[12 * 65], s[13 * 65], s[14 * 65], s[15 * 65]);
        *(u32x4*)(WT + (size_t)(drow0 + n) * K + k0 + 16 * c) = o; }
    LDS_WAIT(); asm volatile("" ::: "memory");
}
__device__ __forceinline__ void cvt_item_regs(const float* W, int ld, int K, unsigned char* WT, int drow0, int k0, int n0, int lane) {
    const float* wp = W + (size_t)k0 * ld + n0 + lane;
    float v[64];
#pragma unroll
    for (int i = 0; i < 64; ++i) v[i] = WNT ? __builtin_nontemporal_load(wp + (size_t)i * ld) : wp[(size_t)i * ld];
    unsigned char* op = WT + (size_t)(drow0 + lane) * K + k0;
#pragma unroll
    for (int c = 0; c < 4; ++c) { u32x4 o;
        o.x = pk4_fp8(v[16 * c + 0] * 32.0f, v[16 * c + 1] * 32.0f, v[16 * c + 2] * 32.0f, v[16 * c + 3] * 32.0f);
        o.y = pk4_fp8(v[16 * c + 4] * 32.0f, v[16 * c + 5] * 32.0f, v[16 * c + 6] * 32.0f, v[16 * c + 7] * 32.0f);
        o.z = pk4_fp8(v[16 * c + 8] * 32.0f, v[16 * c + 9] * 32.0f, v[16 * c + 10] * 32.0f, v[16 * c + 11] * 32.0f);
        o.w = pk4_fp8(v[16 * c + 12] * 32.0f, v[16 * c + 13] * 32.0f, v[16 * c + 14] * 32.0f, v[16 * c + 15] * 32.0f);
        *(u32x4*)(op + 16 * c) = o; }
}
__device__ __forceinline__ float cvt_ld(const CvtJob& j, __amdgpu_buffer_rsrc_t r, int i) { return __builtin_bit_cast(float, __builtin_amdgcn_raw_buffer_load_b32(r, j.lane * 4, i * j.ld * 4, 0)); }
__device__ __forceinline__ __amdgpu_buffer_rsrc_t cvt_rsrc(const CvtJob& j) { return __builtin_amdgcn_make_buffer_rsrc((void*)j.wp, 0, 0x7fffffff, 0x00020000); }
__device__ __forceinline__ CvtJob moe_cvt_job(const float* const* in, unsigned char* ws, int l, int gi_, int lane) {
    CvtJob j; j.lane = lane;
    const int gi = __builtin_amdgcn_readfirstlane(gi_);
    if (gi < 32 * 512) { const int e = gi >> 9, q = gi & 511, kb = q >> 5, n0 = (q & 31) * 64, mat = l * 32 + e;
        const int drow = (n0 < 1024) ? ((n0 >> 7) * 256 + (n0 & 127)) : (((n0 - 1024) >> 7) * 256 + 128 + ((n0 - 1024) & 127));
        j.ld = 2048; j.wp = in[31] + (size_t)mat * 1024 * 2048 + (size_t)(kb * 64) * 2048 + n0; j.op = ws + WS_W1T + (size_t)mat * 2048 * 1024 + (size_t)drow * 1024 + kb * 64; }
    else { const int r = gi - 32 * 512, e = r >> 8, q = r & 255, kb = q >> 4, n0 = (q & 15) * 64, mat = l * 32 + e;
        j.ld = 1024; j.wp = in[33] + (size_t)mat * 1024 * 1024 + (size_t)(kb * 64) * 1024 + n0; j.op = ws + WS_W2T + (size_t)mat * 1024 * 1024 + (size_t)n0 * 1024 + kb * 64; }
    return j;
}
__device__ __forceinline__ void cvt_job_load(const CvtJob& j, float (&v)[64]) {
    const __amdgpu_buffer_rsrc_t r = cvt_rsrc(j);
#pragma unroll
    for (int i = 0; i < 64; ++i) v[i] = cvt_ld(j, r, i);
}
__device__ __forceinline__ void cvt_job_store(const CvtJob& j, const float (&v)[64]) {
    unsigned char* op = j.op + (unsigned)j.lane * 1024u;
#pragma unroll
    for (int c = 0; c < 4; ++c) { u32x4 o;
        o.x = pk4_fp8(v[16 * c + 0] * 32.0f, v[16 * c + 1] * 32.0f, v[16 * c + 2] * 32.0f, v[16 * c + 3] * 32.0f);
        o.y = pk4_fp8(v[16 * c + 4] * 32.0f, v[16 * c + 5] * 32.0f, v[16 * c + 6] * 32.0f, v[16 * c + 7] * 32.0f);
        o.z = pk4_fp8(v[16 * c + 8] * 32.0f, v[16 * c + 9] * 32.0f, v[16 * c + 10] * 32.0f, v[16 * c + 11] * 32.0f);
        o.w = pk4_fp8(v[16 * c + 12] * 32.0f, v[16 * c + 13] * 32.0f, v[16 * c + 14] * 32.0f, v[16 * c + 15] * 32.0f);
        *(u32x4*)(op + 16 * c) = o; }
}
__device__ __forceinline__ void cvt_half_load(const CvtJob& j, int hf, float (&v)[32]) {
#pragma unroll
    for (int i = 0; i < 32; ++i) v[i] = j.wp[(size_t)(32 * hf + i) * j.ld + j.lane];
}
__device__ __forceinline__ void cvt_half_store(const CvtJob& j, int hf, const float (&v)[32]) {
    unsigned char* op = j.op + (unsigned)j.lane * 1024u;
#pragma unroll
    for (int c = 0; c < 2; ++c) { u32x4 o;
        o.x = pk4_fp8(v[16 * c + 0] * 32.0f, v[16 * c + 1] * 32.0f, v[16 * c + 2] * 32.0f, v[16 * c + 3] * 32.0f);
        o.y = pk4_fp8(v[16 * c + 4] * 32.0f, v[16 * c + 5] * 32.0f, v[16 * c + 6] * 32.0f, v[16 * c + 7] * 32.0f);
        o.z = pk4_fp8(v[16 * c + 8] * 32.0f, v[16 * c + 9] * 32.0f, v[16 * c + 10] * 32.0f, v[16 * c + 11] * 32.0f);
        o.w = pk4_fp8(v[16 * c + 12] * 32.0f, v[16 * c + 13] * 32.0f, v[16 * c + 14] * 32.0f, v[16 * c + 15] * 32.0f);
        *(u32x4*)(op + 32 * hf + 16 * c) = o; }
}
__device__ __forceinline__ void bg_convert(const float* const* in, unsigned char* ws, int layer, int slot0, int count, int gw, int NGW, int lane) {
    for (int s = 0; s < count; s += 2) {
        const int ga = (slot0 + s) * NGW + gw, gb = (slot0 + s + 1) * NGW + gw;
        const bool va = ga < 24576, vb = (s + 1 < count) && gb < 24576;
        float xa[64], xb[64]; CvtJob ja, jb;
        if (va) { ja = moe_cvt_job(in, ws, layer, ga, lane); cvt_job_load(ja, xa); }
        if (vb) { jb = moe_cvt_job(in, ws, layer, gb, lane); cvt_job_load(jb, xb); }
        if (va) cvt_job_store(ja, xa);
        if (vb) cvt_job_store(jb, xb);
    }
}
template <int NB1> struct BgCvtT {
    static constexpr bool ON = true;
    const float* const* in; unsigned char* ws; int layerA, giA, limA, nA, layerB, limB, slot, nslot, gw, NGW, lane;
    __device__ __forceinline__ void init(const float* const* in_, unsigned char* ws_, int gw_, int NGW_, int lane_, int layerA_, int giA_, int limA_, int layerB_, int limB_) {
        in = in_; ws = ws_; gw = gw_; NGW = NGW_; lane = lane_; layerA = layerA_; giA = giA_; limA = limA_; layerB = layerB_; limB = limB_;
        nA = layerA_ >= 0 ? (limA_ - giA_ + NGW_ - 1) / NGW_ : 0; nslot = nA + (layerB_ >= 0 ? (limB_ + NGW_ - 1) / NGW_ : 0); slot = 0; }
    __device__ __forceinline__ bool sel(int s, int& layer, int& gi) const {
        if (s >= nslot) return false;
        if (s < nA) { layer = layerA; gi = giA + s * NGW + gw; return gi < limA; }
        layer = layerB; gi = (s - nA) * NGW + gw; return gi < limB; }
    __device__ __forceinline__ bool begin(CvtJob& j) { int layer = 0, gi = 0; const bool ok = sel(slot, layer, gi); ++slot; if (ok) j = moe_cvt_job(in, ws, layer, gi, lane); return ok; }
    static __device__ __forceinline__ void load1(const CvtJob& j, float (&v)[64]) { const __amdgpu_buffer_rsrc_t r = cvt_rsrc(j);
#pragma unroll
        for (int i = 0; i < NB1; ++i) v[i] = cvt_ld(j, r, i); }
    static __device__ __forceinline__ void load2(const CvtJob& j, float (&v)[64]) { const __amdgpu_buffer_rsrc_t r = cvt_rsrc(j);
#pragma unroll
        for (int i = NB1; i < 64; ++i) v[i] = cvt_ld(j, r, i); }
    static __device__ __forceinline__ void store(const CvtJob& j, const float (&v)[64]) { cvt_job_store(j, v); }
    __device__ __forceinline__ void finish() {
        for (; slot < nslot; ++slot) { int layer = 0, gi = 0; if (sel(slot, layer, gi)) { const CvtJob jj = moe_cvt_job(in, ws, layer, gi, lane); float x[64]; cvt_job_load(jj, x); cvt_job_store(jj, x); } } }
};
typedef BgCvtT<48> BgCvt;
typedef BgCvtT<40> BgCvtR;
__device__ __forceinline__ void moe_cvt_item(const float* const* in, unsigned char* ws, int l, int gi, int lane) {
    if (gi < 32 * 512) { const int e = gi >> 9, q = gi & 511, kb = q >> 5, n0 = (q & 31) * 64, mat = l * 32 + e;
        const int drow = (n0 < 1024) ? ((n0 >> 7) * 256 + (n0 & 127)) : (((n0 - 1024) >> 7) * 256 + 128 + ((n0 - 1024) & 127));
        cvt_item_regs(in[31] + (size_t)mat * 1024 * 2048, 2048, 1024, ws + WS_W1T + (size_t)mat * 2048 * 1024, drow, kb * 64, n0, lane); }
    else { const int r = gi - 32 * 512, e = r >> 8, q = r & 255, kb = q >> 4, n0 = (q & 15) * 64, mat = l * 32 + e;
        cvt_item_regs(in[33] + (size_t)mat * 1024 * 1024, 1024, 1024, ws + WS_W2T + (size_t)mat * 1024 * 1024, n0, kb * 64, n0, lane); }
}
__device__ __forceinline__ bool tr_job(int& r, const float* W, int ld, int K, int N, bf16_t* WT, LAS float* scr, int lane) {
    const int nb = N / 64, items = (K / 64) * nb;
    if (r >= items) { r -= items; return false; }
    const int kb = r / nb, nn = r % nb;
    transpose_item(W, ld, K, WT, nn * 64, scr, kb * 64, nn * 64, lane);
    return true;
}

__device__ __forceinline__ bool tr_job8(int& r, const float* W, int ld, int K, int N, unsigned char* WT, LAS float* scr, int lane) {
    const int nb = N / 64, items = (K / 64) * nb;
    if (r >= items) { r -= items; return false; }
    const int kb = r / nb, nn = r % nb;
    transpose_item8(W, ld, K, WT, nn * 64, scr, kb * 64, nn * 64, lane);
    return true;
}
__device__ __forceinline__ void prologue_phase(Frame& F) {
    const float* const* in = F.in; unsigned char* ws = F.ws;
    {
        LAS float* sc = (LAS float*)F.lds;
        LAS float* red = (LAS float*)(F.lds + 32768);
        const float* c = in[1];
        for (int i = F.tid; i < NB * DM; i += NTHR) sc[i] = siluf_(c[i]);
        __syncthreads();
        float* mod = (float*)(ws + WS_MOD);
        for (int it = F.bid; it < 4 * 96; it += F.G) {
            const int l = it / 96, cb = it % 96, col = cb * 64 + F.lane;
            const __amdgpu_buffer_rsrc_t wr = __builtin_amdgcn_make_buffer_rsrc((void*)(in[2] + (size_t)l * DM * 6144), 0, 0x7fffffff, 0x00020000);
            float acc[8];
#pragma unroll
            for (int b = 0; b < 8; ++b) acc[b] = 0.f;
            const int k0 = F.wave * 128;
            const LAS float* scp = sc + k0;
#pragma unroll 1
            for (int kk = 0; kk < 128; kk += 64) {
                float wv[64];
#pragma unroll
                for (int j = 0; j < 64; ++j) wv[j] = __builtin_bit_cast(float, __builtin_amdgcn_raw_buffer_load_b32(wr, col * 4, (k0 + kk + j) * 6144 * 4, 0));
#pragma unroll
                for (int j = 0; j < 64; j += 4)
#pragma unroll
                    for (int b = 0; b < 8; ++b) { const f32x4 s4 = *(const LAS f32x4*)(scp + b * DM + kk + j);
                        acc[b] += s4.x * wv[j] + s4.y * wv[j + 1] + s4.z * wv[j + 2] + s4.w * wv[j + 3]; }
            }
#pragma unroll
            for (int b = 0; b < 8; ++b) red[(F.wave * 8 + b) * 64 + F.lane] = acc[b];
            __syncthreads();
            {
                float s = 0.f;
#pragma unroll
                for (int w8 = 0; w8 < 8; ++w8) s += red[(w8 * 8 + F.wave) * 64 + F.lane];
                mod[((size_t)l * NB + F.wave) * 6144 + col] = s + in[3][(size_t)l * 6144 + col];
            }
            __syncthreads();
        }
    }
    const int gw = F.bid * NWAVES + F.wave, NGW = F.G * NWAVES, gt = F.bid * NTHR + F.tid, NGT = F.G * NTHR;
    {
        f32x2* rope = (f32x2*)(ws + WS_ROPE);
        const float inv_t = (float)exp(-(double)(gt & 127) * (9.210340371976184 / 128.0));
        const bool inv_same = (NGT & 127) == 0;
        for (int i = gt; i < SEQ * 128; i += NGT) {
            const int pos = i >> 7, j = i & 127;
            const float inv = inv_same ? inv_t : (float)exp(-(double)j * (9.210340371976184 / 128.0));
            const float ang = (float)pos * inv;
            const double rev = (double)ang * 0.15915494309189535;
            const float fr = (float)(rev - floor(rev));
            rope[i] = (f32x2){__builtin_amdgcn_cosf(fr), __builtin_amdgcn_sinf(fr)};
        }
    }
    {
        bf16_t* wrt = (bf16_t*)(ws + WS_WRT);
        for (int i = gt; i < 4 * 32 * 1024; i += NGT) {
            const int l = i >> 15, e = (i >> 10) & 31, k = i & 1023;
            const float w = in[29][((size_t)l * 1024 + k) * 32 + e];
            const unsigned hi = f2bf(w); const float lo = w - bf2f((unsigned short)hi);
            wrt[((size_t)(l * 2 + 0) * 32 + e) * 1024 + k] = (bf16_t)hi; wrt[((size_t)(l * 2 + 1) * 32 + e) * 1024 + k] = (bf16_t)f2bf(lo);
        }
        bf16_t* wgl = (bf16_t*)(ws + WS_WGL);
        for (int i = gt; i < 16 * 1024; i += NGT) {
            const int e = i >> 10, k = i & 1023;
            const float w = in[13][(size_t)k * 3088 + 2048 + e];
            const unsigned hi = f2bf(w); const float lo = w - bf2f((unsigned short)hi);
            wgl[(size_t)(0 * 16 + e) * 1024 + k] = (bf16_t)hi; wgl[(size_t)(1 * 16 + e) * 1024 + k] = (bf16_t)f2bf(lo);
        }
    }
    {
        bf16_t* wmg = (bf16_t*)(ws + WS_WMG);
        for (int i = gt; i < 16 * 6144; i += NGT) {
            const int e = i / 6144, k = i % 6144;
            const float w = (e < 8) ? in[24][(size_t)k * 8 + e] : 0.f;
            const unsigned hi = f2bf(w); const float lo = w - bf2f((unsigned short)hi);
            wmg[(size_t)e * 6144 + k] = (bf16_t)hi; wmg[(size_t)(16 + e) * 6144 + k] = (bf16_t)f2bf(lo);
        }
    }
    {
        LAS float* scr = (LAS float*)(F.lds + F.wave * 16640);
        constexpr int I_RET_IN = 16 * 96, I_RET_OUT = 32 * 16, I_ATT_IN = 16 * 48, I_ATT_OUT = 16 * 16, I_GLA_A = 16 * 32, I_GLA_B = 16 * 16, I_GLA_OUT = 16 * 16,
                      I_MLS_IN = 16 * 64, I_MLS_OUT = 32 * 16;
        constexpr int I_DENSE = I_RET_IN + I_RET_OUT + I_ATT_IN + I_ATT_OUT + I_GLA_A + I_GLA_B + I_GLA_OUT + I_MLS_IN + I_MLS_OUT;
        constexpr int I_W1 = 16 * 32, I_W2 = 16 * 16;
        constexpr int NITEMS = I_DENSE + (MOE_FP8 ? (CVT_HOST == 2 ? 0 : MOE_PRO_LAYERS) * 24576 : 128 * I_W1 + 128 * I_W2);
        for (int it = gw; it < NITEMS; it += NGW) {
            int r = it;
            if (r < I_DENSE) {
                if (GFP8_RET) { if (tr_job(r, in[7], 6144, 1024, 4096, (bf16_t*)(ws + WS_W_RET_IN), scr, F.lane)) continue;
                    if (tr_job8(r, in[7] + 4096, 6144, 1024, 2048, (unsigned char*)(ws + WS_W_RET_IN + 8 * MiB), scr, F.lane)) continue; }
                else if (IFP8_RET ? tr_job8(r, in[7], 6144, 1024, 6144, (unsigned char*)(ws + WS_W_RET_IN), scr, F.lane) : tr_job(r, in[7], 6144, 1024, 6144, (bf16_t*)(ws + WS_W_RET_IN), scr, F.lane)) continue;
                if (OUT_FP8 ? tr_job8(r, in[9], 1024, 2048, 1024, (unsigned char*)(ws + WS_W_RET_OUT), scr, F.lane) : tr_job(r, in[9], 1024, 2048, 1024, (bf16_t*)(ws + WS_W_RET_OUT), scr, F.lane)) continue;
                if (IFP8_ATT ? tr_job8(r, in[10], 3072, 1024, 3072, (unsigned char*)(ws + WS_W_ATT_IN), scr, F.lane) : tr_job(r, in[10], 3072, 1024, 3072, (bf16_t*)(ws + WS_W_ATT_IN), scr, F.lane)) continue;
                if (OUT_FP8 ? tr_job8(r, in[12], 1024, 1024, 1024, (unsigned char*)(ws + WS_W_ATT_OUT), scr, F.lane) : tr_job(r, in[12], 1024, 1024, 1024, (bf16_t*)(ws + WS_W_ATT_OUT), scr, F.lane)) continue;
                if (IFP8_GLA ? tr_job8(r, in[13], 3088, 1024, 2048, (unsigned char*)(ws + WS_W_GLA_IN), scr, F.lane) : tr_job(r, in[13], 3088, 1024, 2048, (bf16_t*)(ws + WS_W_GLA_IN), scr, F.lane)) continue;
                if (GFP8_GLA) { if (tr_job8(r, in[13] + 2064, 3088, 1024, 1024, (unsigned char*)(ws + WS_W_GLA_IN + 4 * MiB), scr, F.lane)) continue; }
                else if (IFP8_GLA ? tr_job8(r, in[13] + 2064, 3088, 1024, 1024, (unsigned char*)(ws + WS_W_GLA_IN) + (size_t)2048 * 1024, scr, F.lane) : tr_job(r, in[13] + 2064, 3088, 1024, 1024, (bf16_t*)(ws + WS_W_GLA_IN) + (size_t)2048 * 1024, scr, F.lane)) continue;
                if (OUT_FP8 ? tr_job8(r, in[17], 1024, 1024, 1024, (unsigned char*)(ws + WS_W_GLA_OUT), scr, F.lane) : tr_job(r, in[17], 1024, 1024, 1024, (bf16_t*)(ws + WS_W_GLA_OUT), scr, F.lane)) continue;
                if (GFP8_MLS) { if (tr_job(r, in[18], 4096, 1024, 2048, (bf16_t*)(ws + WS_W_MLS_IN), scr, F.lane)) continue;
                    if (tr_job8(r, in[18] + 2048, 4096, 1024, 2048, (unsigned char*)(ws + WS_W_MLS_IN + 4 * MiB), scr, F.lane)) continue; }
                else if (IFP8_MLS ? tr_job8(r, in[18], 4096, 1024, 4096, (unsigned char*)(ws + WS_W_MLS_IN), scr, F.lane) : tr_job(r, in[18], 4096, 1024, 4096, (bf16_t*)(ws + WS_W_MLS_IN), scr, F.lane)) continue;
                if (OUT_FP8) tr_job8(r, in[28], 1024, 2048, 1024, (unsigned char*)(ws + WS_W_MLS_OUT), scr, F.lane); else tr_job(r, in[28], 1024, 2048, 1024, (bf16_t*)(ws + WS_W_MLS_OUT), scr, F.lane);
                continue;
            }
            r -= I_DENSE;
            if (MOE_FP8) { moe_cvt_item(in, ws, r / 24576, r % 24576, F.lane); continue; }
            if (r < 128 * I_W1) {
                const int mat = r / I_W1, q = r % I_W1, kb = q / 32, nn = q % 32, n0 = nn * 64;
                const int drow = (n0 < 1024) ? ((n0 >> 7) * 256 + (n0 & 127)) : (((n0 - 1024) >> 7) * 256 + 128 + ((n0 - 1024) & 127));
                transpose_item(in[31] + (size_t)mat * 1024 * 2048, 2048, 1024, (bf16_t*)(ws + WS_W1T) + (size_t)mat * 2048 * 1024, drow, scr, kb * 64, n0, F.lane);
                continue;
            }
            r -= 128 * I_W1;
            { const int mat = r / I_W2, q = r % I_W2, kb = q / 16, nn = q % 16;
              transpose_item(in[33] + (size_t)mat * 1024 * 1024, 1024, 1024, (bf16_t*)(ws + WS_W2T) + (size_t)mat * 1024 * 1024, nn * 64, scr, kb * 64, nn * 64, F.lane); }
        }
    }
}

struct NormArgs {
    const void* xin; bf16_t* xout;
    const float* gain;
    const float* sc; const float* sh;
    bf16_t* h;
    unsigned char* h8;
    const bf16_t* yp; const int* tokes_c; const float* tokw_c; const float* gf; const unsigned* cnt_prev;
    const bf16_t* wt;
    const float* rb;
    unsigned* cnt; unsigned short* list; int* tokes; float* tokw;
    float* glow;
    float* out;
};
template <bool COMBINE, int PROJ  , bool FINAL, bool XBF = true, int HOUT = 3>
__device__ __forceinline__ void norm_phase(Frame& F, const NormArgs& a) {
    constexpr bool WANT_H8 = !FINAL && (HOUT & 2), WANT_H16 = !FINAL && ((HOUT & 1) || PROJ != 0);
    LAS unsigned* sbase = (LAS unsigned*)(F.lds + LDS_MISC + 256);
    LAS float* lg = (LAS float*)(F.lds + F.wave * 2176);
    if (COMBINE) {
        if (F.wave == 0) {
            const unsigned t = F.lane < NEXP ? ((a.cnt_prev[F.lane * 64] + 255u) >> 8) << 8 : 0u;
            unsigned incl = t;
#pragma unroll
            for (int d = 1; d < NEXP; d <<= 1) { const unsigned v = __shfl_up(incl, d); if (F.lane >= d) incl += v; }
            if (F.lane < NEXP) sbase[F.lane] = incl - t;
        }
        LDS_WAIT();
        __syncthreads();
    }
    const int gw = F.bid * NWAVES + F.wave, NGW = F.G * NWAVES, lane = F.lane;
    LAS unsigned* hist = (LAS unsigned*)(F.lds + LDS_MISC + 1024);
    LAS unsigned* gbase = (LAS unsigned*)(F.lds + LDS_MISC + 1280);
    if (PROJ == 1) { if (F.tid < 32) hist[F.tid] = 0u; __syncthreads(); }
    const int niter = (T / 16 + NGW - 1) / NGW;
    for (int it = 0; it < niter; ++it) {
        const int tile_ = it * NGW + gw; const bool active = tile_ < T / 16; const int tile = active ? tile_ : 0;
        const int t0 = tile * 16, b = t0 >> 12;
        f32x4 gm[4], shv[4], gfv[4];
        if (active) {
#pragma unroll
        for (int j = 0; j < 4; ++j) {
            const int d = 512 * (j >> 1) + 8 * lane + 4 * (j & 1);
            const f32x4 g = *(const f32x4*)(a.gain + d);
            if (!FINAL) { const f32x4 s = *(const f32x4*)(a.sc + (size_t)b * 6144 + d); gm[j] = g * (s + 1.0f); shv[j] = *(const f32x4*)(a.sh + (size_t)b * 6144 + d); }
            else { gm[j] = g; shv[j] = (f32x4){0.f, 0.f, 0.f, 0.f}; }
            if (COMBINE) gfv[j] = *(const f32x4*)(a.gf + (size_t)b * 6144 + d);
        }
        int es_all = 0; float w_all = 0.f;
        if (COMBINE) { es_all = a.tokes_c[t0 * 4 + lane]; w_all = a.tokw_c[t0 * 4 + lane]; }
        f32x4 xa[4], xb[4]; u32x2 ya[4][4], yb[4][4];
#define NP_LOAD(r, X, Y) do { const int t_ = t0 + (r); \
            _Pragma("unroll") for (int jj = 0; jj < 2; ++jj) { if (XBF) { const u32x4 p_ = *(const u32x4*)((const bf16_t*)a.xin + (size_t)t_ * DM + 512 * jj + 8 * lane); \
                    X[2 * jj] = (f32x4){bflo(p_.x), bfhi(p_.x), bflo(p_.y), bfhi(p_.y)}; X[2 * jj + 1] = (f32x4){bflo(p_.z), bfhi(p_.z), bflo(p_.w), bfhi(p_.w)}; } \
                else { X[2 * jj] = *(const f32x4*)((const float*)a.xin + (size_t)t_ * DM + 512 * jj + 8 * lane); X[2 * jj + 1] = *(const f32x4*)((const float*)a.xin + (size_t)t_ * DM + 512 * jj + 8 * lane + 4); } } \
            if (COMBINE) { _Pragma("unroll") for (int k = 0; k < TOPK; ++k) { const int es = __builtin_amdgcn_readlane(es_all, 4 * (r) + k); \
                const size_t row = (size_t)sbase[es >> 16] + (unsigned)(es & 0xffff); \
                _Pragma("unroll") for (int jj = 0; jj < 2; ++jj) { if (YP_FP8) { const u32x2 y_ = *(const u32x2*)((const unsigned char*)a.yp + row * 1024 + 512 * jj + 8 * lane); Y[k][2 * jj].x = y_.x; Y[k][2 * jj + 1].x = y_.y; } \
                    else { const u32x4 y_ = *(const u32x4*)(a.yp + row * 1024 + 512 * jj + 8 * lane); Y[k][2 * jj] = (u32x2){y_.x, y_.y}; Y[k][2 * jj + 1] = (u32x2){y_.z, y_.w}; } } } } } while (0)
#define NP_PROC(r, X, Y) do { const int t_ = t0 + (r); f32x4 v[4]; \
            _Pragma("unroll") for (int j = 0; j < 4; ++j) v[j] = X[j]; \
            if (COMBINE) { f32x4 y[4]; \
                _Pragma("unroll") for (int j = 0; j < 4; ++j) y[j] = (f32x4){0.f, 0.f, 0.f, 0.f}; \
                _Pragma("unroll") for (int k = 0; k < TOPK; ++k) { const float w = __builtin_bit_cast(float, __builtin_amdgcn_readlane(__builtin_bit_cast(int, w_all), 4 * (r) + k)); \
                    _Pragma("unroll") for (int j = 0; j < 4; ++j) { const u32x2 p = Y[k][j]; \
                        if (YP_FP8) { const f32x2 lo_ = __builtin_amdgcn_cvt_pk_f32_fp8((int)p.x, false), hi_ = __builtin_amdgcn_cvt_pk_f32_fp8((int)p.x, true); y[j] += (f32x4){lo_.x, lo_.y, hi_.x, hi_.y} * w; } \
                        else y[j] += (f32x4){bflo(p.x), bfhi(p.x), bflo(p.y), bfhi(p.y)} * w; } } \
                _Pragma("unroll") for (int j = 0; j < 4; ++j) v[j] += gfv[j] * y[j]; \
                _Pragma("unroll") for (int jj = 0; jj < 2; ++jj) { u32x4 q_; q_.x = pk2(v[2 * jj].x, v[2 * jj].y); q_.y = pk2(v[2 * jj].z, v[2 * jj].w); q_.z = pk2(v[2 * jj + 1].x, v[2 * jj + 1].y); q_.w = pk2(v[2 * jj + 1].z, v[2 * jj + 1].w); \
                    *(u32x4*)(a.xout + (size_t)t_ * DM + 512 * jj + 8 * lane) = q_; } } \
            float ss = 0.f; \
            _Pragma("unroll") for (int j = 0; j < 4; ++j) ss += (v[j].x * v[j].x + v[j].y * v[j].y) + (v[j].z * v[j].z + v[j].w * v[j].w); \
            const float rstd = rsqrtf(wave_sum(ss) * (1.0f / DM) + EPS); \
            _Pragma("unroll") for (int jj = 0; jj < 2; ++jj) { const f32x4 h0 = v[2 * jj] * rstd * gm[2 * jj] + shv[2 * jj], h1 = v[2 * jj + 1] * rstd * gm[2 * jj + 1] + shv[2 * jj + 1]; \
                if (FINAL) { *(f32x4*)(a.out + (size_t)t_ * DM + 512 * jj + 8 * lane) = h0; *(f32x4*)(a.out + (size_t)t_ * DM + 512 * jj + 8 * lane + 4) = h1; } \
                else { if (WANT_H16) { u32x4 p; p.x = pk2(h0.x, h0.y); p.y = pk2(h0.z, h0.w); p.z = pk2(h1.x, h1.y); p.w = pk2(h1.z, h1.w); *(u32x4*)(a.h + (size_t)t_ * DM + 512 * jj + 8 * lane) = p; } \
                    if (WANT_H8) { u32x2 p8; p8.x = pk4_fp8(h0.x, h0.y, h0.z, h0.w); p8.y = pk4_fp8(h1.x, h1.y, h1.z, h1.w); *(u32x2*)(a.h8 + (size_t)t_ * DM + 512 * jj + 8 * lane) = p8; } } } } while (0)
        f32x4 xc[4]; u32x2 yc[4][4];
        NP_LOAD(0, xa, ya); NP_LOAD(1, xb, yb);
#pragma unroll 1
        for (int r = 0; r < 15; r += 3) {
            NP_LOAD(r + 2, xc, yc);
            NP_PROC(r, xa, ya);
            NP_LOAD(r + 3, xa, ya);
            NP_PROC(r + 1, xb, yb);
            if (r + 4 < 16) NP_LOAD(r + 4, xb, yb);
            NP_PROC(r + 2, xc, yc);
        }
        NP_PROC(15, xa, ya);
#undef NP_LOAD
#undef NP_PROC
        }
        if (PROJ != 0) {
            constexpr int NT = (PROJ == 1) ? 2 : 1;
            VM_WAIT();
            f32x4 acc[NT];
#pragma unroll
            for (int n = 0; n < NT; ++n) acc[n] = (f32x4){0.f, 0.f, 0.f, 0.f};
            const bf16_t* ap = a.h + (size_t)(t0 + (lane & 15)) * DM + 8 * (lane >> 4);
            const bf16_t* bp = a.wt + (size_t)(lane & 15) * DM + 8 * (lane >> 4);
#pragma unroll 4
            for (int ks = 0; ks < 32; ++ks) {
                const bf16x8 av = *(const bf16x8*)(ap + 32 * ks);
#pragma unroll
                for (int n = 0; n < NT; ++n) {
                    const bf16x8 bh = *(const bf16x8*)(bp + (size_t)(16 * n) * DM + 32 * ks);
                    const bf16x8 bl = *(const bf16x8*)(bp + (size_t)(NT * 16 + 16 * n) * DM + 32 * ks);
                    acc[n] = __builtin_amdgcn_mfma_f32_16x16x32_bf16(av, bh, acc[n], 0, 0, 0);
                    acc[n] = __builtin_amdgcn_mfma_f32_16x16x32_bf16(av, bl, acc[n], 0, 0, 0);
                }
            }
            if (PROJ == 2) {
                if (active)
#pragma unroll
                for (int i = 0; i < 4; ++i) a.glow[(size_t)(t0 + 4 * (lane >> 4) + i) * 16 + (lane & 15)] = acc[0][i];
            } else {
#pragma unroll
                for (int n = 0; n < NT; ++n)
#pragma unroll
                    for (int i = 0; i < 4; ++i) lg[(4 * (lane >> 4) + i) * 34 + 16 * n + (lane & 15)] = acc[n][i];
                LDS_WAIT(); asm volatile("" ::: "memory");
                float tv[4]; int ti[4]; unsigned lr[4];
                const bool picker = active && lane < 16;
#pragma unroll
                for (int k = 0; k < 4; ++k) { tv[k] = 0.f; ti[k] = 0; lr[k] = 0u; }
                if (picker) {
                    float v[32];
#pragma unroll
                    for (int e = 0; e < 32; ++e) v[e] = lg[lane * 34 + e] + a.rb[e];
#pragma unroll
                    for (int k = 0; k < 4; ++k) {
                        float best = -3.0e38f; int bi = 0;
#pragma unroll
                        for (int e = 0; e < 32; ++e) { const bool gt = v[e] > best; best = gt ? v[e] : best; bi = gt ? e : bi; }
#pragma unroll
                        for (int e = 0; e < 32; ++e) v[e] = (e == bi) ? -3.0e38f : v[e];
                        tv[k] = best; ti[k] = bi;
                    }
#pragma unroll
                    for (int k = 0; k < 4; ++k) lr[k] = __hip_atomic_fetch_add(hist + ti[k], 1u, __ATOMIC_RELAXED, __HIP_MEMORY_SCOPE_WORKGROUP);
                }
                LDS_WAIT();
                __syncthreads();
                if (F.tid < 32) { const unsigned hc = hist[F.tid]; gbase[F.tid] = hc ? atomicAdd(a.cnt + F.tid * 64, hc) : 0u; hist[F.tid] = 0u; }
                LDS_WAIT();
                __syncthreads();
                if (picker) {
                    const int t = t0 + lane;
                    const float e1 = __expf(tv[1] - tv[0]), e2 = __expf(tv[2] - tv[0]), e3 = __expf(tv[3] - tv[0]);
                    const float inv = 1.0f / (1.0f + e1 + e2 + e3);
                    const float wk[4] = {inv, e1 * inv, e2 * inv, e3 * inv};
#pragma unroll
                    for (int k = 0; k < 4; ++k) {
                        const unsigned slot = gbase[ti[k]] + lr[k];
                        a.list[(size_t)ti[k] * T + slot] = (unsigned short)t;
                        a.tokes[t * 4 + k] = (ti[k] << 16) | (int)slot;
                        a.tokw[t * 4 + k] = wk[k];
                    }
                }
                LDS_WAIT();
                __syncthreads();
            }
        }
    }
}

template <int NPN, bool GATHER, bool FP8, class Epi, bool HOT = false, bool HOSTCVT = false>
__device__ __forceinline__ void moe_gemm_phase(Frame& F, const bf16_t* A, const bf16_t* Bt, const unsigned* cnt, const unsigned short* list, const Epi& E, const float* const* in = nullptr, unsigned char* ws = nullptr, int cvt_layer = -1, int w2_layer = -1) {
    BgCvt bgc; if constexpr (HOSTCVT) bgc.init(in, ws, F.bid * NWAVES + F.wave, F.G * NWAVES, F.lane, w2_layer, 16384, 24576, cvt_layer, 24576);
    LAS int* tb = (LAS int*)(F.lds + LDS_MISC + 512);
    LAS int* cn = (LAS int*)(F.lds + LDS_MISC + 768);
    LAS unsigned short* idx = (LAS unsigned short*)(F.lds + LDS_IDX);
    LAS int* utab = (LAS int*)(F.lds + LDS_IDX + 18 * 512);
    if (F.wave == 0) {
        const int c = F.lane < NEXP ? (int)cnt[F.lane * 64] : 0, t = (c + 255) >> 8;
        int incl = t;
#pragma unroll
        for (int d = 1; d < NEXP; d <<= 1) { const int v = __shfl_up(incl, d); if (F.lane >= d) incl += v; }
        if (F.lane < NEXP) { cn[F.lane] = c; tb[F.lane] = incl - t; }
        if (F.lane == NEXP - 1) tb[NEXP] = incl;
    }
    LDS_WAIT();
    __syncthreads();
    const int NT = tb[NEXP];
    const bool xcd_deal = (F.G % 8 == 0);
    const int ncls = xcd_deal ? 8 : 1, cls = xcd_deal ? (F.bid & 7) : 0, rank = xcd_deal ? (F.bid >> 3) : F.bid, W = F.G / ncls;
    const int r0 = (int)(((long)cls * NT) / ncls), r1 = (int)(((long)(cls + 1) * NT) / ncls);
    const int U = (r1 - r0) * NPN;
    int e = GATHER ? 0 : NEXP - 1;
    for (int i0 = 0; i0 * W + rank < U; i0 += 18) {
        if (i0 > 0) __syncthreads();
        int nmy = 0;
        int goff[18];
#pragma unroll
        for (int i = 0; i < 18; ++i) {
            goff[i] = 0;
            const int L = (i0 + i) * W + rank;
            if (L < U) {
                const int rt = GATHER ? (r0 + L / NPN) : (r1 - 1 - L / NPN), pl = L % NPN;
                if (GATHER) { while (e < NEXP - 1 && rt >= tb[e + 1]) ++e; } else { while (e > 0 && rt < tb[e]) --e; }
                if (F.tid == 0) { utab[2 * i] = HOT ? 0 : rt; utab[2 * i + 1] = HOT ? 0 : (e * NPN + pl); }
                if (GATHER) { int j = (rt - tb[e]) * 256 + (F.tid & 255); const int c = cn[e]; j = j < c ? j : c - 1; goff[i] = e * T + j; }
                nmy = i + 1;
            }
        }
        if (GATHER && F.tid < 256) {
            unsigned short lv[18];
#pragma unroll
            for (int i = 0; i < 18; ++i) lv[i] = (i < nmy) ? list[goff[i]] : (unsigned short)0;
#pragma unroll
            for (int i = 0; i < 18; ++i) if (i < nmy) idx[i * 256 + F.tid] = HOT ? (unsigned short)F.tid : lv[i];
        }
        VM_WAIT(); LDS_WAIT();
        __syncthreads();
        pg8::MoeOrder S; S.utab = utab; S.idx = idx; S.nmy = nmy;
        pg8::Gemm g{A, Bt, 0, 0, FP8 ? 512 : 1024};
        if constexpr (HOSTCVT) pg8::gemm_phase_bg<Epi, pg8::MoeOrder, GATHER, FP8, BgCvt>(F.lds, g, S, E, bgc);
        else pg8::gemm_phase<Epi, pg8::MoeOrder, GATHER, FP8>(F.lds, g, S, E);
    }
    if constexpr (HOSTCVT) bgc.finish();
}
template <int MODE, int ABL = 0>
__device__ __forceinline__ void s2_phase(Frame& F, const bf16_t* Q, const bf16_t* PT, const bf16_t* KT, const bf16_t* VT, const float* REC, bf16_t* mix,
                                         const float* const* in = nullptr, unsigned char* ws = nullptr, int cvt_layer = -1) {
    constexpr bool ML = (MODE == 2 || MODE == 3);
    constexpr int DK = MODE == 0 ? 256 : (MODE == 1 ? 128 : 512);
    constexpr int NER = (MODE == 1 || MODE == 3) ? 2 : 4;
    constexpr int NE = ML ? NER + 1 : NER;
    constexpr int NEB = (MODE == 3) ? 16 : 8;
    constexpr int EW = 16 * NER, MT = DK / 128, KS = DK / 32, NJ = (NE + 1) / 2;
    constexpr int KSE = (MODE == 2) ? KS / 2 : KS;
    constexpr int LDQ = MODE == 0 ? 6144 : (MODE == 1 ? 512 : 2048);
    constexpr int QH = MODE == 0 ? 256 : (MODE == 1 ? 128 : 512);
    constexpr int VH = MODE == 1 ? 256 : 512;
    constexpr int LDM = MODE == 1 ? 1024 : 2048;
    constexpr int LDS_ST = DK * 2 + 16, LDO = EW * 2 + 16;
    constexpr int VCOLS = ML ? EW + 16 : EW, LDV = VCOLS * 2 + 16;
    constexpr int LDVS = MODE == 0 ? 6144 : (MODE == 1 ? 3072 : 2048);
    constexpr int NROWS = ML ? EW + 2 : EW;
    constexpr int ST_BYTES = NROWS * LDS_ST, VT_BYTES = 64 * LDV;
    constexpr bool QLDS = (MODE == 2);
    constexpr int LDQL = 528;
    LAS unsigned char* ST = F.lds;
    LAS unsigned char* VTs = F.lds + ST_BYTES;
    LAS unsigned char* Os = VTs + 2 * VT_BYTES;
    LAS float* QN = (LAS float*)(Os + 64 * LDO);
    LAS float* RS = QN + 64;
    LAS float* NL = RS + 64;
    LAS float* BLA = NL + 512;
    LAS unsigned char* QL = (LAS unsigned char*)(BLA + 256);
    const int lane = F.lane, l15 = lane & 15, g = lane >> 4, w = F.wave, lt = w >> 1, eh = w & 1;
    const int nrow = EW + (l15 == 0 ? 0 : 1);
    constexpr int VPR = EW / 8;
    const int se = F.tid / VPR, sq = F.tid % VPR;
    const int tq = l15 >> 2, tp = l15 & 3;
    const bool stager = F.tid < 64 * VPR;
    const unsigned qs_lo = (unsigned)((F.tid >> 5) * LDQ + 8 * (F.tid & 31)) * 2u;
    const unsigned q_lo = (unsigned)((16 * lt + l15) * LDQ + 8 * g) * 2u, p_lo = (unsigned)((16 * lt + l15) * 64 + 8 * g) * 2u, v_lo = (unsigned)(se * LDVS + 8 * sq) * 2u, k_lo = (unsigned)lane * 16u;
    constexpr bool BG = (MODE == 0 || MODE == 1) && ABL == 0;
    const int gw_ = F.bid * NWAVES + F.wave, NGW_ = F.G * NWAVES;
    const int bg_n = (BG && cvt_layer >= 0) ? 2 * ((24576 + NGW_ - 1) / NGW_) : 0;
    const int bg_period = bg_n > 0 ? ((NCHUNK / bg_n) > 2 ? (NCHUNK / bg_n) : 2) : 1;
    int bg_done = 0;
    float bgx[32]; CvtJob bgj; bgj.wp = nullptr; bgj.op = nullptr; bgj.ld = 0; bool bg_pending = false;
    for (int u0 = F.bid; u0 < NB * 4 * NEB; u0 += F.G) {
        int eb, bh;
        if (F.G == 256) { const int x = u0 & 7, j = (u0 >> 3) & 31, r = u0 >> 8; bh = x * 4 + (j >> 3); eb = (j & 7) + 8 * r; }
        else { eb = u0 % NEB; bh = u0 / NEB; }
        const int h = bh & 3, b = bh >> 2;
        const size_t ubase = ((size_t)(b * 4 + h)) * NCHUNK;
        f32x4 S[MT][NER];
#pragma unroll
        for (int mt = 0; mt < MT; ++mt)
#pragma unroll
            for (int nt = 0; nt < NER; ++nt) S[mt][nt] = (f32x4){0.f, 0.f, 0.f, 0.f};
        if (ML) { NL[F.tid] = 0.f; }
        for (int i = F.tid; i < ST_BYTES / 4; i += NTHR) ((LAS unsigned*)ST)[i] = 0u;
        float vsc[8], rsi[4], rso[4], dec64 = 1.f;
        if (MODE == 0) {
            const float lg = log1pf(-exp2f(-5.0f - (float)h));
#pragma unroll
            for (int j = 0; j < 8; ++j) vsc[j] = __expf((float)(63 - se) * lg);
#pragma unroll
            for (int r = 0; r < 4; ++r) { const int l = 16 * lt + 4 * g + r; rsi[r] = __expf((float)(l - 63) * lg); rso[r] = __expf((float)(l + 1) * lg); }
            dec64 = __expf(64.0f * lg);
        }
        float m_prev = 0.f;
        bf16x8 qf[KS] = {}, pf[2] = {}, kf[MT][2] = {}; u32x4 qst[4] = {}; float recv = 0.f; u32x4 vraw = (u32x4){0u, 0u, 0u, 0u}; f32x4 z0 = (f32x4){0.f, 0.f, 0.f, 0.f}, z1 = z0, blv = z0, alv = z0, dcv = z0; float Amax = 0.f, blast = 0.f;
#define S2_PREFETCH(cc) do { const size_t uidx_ = ubase + (cc); const size_t t0_ = (size_t)b * SEQ + (size_t)(cc) * 64; \
          \
        if (stager) vraw = *(const u32x4*)((const char*)(VT + t0_ * LDVS + VH * h + EW * eb) + v_lo); \
        if (MODE == 1) dcv = *(const f32x4*)(REC + uidx_ * 128 + 16 * w + 4 * g); \
        if (ML) { const float* rec_ = REC + uidx_ * 192; z0.x = rec_[64 + (se & 63)]; \
            Amax = rec_[128 + 63]; blast = rec_[63]; if (F.tid < 128) recv = rec_[(F.tid < 64) ? F.tid : (64 + F.tid)]; } \
        _Pragma("unroll") for (int ks = 0; ks < 2; ++ks) pf[ks] = *(const bf16x8*)((const char*)(PT + uidx_ * 4096 + 32 * ks) + p_lo); \
        if (QLDS) { _Pragma("unroll") for (int i = 0; i < 4; ++i) qst[i] = *(const u32x4*)((const char*)(Q + (t0_ + 16 * i) * LDQ + QH * h) + qs_lo); } \
        if (ABL < 2 && !QLDS) { _Pragma("unroll") for (int ks = 0; ks < KSE; ++ks) qf[ks] = *(const bf16x8*)((const char*)(Q + t0_ * LDQ + QH * h + 32 * ks) + q_lo); } } while (0)
        S2_PREFETCH(0);
#define S2_VFRAG(dst, c0_, ks_) do { const LAS unsigned char* a_ = vt + (32 * (ks_) + 8 * g + tq) * LDV + 2 * ((c0_) + 4 * tp); \
        const s16x4 lo_ = __builtin_amdgcn_ds_read_tr16_b64_v4i16((LAS s16x4*)a_), hi_ = __builtin_amdgcn_ds_read_tr16_b64_v4i16((LAS s16x4*)(a_ + 4 * LDV)); \
        dst = (bf16x8){lo_.x, lo_.y, lo_.z, lo_.w, hi_.x, hi_.y, hi_.z, hi_.w}; } while (0)
        for (int c = 0; c < NCHUNK; ++c) {
            const size_t t0 = (size_t)b * SEQ + (size_t)c * 64;
            const size_t uidx = ubase + c;
            LAS unsigned char* vt = VTs + (c & 1) * VT_BYTES;
            const float Mx = fmaxf(m_prev, Amax), keep = ML ? __expf(m_prev - Mx) : 1.f, bl_c = blast;
            f32x4 blc = blv, alc = alv; const f32x4 dcc = dcv;
            if (stager) {
                u32x4 o = vraw;
                if (MODE != 1) {
                    float wrow = 1.f;
                    if (MODE == 0) wrow = vsc[0];
                    if (ML) wrow = __expf(z0.x - Mx);
                    o.x = pk2(bflo(vraw.x) * wrow, bfhi(vraw.x) * wrow); o.y = pk2(bflo(vraw.y) * wrow, bfhi(vraw.y) * wrow);
                    o.z = pk2(bflo(vraw.z) * wrow, bfhi(vraw.z) * wrow); o.w = pk2(bflo(vraw.w) * wrow, bfhi(vraw.w) * wrow);
                    if (ML && sq == 0) {
                        *(LAS u32x4*)(vt + se * LDV + 2 * EW) = (u32x4){pk2(wrow, 0.f), 0u, 0u, 0u};
                        *(LAS u32x4*)(vt + se * LDV + 2 * EW + 16) = (u32x4){0u, 0u, 0u, 0u}; }
                }
                *(LAS u32x4*)(vt + se * LDV + 16 * sq) = o;
            }
            asm volatile("" ::: "memory");
            if (QLDS) {
#pragma unroll
                for (int i = 0; i < 4; ++i) { const int p_ = F.tid + i * NTHR; *(LAS u32x4*)(QL + (p_ >> 5) * LDQL + 16 * (p_ & 31)) = qst[i]; }
                asm volatile("" ::: "memory");
#pragma unroll
                for (int ks = KS - KSE; ks < KS; ++ks) { if (ABL < 2) qf[ks] = *(const bf16x8*)((const char*)(Q + t0 * LDQ + QH * h + 32 * ks) + q_lo); }
            }
            if (ML) { if (F.tid < 128) BLA[(c & 1) * 128 + F.tid] = recv; }
            if (MODE != 2) {
#pragma unroll
                for (int mt = 0; mt < MT; ++mt)
#pragma unroll
                    for (int ks = 0; ks < 2; ++ks) if (ABL < 3) kf[mt][ks] = *(const bf16x8*)((const char*)(KT + uidx * (DK * 64) + ((((MT * w + mt) * 2 + ks) * 64) << 3)) + k_lo);
            }
            WG_SYNC_LDS();
            if (c > 0) {
                if (EW == 64) { const int r = F.tid >> 3, q = F.tid & 7; *(u32x4*)(mix + (t0 - 64 + r) * LDM + VH * h + EW * eb + 8 * q) = *(const LAS u32x4*)(Os + r * LDO + 16 * q); }
                else if (F.tid < 256) { const int r = F.tid >> 2, q = F.tid & 3; *(u32x4*)(mix + (t0 - 64 + r) * LDM + VH * h + EW * eb + 8 * q) = *(const LAS u32x4*)(Os + r * LDO + 16 * q); }
            }
            f32x4 oi[NJ], oo[NJ];
#pragma unroll
            for (int j = 0; j < NJ; ++j) { oi[j] = (f32x4){0.f, 0.f, 0.f, 0.f}; oo[j] = (f32x4){0.f, 0.f, 0.f, 0.f}; }
#pragma unroll
            for (int j = 0; j < NJ; ++j) { const int nt = eh + 2 * j;
                if (2 * j + 1 < NE || eh == 0) {
#pragma unroll
                    for (int ks = 0; ks < 2; ++ks) { bf16x8 vf; S2_VFRAG(vf, 16 * nt, ks);
                        if (ABL == 0) oi[j] = __builtin_amdgcn_mfma_f32_16x16x32_bf16(pf[ks], vf, oi[j], 0, 0, 0); else asm volatile("" :: "v"(vf), "v"(pf[ks])); } } }
#pragma unroll
            for (int ks = 0; ks < KS; ++ks) {
                bf16x8 qa;
                if (QLDS && ks < KS - KSE) qa = *(const LAS bf16x8*)(QL + (16 * lt + l15) * LDQL + 64 * ks + 16 * g); else qa = qf[ks];
#pragma unroll
                for (int j = 0; j < NJ; ++j) { const int nt = eh + 2 * j;
                    if ((2 * j + 1 < NE || eh == 0) && ABL < 4) { const bf16x8 sf = *(const LAS bf16x8*)(ST + ((ML && nt == NER) ? nrow : (16 * nt + l15)) * LDS_ST + 64 * ks + 16 * g);
                        if (ABL == 0) oo[j] = __builtin_amdgcn_mfma_f32_16x16x32_bf16(qa, sf, oo[j], 0, 0, 0); else asm volatile("" :: "v"(sf), "v"(qa)); } }
                if (MODE == 2 && (ks & 3) == 3) __builtin_amdgcn_sched_barrier(0);
            }
            if (ML) { if (((NE - 1) & 1) == eh && l15 == 0) {
#pragma unroll
                    for (int r = 0; r < 4; ++r) { QN[16 * lt + 4 * g + r] = oo[NJ - 1][r]; RS[16 * lt + 4 * g + r] = oi[NJ - 1][r]; } } }
            if (MODE == 2) {
#pragma unroll
                for (int mt = 0; mt < MT; ++mt)
#pragma unroll
                    for (int ks = 0; ks < 2; ++ks) if (ABL < 3) kf[mt][ks] = *(const bf16x8*)((const char*)(KT + uidx * (DK * 64) + ((((MT * w + mt) * 2 + ks) * 64) << 3)) + k_lo);
            }
            { const int cn = (c + 1 < NCHUNK) ? c + 1 : c; S2_PREFETCH(cn); }
            WG_SYNC_LDS();
            if (ML) { blc = *(const LAS f32x4*)(BLA + (c & 1) * 128 + 16 * lt + 4 * g); alc = *(const LAS f32x4*)(BLA + (c & 1) * 128 + 64 + 16 * lt + 4 * g); }
#pragma unroll
            for (int r = 0; r < 4; ++r) { const int l = 16 * lt + 4 * g + r;
                float ci = 1.f, co = 1.f;
                if (MODE == 0) { ci = rsi[r]; co = rso[r]; }
                if (ML) { const float Ml = fmaxf(m_prev, alc[r]), rho = __expf(Mx - Ml), wi = __expf(m_prev - Ml);
                    const float den = wi * QN[l] + rho * RS[l];
                    const float inv = 1.0f / fmaxf(fabsf(den), __expf(-(blc[r] + Ml)));
                    ci = rho * inv; co = wi * inv; }
#pragma unroll
                for (int j = 0; j < NER / 2; ++j) { const int nt = eh + 2 * j;
                    *(LAS unsigned short*)(Os + l * LDO + 2 * (16 * nt + l15)) = (unsigned short)f2bf(ci * oi[j][r] + co * oo[j][r]); } }
#pragma unroll
            for (int nt = 0; nt < NER; ++nt) {
                bf16x8 vf[2];
#pragma unroll
                for (int ks = 0; ks < 2; ++ks) S2_VFRAG(vf[ks], 16 * nt, ks);
#pragma unroll
                for (int mt = 0; mt < MT; ++mt) {
                    if (MODE == 0) S[mt][nt] = S[mt][nt] * dec64;
                    if (MODE == 1) S[mt][nt] = S[mt][nt] * dcc;
                    if (ML) S[mt][nt] = S[mt][nt] * keep;
#pragma unroll
                    for (int ks = 0; ks < 2; ++ks) { if (ABL == 0) S[mt][nt] = __builtin_amdgcn_mfma_f32_16x16x32_bf16(kf[mt][ks], vf[ks], S[mt][nt], 0, 0, 0); else asm volatile("" :: "v"(vf[ks]), "v"(kf[mt][ks])); }
                    u32x2 o; o.x = pk2(S[mt][nt][0], S[mt][nt][1]); o.y = pk2(S[mt][nt][2], S[mt][nt][3]);
                    if (ABL < 4) *(LAS u32x2*)(ST + (16 * nt + l15) * LDS_ST + 2 * (DK / 8 * w + 16 * mt + 4 * g)) = o; }
            }
            if (ML) {
                bf16x8 vf[2];
#pragma unroll
                for (int ks = 0; ks < 2; ++ks) S2_VFRAG(vf[ks], EW, ks);
#pragma unroll
                for (int mt = 0; mt < MT; ++mt) { const int d0 = DK / 8 * w + 16 * mt + 4 * g;
                    f32x4 na = (f32x4){0.f, 0.f, 0.f, 0.f};
                    if (l15 == 0) na = *(const LAS f32x4*)(NL + d0) * keep;
#pragma unroll
                    for (int ks = 0; ks < 2; ++ks) { if (ABL == 0) na = __builtin_amdgcn_mfma_f32_16x16x32_bf16(kf[mt][ks], vf[ks], na, 0, 0, 0); else asm volatile("" :: "v"(vf[ks]), "v"(kf[mt][ks])); }
                    if (l15 == 0) { *(LAS f32x4*)(NL + d0) = na; u32x2 o; o.x = pk2(na[0], na[1]); o.y = pk2(na[2], na[3]); *(LAS u32x2*)(ST + EW * LDS_ST + 2 * d0) = o; } }
            }
            if (ML) m_prev = bl_c + Mx;
            if (BG) {
                if (bg_pending) { cvt_half_store(bgj, bg_done & 1, bgx); bg_pending = false; ++bg_done; }
                else if (bg_done < bg_n && (c % bg_period) == 0) { const int gi = (bg_done >> 1) * NGW_ + gw_;
                    if (gi < 24576) { bgj = moe_cvt_job(in, ws, cvt_layer, gi, lane); cvt_half_load(bgj, bg_done & 1, bgx); bg_pending = true; } else ++bg_done; }
            }
        }
#undef S2_PREFETCH
#undef S2_VFRAG
        LDS_WAIT();
        __syncthreads();
        { const size_t t0 = (size_t)b * SEQ + (size_t)(NCHUNK - 1) * 64;
          if (EW == 64) { const int r = F.tid >> 3, q = F.tid & 7; *(u32x4*)(mix + (t0 + r) * LDM + VH * h + EW * eb + 8 * q) = *(const LAS u32x4*)(Os + r * LDO + 16 * q); }
          else if (F.tid < 256) { const int r = F.tid >> 2, q = F.tid & 3; *(u32x4*)(mix + (t0 + r) * LDM + VH * h + EW * eb + 8 * q) = *(const LAS u32x4*)(Os + r * LDO + 16 * q); } }
        LDS_WAIT();
        __syncthreads();
    }
    if (BG) {
        if (bg_pending) { cvt_half_store(bgj, bg_done & 1, bgx); ++bg_done; }
        for (; bg_done < bg_n; ++bg_done) { const int gi = (bg_done >> 1) * NGW_ + gw_;
            if (gi < 24576) { bgj = moe_cvt_job(in, ws, cvt_layer, gi, lane); cvt_half_load(bgj, bg_done & 1, bgx); cvt_half_store(bgj, bg_done & 1, bgx); } }
    }
}

template <int MODE>
__device__ __forceinline__ void s2x_phase(Frame& F, const bf16_t* Q, const bf16_t* PT, const bf16_t* KT, const bf16_t* VT, const float* REC, bf16_t* mix) {
    constexpr int DK = MODE == 0 ? 256 : 128, NER = MODE == 0 ? 4 : 2, EW = 16 * NER, KS = DK / 32, MTY = DK / 64, NEB = 8;
    constexpr int LDQ = MODE == 0 ? 6144 : 512, QH = MODE == 0 ? 256 : 128, VH = MODE == 1 ? 256 : 512, LDM = MODE == 1 ? 1024 : 2048;
    constexpr int LDS_ST = DK * 2 + 16, LDV = EW * 2 + 16, LDVS = MODE == 0 ? 6144 : 3072;
    constexpr int ST_BYTES = EW * LDS_ST, VT_BYTES = 64 * LDV, VPR = EW / 8;
    LAS unsigned char* ST = F.lds;
    LAS unsigned char* VTs = F.lds + 2 * ST_BYTES;
    const int lane = F.lane, l15 = lane & 15, g = lane >> 4, w = F.wave, lt = w & 3, yw = w & 3;
    const bool isX = w < 4;
    const int se = F.tid / VPR, sq = F.tid % VPR, tq = l15 >> 2, tp = l15 & 3;
    const bool stager = F.tid < 64 * VPR;
    unsigned q_lo = (unsigned)((16 * lt + l15) * LDQ + 8 * g) * 2u, p_lo = (unsigned)((16 * lt + l15) * 64 + 8 * g) * 2u, v_lo = (unsigned)(se * LDVS + 8 * sq) * 2u, k_lo = (unsigned)lane * 16u;
    unsigned o_lo = (unsigned)((16 * lt + l15) * LDM + 4 * g) * 2u;
    for (int u0 = F.bid; u0 < NB * 4 * NEB; u0 += F.G) {
        int eb, bh;
        if (F.G == 256) { const int x = u0 & 7, j = (u0 >> 3) & 31, r = u0 >> 8; bh = x * 4 + (j >> 3); eb = (j & 7) + 8 * r; }
        else { eb = u0 % NEB; bh = u0 / NEB; }
        const int h = bh & 3, b = bh >> 2;
        const size_t ubase = ((size_t)(b * 4 + h)) * NCHUNK;
        for (int i = F.tid; i < 2 * ST_BYTES / 4; i += NTHR) ((LAS unsigned*)ST)[i] = 0u;
        float vsc = 1.f, rsi = 1.f, rso = 1.f, dec64 = 1.f;
        if (MODE == 0) {
            const float lg = log1pf(-exp2f(-5.0f - (float)h));
            vsc = __expf((float)(63 - se) * lg);
            { const int l = 16 * lt + l15; rsi = __expf((float)(l - 63) * lg); rso = __expf((float)(l + 1) * lg); }
            dec64 = __expf(64.0f * lg);
        }
#define S2X_CL(cc) ((cc) < NCHUNK ? (cc) : NCHUNK - 1)
#define S2X_LOADX(QF, PF, cc) do { const size_t uidx_ = ubase + (cc); const size_t t0_ = (size_t)b * SEQ + (size_t)(cc) * 64; \
        _Pragma("unroll") for (int ks = 0; ks < 2; ++ks) PF[ks] = *(const bf16x8*)((const char*)(PT + uidx_ * 4096 + 32 * ks) + p_lo); \
        _Pragma("unroll") for (int ks = 0; ks < KS; ++ks) QF[ks] = *(const bf16x8*)((const char*)(Q + t0_ * LDQ + QH * h + 32 * ks) + q_lo); } while (0)
#define S2X_LOADY(KF, DC, cc) do { const size_t uidx_ = ubase + (cc); \
        _Pragma("unroll") for (int mt = 0; mt < MTY; ++mt) { \
            _Pragma("unroll") for (int ks = 0; ks < 2; ++ks) KF[mt][ks] = *(const bf16x8*)((const char*)(KT + uidx_ * (DK * 64) + ((((MTY * yw + mt) * 2 + ks) * 64) << 3)) + k_lo); \
            if (MODE == 1) DC[mt] = *(const f32x4*)(REC + uidx_ * 128 + 16 * (MTY * yw + mt) + 4 * g); } } while (0)
#define S2X_LOADV(VR, cc) do { const size_t t0_ = (size_t)b * SEQ + (size_t)(cc) * 64; if (stager) VR = *(const u32x4*)((const char*)(VT + t0_ * LDVS + VH * h + EW * eb) + v_lo); } while (0)
#define S2X_STAGE(VR, vt_) do { if (stager) { u32x4 o = VR; \
            if (MODE == 0) { o.x = pk2(bflo(VR.x) * vsc, bfhi(VR.x) * vsc); o.y = pk2(bflo(VR.y) * vsc, bfhi(VR.y) * vsc); o.z = pk2(bflo(VR.z) * vsc, bfhi(VR.z) * vsc); o.w = pk2(bflo(VR.w) * vsc, bfhi(VR.w) * vsc); } \
            *(LAS u32x4*)((vt_) + se * LDV + 16 * sq) = o; } } while (0)
#define S2X_VFRAG(dst, c0_, ks_) do { const LAS unsigned char* a_ = vt + (32 * (ks_) + 8 * g + tq) * LDV + 2 * ((c0_) + 4 * tp); \
        const s16x4 lo_ = __builtin_amdgcn_ds_read_tr16_b64_v4i16((LAS s16x4*)a_), hi_ = __builtin_amdgcn_ds_read_tr16_b64_v4i16((LAS s16x4*)(a_ + 4 * LDV)); \
        dst = (bf16x8){lo_.x, lo_.y, lo_.z, lo_.w, hi_.x, hi_.y, hi_.z, hi_.w}; } while (0)
        u32x4 vrA = (u32x4){0u, 0u, 0u, 0u}, vrB = vrA;
        S2X_LOADV(vrA, 0);
        if (isX) {
            bf16x8 qfA[KS], pfA[2], qfB[KS], pfB[2];
            S2X_LOADX(qfA, pfA, 0); S2X_LOADV(vrB, 1); S2X_LOADX(qfB, pfB, 1);
            S2X_STAGE(vrA, VTs);
            S2X_LOADV(vrA, 2);
            WG_SYNC_LDS();
#define S2X_XBODY(QF, PF, VRN, c) do { \
                asm volatile("" : "+v"(q_lo), "+v"(p_lo), "+v"(v_lo), "+v"(o_lo)); \
                const size_t t0 = (size_t)b * SEQ + (size_t)(c) * 64; \
                LAS unsigned char* vt = VTs + ((c) & 1) * VT_BYTES; \
                const LAS unsigned char* STr = ST + (((c) + 1) & 1) * ST_BYTES;           \
                f32x4 oi[NER], oo[NER]; \
                _Pragma("unroll") for (int nt = 0; nt < NER; ++nt) { oi[nt] = (f32x4){0.f, 0.f, 0.f, 0.f}; oo[nt] = (f32x4){0.f, 0.f, 0.f, 0.f}; } \
                _Pragma("unroll") for (int nt = 0; nt < NER; ++nt) _Pragma("unroll") for (int ks = 0; ks < 2; ++ks) { bf16x8 vf; S2X_VFRAG(vf, 16 * nt, ks); oi[nt] = __builtin_amdgcn_mfma_f32_16x16x32_bf16(vf, PF[ks], oi[nt], 0, 0, 0); } \
                _Pragma("unroll") for (int ks = 0; ks < KS; ++ks) _Pragma("unroll") for (int nt = 0; nt < NER; ++nt) { const bf16x8 sf = *(const LAS bf16x8*)(STr + (16 * nt + l15) * LDS_ST + 64 * ks + 16 * g); \
                        oo[nt] = __builtin_amdgcn_mfma_f32_16x16x32_bf16(sf, QF[ks], oo[nt], 0, 0, 0); } \
                S2X_LOADX(QF, PF, S2X_CL((c) + 2)); \
                  \
                _Pragma("unroll") for (int nt = 0; nt < NER; ++nt) { const f32x4 ov = oi[nt] * rsi + oo[nt] * rso; \
                    u32x2 o; o.x = pk2(ov[0], ov[1]); o.y = pk2(ov[2], ov[3]); \
                    *(u32x2*)((char*)(mix + t0 * LDM + VH * h + EW * eb + 16 * nt) + o_lo) = o; } \
                S2X_STAGE(VRN, VTs + (((c) + 1) & 1) * VT_BYTES); \
                S2X_LOADV(VRN, S2X_CL((c) + 3)); \
                WG_SYNC_LDS(); } while (0)
            for (int c = 0; c < NCHUNK; c += 2) { S2X_XBODY(qfA, pfA, vrB, c); S2X_XBODY(qfB, pfB, vrA, c + 1); }
#undef S2X_XBODY
        } else {
            bf16x8 kfA[MTY][2], kfB[MTY][2]; f32x4 dcA[MTY], dcB[MTY]; f32x4 S[MTY][NER];
#pragma unroll
            for (int mt = 0; mt < MTY; ++mt) { dcA[mt] = (f32x4){1.f, 1.f, 1.f, 1.f}; dcB[mt] = dcA[mt];
#pragma unroll
                for (int nt = 0; nt < NER; ++nt) S[mt][nt] = (f32x4){0.f, 0.f, 0.f, 0.f}; }
            S2X_LOADY(kfA, dcA, 0); S2X_LOADV(vrB, 1); S2X_LOADY(kfB, dcB, 1);
            S2X_STAGE(vrA, VTs);
            S2X_LOADV(vrA, 2);
            WG_SYNC_LDS();
#define S2X_YBODY(KF, DC, VRN, c) do { \
                asm volatile("" : "+v"(k_lo), "+v"(v_lo)); \
                LAS unsigned char* vt = VTs + ((c) & 1) * VT_BYTES; \
                LAS unsigned char* STw = ST + ((c) & 1) * ST_BYTES; \
                _Pragma("unroll") for (int nt = 0; nt < NER; ++nt) { \
                    bf16x8 vf[2]; \
                    _Pragma("unroll") for (int ks = 0; ks < 2; ++ks) S2X_VFRAG(vf[ks], 16 * nt, ks); \
                    _Pragma("unroll") for (int mt = 0; mt < MTY; ++mt) { \
                        if (MODE == 0) S[mt][nt] = S[mt][nt] * dec64; else S[mt][nt] = S[mt][nt] * DC[mt]; \
                        _Pragma("unroll") for (int ks = 0; ks < 2; ++ks) S[mt][nt] = __builtin_amdgcn_mfma_f32_16x16x32_bf16(KF[mt][ks], vf[ks], S[mt][nt], 0, 0, 0); \
                        u32x2 o; o.x = pk2(S[mt][nt][0], S[mt][nt][1]); o.y = pk2(S[mt][nt][2], S[mt][nt][3]); \
                        *(LAS u32x2*)(STw + (16 * nt + l15) * LDS_ST + 2 * (16 * (MTY * yw + mt) + 4 * g)) = o; } } \
                S2X_LOADY(KF, DC, S2X_CL((c) + 2)); \
                S2X_STAGE(VRN, VTs + (((c) + 1) & 1) * VT_BYTES); \
                S2X_LOADV(VRN, S2X_CL((c) + 3)); \
                WG_SYNC_LDS(); } while (0)
            for (int c = 0; c < NCHUNK; c += 2) { S2X_YBODY(kfA, dcA, vrB, c); S2X_YBODY(kfB, dcB, vrA, c + 1); }
#undef S2X_YBODY
        }
#undef S2X_CL
#undef S2X_LOADX
#undef S2X_LOADY
#undef S2X_LOADV
#undef S2X_STAGE
#undef S2X_VFRAG
    }
}

__device__ __forceinline__ void s2m_phase(Frame& F, const bf16_t* Q, const bf16_t* PT, const bf16_t* KT, const bf16_t* VT, const float* REC, bf16_t* mix) {
    constexpr int DK = 512, NER = 4, NE = 5, EW = 64, KS = 16, MTY = 8, NEB = 8;
    constexpr int LDQ = 2048, QH = 512, VH = 512, LDM = 2048, LDVS = 2048;
    constexpr int LDS_ST = DK * 2 + 16, VCOLS = EW + 16, LDV = VCOLS * 2 + 16, NROWS = EW + 2;
    constexpr int ST_BYTES = NROWS * LDS_ST, VT_BYTES = 64 * LDV;
    LAS unsigned char* ST = F.lds;
    LAS unsigned char* VTs = F.lds + 2 * ST_BYTES;
    LAS float* NL = (LAS float*)(VTs + 2 * VT_BYTES);
    static_assert(2 * ST_BYTES + 2 * VT_BYTES + 2048 <= LDS_MISC, "s2m LDS");
    const int lane = F.lane, l15 = lane & 15, g = lane >> 4, w = F.wave, lt = w & 3, yw = w & 3;
    const bool isX = w < 4;
    const int se = (F.tid & 255) >> 2, sq = 2 * (F.tid & 3), tq = l15 >> 2, tp = l15 & 3;
    const int nrow = EW + (l15 == 0 ? 0 : 1);
    unsigned q_lo = (unsigned)((16 * lt + l15) * LDQ + 8 * g) * 2u, p_lo = (unsigned)((16 * lt + l15) * 64 + 8 * g) * 2u, v_lo = (unsigned)(se * LDVS + 8 * sq) * 2u, k_lo = (unsigned)lane * 16u;
    unsigned o_lo = (unsigned)((16 * lt + l15) * LDM + 4 * g) * 2u;
    unsigned rb_lo = (unsigned)(16 * lt + l15) * 4u, rz_lo = (unsigned)(64 + se) * 4u;
    unsigned st_lo = (unsigned)(l15 * LDS_ST + 2 * (16 * MTY * yw + 4 * g)), nl_lo = (unsigned)(4 * (16 * MTY * yw + 4 * g)), sn_lo = (unsigned)(EW * LDS_ST + 2 * (16 * MTY * yw + 4 * g));
    for (int u0 = F.bid; u0 < NB * 4 * NEB; u0 += F.G) {
        int eb, bh;
        if (F.G == 256) { const int x = u0 & 7, j = (u0 >> 3) & 31, r = u0 >> 8; bh = x * 4 + (j >> 3); eb = (j & 7) + 8 * r; }
        else { eb = u0 % NEB; bh = u0 / NEB; }
        const int h = bh & 3, b = bh >> 2;
        const size_t ubase = ((size_t)(b * 4 + h)) * NCHUNK;
        for (int i = F.tid; i < 2 * ST_BYTES / 4; i += NTHR) ((LAS unsigned*)ST)[i] = 0u;
        NL[F.tid] = 0.f;
        u32x4 vraw[2] = {(u32x4){0u, 0u, 0u, 0u}, (u32x4){0u, 0u, 0u, 0u}}; float z_s = 0.f, Amax_s = 0.f, blast_s = 0.f;
#define S2M_RFL(x) __builtin_bit_cast(float, __builtin_amdgcn_readfirstlane(__builtin_bit_cast(int, (float)(x))))
#define S2M_LOADS(cc) do { const float* rec_ = REC + (ubase + (cc)) * 192; Amax_s = rec_[128 + 63]; blast_s = rec_[63]; } while (0)
#define S2M_LOADV(cc) do { const size_t t0_ = (size_t)b * SEQ + (size_t)(cc) * 64; const float* rec_ = REC + (ubase + (cc)) * 192; \
        vraw[0] = *(const u32x4*)((const char*)(VT + t0_ * LDVS + VH * h + EW * eb) + v_lo); vraw[1] = *(const u32x4*)((const char*)(VT + t0_ * LDVS + VH * h + EW * eb + 8) + v_lo); \
        z_s = *(const float*)((const char*)rec_ + rz_lo); Amax_s = rec_[128 + 63]; blast_s = rec_[63]; } while (0)
#define S2M_STAGE(vt_, Mx_) do { const float wrow = __expf(z_s - (Mx_)); \
        _Pragma("unroll") for (int i_ = 0; i_ < 2; ++i_) { u32x4 o; const u32x4 vr_ = vraw[i_]; \
            o.x = pk2(bflo(vr_.x) * wrow, bfhi(vr_.x) * wrow); o.y = pk2(bflo(vr_.y) * wrow, bfhi(vr_.y) * wrow); o.z = pk2(bflo(vr_.z) * wrow, bfhi(vr_.z) * wrow); o.w = pk2(bflo(vr_.w) * wrow, bfhi(vr_.w) * wrow); \
            *(LAS u32x4*)((vt_) + se * LDV + 16 * (sq + i_)) = o; } \
        if (sq == 0) { *(LAS u32x4*)((vt_) + se * LDV + 2 * EW) = (u32x4){pk2(wrow, 0.f), 0u, 0u, 0u}; *(LAS u32x4*)((vt_) + se * LDV + 2 * EW + 16) = (u32x4){0u, 0u, 0u, 0u}; } } while (0)
#define S2M_VFRAG(dst, c0_, ks_) do { const LAS unsigned char* a_ = vt + (32 * (ks_) + 8 * g + tq) * LDV + 2 * ((c0_) + 4 * tp); \
        const s16x4 lo_ = __builtin_amdgcn_ds_read_tr16_b64_v4i16((LAS s16x4*)a_), hi_ = __builtin_amdgcn_ds_read_tr16_b64_v4i16((LAS s16x4*)(a_ + 4 * LDV)); \
        dst = (bf16x8){lo_.x, lo_.y, lo_.z, lo_.w, hi_.x, hi_.y, hi_.z, hi_.w}; } while (0)
        float m_prev = 0.f, Mx, keep, bl_c;
        if (isX) { S2M_LOADV(0); } else { S2M_LOADS(0); }
        Mx = S2M_RFL(fmaxf(m_prev, Amax_s)); keep = S2M_RFL(__expf(m_prev - Mx)); bl_c = S2M_RFL(blast_s);
        if (isX) { S2M_STAGE(VTs, Mx); S2M_LOADV(1); } else { S2M_LOADS(1); }
#define S2M_ADVANCE(XR) do { const float m_next = S2M_RFL(bl_c + Mx), Mx_next = S2M_RFL(fmaxf(m_next, Amax_s)), bl_next = S2M_RFL(blast_s); \
        if (XR) { S2M_STAGE(VTs + ((c + 1) & 1) * VT_BYTES, Mx_next); S2M_LOADV(cn2); } else { S2M_LOADS(cn2); } \
        m_prev = m_next; Mx = Mx_next; keep = S2M_RFL(__expf(m_prev - Mx)); bl_c = bl_next; } while (0)
        if (isX) {
            bf16x8 qf[KS], pf[2]; float b_l, a_l;
#define S2M_LOADX(cc) do { const size_t uidx_ = ubase + (cc); const size_t t0_ = (size_t)b * SEQ + (size_t)(cc) * 64; const float* rec_ = REC + uidx_ * 192; \
            _Pragma("unroll") for (int ks = 0; ks < 2; ++ks) pf[ks] = *(const bf16x8*)((const char*)(PT + uidx_ * 4096 + 32 * ks) + p_lo); \
            _Pragma("unroll") for (int ks = 0; ks < KS; ++ks) qf[ks] = *(const bf16x8*)((const char*)(Q + t0_ * LDQ + QH * h + 32 * ks) + q_lo); \
            b_l = *(const float*)((const char*)rec_ + rb_lo); a_l = *(const float*)((const char*)(rec_ + 128) + rb_lo); } while (0)
            S2M_LOADX(0);
            WG_SYNC_LDS();
            for (int c = 0; c < NCHUNK; ++c) {
                asm volatile("" : "+v"(q_lo), "+v"(p_lo), "+v"(v_lo), "+v"(rb_lo), "+v"(rz_lo), "+v"(o_lo));
                const size_t t0 = (size_t)b * SEQ + (size_t)c * 64;
                const int cn = (c + 1 < NCHUNK) ? c + 1 : c, cn2 = (c + 2 < NCHUNK) ? c + 2 : NCHUNK - 1;
                LAS unsigned char* vt = VTs + (c & 1) * VT_BYTES;
                const LAS unsigned char* STr = ST + ((c + 1) & 1) * ST_BYTES;
                f32x4 oi[NE], oo[NE];
#pragma unroll
                for (int nt = 0; nt < NE; ++nt) { oi[nt] = (f32x4){0.f, 0.f, 0.f, 0.f}; oo[nt] = (f32x4){0.f, 0.f, 0.f, 0.f}; }
#pragma unroll
                for (int nt = 0; nt < NE; ++nt)
#pragma unroll
                    for (int ks = 0; ks < 2; ++ks) { bf16x8 vf; S2M_VFRAG(vf, 16 * nt, ks); oi[nt] = __builtin_amdgcn_mfma_f32_16x16x32_bf16(vf, pf[ks], oi[nt], 0, 0, 0); }
#pragma unroll
                for (int ks = 0; ks < KS; ++ks) {
#pragma unroll
                    for (int nt = 0; nt < NE; ++nt) { const bf16x8 sf = *(const LAS bf16x8*)(STr + ((nt == NER) ? nrow : (16 * nt + l15)) * LDS_ST + 64 * ks + 16 * g);
                        oo[nt] = __builtin_amdgcn_mfma_f32_16x16x32_bf16(sf, qf[ks], oo[nt], 0, 0, 0); }
                    if ((ks & 3) == 3) __builtin_amdgcn_sched_barrier(0);
                }
                const float QNl = __shfl(oo[NER][0], l15), RSl = __shfl(oi[NER][0], l15);
                const float Ml = fmaxf(m_prev, a_l), rho = __expf(Mx - Ml), wi = __expf(m_prev - Ml);
                const float den = wi * QNl + rho * RSl;
                const float inv = 1.0f / fmaxf(fabsf(den), __expf(-(b_l + Ml)));
                const float ci = rho * inv, co = wi * inv;
#pragma unroll
                for (int nt = 0; nt < NER; ++nt) { const f32x4 ov = oi[nt] * ci + oo[nt] * co;
                    u32x2 o; o.x = pk2(ov[0], ov[1]); o.y = pk2(ov[2], ov[3]);
                    *(u32x2*)((char*)(mix + t0 * LDM + VH * h + EW * eb + 16 * nt) + o_lo) = o; }
                S2M_LOADX(cn);
                S2M_ADVANCE(true);
                WG_SYNC_LDS();
            }
#undef S2M_LOADX
        } else {
            bf16x8 kf[MTY][2]; f32x4 S[MTY][NER];
#pragma unroll
            for (int mt = 0; mt < MTY; ++mt)
#pragma unroll
                for (int nt = 0; nt < NER; ++nt) S[mt][nt] = (f32x4){0.f, 0.f, 0.f, 0.f};
#define S2M_LOADY(cc) do { const size_t uidx_ = ubase + (cc); \
            _Pragma("unroll") for (int mt = 0; mt < MTY; ++mt) _Pragma("unroll") for (int ks = 0; ks < 2; ++ks) \
                kf[mt][ks] = *(const bf16x8*)((const char*)(KT + uidx_ * (DK * 64) + ((((MTY * yw + mt) * 2 + ks) * 64) << 3)) + k_lo); } while (0)
            S2M_LOADY(0);
            WG_SYNC_LDS();
            for (int c = 0; c < NCHUNK; ++c) {
                asm volatile("" : "+v"(k_lo), "+v"(st_lo), "+v"(nl_lo), "+v"(sn_lo));
                const int cn = (c + 1 < NCHUNK) ? c + 1 : c, cn2 = (c + 2 < NCHUNK) ? c + 2 : NCHUNK - 1;
                LAS unsigned char* vt = VTs + (c & 1) * VT_BYTES;
                LAS unsigned char* STw = ST + (c & 1) * ST_BYTES;
#pragma unroll
                for (int nt = 0; nt < NER; ++nt) {
                    bf16x8 vf[2];
#pragma unroll
                    for (int ks = 0; ks < 2; ++ks) S2M_VFRAG(vf[ks], 16 * nt, ks);
#pragma unroll
                    for (int mt = 0; mt < MTY; ++mt) {
                        S[mt][nt] = S[mt][nt] * keep;
#pragma unroll
                        for (int ks = 0; ks < 2; ++ks) S[mt][nt] = __builtin_amdgcn_mfma_f32_16x16x32_bf16(kf[mt][ks], vf[ks], S[mt][nt], 0, 0, 0);
                        u32x2 o; o.x = pk2(S[mt][nt][0], S[mt][nt][1]); o.y = pk2(S[mt][nt][2], S[mt][nt][3]);
                        *(LAS u32x2*)(STw + st_lo + (16 * nt * LDS_ST + 32 * mt)) = o; }
                }
                {
                    bf16x8 vf[2];
#pragma unroll
                    for (int ks = 0; ks < 2; ++ks) S2M_VFRAG(vf[ks], EW, ks);
#pragma unroll
                    for (int mt = 0; mt < MTY; ++mt) {
                        f32x4 na = (f32x4){0.f, 0.f, 0.f, 0.f};
                        if (l15 == 0) na = *(const LAS f32x4*)((LAS unsigned char*)NL + nl_lo + 64 * mt) * keep;
#pragma unroll
                        for (int ks = 0; ks < 2; ++ks) na = __builtin_amdgcn_mfma_f32_16x16x32_bf16(kf[mt][ks], vf[ks], na, 0, 0, 0);
                        if (l15 == 0) { *(LAS f32x4*)((LAS unsigned char*)NL + nl_lo + 64 * mt) = na; u32x2 o; o.x = pk2(na[0], na[1]); o.y = pk2(na[2], na[3]); *(LAS u32x2*)(STw + sn_lo + 32 * mt) = o; } }
                }
                S2M_LOADY(cn);
                S2M_ADVANCE(false);
                WG_SYNC_LDS();
            }
#undef S2M_LOADY
        }
#undef S2M_ADVANCE
#undef S2M_LOADV
#undef S2M_LOADS
#undef S2M_RFL
#undef S2M_STAGE
#undef S2M_VFRAG
    }
}
template <int MODE>
__device__ __forceinline__ void hn_phase(Frame& F, const bf16_t* mix, const bf16_t* gate, const bf16_t* xc, const float* gn, const float* skip, bf16_t* amix) {
    constexpr int HD = MODE == 1 ? 256 : 512, NV = HD / 64;
    constexpr int LDM = 4 * HD;
    constexpr int LDG = MODE == 0 ? 6144 : (MODE == 1 ? 3072 : 4096), GOFF = MODE == 0 ? 4096 : 2048;
    const int gw = F.bid * NWAVES + F.wave, NGW = F.G * NWAVES, lane = F.lane;
    for (int t = gw; t < T; t += NGW) {
        float v[4][NV], gv[4][NV], xv[4][NV];
#pragma unroll
        for (int h = 0; h < 4; ++h) {
            if (NV == 8) {
                const u32x4 a = *(const u32x4*)(mix + (size_t)t * LDM + HD * h + 8 * lane), b = *(const u32x4*)(gate + (size_t)t * LDG + GOFF + HD * h + 8 * lane);
                v[h][0] = bflo(a.x); v[h][1] = bfhi(a.x); v[h][2] = bflo(a.y); v[h][3] = bfhi(a.y); v[h][4 % NV] = bflo(a.z); v[h][5 % NV] = bfhi(a.z); v[h][6 % NV] = bflo(a.w); v[h][7 % NV] = bfhi(a.w);
                gv[h][0] = bflo(b.x); gv[h][1] = bfhi(b.x); gv[h][2] = bflo(b.y); gv[h][3] = bfhi(b.y); gv[h][4 % NV] = bflo(b.z); gv[h][5 % NV] = bfhi(b.z); gv[h][6 % NV] = bflo(b.w); gv[h][7 % NV] = bfhi(b.w);
                if (MODE == 2) { const u32x4 c = *(const u32x4*)(xc + (size_t)t * LDM + HD * h + 8 * lane);
                    xv[h][0] = bflo(c.x); xv[h][1] = bfhi(c.x); xv[h][2] = bflo(c.y); xv[h][3] = bfhi(c.y); xv[h][4 % NV] = bflo(c.z); xv[h][5 % NV] = bfhi(c.z); xv[h][6 % NV] = bflo(c.w); xv[h][7 % NV] = bfhi(c.w); }
            } else {
                const u32x2 a = *(const u32x2*)(mix + (size_t)t * LDM + HD * h + 4 * lane), b = *(const u32x2*)(gate + (size_t)t * LDG + GOFF + HD * h + 4 * lane);
                v[h][0] = bflo(a.x); v[h][1] = bfhi(a.x); v[h][2] = bflo(a.y); v[h][3] = bfhi(a.y);
                gv[h][0] = bflo(b.x); gv[h][1] = bfhi(b.x); gv[h][2] = bflo(b.y); gv[h][3] = bfhi(b.y);
            }
        }
#pragma unroll
        for (int h = 0; h < 4; ++h) {
            if (MODE != 1) { float s = 0.f;
#pragma unroll
                for (int j = 0; j < NV; ++j) s += v[h][j];
                const float mean = wave_sum(s) * (1.0f / HD);
#pragma unroll
                for (int j = 0; j < NV; ++j) v[h][j] -= mean; }
            float q = 0.f;
#pragma unroll
            for (int j = 0; j < NV; ++j) q += v[h][j] * v[h][j];
            const float rstd = rsqrtf(wave_sum(q) * (1.0f / HD) + EPS);
            float o[NV];
#pragma unroll
            for (int j = 0; j < NV; ++j) { const int ch = HD * h + NV * lane + j;
                float y = v[h][j] * rstd * gn[ch];
                if (MODE == 2) y += skip[ch] * xv[h][j];
                o[j] = y * siluf_(gv[h][j]); }
            if (OUT_FP8) { unsigned char* a8 = (unsigned char*)amix;
                if (NV == 8) { u32x2 ow; ow.x = pk4_fp8(o[0], o[1], o[2], o[3]); ow.y = pk4_fp8(o[4 % NV], o[5 % NV], o[6 % NV], o[7 % NV]); *(u32x2*)(a8 + (size_t)t * LDM + HD * h + 8 * lane) = ow; }
                else *(unsigned*)(a8 + (size_t)t * LDM + HD * h + 4 * lane) = pk4_fp8(o[0], o[1], o[2], o[3]); }
            else if (NV == 8) { u32x4 ow; ow.x = pk2(o[0], o[1]); ow.y = pk2(o[2], o[3]); ow.z = pk2(o[4 % NV], o[5 % NV]); ow.w = pk2(o[6 % NV], o[7 % NV]);
                *(u32x4*)(amix + (size_t)t * LDM + HD * h + 8 * lane) = ow; }
            else { u32x2 ow; ow.x = pk2(o[0], o[1]); ow.y = pk2(o[2], o[3]); *(u32x2*)(amix + (size_t)t * LDM + HD * h + 4 * lane) = ow; }
        }
    }
}
__device__ __forceinline__ int kt_off(int d, int m) { return ((((d >> 4) * 2 + (m >> 5)) * 64 + 16 * ((m >> 3) & 3) + (d & 15)) << 3) + (m & 7); }

template <int NC, bool FRAG>
__device__ __forceinline__ void s1_write_transposed(const LAS unsigned char* src, int ldb, bf16_t* dst, int tid) {
    for (int p = tid; p < NC * 8; p += NTHR) {
        const int col = p % NC, mc = p / NC;
        unsigned short v[8];
#pragma unroll
        for (int e = 0; e < 8; ++e) v[e] = *(const LAS unsigned short*)(src + (size_t)(8 * mc + e) * ldb + 2 * col);
        u32x4 w; w.x = v[0] | ((unsigned)v[1] << 16); w.y = v[2] | ((unsigned)v[3] << 16); w.z = v[4] | ((unsigned)v[5] << 16); w.w = v[6] | ((unsigned)v[7] << 16);
        const int off = FRAG ? kt_off(col, 8 * mc) : (col * 64 + 8 * mc);
        *(u32x4*)(dst + off) = w;
    }
}
template <int DK>
__device__ __forceinline__ void s1_write_kt_tr(const LAS unsigned char* src, int ldb, bf16_t* dst, int wave, int lane) {
    const int l15 = lane & 15, g = lane >> 4, q = l15 >> 2, p = l15 & 3;
#pragma unroll
    for (int f = wave; f < (DK / 16) * 2; f += NWAVES) {
        const int dt = f >> 1, ks = f & 1;
        const LAS unsigned char* a = src + (32 * ks + 8 * g + q) * ldb + 2 * (16 * dt + 4 * p);
        const s16x4 lo = __builtin_amdgcn_ds_read_tr16_b64_v4i16((LAS s16x4*)a), hi = __builtin_amdgcn_ds_read_tr16_b64_v4i16((LAS s16x4*)(a + 4 * ldb));
        const bf16x8 v = (bf16x8){lo.x, lo.y, lo.z, lo.w, hi.x, hi.y, hi.z, hi.w};
        *(bf16x8*)(dst + ((size_t)f * 64 + lane) * 8) = v;
    }
}
template <int NC>
__device__ __forceinline__ void s1_load_tile(const bf16_t* src, int ld, LAS unsigned char* dst, int ldb, int tid) {
    constexpr int PPR = NC / 8;
    for (int p = tid; p < 64 * PPR; p += NTHR) { const int r = p / PPR, q = p % PPR;
        *(LAS u32x4*)(dst + (size_t)r * ldb + 16 * q) = *(const u32x4*)(src + (size_t)r * ld + 8 * q); }
}

template <int NC>
__device__ __forceinline__ void s1_gload(const bf16_t* src, int ld, u32x4 (&r)[64 * NC / 8 / NTHR], int tid) {
    constexpr int PPR = NC / 8;
#pragma unroll
    for (int i = 0; i < 64 * NC / 8 / NTHR; ++i) { const int p = tid + i * NTHR, row = p / PPR, q = p % PPR; r[i] = *(const u32x4*)(src + (size_t)row * ld + 8 * q); }
}
template <int NC>
__device__ __forceinline__ void s1_lstore(const u32x4 (&r)[64 * NC / 8 / NTHR], LAS unsigned char* dst, int ldb, int tid) {
    constexpr int PPR = NC / 8;
#pragma unroll
    for (int i = 0; i < 64 * NC / 8 / NTHR; ++i) { const int p = tid + i * NTHR, row = p / PPR, q = p % PPR; *(LAS u32x4*)(dst + (size_t)row * ldb + 16 * q) = r[i]; }
}
__device__ __forceinline__ void ret_s1_phase(Frame& F, const bf16_t* proj, bf16_t* PT, bf16_t* KT, bf16_t* VT) {
    constexpr int LDK = 528, LDV = 1040, LDP = 144;
    LAS unsigned char* Ks = F.lds;
    LAS unsigned char* Vs = F.lds + 33792;
    LAS unsigned char* Ps = F.lds + 33792 + 66560;
    const int lane = F.lane, l15 = lane & 15, g = lane >> 4, w = F.wave, lt = w >> 1, mh = w & 1;
    u32x4 kr[4]; bf16x8 qf[8];
#define RS1_LOAD(uu) do { const int c_ = (uu) % NCHUNK, h_ = ((uu) / NCHUNK) % 4, b_ = (uu) / (NCHUNK * 4); const size_t t0_ = (size_t)b_ * SEQ + (size_t)c_ * 64; \
        s1_gload<256>(proj + t0_ * 6144 + 1024 + 256 * h_, 6144, kr, F.tid); \
        _Pragma("unroll") for (int ks = 0; ks < 8; ++ks) qf[ks] = *(const bf16x8*)(proj + (t0_ + 16 * lt + l15) * 6144 + 256 * h_ + 32 * ks + 8 * g); } while (0)
    if (F.bid < NB * 4 * NCHUNK) RS1_LOAD(F.bid);
    for (int u = F.bid; u < NB * 4 * NCHUNK; u += F.G) {
        s1_lstore<256>(kr, Ks, LDK, F.tid);
        WG_SYNC_LDS();
        f32x4 acc[2];
#pragma unroll
        for (int nt = 0; nt < 2; ++nt) { acc[nt] = (f32x4){0.f, 0.f, 0.f, 0.f};
#pragma unroll
            for (int ks = 0; ks < 8; ++ks) { const bf16x8 kf = *(const LAS bf16x8*)(Ks + (size_t)(32 * mh + 16 * nt + l15) * LDK + 64 * ks + 16 * g);
                acc[nt] = __builtin_amdgcn_mfma_f32_16x16x32_bf16(qf[ks], kf, acc[nt], 0, 0, 0); } }
#pragma unroll
        for (int nt = 0; nt < 2; ++nt)
#pragma unroll
            for (int r = 0; r < 4; ++r) { const int l = 16 * lt + 4 * g + r, m = 32 * mh + 16 * nt + l15;
                *(LAS unsigned short*)(Ps + l * LDP + 2 * m) = (unsigned short)f2bf(m <= l ? acc[nt][r] : 0.f); }
        { const int un = u + F.G; if (un < NB * 4 * NCHUNK) RS1_LOAD(un); }
        WG_SYNC_LDS();
        { const int r = F.tid >> 3, q = F.tid & 7; *(u32x4*)(PT + (size_t)u * 4096 + r * 64 + 8 * q) = *(const LAS u32x4*)(Ps + r * LDP + 16 * q); }
        s1_write_kt_tr<256>(Ks, LDK, KT + (size_t)u * 256 * 64, F.wave, lane);
        WG_SYNC_LDS();
    }
#undef RS1_LOAD
}

__device__ __forceinline__ void ret_s2_phase(Frame& F, const bf16_t* proj, const bf16_t* PT, const bf16_t* KT, const bf16_t* VT, bf16_t* mix) {
    constexpr int LDS_ST = 528, LDV = 144, LDO = 144;
    LAS unsigned char* ST = F.lds;
    LAS unsigned char* VTs = F.lds + 33792;
    LAS unsigned char* Os = F.lds + 33792 + 18432;
    const int lane = F.lane, l15 = lane & 15, g = lane >> 4, w = F.wave, lt = w >> 1, eh = w & 1;
    for (int u = F.bid; u < NB * 4 * 8; u += F.G) {
        const int eb = u & 7, h = (u >> 3) & 3, b = u >> 5;
        const float lg = log1pf(-exp2f(-5.0f - (float)h));
        f32x4 S[2][4];
#pragma unroll
        for (int mt = 0; mt < 2; ++mt)
#pragma unroll
            for (int nt = 0; nt < 4; ++nt) S[mt][nt] = (f32x4){0.f, 0.f, 0.f, 0.f};
        for (int i = F.tid; i < 33792 / 4; i += NTHR) ((LAS unsigned*)ST)[i] = 0u;
        const float dec64 = __expf(64.0f * lg);
        for (int c = 0; c < NCHUNK; ++c) {
            const size_t t0 = (size_t)b * SEQ + (size_t)c * 64;
            const size_t uidx = ((size_t)(b * 4 + h)) * NCHUNK + c;
            LAS unsigned char* vt = VTs + (c & 1) * 9216;
            bf16x8 kf[2][2], qf[8], pf[2];
#pragma unroll
            for (int mt = 0; mt < 2; ++mt)
#pragma unroll
                for (int ks = 0; ks < 2; ++ks) kf[mt][ks] = *(const bf16x8*)(KT + uidx * (256 * 64) + ((((2 * w + mt) * 2 + ks) * 64 + lane) << 3));
#pragma unroll
            for (int ks = 0; ks < 8; ++ks) qf[ks] = *(const bf16x8*)(proj + (t0 + 16 * lt + l15) * 6144 + 256 * h + 32 * ks + 8 * g);
#pragma unroll
            for (int ks = 0; ks < 2; ++ks) pf[ks] = *(const bf16x8*)(PT + uidx * 4096 + (16 * lt + l15) * 64 + 32 * ks + 8 * g);
            {
                const int e = F.tid >> 3, q = F.tid & 7;
                const u32x4 raw = *(const u32x4*)(VT + uidx * (512 * 64) + (size_t)(64 * eb + e) * 64 + 8 * q);
                float f[8] = {bflo(raw.x), bfhi(raw.x), bflo(raw.y), bfhi(raw.y), bflo(raw.z), bfhi(raw.z), bflo(raw.w), bfhi(raw.w)};
#pragma unroll
                for (int j = 0; j < 8; ++j) f[j] *= __expf((float)(63 - (8 * q + j)) * lg);
                u32x4 o; o.x = pk2(f[0], f[1]); o.y = pk2(f[2], f[3]); o.z = pk2(f[4], f[5]); o.w = pk2(f[6], f[7]);
                *(LAS u32x4*)(vt + e * LDV + 16 * q) = o;
            }
            LDS_WAIT();
            __syncthreads();
            f32x4 oi[2], oo[2];
#pragma unroll
            for (int nt = 0; nt < 2; ++nt) {
                const int e = 32 * eh + 16 * nt + l15;
                oi[nt] = (f32x4){0.f, 0.f, 0.f, 0.f}; oo[nt] = (f32x4){0.f, 0.f, 0.f, 0.f};
#pragma unroll
                for (int ks = 0; ks < 2; ++ks) { const bf16x8 vf = *(const LAS bf16x8*)(vt + e * LDV + 64 * ks + 16 * g);
                    oi[nt] = __builtin_amdgcn_mfma_f32_16x16x32_bf16(pf[ks], vf, oi[nt], 0, 0, 0); }
#pragma unroll
                for (int ks = 0; ks < 8; ++ks) { const bf16x8 sf = *(const LAS bf16x8*)(ST + e * LDS_ST + 64 * ks + 16 * g);
                    oo[nt] = __builtin_amdgcn_mfma_f32_16x16x32_bf16(qf[ks], sf, oo[nt], 0, 0, 0); }
            }
#pragma unroll
            for (int r = 0; r < 4; ++r) { const int l = 16 * lt + 4 * g + r;
                const float si = __expf((float)(l - 63) * lg), so = __expf((float)(l + 1) * lg);
#pragma unroll
                for (int nt = 0; nt < 2; ++nt) *(LAS unsigned short*)(Os + l * LDO + 2 * (32 * eh + 16 * nt + l15)) = (unsigned short)f2bf(si * oi[nt][r] + so * oo[nt][r]); }
            LDS_WAIT();
            __syncthreads();
            { const int r = F.tid >> 3, q = F.tid & 7; *(u32x4*)(mix + (t0 + r) * 2048 + 512 * h + 64 * eb + 8 * q) = *(const LAS u32x4*)(Os + r * LDO + 16 * q); }
#pragma unroll
            for (int mt = 0; mt < 2; ++mt)
#pragma unroll
                for (int nt = 0; nt < 4; ++nt) { S[mt][nt] = S[mt][nt] * dec64;
#pragma unroll
                    for (int ks = 0; ks < 2; ++ks) { const bf16x8 vf = *(const LAS bf16x8*)(vt + (16 * nt + l15) * LDV + 64 * ks + 16 * g);
                        S[mt][nt] = __builtin_amdgcn_mfma_f32_16x16x32_bf16(kf[mt][ks], vf, S[mt][nt], 0, 0, 0); }
                    u32x2 o; o.x = pk2(S[mt][nt][0], S[mt][nt][1]); o.y = pk2(S[mt][nt][2], S[mt][nt][3]);
                    *(LAS u32x2*)(ST + (16 * nt + l15) * LDS_ST + 2 * (32 * w + 16 * mt + 4 * g)) = o; }
        }
        LDS_WAIT();
        __syncthreads();
    }
}

__device__ __forceinline__ void ret_norm_phase(Frame& F, const bf16_t* mix, const bf16_t* proj, const float* gn, bf16_t* amix) {
    const int gw = F.bid * NWAVES + F.wave, NGW = F.G * NWAVES, lane = F.lane;
    for (int i = gw; i < T * 4; i += NGW) {
        const int t = i >> 2, h = i & 3;
        const u32x4 raw = *(const u32x4*)(mix + (size_t)t * 2048 + 512 * h + 8 * lane);
        const u32x4 gr = *(const u32x4*)(proj + (size_t)t * 6144 + 4096 + 512 * h + 8 * lane);
        float v[8] = {bflo(raw.x), bfhi(raw.x), bflo(raw.y), bfhi(raw.y), bflo(raw.z), bfhi(raw.z), bflo(raw.w), bfhi(raw.w)};
        const float gv[8] = {bflo(gr.x), bfhi(gr.x), bflo(gr.y), bfhi(gr.y), bflo(gr.z), bfhi(gr.z), bflo(gr.w), bfhi(gr.w)};
        float s = 0.f;
#pragma unroll
        for (int j = 0; j < 8; ++j) s += v[j];
        const float mean = wave_sum(s) * (1.0f / 512.0f);
        float q = 0.f;
#pragma unroll
        for (int j = 0; j < 8; ++j) { v[j] -= mean; q += v[j] * v[j]; }
        const float rstd = rsqrtf(wave_sum(q) * (1.0f / 512.0f) + EPS);
        const f32x4 g0 = *(const f32x4*)(gn + 512 * h + 8 * lane), g1 = *(const f32x4*)(gn + 512 * h + 8 * lane + 4);
        const float gg[8] = {g0.x, g0.y, g0.z, g0.w, g1.x, g1.y, g1.z, g1.w};
        float o[8];
#pragma unroll
        for (int j = 0; j < 8; ++j) o[j] = v[j] * rstd * gg[j] * siluf_(gv[j]);
        u32x4 ow; ow.x = pk2(o[0], o[1]); ow.y = pk2(o[2], o[3]); ow.z = pk2(o[4], o[5]); ow.w = pk2(o[6], o[7]);
        *(u32x4*)(amix + (size_t)t * 2048 + 512 * h + 8 * lane) = ow;
    }
}
#define NPH_RET 5
#define LAYER_RET() do { \
        { pg8::Gemm g{IFP8_RET ? (const bf16_t*)(ws + WS_H8) : hbuf, (const bf16_t*)(ws + WS_W_RET_IN), T, GFP8_RET ? 4096 : 6144, IFP8_RET ? 512 : 1024}; pg8::EpiRet E{proj, (const f32x2*)(ws + WS_ROPE), IFP8_RET ? 0.03125f : 1.0f}; \
          pg8::Gemm g2{(const bf16_t*)(ws + WS_H8), (const bf16_t*)(ws + WS_W_RET_IN + 8 * MiB), T, 2048, 512}; pg8::EpiBf16S E2{proj + 4096, 6144, 0, 1.0f, 0.03125f}; \
          RUN_PHASE({ pg8::StaticOrder S; S.init(T, GFP8_RET ? 4096 : 6144, F.G, F.bid); \
            if (CVT_HOST == 2 && MOE_FP8) { BgCvtR bgc; bgc.init(in, ws, F.bid * NWAVES + F.wave, F.G * NWAVES, F.lane, -1, 0, 0, 0, 16384);       \
              pg8::gemm_phase_bg<pg8::EpiRet, pg8::StaticOrder, false, (IFP8_RET != 0), BgCvtR>(F.lds, g, S, E, bgc); bgc.finish(); } \
            else pg8::gemm_phase<pg8::EpiRet, pg8::StaticOrder, false, (IFP8_RET != 0)>(F.lds, g, S, E); \
            if (GFP8_RET) { pg8::StaticOrder S2; S2.init(T, 2048, F.G, F.bid); pg8::gemm_phase<pg8::EpiBf16S, pg8::StaticOrder, false, true>(F.lds, g2, S2, E2); } }); } \
        RUN_PHASE_N(REP_S1, ret_s1_phase(F, proj, (bf16_t*)(ws + WS_PT), (bf16_t*)(ws + WS_KT), (bf16_t*)(ws + WS_VT))); \
        RUN_PHASE({ if (S2X) s2x_phase<0>(F, proj, (const bf16_t*)(ws + WS_PT), (const bf16_t*)(ws + WS_KT), proj + 2048, nullptr, (bf16_t*)(ws + WS_MIX)); else s2_phase<0>(F, proj, (const bf16_t*)(ws + WS_PT), (const bf16_t*)(ws + WS_KT), proj + 2048, nullptr, (bf16_t*)(ws + WS_MIX), in, ws, -1); \
            if (REP_S2R > 1) { VM_WAIT(); __syncthreads(); s2_phase<0, S2_ABL>(F, proj, (const bf16_t*)(ws + WS_PT), (const bf16_t*)(ws + WS_KT), proj + 2048, nullptr, (bf16_t*)(ws + WS_AMIX)); } }); \
        RUN_PHASE_N(REP_HN, hn_phase<0>(F, (const bf16_t*)(ws + WS_MIX), proj, nullptr, in[8], nullptr, amix)); \
        OUTPROJ(0, WS_W_RET_OUT, 2048); \
    } while (0)
__device__ __forceinline__ void attn_phase(Frame& F, const bf16_t* qkv, const float* relb, bf16_t* o, const float* const* in, unsigned char* ws) {
    const int gw_ = F.bid * NWAVES + F.wave, NGW_ = F.G * NWAVES;
    const int n_it = 2 * ((NB * NCHUNK + F.G - 1) / F.G);
    constexpr int NLY = CVT_HOST ? 0 : 4 - MOE_PRO_LAYERS;
    const int per_ly = (MOE_FP8 && NLY > 0) ? ((24576 + NGW_ * n_it - 1) / (NGW_ * n_it)) : 0, per_it = per_ly * NLY;
    int it_ = 0;
    LAS unsigned char* wl = F.lds + F.wave * 8192;
    LAS float* rb = (LAS float*)(wl + 5120);
    const int lane = F.lane, l15 = lane & 15, g = lane >> 4;
    const __amdgpu_buffer_rsrc_t qrs = __builtin_amdgcn_make_buffer_rsrc((void*)qkv, 0, 0x7fffffff, 0x00020000);
    const unsigned kofs = (unsigned)(l15 * 3072 + 8 * g) * 2u, vofs = (unsigned)((lane >> 3) * 3072 + 8 * (lane & 7)) * 2u;
    for (int u0 = F.bid; u0 < NB * NCHUNK; u0 += F.G) {
        int u = u0;
        if (F.G == 256) { const int x = u0 & 7, j = (u0 >> 3) & 31, r = u0 >> 8; u = x * NCHUNK + r * 32 + j; }
        const int b = u / NCHUNK, c = u % NCHUNK;
        const size_t t0 = (size_t)b * SEQ + (size_t)c * 64;
        for (int hh = 0; hh < 2; ++hh) {
            const int h = F.wave * 2 + hh;
            if (per_it) { for (int ly = 0; ly < NLY; ++ly) bg_convert(in, ws, MOE_PRO_LAYERS + ly, it_ * per_ly, per_ly, gw_, NGW_, lane); }
            ++it_;
            for (int i = lane; i < 320; i += 64) rb[i] = relb[h * 320 + i] * 1.4426950408889634f;
            bf16x8 qf[4][2];
#pragma unroll
            for (int nt = 0; nt < 4; ++nt)
#pragma unroll
                for (int ks = 0; ks < 2; ++ks) qf[nt][ks] = *(const bf16x8*)(qkv + (t0 + 16 * nt + l15) * 3072 + 64 * h + 32 * ks + 8 * g);
            f32x4 oacc[4][4];
#pragma unroll
            for (int dt = 0; dt < 4; ++dt)
#pragma unroll
                for (int nt = 0; nt < 4; ++nt) oacc[dt][nt] = (f32x4){0.f, 0.f, 0.f, 0.f};
            float mrun[4], lsum[4];
#pragma unroll
            for (int nt = 0; nt < 4; ++nt) { mrun[nt] = -1.0e30f; lsum[nt] = 0.f; }
            const int kt0 = (16 - 2 * c) > 0 ? (16 - 2 * c) : 0;
            bf16x8 kf[2][2]; u32x4 vv[4];
#define ATT_GLOAD(KF, VV, kt_) do { const unsigned sb_ = (unsigned)((t0 - 512 + 32 * (kt_)) * 3072 + 64 * h) * 2u;        \
                _Pragma("unroll") for (int mt = 0; mt < 2; ++mt) _Pragma("unroll") for (int ks = 0; ks < 2; ++ks) \
                    KF[mt][ks] = __builtin_bit_cast(bf16x8, __builtin_amdgcn_raw_buffer_load_b128(qrs, kofs, sb_ + (unsigned)((16 * mt * 3072 + 1024 + 32 * ks) * 2), 0)); \
                _Pragma("unroll") for (int i = 0; i < 4; ++i) VV[i] = __builtin_bit_cast(u32x4, __builtin_amdgcn_raw_buffer_load_b128(qrs, vofs, sb_ + (unsigned)((8 * i * 3072 + 2048) * 2), 0)); } while (0)
            ATT_GLOAD(kf, vv, kt0);
            for (int kt = kt0; kt < 18; ++kt) {
                bf16x8 kfn[2][2]; u32x4 vvn[4];
                { const int ktn = kt + 1 < 18 ? kt + 1 : kt; ATT_GLOAD(kfn, vvn, ktn); }
                f32x4 sacc[2][4];
#pragma unroll
                for (int mt = 0; mt < 2; ++mt)
#pragma unroll
                    for (int nt = 0; nt < 4; ++nt) { sacc[mt][nt] = (f32x4){0.f, 0.f, 0.f, 0.f};
#pragma unroll
                        for (int ks = 0; ks < 2; ++ks) sacc[mt][nt] = __builtin_amdgcn_mfma_f32_16x16x32_bf16(kf[mt][ks], qf[nt][ks], sacc[mt][nt], 0, 0, 0); }
#pragma unroll
                for (int i = 0; i < 4; ++i) *(LAS u32x4*)(wl + ((lane >> 3) + 8 * i) * 144 + 16 * (lane & 7)) = vv[i];
                bf16x8 pf[4];
#pragma unroll
                for (int nt = 0; nt < 4; ++nt) {
                    float tmax = -1.0e30f;
                    if (kt <= 7) {
                        const float cb = rb[256 + 63];
#pragma unroll
                        for (int mt = 0; mt < 2; ++mt)
#pragma unroll
                            for (int r = 0; r < 4; ++r) { const float s = sacc[mt][nt][r] + cb; sacc[mt][nt][r] = s; tmax = fmaxf(tmax, s); }
                    } else {
#pragma unroll
                        for (int mt = 0; mt < 2; ++mt)
#pragma unroll
                            for (int r = 0; r < 4; ++r) {
                                int dist = (16 * nt + l15) - (32 * kt + 16 * mt + 4 * g + r) + 512;
                                dist = dist < -63 ? -63 : (dist > 256 ? 256 : dist);
                                const float s = sacc[mt][nt][r] + rb[dist + 63];
                                sacc[mt][nt][r] = s; tmax = fmaxf(tmax, s);
                            }
                    }
                    tmax = fmaxf(tmax, __shfl_xor(tmax, 16)); tmax = fmaxf(tmax, __shfl_xor(tmax, 32));
                    const float mnew = fmaxf(mrun[nt], tmax);
                    const float alpha = __builtin_amdgcn_exp2f(mrun[nt] - mnew);
                    mrun[nt] = mnew;
                    float ps = 0.f; float p[8];
#pragma unroll
                    for (int mt = 0; mt < 2; ++mt)
#pragma unroll
                        for (int r = 0; r < 4; ++r) { const float e = __builtin_amdgcn_exp2f(sacc[mt][nt][r] - mnew); p[4 * mt + r] = e; ps += e; }
                    lsum[nt] = lsum[nt] * alpha + ps;
                    if (__builtin_amdgcn_ballot_w64(alpha != 1.0f) != 0) {
#pragma unroll
                        for (int dt = 0; dt < 4; ++dt) oacc[dt][nt] = oacc[dt][nt] * alpha; }
                    u32x4 pw; pw.x = cvt_pk_bf16(p[0], p[1]); pw.y = cvt_pk_bf16(p[2], p[3]); pw.z = cvt_pk_bf16(p[4], p[5]); pw.w = cvt_pk_bf16(p[6], p[7]);
                    pf[nt] = __builtin_bit_cast(bf16x8, pw);
                }
#pragma unroll
                for (int dt = 0; dt < 4; ++dt) {
                    const LAS unsigned char* ta = wl + (4 * g + (l15 >> 2)) * 144 + 2 * (16 * dt + 4 * (l15 & 3));
                    const s16x4 lo = __builtin_amdgcn_ds_read_tr16_b64_v4i16((LAS s16x4*)ta), hi = __builtin_amdgcn_ds_read_tr16_b64_v4i16((LAS s16x4*)(ta + 16 * 144));
                    const bf16x8 vf = (bf16x8){lo.x, lo.y, lo.z, lo.w, hi.x, hi.y, hi.z, hi.w};
#pragma unroll
                    for (int nt = 0; nt < 4; ++nt) oacc[dt][nt] = __builtin_amdgcn_mfma_f32_16x16x32_bf16(vf, pf[nt], oacc[dt][nt], 0, 0, 0);
                }
#pragma unroll
                for (int mt = 0; mt < 2; ++mt)
#pragma unroll
                    for (int ks = 0; ks < 2; ++ks) kf[mt][ks] = kfn[mt][ks];
#pragma unroll
                for (int i = 0; i < 4; ++i) vv[i] = vvn[i];
            }
#undef ATT_GLOAD
#pragma unroll
            for (int nt = 0; nt < 4; ++nt) {
                float l = lsum[nt]; l += __shfl_xor(l, 16); l += __shfl_xor(l, 32);
                const float inv = 1.0f / l;
#pragma unroll
                for (int dt = 0; dt < 4; ++dt) { const f32x4 v = oacc[dt][nt] * inv;
                    if (OUT_FP8) *(unsigned*)((unsigned char*)o + (t0 + 16 * nt + l15) * 1024 + 64 * h + 16 * dt + 4 * g) = pk4_fp8(v[0], v[1], v[2], v[3]);
                    else { u32x2 w; w.x = cvt_pk_bf16(v[0], v[1]); w.y = cvt_pk_bf16(v[2], v[3]);
                    *(u32x2*)(o + (t0 + 16 * nt + l15) * 1024 + 64 * h + 16 * dt + 4 * g) = w; } }
            }
        }
    }
    for (; it_ < n_it; ++it_) { if (per_it) for (int ly = 0; ly < NLY; ++ly) bg_convert(in, ws, MOE_PRO_LAYERS + ly, it_ * per_ly, per_ly, gw_, NGW_, lane); }
}
#define NPH_ATT 3
#define LAYER_ATT() do { \
        { pg8::Gemm g{IFP8_ATT ? (const bf16_t*)(ws + WS_H8) : hbuf, (const bf16_t*)(ws + WS_W_ATT_IN), T, 3072, IFP8_ATT ? 512 : 1024}; pg8::EpiBf16S E{proj, 3072, 4, 0.125f * 1.4426950408889634f, IFP8_ATT ? 0.03125f : 1.0f};       \
          RUN_PHASE_DUP(REP_INPROJ, { pg8::StaticOrder S; S.init(T, 3072, F.G, F.bid); pg8::gemm_phase<pg8::EpiBf16S, pg8::StaticOrder, false, (IFP8_ATT != 0)>(F.lds, g, S, E); }); } \
        RUN_PHASE_N(REP_ATT, attn_phase(F, proj, in[11], amix, in, ws)); \
        OUTPROJ(1, WS_W_ATT_OUT, 1024); \
    } while (0)
__device__ __forceinline__ void gla_s1_phase(Frame& F, const bf16_t* proj, const float* glow, const float* wgate, const float* bgate,
                                             bf16_t* PT, bf16_t* KT, bf16_t* VT, bf16_t* QS, float* REC) {
    constexpr int LDQ = 272, LDV = 528, LDP = 144;
    LAS float* Bc = (LAS float*)F.lds;
    LAS float* Gl = (LAS float*)(F.lds + 32768);
    LAS float* Wg = (LAS float*)(F.lds + 36864);
    LAS unsigned char* Qi = F.lds + 45056;
    LAS unsigned char* Ki = F.lds + 45056 + 17408;
    LAS unsigned char* Kst = F.lds + 45056 + 2 * 17408;
    LAS unsigned char* Vs = F.lds + 45056 + 3 * 17408;
    LAS unsigned char* Ps = F.lds + 45056 + 3 * 17408 + 33792;
    const int lane = F.lane, l15 = lane & 15, g = lane >> 4, w = F.wave, lt = w >> 1, mh = w & 1;
    float glr[2], wgr[4], bgr = 0.f; u32x4 qrr[2], krr[2];
#define GS1_LOAD(uu) do { const int c_ = (uu) % NCHUNK, h_ = ((uu) / NCHUNK) % 4, b_ = (uu) / (NCHUNK * 4); const size_t t0_ = (size_t)b_ * SEQ + (size_t)c_ * 64; \
        _Pragma("unroll") for (int i = 0; i < 2; ++i) glr[i] = glow[t0_ * 16 + F.tid + NTHR * i]; \
        _Pragma("unroll") for (int i = 0; i < 4; ++i) { const int x_ = F.tid + NTHR * i; wgr[i] = wgate[(size_t)(x_ >> 7) * 512 + 128 * h_ + (x_ & 127)]; } \
        bgr = bgate[128 * h_ + (F.tid & 127)]; \
        _Pragma("unroll") for (int i = 0; i < 2; ++i) { const int p_ = F.tid + NTHR * i, l_ = p_ >> 4, q8_ = p_ & 15; \
            qrr[i] = *(const u32x4*)(proj + (t0_ + l_) * 3072 + 128 * h_ + 8 * q8_); krr[i] = *(const u32x4*)(proj + (t0_ + l_) * 3072 + 512 + 128 * h_ + 8 * q8_); } } while (0)
    if (F.bid < NB * 4 * NCHUNK) GS1_LOAD(F.bid);
    for (int u = F.bid; u < NB * 4 * NCHUNK; u += F.G) {
        const int c = u % NCHUNK, h = (u / NCHUNK) % 4, b = u / (NCHUNK * 4);
        const size_t t0 = (size_t)b * SEQ + (size_t)c * 64;
#pragma unroll
        for (int i = 0; i < 2; ++i) Gl[F.tid + NTHR * i] = glr[i];
#pragma unroll
        for (int i = 0; i < 4; ++i) Wg[F.tid + NTHR * i] = wgr[i];
        const float bg_cur = bgr; const u32x4 qc[2] = {qrr[0], qrr[1]}, kc[2] = {krr[0], krr[1]};
        if (u + F.G < NB * 4 * NCHUNK) GS1_LOAD(u + F.G);
        WG_SYNC_LDS();
        { const int d = F.tid & 127; const float bg = bg_cur;
          float wg[16];
#pragma unroll
          for (int k = 0; k < 16; ++k) wg[k] = Wg[k * 128 + d];
          for (int i = 0; i < 16; ++i) { const int l = (F.tid >> 7) + 4 * i; float z = bg;
#pragma unroll
              for (int k = 0; k < 16; ++k) z += Gl[l * 16 + k] * wg[k];
              Bc[l * 128 + d] = logsigmoidf_(z) * (1.0f / 16.0f); } }
        WG_SYNC_LDS();
        if (F.tid < 128) { float a = 0.f; for (int l = 0; l < 64; ++l) { a += Bc[l * 128 + F.tid]; Bc[l * 128 + F.tid] = a; } REC[(size_t)u * 128 + F.tid] = __expf(a); }
        WG_SYNC_LDS();
#pragma unroll
        for (int pi = 0; pi < 2; ++pi) { const int p = F.tid + NTHR * pi;
            const int l = p >> 4, q8 = p & 15;
            const u32x4 qr = qc[pi], kr = kc[pi];
            const float qv[8] = {bflo(qr.x), bfhi(qr.x), bflo(qr.y), bfhi(qr.y), bflo(qr.z), bfhi(qr.z), bflo(qr.w), bfhi(qr.w)};
            const float kv[8] = {bflo(kr.x), bfhi(kr.x), bflo(kr.y), bfhi(kr.y), bflo(kr.z), bfhi(kr.z), bflo(kr.w), bfhi(kr.w)};
            float qi[8], ki[8], ks[8];
#pragma unroll
            for (int j = 0; j < 8; ++j) { const float bb = Bc[l * 128 + 8 * q8 + j], bl = Bc[63 * 128 + 8 * q8 + j];
                qi[j] = qv[j] * __expf(bb); ki[j] = kv[j] * __expf(-bb); ks[j] = kv[j] * __expf(bl - bb); }
            u32x4 o; o.x = pk2(qi[0], qi[1]); o.y = pk2(qi[2], qi[3]); o.z = pk2(qi[4], qi[5]); o.w = pk2(qi[6], qi[7]);
            *(LAS u32x4*)(Qi + l * LDQ + 16 * q8) = o; *(u32x4*)(QS + (t0 + l) * 512 + 128 * h + 8 * q8) = o;
            o.x = pk2(ki[0], ki[1]); o.y = pk2(ki[2], ki[3]); o.z = pk2(ki[4], ki[5]); o.w = pk2(ki[6], ki[7]);
            *(LAS u32x4*)(Ki + l * LDQ + 16 * q8) = o;
            o.x = pk2(ks[0], ks[1]); o.y = pk2(ks[2], ks[3]); o.z = pk2(ks[4], ks[5]); o.w = pk2(ks[6], ks[7]);
            *(LAS u32x4*)(Kst + l * LDQ + 16 * q8) = o;
        }
        WG_SYNC_LDS();
        f32x4 acc[2];
#pragma unroll
        for (int nt = 0; nt < 2; ++nt) { acc[nt] = (f32x4){0.f, 0.f, 0.f, 0.f};
#pragma unroll
            for (int ks = 0; ks < 4; ++ks) { const bf16x8 qf = *(const LAS bf16x8*)(Qi + (16 * lt + l15) * LDQ + 64 * ks + 16 * g);
                const bf16x8 kf = *(const LAS bf16x8*)(Ki + (32 * mh + 16 * nt + l15) * LDQ + 64 * ks + 16 * g);
                acc[nt] = __builtin_amdgcn_mfma_f32_16x16x32_bf16(qf, kf, acc[nt], 0, 0, 0); } }
#pragma unroll
        for (int nt = 0; nt < 2; ++nt)
#pragma unroll
            for (int r = 0; r < 4; ++r) { const int l = 16 * lt + 4 * g + r, m = 32 * mh + 16 * nt + l15;
                *(LAS unsigned short*)(Ps + l * LDP + 2 * m) = (unsigned short)f2bf(m <= l ? acc[nt][r] : 0.f); }
        WG_SYNC_LDS();
        { const int r = F.tid >> 3, q = F.tid & 7; *(u32x4*)(PT + (size_t)u * 4096 + r * 64 + 8 * q) = *(const LAS u32x4*)(Ps + r * LDP + 16 * q); }
        s1_write_kt_tr<128>(Kst, LDQ, KT + (size_t)u * 128 * 64, F.wave, lane);
        WG_SYNC_LDS();
    }
#undef GS1_LOAD
}

__device__ __forceinline__ void gla_s2_phase(Frame& F, const bf16_t* QS, const bf16_t* PT, const bf16_t* KT, const bf16_t* VT, const float* REC, bf16_t* mix) {
    constexpr int LDS_ST = 272, LDV = 144, LDO = 80;
    LAS unsigned char* ST = F.lds;
    LAS unsigned char* VTs = F.lds + 8704;
    LAS unsigned char* Os = F.lds + 8704 + 9216;
    const int lane = F.lane, l15 = lane & 15, g = lane >> 4, w = F.wave, lt = w >> 1, eh = w & 1;
    for (int u = F.bid; u < NB * 4 * 8; u += F.G) {
        const int eb = u & 7, h = (u >> 3) & 3, b = u >> 5;
        f32x4 S[2];
#pragma unroll
        for (int nt = 0; nt < 2; ++nt) S[nt] = (f32x4){0.f, 0.f, 0.f, 0.f};
        for (int i = F.tid; i < 8704 / 4; i += NTHR) ((LAS unsigned*)ST)[i] = 0u;
        for (int c = 0; c < NCHUNK; ++c) {
            const size_t t0 = (size_t)b * SEQ + (size_t)c * 64;
            const size_t uidx = ((size_t)(b * 4 + h)) * NCHUNK + c;
            LAS unsigned char* vt = VTs + (c & 1) * 4608;
            bf16x8 kf[2], qf[4], pf[2];
#pragma unroll
            for (int ks = 0; ks < 2; ++ks) kf[ks] = *(const bf16x8*)(KT + uidx * (128 * 64) + (((w * 2 + ks) * 64 + lane) << 3));
#pragma unroll
            for (int ks = 0; ks < 4; ++ks) qf[ks] = *(const bf16x8*)(QS + (t0 + 16 * lt + l15) * 512 + 128 * h + 32 * ks + 8 * g);
#pragma unroll
            for (int ks = 0; ks < 2; ++ks) pf[ks] = *(const bf16x8*)(PT + uidx * 4096 + (16 * lt + l15) * 64 + 32 * ks + 8 * g);
            f32x4 dec;
#pragma unroll
            for (int r = 0; r < 4; ++r) dec[r] = REC[uidx * 128 + 16 * w + 4 * g + r];
            if (F.tid < 256) { const int e = F.tid >> 3, q = F.tid & 7;
                *(LAS u32x4*)(vt + e * LDV + 16 * q) = *(const u32x4*)(VT + uidx * (256 * 64) + (size_t)(32 * eb + e) * 64 + 8 * q); }
            LDS_WAIT();
            __syncthreads();
            f32x4 oo = (f32x4){0.f, 0.f, 0.f, 0.f};
            { const int e = 16 * eh + l15;
#pragma unroll
              for (int ks = 0; ks < 2; ++ks) { const bf16x8 vf = *(const LAS bf16x8*)(vt + e * LDV + 64 * ks + 16 * g);
                  oo = __builtin_amdgcn_mfma_f32_16x16x32_bf16(pf[ks], vf, oo, 0, 0, 0); }
#pragma unroll
              for (int ks = 0; ks < 4; ++ks) { const bf16x8 sf = *(const LAS bf16x8*)(ST + e * LDS_ST + 64 * ks + 16 * g);
                  oo = __builtin_amdgcn_mfma_f32_16x16x32_bf16(qf[ks], sf, oo, 0, 0, 0); } }
#pragma unroll
            for (int r = 0; r < 4; ++r) *(LAS unsigned short*)(Os + (16 * lt + 4 * g + r) * LDO + 2 * (16 * eh + l15)) = (unsigned short)f2bf(oo[r]);
            LDS_WAIT();
            __syncthreads();
            if (F.tid < 256) { const int r = F.tid >> 2, q = F.tid & 3; *(u32x4*)(mix + (t0 + r) * 1024 + 256 * h + 32 * eb + 8 * q) = *(const LAS u32x4*)(Os + r * LDO + 16 * q); }
#pragma unroll
            for (int nt = 0; nt < 2; ++nt) { S[nt] = S[nt] * dec;
#pragma unroll
                for (int ks = 0; ks < 2; ++ks) { const bf16x8 vf = *(const LAS bf16x8*)(vt + (16 * nt + l15) * LDV + 64 * ks + 16 * g);
                    S[nt] = __builtin_amdgcn_mfma_f32_16x16x32_bf16(kf[ks], vf, S[nt], 0, 0, 0); }
                u32x2 o; o.x = pk2(S[nt][0], S[nt][1]); o.y = pk2(S[nt][2], S[nt][3]);
                *(LAS u32x2*)(ST + (16 * nt + l15) * LDS_ST + 2 * (16 * w + 4 * g)) = o; }
        }
        LDS_WAIT();
        __syncthreads();
    }
}

__device__ __forceinline__ void gla_norm_phase(Frame& F, const bf16_t* mix, const bf16_t* proj, const float* gn, bf16_t* amix) {
    const int gw = F.bid * NWAVES + F.wave, NGW = F.G * NWAVES, lane = F.lane;
    for (int i = gw; i < T * 4; i += NGW) {
        const int t = i >> 2, h = i & 3;
        const u32x2 raw = *(const u32x2*)(mix + (size_t)t * 1024 + 256 * h + 4 * lane);
        const u32x2 rr = *(const u32x2*)(proj + (size_t)t * 3072 + 2048 + 256 * h + 4 * lane);
        const float v[4] = {bflo(raw.x), bfhi(raw.x), bflo(raw.y), bfhi(raw.y)};
        const float rv[4] = {bflo(rr.x), bfhi(rr.x), bflo(rr.y), bfhi(rr.y)};
        float q = 0.f;
#pragma unroll
        for (int j = 0; j < 4; ++j) q += v[j] * v[j];
        const float rstd = rsqrtf(wave_sum(q) * (1.0f / 256.0f) + EPS);
        const f32x4 g0 = *(const f32x4*)(gn + 256 * h + 4 * lane);
        const float gg[4] = {g0.x, g0.y, g0.z, g0.w};
        float o[4];
#pragma unroll
        for (int j = 0; j < 4; ++j) o[j] = v[j] * rstd * gg[j] * siluf_(rv[j]);
        u32x2 ow; ow.x = pk2(o[0], o[1]); ow.y = pk2(o[2], o[3]);
        *(u32x2*)(amix + (size_t)t * 1024 + 256 * h + 4 * lane) = ow;
    }
}
#define NPH_GLA 5
#define LAYER_GLA() do { \
        { pg8::Gemm g{IFP8_GLA ? (const bf16_t*)(ws + WS_H8) : hbuf, (const bf16_t*)(ws + WS_W_GLA_IN), T, GFP8_GLA ? 2048 : 3072, IFP8_GLA ? 512 : 1024}; pg8::EpiBf16S E{proj, 3072, 2, 0.08838834764831845f, IFP8_GLA ? 0.03125f : 1.0f}; \
          pg8::Gemm g2{(const bf16_t*)(ws + WS_H8), (const bf16_t*)(ws + WS_W_GLA_IN + 4 * MiB), T, 1024, 512}; pg8::EpiBf16S E2{proj + 2048, 3072, 0, 1.0f, 0.03125f}; \
          RUN_PHASE({ pg8::StaticOrder S; S.init(T, GFP8_GLA ? 2048 : 3072, F.G, F.bid); pg8::gemm_phase<pg8::EpiBf16S, pg8::StaticOrder, false, (IFP8_GLA != 0)>(F.lds, g, S, E); \
            if (GFP8_GLA) { pg8::StaticOrder S2; S2.init(T, 1024, F.G, F.bid); pg8::gemm_phase<pg8::EpiBf16S, pg8::StaticOrder, false, true>(F.lds, g2, S2, E2); } }); } \
        RUN_PHASE_N(REP_S1, gla_s1_phase(F, proj, (const float*)(ws + WS_GLOW), in[14], in[15], (bf16_t*)(ws + WS_PT), (bf16_t*)(ws + WS_KT), (bf16_t*)(ws + WS_VT), (bf16_t*)(ws + WS_QS), (float*)(ws + WS_REC))); \
        RUN_PHASE_N(REP_S2, { if (S2X) s2x_phase<1>(F, (const bf16_t*)(ws + WS_QS), (const bf16_t*)(ws + WS_PT), (const bf16_t*)(ws + WS_KT), proj + 1024, (const float*)(ws + WS_REC), (bf16_t*)(ws + WS_MIX)); else s2_phase<1>(F, (const bf16_t*)(ws + WS_QS), (const bf16_t*)(ws + WS_PT), (const bf16_t*)(ws + WS_KT), proj + 1024, (const float*)(ws + WS_REC), (bf16_t*)(ws + WS_MIX), in, ws, -1); }); \
        RUN_PHASE_N(REP_HN, hn_phase<1>(F, (const bf16_t*)(ws + WS_MIX), proj, nullptr, in[16], nullptr, amix)); \
        OUTPROJ(2, WS_W_GLA_OUT, 1024); \
    } while (0)
__device__ __forceinline__ void mls_pre_phase(Frame& F, const bf16_t* proj, const float* conv_w, const float* conv_b, const float* w_q, const float* w_k, const float* w_v,
                                              const bf16_t* wmg, const float* b_gates, bf16_t* MQ, bf16_t* MK, bf16_t* MV, bf16_t* MXC, float* GATES) {
    LAS float* red = (LAS float*)F.lds;
    const int n = F.tid, lane = F.lane, l15 = lane & 15, g = lane >> 4, w = F.wave;
    f32x2 cw2[4][2], cb2[2], wq2[4][2], wk2[4][2], wv2[4][2];
#pragma unroll
    for (int j = 0; j < 4; ++j) { const f32x4 t4 = *(const f32x4*)(conv_w + (size_t)j * 2048 + 4 * n); cw2[j][0] = (f32x2){t4.x, t4.y}; cw2[j][1] = (f32x2){t4.z, t4.w}; }
    { const f32x4 t4 = *(const f32x4*)(conv_b + 4 * n); cb2[0] = (f32x2){t4.x, t4.y}; cb2[1] = (f32x2){t4.z, t4.w}; }
    const float kscale = 0.044194173824159216f;
#pragma unroll
    for (int c4 = 0; c4 < 4; ++c4) { const f32x4 a = *(const f32x4*)(w_q + (size_t)n * 16 + 4 * c4), bb = *(const f32x4*)(w_k + (size_t)n * 16 + 4 * c4), cc = *(const f32x4*)(w_v + (size_t)n * 16 + 4 * c4);
        wq2[c4][0] = (f32x2){a.x, a.y}; wq2[c4][1] = (f32x2){a.z, a.w};
        wk2[c4][0] = (f32x2){bb.x, bb.y} * kscale; wk2[c4][1] = (f32x2){bb.z, bb.w} * kscale;
        wv2[c4][0] = (f32x2){cc.x, cc.y}; wv2[c4][1] = (f32x2){cc.z, cc.w}; }
    for (int u = F.bid; u < NB * NCHUNK; u += F.G) {
        const int b = u / NCHUNK, c = u % NCHUNK;
        const size_t t0 = (size_t)b * SEQ + (size_t)c * 64;
        f32x2 x3[2], x2[2], x1[2];
        if (c > 0) {
            const u32x2 r3 = *(const u32x2*)(proj + (t0 - 3) * 4096 + 4 * n), r2 = *(const u32x2*)(proj + (t0 - 2) * 4096 + 4 * n), r1 = *(const u32x2*)(proj + (t0 - 1) * 4096 + 4 * n);
            x3[0] = (f32x2){bflo(r3.x), bfhi(r3.x)}; x3[1] = (f32x2){bflo(r3.y), bfhi(r3.y)};
            x2[0] = (f32x2){bflo(r2.x), bfhi(r2.x)}; x2[1] = (f32x2){bflo(r2.y), bfhi(r2.y)};
            x1[0] = (f32x2){bflo(r1.x), bfhi(r1.x)}; x1[1] = (f32x2){bflo(r1.y), bfhi(r1.y)};
        } else {
#pragma unroll
            for (int p = 0; p < 2; ++p) { x3[p] = (f32x2){0.f, 0.f}; x2[p] = x3[p]; x1[p] = x3[p]; }
        }
        for (int l0 = 0; l0 < 64; l0 += 8) {
            u32x2 xr[8];
#pragma unroll
            for (int j = 0; j < 8; ++j) xr[j] = *(const u32x2*)(proj + (t0 + l0 + j) * 4096 + 4 * n);
#pragma unroll
            for (int j = 0; j < 8; ++j) {
                const f32x2 x0[2] = {(f32x2){bflo(xr[j].x), bfhi(xr[j].x)}, (f32x2){bflo(xr[j].y), bfhi(xr[j].y)}};
                f32x2 xc[2];
#pragma unroll
                for (int p = 0; p < 2; ++p) { const f32x2 cv = cb2[p] + cw2[0][p] * x3[p] + cw2[1][p] * x2[p] + cw2[2][p] * x1[p] + cw2[3][p] * x0[p];
                    xc[p] = (f32x2){siluf_(cv.x), siluf_(cv.y)}; }
                const float xcs[4] = {xc[0].x, xc[0].y, xc[1].x, xc[1].y}, x0s[4] = {x0[0].x, x0[0].y, x0[1].x, x0[1].y};
                f32x2 q[2], k[2], v[2];
#pragma unroll
                for (int p = 0; p < 2; ++p) {
                    q[p] = wq2[0][p] * xcs[0] + wq2[1][p] * xcs[1] + wq2[2][p] * xcs[2] + wq2[3][p] * xcs[3];
                    k[p] = wk2[0][p] * xcs[0] + wk2[1][p] * xcs[1] + wk2[2][p] * xcs[2] + wk2[3][p] * xcs[3];
                    v[p] = wv2[0][p] * x0s[0] + wv2[1][p] * x0s[1] + wv2[2][p] * x0s[2] + wv2[3][p] * x0s[3];
                }
                const size_t o = (t0 + l0 + j) * 2048 + 4 * n;
                u32x2 pq; pq.x = pk2(q[0].x, q[0].y); pq.y = pk2(q[1].x, q[1].y); *(u32x2*)(MQ + o) = pq;
                pq.x = pk2(k[0].x, k[0].y); pq.y = pk2(k[1].x, k[1].y); *(u32x2*)(MK + o) = pq;
                pq.x = pk2(v[0].x, v[0].y); pq.y = pk2(v[1].x, v[1].y); *(u32x2*)(MV + o) = pq;
                pq.x = pk2(xc[0].x, xc[0].y); pq.y = pk2(xc[1].x, xc[1].y); *(u32x2*)(MXC + o) = pq;
#pragma unroll
                for (int p = 0; p < 2; ++p) { x3[p] = x2[p]; x2[p] = x1[p]; x1[p] = x0[p]; }
            }
        }
        VM_WAIT();
        __syncthreads();
        f32x4 acc[4];
#pragma unroll
        for (int mt = 0; mt < 4; ++mt) acc[mt] = (f32x4){0.f, 0.f, 0.f, 0.f};
        for (int ks0 = 0; ks0 < 24; ks0 += 4) {
            bf16x8 bh[4], bl[4], af[4][4];
#pragma unroll
            for (int u4 = 0; u4 < 4; ++u4) {
                const int kk = 768 * w + 32 * (ks0 + u4), buf = kk >> 11, col = kk & 2047;
                const bf16_t* src = buf == 0 ? MQ : (buf == 1 ? MK : MV);
                bh[u4] = *(const bf16x8*)(wmg + (size_t)l15 * 6144 + kk + 8 * g);
                bl[u4] = *(const bf16x8*)(wmg + (size_t)(16 + l15) * 6144 + kk + 8 * g);
#pragma unroll
                for (int mt = 0; mt < 4; ++mt) af[u4][mt] = *(const bf16x8*)(src + (t0 + 16 * mt + l15) * 2048 + col + 8 * g);
            }
#pragma unroll
            for (int u4 = 0; u4 < 4; ++u4)
#pragma unroll
                for (int mt = 0; mt < 4; ++mt) {
                    acc[mt] = __builtin_amdgcn_mfma_f32_16x16x32_bf16(af[u4][mt], bh[u4], acc[mt], 0, 0, 0);
                    acc[mt] = __builtin_amdgcn_mfma_f32_16x16x32_bf16(af[u4][mt], bl[u4], acc[mt], 0, 0, 0); }
        }
#pragma unroll
        for (int mt = 0; mt < 4; ++mt)
#pragma unroll
            for (int r = 0; r < 4; ++r) red[(w * 64 + 16 * mt + 4 * g + r) * 16 + l15] = acc[mt][r];
        LDS_WAIT();
        __syncthreads();
        { const int tok = F.tid >> 3, j = F.tid & 7; float s = b_gates[j];
#pragma unroll
          for (int ww = 0; ww < 8; ++ww) s += red[(ww * 64 + tok) * 16 + j];
          GATES[(t0 + tok) * 8 + j] = (j < 4) ? s : logsigmoidf_(s); }
        LDS_WAIT();
        __syncthreads();
    }
}

__device__ __forceinline__ void mls_s1_phase(Frame& F, const bf16_t* MQ, const bf16_t* MK, const bf16_t* MV, const float* GATES, bf16_t* PT, bf16_t* KT, bf16_t* VT, float* REC) {
    constexpr int LDK = 1040, LDP = 144;
    LAS unsigned char* Ks = F.lds;
    LAS unsigned char* Vs = F.lds + 66560;
    LAS unsigned char* Ps = F.lds + 133120;
    const int lane = F.lane, l15 = lane & 15, g = lane >> 4, w = F.wave, lt = w >> 1, mh = w & 1;
    u32x4 kr[8]; bf16x8 qf[16]; float g_f = 0.f, g_i = 0.f;
#define MS1_LOAD(uu) do { const int c_ = (uu) % NCHUNK, h_ = ((uu) / NCHUNK) % 4, b_ = (uu) / (NCHUNK * 4); const size_t t0_ = (size_t)b_ * SEQ + (size_t)c_ * 64; \
        s1_gload<512>(MK + t0_ * 2048 + 512 * h_, 2048, kr, F.tid); \
        if (w == 0) { g_f = GATES[(t0_ + lane) * 8 + 4 + h_]; g_i = GATES[(t0_ + lane) * 8 + h_]; } \
        _Pragma("unroll") for (int ks = 0; ks < 16; ++ks) qf[ks] = *(const bf16x8*)(MQ + (t0_ + 16 * lt + l15) * 2048 + 512 * h_ + 32 * ks + 8 * g); } while (0)
    if (F.bid < NB * 4 * NCHUNK) MS1_LOAD(F.bid);
    for (int u = F.bid; u < NB * 4 * NCHUNK; u += F.G) {
        const int c = u % NCHUNK, h = (u / NCHUNK) % 4, b = u / (NCHUNK * 4);
        const size_t t0 = (size_t)b * SEQ + (size_t)c * 64;
        s1_lstore<512>(kr, Ks, LDK, F.tid);
        if (w == 0) {
            float bsum = g_f;
#pragma unroll
            for (int o = 1; o < 64; o <<= 1) { const float t = __shfl_up(bsum, o); if (lane >= o) bsum += t; }
            const float z = g_i - bsum;
            float a = z;
#pragma unroll
            for (int o = 1; o < 64; o <<= 1) { const float t = __shfl_up(a, o); if (lane >= o) a = fmaxf(a, t); }
            REC[(size_t)u * 192 + lane] = bsum; REC[(size_t)u * 192 + 64 + lane] = z; REC[(size_t)u * 192 + 128 + lane] = a;
        }
        WG_SYNC_LDS();
        f32x4 acc[2];
#pragma unroll
        for (int nt = 0; nt < 2; ++nt) acc[nt] = (f32x4){0.f, 0.f, 0.f, 0.f};
#pragma unroll
        for (int ks = 0; ks < 16; ++ks) {
#pragma unroll
            for (int nt = 0; nt < 2; ++nt) { const bf16x8 kf = *(const LAS bf16x8*)(Ks + (size_t)(32 * mh + 16 * nt + l15) * LDK + 64 * ks + 16 * g);
                acc[nt] = __builtin_amdgcn_mfma_f32_16x16x32_bf16(qf[ks], kf, acc[nt], 0, 0, 0); }
        }
#pragma unroll
        for (int nt = 0; nt < 2; ++nt)
#pragma unroll
            for (int r = 0; r < 4; ++r) { const int l = 16 * lt + 4 * g + r, m = 32 * mh + 16 * nt + l15;
                *(LAS unsigned short*)(Ps + l * LDP + 2 * m) = (unsigned short)f2bf(m <= l ? acc[nt][r] : 0.f); }
        { const int un = u + F.G; if (un < NB * 4 * NCHUNK) MS1_LOAD(un); }
        WG_SYNC_LDS();
        { const int r = F.tid >> 3, q = F.tid & 7; *(u32x4*)(PT + (size_t)u * 4096 + r * 64 + 8 * q) = *(const LAS u32x4*)(Ps + r * LDP + 16 * q); }
        s1_write_kt_tr<512>(Ks, LDK, KT + (size_t)u * 512 * 64, F.wave, lane);
        WG_SYNC_LDS();
    }
#undef MS1_LOAD
}

__device__ __forceinline__ void mls_s2_phase(Frame& F, const bf16_t* MQ, const bf16_t* PT, const bf16_t* KT, const bf16_t* VT, const float* REC, bf16_t* mix) {
    constexpr int LDS_ST = 1040, LDV = 144, LDO = 144;
    LAS unsigned char* ST = F.lds;
    LAS unsigned char* VTs = F.lds + 83200;
    LAS unsigned char* Os = F.lds + 83200 + 23040;
    LAS float* QN = (LAS float*)(F.lds + 83200 + 23040 + 9216);
    LAS float* RS = QN + 64;
    const int lane = F.lane, l15 = lane & 15, g = lane >> 4, w = F.wave, lt = w >> 1, eh = w & 1;
    for (int u = F.bid; u < NB * 4 * 8; u += F.G) {
        const int eb = u & 7, h = (u >> 3) & 3, b = u >> 5;
        f32x4 S[4][5];
#pragma unroll
        for (int mt = 0; mt < 4; ++mt)
#pragma unroll
            for (int nt = 0; nt < 5; ++nt) S[mt][nt] = (f32x4){0.f, 0.f, 0.f, 0.f};
        for (int i = F.tid; i < 83200 / 4; i += NTHR) ((LAS unsigned*)ST)[i] = 0u;
        float m_prev = 0.f;
        for (int c = 0; c < NCHUNK; ++c) {
            const size_t t0 = (size_t)b * SEQ + (size_t)c * 64;
            const size_t uidx = ((size_t)(b * 4 + h)) * NCHUNK + c;
            const float* rec = REC + uidx * 192;
            LAS unsigned char* vt = VTs + (c & 1) * 11520;
            const float Amax = rec[128 + 63], blast = rec[63];
            const float Mx = fmaxf(m_prev, Amax), keep = __expf(m_prev - Mx);
            {
                const int e = F.tid >> 3, q = F.tid & 7;
                const f32x4 z0 = *(const f32x4*)(rec + 64 + 8 * q), z1 = *(const f32x4*)(rec + 64 + 8 * q + 4);
                const float wm[8] = {__expf(z0.x - Mx), __expf(z0.y - Mx), __expf(z0.z - Mx), __expf(z0.w - Mx), __expf(z1.x - Mx), __expf(z1.y - Mx), __expf(z1.z - Mx), __expf(z1.w - Mx)};
                const u32x4 raw = *(const u32x4*)(VT + uidx * (512 * 64) + (size_t)(64 * eb + e) * 64 + 8 * q);
                const float f[8] = {bflo(raw.x) * wm[0], bfhi(raw.x) * wm[1], bflo(raw.y) * wm[2], bfhi(raw.y) * wm[3], bflo(raw.z) * wm[4], bfhi(raw.z) * wm[5], bflo(raw.w) * wm[6], bfhi(raw.w) * wm[7]};
                u32x4 o; o.x = pk2(f[0], f[1]); o.y = pk2(f[2], f[3]); o.z = pk2(f[4], f[5]); o.w = pk2(f[6], f[7]);
                *(LAS u32x4*)(vt + e * LDV + 16 * q) = o;
                if (F.tid < 128) { u32x4 o2 = (u32x4){0u, 0u, 0u, 0u};
                    if (e == 0) { o2.x = pk2(wm[0], wm[1]); o2.y = pk2(wm[2], wm[3]); o2.z = pk2(wm[4], wm[5]); o2.w = pk2(wm[6], wm[7]); }
                    *(LAS u32x4*)(vt + (64 + e) * LDV + 16 * q) = o2; }
            }
            bf16x8 pf[2];
#pragma unroll
            for (int ks = 0; ks < 2; ++ks) pf[ks] = *(const bf16x8*)(PT + uidx * 4096 + (16 * lt + l15) * 64 + 32 * ks + 8 * g);
            LDS_WAIT();
            __syncthreads();
            if (c > 0) { const int r = F.tid >> 3, q = F.tid & 7; *(u32x4*)(mix + (t0 - 64 + r) * 2048 + 512 * h + 64 * eb + 8 * q) = *(const LAS u32x4*)(Os + r * LDO + 16 * q); }
            f32x4 oi[3], oo[3];
#pragma unroll
            for (int j = 0; j < 3; ++j) { oi[j] = (f32x4){0.f, 0.f, 0.f, 0.f}; oo[j] = (f32x4){0.f, 0.f, 0.f, 0.f}; }
#pragma unroll
            for (int j = 0; j < 3; ++j) { const int nt = eh + 2 * j;
                if (nt < 5) {
#pragma unroll
                    for (int ks = 0; ks < 2; ++ks) { const bf16x8 vf = *(const LAS bf16x8*)(vt + (16 * nt + l15) * LDV + 64 * ks + 16 * g);
                        oi[j] = __builtin_amdgcn_mfma_f32_16x16x32_bf16(pf[ks], vf, oi[j], 0, 0, 0); } } }
#pragma unroll 4
            for (int ks = 0; ks < 16; ++ks) {
                const bf16x8 qf = *(const bf16x8*)(MQ + (t0 + 16 * lt + l15) * 2048 + 512 * h + 32 * ks + 8 * g);
#pragma unroll
                for (int j = 0; j < 3; ++j) { const int nt = eh + 2 * j;
                    if (nt < 5) { const bf16x8 sf = *(const LAS bf16x8*)(ST + (16 * nt + l15) * LDS_ST + 64 * ks + 16 * g);
                        oo[j] = __builtin_amdgcn_mfma_f32_16x16x32_bf16(qf, sf, oo[j], 0, 0, 0); } }
            }
            if (eh == 0 && l15 == 0) {
#pragma unroll
                for (int r = 0; r < 4; ++r) { QN[16 * lt + 4 * g + r] = oo[2][r]; RS[16 * lt + 4 * g + r] = oi[2][r]; }
            }
            LDS_WAIT();
            __syncthreads();
#pragma unroll
            for (int r = 0; r < 4; ++r) { const int l = 16 * lt + 4 * g + r;
                const float bl = rec[l], al = rec[128 + l];
                const float Ml = fmaxf(m_prev, al), rho = __expf(Mx - Ml), wi = __expf(m_prev - Ml);
                const float den = wi * QN[l] + rho * RS[l];
                const float dn = fmaxf(fabsf(den), __expf(-(bl + Ml)));
                const float inv = 1.0f / dn;
#pragma unroll
                for (int j = 0; j < 2; ++j) { const int nt = eh + 2 * j;
                    *(LAS unsigned short*)(Os + l * LDO + 2 * (16 * nt + l15)) = (unsigned short)f2bf((wi * oo[j][r] + rho * oi[j][r]) * inv); } }
            bf16x8 kf[4][2];
#pragma unroll
            for (int mt = 0; mt < 4; ++mt)
#pragma unroll
                for (int ks = 0; ks < 2; ++ks) kf[mt][ks] = *(const bf16x8*)(KT + uidx * (512 * 64) + ((((4 * w + mt) * 2 + ks) * 64 + lane) << 3));
#pragma unroll
            for (int nt = 0; nt < 5; ++nt) {
                bf16x8 vf[2];
#pragma unroll
                for (int ks = 0; ks < 2; ++ks) vf[ks] = *(const LAS bf16x8*)(vt + (16 * nt + l15) * LDV + 64 * ks + 16 * g);
#pragma unroll
                for (int mt = 0; mt < 4; ++mt) { S[mt][nt] = S[mt][nt] * keep;
#pragma unroll
                    for (int ks = 0; ks < 2; ++ks) S[mt][nt] = __builtin_amdgcn_mfma_f32_16x16x32_bf16(kf[mt][ks], vf[ks], S[mt][nt], 0, 0, 0);
                    u32x2 o; o.x = pk2(S[mt][nt][0], S[mt][nt][1]); o.y = pk2(S[mt][nt][2], S[mt][nt][3]);
                    *(LAS u32x2*)(ST + (16 * nt + l15) * LDS_ST + 2 * (64 * w + 16 * mt + 4 * g)) = o; }
            }
            m_prev = blast + Mx;
        }
        LDS_WAIT();
        __syncthreads();
        { const size_t t0 = (size_t)b * SEQ + (size_t)(NCHUNK - 1) * 64; const int r = F.tid >> 3, q = F.tid & 7;
          *(u32x4*)(mix + (t0 + r) * 2048 + 512 * h + 64 * eb + 8 * q) = *(const LAS u32x4*)(Os + r * LDO + 16 * q); }
        LDS_WAIT();
        __syncthreads();
    }
}

__device__ __forceinline__ void mls_norm_phase(Frame& F, const bf16_t* mix, const bf16_t* proj, const bf16_t* MXC, const float* gn, const float* skip, bf16_t* amix) {
    const int gw = F.bid * NWAVES + F.wave, NGW = F.G * NWAVES, lane = F.lane;
    for (int i = gw; i < T * 4; i += NGW) {
        const int t = i >> 2, h = i & 3, ch = 512 * h + 8 * lane;
        const u32x4 raw = *(const u32x4*)(mix + (size_t)t * 2048 + ch);
        const u32x4 zr = *(const u32x4*)(proj + (size_t)t * 4096 + 2048 + ch);
        const u32x4 xr = *(const u32x4*)(MXC + (size_t)t * 2048 + ch);
        float v[8] = {bflo(raw.x), bfhi(raw.x), bflo(raw.y), bfhi(raw.y), bflo(raw.z), bfhi(raw.z), bflo(raw.w), bfhi(raw.w)};
        const float zv[8] = {bflo(zr.x), bfhi(zr.x), bflo(zr.y), bfhi(zr.y), bflo(zr.z), bfhi(zr.z), bflo(zr.w), bfhi(zr.w)};
        const float xv[8] = {bflo(xr.x), bfhi(xr.x), bflo(xr.y), bfhi(xr.y), bflo(xr.z), bfhi(xr.z), bflo(xr.w), bfhi(xr.w)};
        float s = 0.f;
#pragma unroll
        for (int j = 0; j < 8; ++j) s += v[j];
        const float mean = wave_sum(s) * (1.0f / 512.0f);
        float q = 0.f;
#pragma unroll
        for (int j = 0; j < 8; ++j) { v[j] -= mean; q += v[j] * v[j]; }
        const float rstd = rsqrtf(wave_sum(q) * (1.0f / 512.0f) + EPS);
        const f32x4 g0 = *(const f32x4*)(gn + ch), g1 = *(const f32x4*)(gn + ch + 4), s0 = *(const f32x4*)(skip + ch), s1 = *(const f32x4*)(skip + ch + 4);
        const float gg[8] = {g0.x, g0.y, g0.z, g0.w, g1.x, g1.y, g1.z, g1.w};
        const float sk[8] = {s0.x, s0.y, s0.z, s0.w, s1.x, s1.y, s1.z, s1.w};
        float o[8];
#pragma unroll
        for (int j = 0; j < 8; ++j) o[j] = (v[j] * rstd * gg[j] + sk[j] * xv[j]) * siluf_(zv[j]);
        u32x4 ow; ow.x = pk2(o[0], o[1]); ow.y = pk2(o[2], o[3]); ow.z = pk2(o[4], o[5]); ow.w = pk2(o[6], o[7]);
        *(u32x4*)(amix + (size_t)t * 2048 + ch) = ow;
    }
}
#define NPH_MLS 6
#define LAYER_MLS() do { \
        { pg8::Gemm g{IFP8_MLS ? (const bf16_t*)(ws + WS_H8) : hbuf, (const bf16_t*)(ws + WS_W_MLS_IN), T, GFP8_MLS ? 2048 : 4096, IFP8_MLS ? 512 : 1024}; pg8::EpiBf16S E{proj, 4096, 0, 1.0f, IFP8_MLS ? 0.03125f : 1.0f}; \
          pg8::Gemm g2{(const bf16_t*)(ws + WS_H8), (const bf16_t*)(ws + WS_W_MLS_IN + 4 * MiB), T, 2048, 512}; pg8::EpiBf16S E2{proj + 2048, 4096, 0, 1.0f, 0.03125f}; \
          RUN_PHASE({ pg8::StaticOrder S; S.init(T, GFP8_MLS ? 2048 : 4096, F.G, F.bid); pg8::gemm_phase<pg8::EpiBf16S, pg8::StaticOrder, false, (IFP8_MLS != 0)>(F.lds, g, S, E); \
            if (GFP8_MLS) { pg8::StaticOrder S2; S2.init(T, 2048, F.G, F.bid); pg8::gemm_phase<pg8::EpiBf16S, pg8::StaticOrder, false, true>(F.lds, g2, S2, E2); } }); } \
        RUN_PHASE_N(REP_PRE, mls_pre_phase(F, proj, in[19], in[20], in[21], in[22], in[23], (const bf16_t*)(ws + WS_WMG), in[25], (bf16_t*)(ws + WS_MQ), (bf16_t*)(ws + WS_MK), (bf16_t*)(ws + WS_MV), (bf16_t*)(ws + WS_MXC), (float*)(ws + WS_GATES))); \
        RUN_PHASE_N(REP_S1, mls_s1_phase(F, (const bf16_t*)(ws + WS_MQ), (const bf16_t*)(ws + WS_MK), (const bf16_t*)(ws + WS_MV), (const float*)(ws + WS_GATES), (bf16_t*)(ws + WS_PT), (bf16_t*)(ws + WS_KT), (bf16_t*)(ws + WS_VT), (float*)(ws + WS_REC))); \
        RUN_PHASE({ if (S2M) s2m_phase(F, (const bf16_t*)(ws + WS_MQ), (const bf16_t*)(ws + WS_PT), (const bf16_t*)(ws + WS_KT), (const bf16_t*)(ws + WS_MV), (const float*)(ws + WS_REC), (bf16_t*)(ws + WS_MIX)); else s2_phase<MLS_S2MODE>(F, (const bf16_t*)(ws + WS_MQ), (const bf16_t*)(ws + WS_PT), (const bf16_t*)(ws + WS_KT), (const bf16_t*)(ws + WS_MV), (const float*)(ws + WS_REC), (bf16_t*)(ws + WS_MIX)); \
            if (REP_S2M > 1) { VM_WAIT(); __syncthreads(); if (S2M) s2m_phase(F, (const bf16_t*)(ws + WS_MQ), (const bf16_t*)(ws + WS_PT), (const bf16_t*)(ws + WS_KT), (const bf16_t*)(ws + WS_MV), (const float*)(ws + WS_REC), (bf16_t*)(ws + WS_AMIX)); else s2_phase<2, S2_ABL>(F, (const bf16_t*)(ws + WS_MQ), (const bf16_t*)(ws + WS_PT), (const bf16_t*)(ws + WS_KT), (const bf16_t*)(ws + WS_MV), (const float*)(ws + WS_REC), (bf16_t*)(ws + WS_AMIX)); } }); \
        RUN_PHASE_N(REP_HN, hn_phase<2>(F, (const bf16_t*)(ws + WS_MIX), proj, (const bf16_t*)(ws + WS_MXC), in[26], in[27], amix)); \
        OUTPROJ(3, WS_W_MLS_OUT, 2048); \
    } while (0)
#ifndef N_LAUNCH_MODE
#define N_LAUNCH_MODE 0
#endif
struct Args { const float* in[35]; float* out; unsigned char* ws; int ph_lo, ph_hi; };

__global__ void __launch_bounds__(NTHR, 2) trunk_fwd(Args args) {
    extern __shared__ __attribute__((aligned(16))) unsigned char lds_raw[];
    Frame F;
    F.lds = (LAS unsigned char*)lds_raw;
    F.tid = threadIdx.x; F.lane = F.tid & 63; F.wave = __builtin_amdgcn_readfirstlane(F.tid >> 6);
    F.G = gridDim.x; F.bid = blockIdx.x;
    F.ws = args.ws; F.in = args.in; F.out = args.out; F.ctl = (unsigned*)(args.ws + WS_CTL);
    unsigned char* ws = args.ws; const float* const* in = args.in;
    const int lo = args.ph_lo, hi = args.ph_hi;
    volatile LAS unsigned* xbw = (volatile LAS unsigned*)(F.lds + LDS_MISC);
    if (F.tid < 4) xbw[F.tid] = 0u;
    __syncthreads();
    XcdBarrier bar; bar.bar = F.ctl + CW_BAR; bar.x = 0; bar.st = xbw;
    if (hi - lo > 1) bar = xcd_barrier_post(F.ctl + CW_BAR, xbw);
    int ph = 0;
#define RUN_PHASE(...) do { if (ph >= lo && ph < hi) { __VA_ARGS__; if (ph + 1 < hi) { xcd_barrier(bar); if (REP_BAR > 1) xcd_barrier(bar); } } ++ph; } while (0)
#define RUN_PHASE_DUP(NREP, ...) do { if (ph >= lo && ph < hi) { __VA_ARGS__; if ((NREP) > 1) { VM_WAIT(); __syncthreads(); __VA_ARGS__; } if (ph + 1 < hi) xcd_barrier(bar); } ++ph; } while (0)
#define RUN_PHASE_N(NREP, ...) do { if (ph >= lo && ph < hi) { for (int rep_ = 0; rep_ < (NREP); ++rep_) { if (rep_) { VM_WAIT(); __syncthreads(); } __VA_ARGS__; } if (ph + 1 < hi) xcd_barrier(bar); } ++ph; } while (0)

    float* mod = (float*)(ws + WS_MOD);
    bf16_t* xres = (bf16_t*)(ws + WS_XRES);
    bf16_t* hbuf = (bf16_t*)(ws + WS_H);
    bf16_t* proj = (bf16_t*)(ws + WS_PROJ);
    bf16_t* amix = (bf16_t*)(ws + WS_AMIX);
    bf16_t* act = (bf16_t*)(ws + WS_ACT);
    bf16_t* yp = (bf16_t*)(ws + WS_YP);
    int* tokes = (int*)(ws + WS_TOKES); float* tokw = (float*)(ws + WS_TOKW);
    unsigned short* list = (unsigned short*)(ws + WS_LIST);
    const void* xcur = in[0];

    RUN_PHASE_N(REP_PRO, prologue_phase(F));

#define MOD(l, k) (mod + (size_t)(l) * NB * 6144 + (k) * 1024)
#define CNT(l) (F.ctl + CW_CNT + (l) * 32 * 64)
#define NORM1(l, PROJ) do { constexpr bool CMB = ((l) > 0) && ENABLE_MOE; NormArgs a{}; a.xin = xcur; a.xout = xres; a.gain = in[4] + (l) * 1024; a.sc = MOD(l, 1); a.sh = MOD(l, 0); a.h = hbuf; \
        if (CMB) { a.yp = yp; a.tokes_c = tokes; a.tokw_c = tokw; a.gf = MOD((l) - 1, 5); a.cnt_prev = CNT((l) - 1); } \
        a.wt = (const bf16_t*)(ws + WS_WGL); a.glow = (float*)(ws + WS_GLOW); a.h8 = (unsigned char*)(ws + WS_H8); \
        constexpr int IF8 = (l) == 0 ? IFP8_RET : ((l) == 1 ? IFP8_ATT : ((l) == 2 ? IFP8_GLA : IFP8_MLS)); \
        constexpr int GF8 = (l) == 0 ? GFP8_RET : ((l) == 2 ? GFP8_GLA : ((l) == 3 ? GFP8_MLS : 0)); \
        RUN_PHASE({ norm_phase<CMB, PROJ, false, ((l) > 0), (IF8 ? 2 : (GF8 ? 3 : 1))>(F, a); \
            if (REP_NORM > 1) { VM_WAIT(); __syncthreads(); NormArgs a2 = a; a2.xout = (bf16_t*)(ws + WS_PT); a2.h = (bf16_t*)(ws + WS_MIX); a2.h8 = (unsigned char*)(ws + WS_AMIX); norm_phase<CMB, 0, false, ((l) > 0), (IF8 ? 2 : (GF8 ? 3 : 1))>(F, a2); } }); if (CMB) xcur = xres; } while (0)
#define OUTPROJ(l, WOFF, KK) do { pg8::Gemm g{amix, (const bf16_t*)(ws + (WOFF)), T, DM, OUT_FP8 ? (KK) / 2 : (KK)}; pg8::EpiResid<((l) > 0)> E{xcur, xres, MOD(l, 2), OUT_FP8 ? 0.03125f : 1.0f}; \
        RUN_PHASE({ pg8::StaticOrder S; S.init(T, DM, F.G, F.bid); pg8::gemm_phase<pg8::EpiResid<((l) > 0)>, pg8::StaticOrder, false, (OUT_FP8 != 0)>(F.lds, g, S, E); \
            if (REP_OUT > 1) { VM_WAIT(); __syncthreads(); pg8::EpiResid<((l) > 0)> E2{(l) > 0 ? (const void*)(ws + WS_PT) : xcur, (bf16_t*)(ws + WS_PT), MOD(l, 2), 1.0f}; pg8::gemm_phase<pg8::EpiResid<((l) > 0)>, pg8::StaticOrder, false, (OUT_FP8 != 0)>(F.lds, g, S, E2); } }); xcur = xres; } while (0)
#define MOE(l) do { if (!ENABLE_MOE) break; \
        { NormArgs a{}; a.xin = xcur; a.gain = in[5] + (l) * 1024; a.sc = MOD(l, 4); a.sh = MOD(l, 3); a.h = hbuf; \
          a.wt = (const bf16_t*)(ws + WS_WRT) + (size_t)(l) * 2 * 32 * 1024; a.rb = in[30] + (l) * 32; a.cnt = CNT(l); a.list = list; a.tokes = tokes; a.tokw = tokw; a.h8 = (unsigned char*)(ws + WS_H8); \
          RUN_PHASE({ norm_phase<false, 1, false, true, (MOE_FP8 ? 3 : 1)>(F, a); \
            if (REP_NORM > 1) { VM_WAIT(); __syncthreads(); NormArgs a2 = a; a2.h = (bf16_t*)(ws + WS_MIX); a2.h8 = (unsigned char*)(ws + WS_AMIX); norm_phase<false, 0, false, true, (MOE_FP8 ? 3 : 1)>(F, a2); } }); } \
        if (MOE_FP8) { \
          { pg8::EpiSwiglu8 E{(unsigned char*)act, in[32] + (size_t)(l) * 32 * 2048}; pg8::EpiNull EN{(float*)(ws + WS_GLOW)}; \
            RUN_PHASE({ if (CVT_HOST && (l) >= MOE_PRO_LAYERS - 1 && (l) < 3) moe_gemm_phase<8, true, true, pg8::EpiSwiglu8, false, true>(F, (const bf16_t*)(ws + WS_H8), (const bf16_t*)(ws + WS_W1T + (size_t)(l) * 32 * 2048 * 1024), CNT(l), list, E, in, ws, (l) + 1, (CVT_HOST == 2 && (l) == 0) ? 0 : -1); \
              else moe_gemm_phase<8, true, true, pg8::EpiSwiglu8>(F, (const bf16_t*)(ws + WS_H8), (const bf16_t*)(ws + WS_W1T + (size_t)(l) * 32 * 2048 * 1024), CNT(l), list, E); \
              if (REP_MOE > 1 && (MOE_WHICH & 1)) { VM_WAIT(); __syncthreads(); if (MOE_NULL) moe_gemm_phase<8, true, true, pg8::EpiNull, (MOE_HOT != 0)>(F, (const bf16_t*)(ws + WS_H8), (const bf16_t*)(ws + WS_W1T + (size_t)(l) * 32 * 2048 * 1024), CNT(l), list, EN); \
                else moe_gemm_phase<8, true, true, pg8::EpiSwiglu8>(F, (const bf16_t*)(ws + WS_H8), (const bf16_t*)(ws + WS_W1T + (size_t)(l) * 32 * 2048 * 1024), CNT(l), list, E); } }); } \
          { pg8::EpiMoe2 E{yp, in[34] + (size_t)(l) * 32 * 1024, 0.03125f}; pg8::EpiNull EN{(float*)(ws + WS_GLOW)}; \
            RUN_PHASE({ moe_gemm_phase<4, false, true, pg8::EpiMoe2>(F, act, (const bf16_t*)(ws + WS_W2T + (size_t)(l) * 32 * 1024 * 1024), CNT(l), list, E); \
              if (REP_MOE > 1 && (MOE_WHICH & 2)) { VM_WAIT(); __syncthreads(); if (MOE_NULL) moe_gemm_phase<4, false, true, pg8::EpiNull, (MOE_HOT != 0)>(F, act, (const bf16_t*)(ws + WS_W2T + (size_t)(l) * 32 * 1024 * 1024), CNT(l), list, EN); \
                else moe_gemm_phase<4, false, true, pg8::EpiMoe2>(F, act, (const bf16_t*)(ws + WS_W2T + (size_t)(l) * 32 * 1024 * 1024), CNT(l), list, E); } }); } \
        } else { \
          { pg8::EpiSwiglu E{act, in[32] + (size_t)(l) * 32 * 2048}; \
            RUN_PHASE_N(REP_MOE, moe_gemm_phase<8, true, false, pg8::EpiSwiglu>(F, hbuf, (const bf16_t*)(ws + WS_W1T) + (size_t)(l) * 32 * 2048 * 1024, CNT(l), list, E)); } \
          { pg8::EpiMoe2 E{yp, in[34] + (size_t)(l) * 32 * 1024, 1.0f}; \
            RUN_PHASE_N(REP_MOE, moe_gemm_phase<4, false, false, pg8::EpiMoe2>(F, act, (const bf16_t*)(ws + WS_W2T) + (size_t)(l) * 32 * 1024 * 1024, CNT(l), list, E)); } \
        } \
    } while (0)

    NORM1(0, 0);
#if ENABLE_RET
    LAYER_RET();
#endif
    MOE(0);
    NORM1(1, 0);
#if ENABLE_ATT
    LAYER_ATT();
#endif
    MOE(1);
    NORM1(2, 2);
#if ENABLE_GLA
    LAYER_GLA();
#endif
    MOE(2);
    NORM1(3, 0);
#if ENABLE_MLS
    LAYER_MLS();
#endif
    MOE(3);
    { NormArgs a{}; a.xin = xcur; a.xout = xres; a.gain = in[6]; a.yp = yp; a.tokes_c = tokes; a.tokw_c = tokw; a.gf = MOD(3, 5); a.cnt_prev = CNT(3); a.out = F.out;
      RUN_PHASE({ norm_phase<(ENABLE_MOE != 0), 0, true, true>(F, a); if (REP_NORM > 1) { VM_WAIT(); __syncthreads(); NormArgs a2 = a; a2.xout = (bf16_t*)(ws + WS_PT); a2.out = (float*)(ws + WS_MIX); norm_phase<(ENABLE_MOE != 0), 0, true, true>(F, a2); } }); }
#undef RUN_PHASE
}

static int count_phases() {
    int n = 1;
    const int mixer[4] = {ENABLE_RET ? NPH_RET : 0, ENABLE_ATT ? NPH_ATT : 0, ENABLE_GLA ? NPH_GLA : 0, ENABLE_MLS ? NPH_MLS : 0};
    for (int l = 0; l < 4; ++l) n += 1 + mixer[l] + (ENABLE_MOE ? 3 : 0);
    return n + 1;
}

extern "C" void kernel_launch(void* const* d_in, const int* in_sizes, int n_in, void* d_out, int out_size, void* d_ws, size_t ws_size, hipStream_t stream) {
    static int grid = 0;
    if (grid == 0) {
        if (n_in != 35 || out_size != T * DM || ws_size < WS_END) { fprintf(stderr, "kernel_launch: unexpected shapes (n_in %d out %d ws %zu)\n", n_in, out_size, ws_size); grid = -1; return; }
        int dev = 0, cus = 0, per_cu = 0;
        if (hipGetDevice(&dev) != hipSuccess || hipDeviceGetAttribute(&cus, hipDeviceAttributeMultiprocessorCount, dev) != hipSuccess) { grid = -1; return; }
        if (hipFuncSetAttribute((const void*)trunk_fwd, hipFuncAttributeMaxDynamicSharedMemorySize, LDS_BYTES) != hipSuccess) { fprintf(stderr, "kernel_launch: hipFuncSetAttribute failed\n"); grid = -1; return; }
        if (hipOccupancyMaxActiveBlocksPerMultiprocessor(&per_cu, (const void*)trunk_fwd, NTHR, LDS_BYTES) != hipSuccess || per_cu < 1) { fprintf(stderr, "kernel_launch: occupancy query says %d\n", per_cu); grid = -1; return; }
        grid = cus;
    }
    if (grid <= 0) return;
    hipMemsetAsync((char*)d_ws + WS_CTL, 0, CTL_ZERO_BYTES, stream);
    Args a{};
    for (int i = 0; i < 35; ++i) a.in[i] = (const float*)d_in[i];
    a.out = (float*)d_out; a.ws = (unsigned char*)d_ws;
    const int nph = count_phases();
#if N_LAUNCH_MODE == 1
    for (int p = 0; p < nph; ++p) { a.ph_lo = p; a.ph_hi = p + 1; hipLaunchKernelGGL(trunk_fwd, dim3(grid), dim3(NTHR), LDS_BYTES, stream, a); }
#else
    a.ph_lo = 0; a.ph_hi = nph;
    hipLaunchKernelGGL(trunk_fwd, dim3(grid), dim3(NTHR), LDS_BYTES, stream, a);
#endif
    hipError_t le = hipGetLastError();
    if (le != hipSuccess) fprintf(stderr, "kernel_launch: launch failed: %s\n", hipGetErrorName(le));
}
```

```cpp
#include <hip/hip_runtime.h>
#include <stdint.h>
#include <stdio.h>

#define GAS __attribute__((address_space(1)))
#define LAS __attribute__((address_space(3)))
typedef unsigned short bf16_t;
typedef short bf16x8 __attribute__((ext_vector_type(8)));
typedef float f32x4 __attribute__((ext_vector_type(4)));
typedef float f32x2 __attribute__((ext_vector_type(2)));
typedef unsigned u32x4 __attribute__((ext_vector_type(4)));
typedef unsigned u32x2 __attribute__((ext_vector_type(2)));
typedef short s16x4 __attribute__((ext_vector_type(4)));
typedef int i32x8 __attribute__((ext_vector_type(8)));
typedef int i32x4 __attribute__((ext_vector_type(4)));

constexpr int NB = 8, SEQ = 4096, DM = 1024, T = NB * SEQ;
constexpr int NCHUNK = SEQ / 64;
constexpr int NEXP = 32, TOPK = 4;
constexpr int NWAVES = 8, NTHR = NWAVES * 64;
constexpr float EPS = 1e-6f;

constexpr size_t MiB = 1u << 20;
constexpr size_t WS_CTL = 0, CTL_ZERO_BYTES = 1 * MiB;
constexpr size_t WS_MOD = 1 * MiB;
constexpr size_t WS_ROPE = 2 * MiB;
constexpr size_t WS_WRT = 6 * MiB;
constexpr size_t WS_WGL = 7 * MiB;
constexpr size_t WS_WMG = 7 * MiB + 131072;
constexpr size_t WS_W_RET_IN = 8 * MiB, WS_W_RET_OUT = 20 * MiB, WS_W_ATT_IN = 24 * MiB, WS_W_ATT_OUT = 30 * MiB;
constexpr size_t WS_W_GLA_IN = 32 * MiB, WS_W_GLA_OUT = 38 * MiB, WS_W_MLS_IN = 40 * MiB, WS_W_MLS_OUT = 48 * MiB;
constexpr size_t WS_W1T = 64 * MiB;
constexpr size_t WS_W2T = 576 * MiB;
constexpr size_t WS_XRES = 832 * MiB;
constexpr size_t WS_H = 960 * MiB;
constexpr size_t WS_PROJ = 1024 * MiB;
constexpr size_t WS_MIX = 1408 * MiB;
constexpr size_t WS_AMIX = 1536 * MiB;
constexpr size_t WS_PT = 1664 * MiB;
constexpr size_t WS_KT = 1680 * MiB;
constexpr size_t WS_VT = 1808 * MiB;
constexpr size_t WS_QS = 1936 * MiB;
constexpr size_t WS_REC = 1968 * MiB;
constexpr size_t WS_MQ = WS_PROJ + 256 * MiB;
constexpr size_t WS_MK = 1984 * MiB, WS_MV = 2112 * MiB, WS_MXC = 2240 * MiB;
constexpr size_t WS_ACT = 2368 * MiB;
constexpr size_t WS_YP = 2640 * MiB;
constexpr size_t WS_TOKES = 2912 * MiB;
constexpr size_t WS_TOKW = 2913 * MiB;
constexpr size_t WS_LIST = 2914 * MiB;
constexpr size_t WS_GLOW = 2918 * MiB;
constexpr size_t WS_GATES = 2920 * MiB;
constexpr size_t WS_H8 = 2928 * MiB;
constexpr size_t WS_END = 2960 * MiB;
constexpr int CW_BAR = 4096;
constexpr int CW_CNT = 16384;

constexpr int LDS_BYTES = 163840;
constexpr int LDS_MISC = 163840 - 1536;
constexpr int LDS_IDX = 131072;

#define LDS_WAIT() asm volatile("s_waitcnt lgkmcnt(0)" ::: "memory")
#define VM_WAIT() asm volatile("s_waitcnt vmcnt(0)" ::: "memory")
#define WG_SYNC_LDS() do { asm volatile("s_waitcnt lgkmcnt(0)" ::: "memory"); __builtin_amdgcn_s_barrier(); asm volatile("" ::: "memory"); } while (0)
typedef __bf16 bf16n2 __attribute__((ext_vector_type(2)));
__device__ __forceinline__ unsigned pk2(float lo, float hi) { const f32x2 v = {lo, hi}; return __builtin_bit_cast(unsigned, __builtin_convertvector(v, bf16n2)); }
__device__ __forceinline__ unsigned f2bf(float f) { return pk2(f, 0.f) & 0xffffu; }
__device__ __forceinline__ float bf2f(unsigned short b) { return __builtin_bit_cast(float, ((unsigned)b) << 16); }
__device__ __forceinline__ float bflo(unsigned u) { return __builtin_bit_cast(float, u << 16); }
__device__ __forceinline__ float bfhi(unsigned u) { return __builtin_bit_cast(float, u & 0xffff0000u); }
__device__ __forceinline__ unsigned cvt_pk_bf16(float lo, float hi) { return pk2(lo, hi); }
__device__ __forceinline__ unsigned pk4_fp8(float a, float b, float c, float d) { int r = 0; r = __builtin_amdgcn_cvt_pk_fp8_f32(a, b, r, false); r = __builtin_amdgcn_cvt_pk_fp8_f32(c, d, r, true); return (unsigned)r; }
__device__ __forceinline__ float wave_sum(float v) {
#pragma unroll
    for (int o = 1; o < 64; o <<= 1) v += __shfl_xor(v, o);
    return v;
}
__device__ __forceinline__ float wave_max(float v) {
#pragma unroll
    for (int o = 1; o < 64; o <<= 1) v = fmaxf(v, __shfl_xor(v, o));
    return v;
}
__device__ __forceinline__ float sigmoidf_(float x) { return __builtin_amdgcn_rcpf(1.0f + __builtin_amdgcn_exp2f(-1.4426950408889634f * x)); }
__device__ __forceinline__ float siluf_(float x) { return x * __builtin_amdgcn_rcpf(1.0f + __builtin_amdgcn_exp2f(-1.4426950408889634f * x)); }
__device__ __forceinline__ float logsigmoidf_(float x) { return fminf(x, 0.f) - log1pf(__expf(-fabsf(x))); }

#define XB_TMO      128
#define XB_XCNT(j)  (256  + 64 * (j))
#define XB_XSUB(j)  (1280 + 64 * (j))
#define XB_XGEN(j)  (2304 + 64 * (j))
#define XB_TOP      3328
#define XB_TOPGEN   3392
#define XCD_BAR_WORDS 3456
#define XB_SPIN_CAP (1u << 20)

__device__ __forceinline__ unsigned xb_ld(unsigned* p)              { return __hip_atomic_load(p, __ATOMIC_RELAXED, __HIP_MEMORY_SCOPE_AGENT); }
__device__ __forceinline__ unsigned xb_add(unsigned* p, unsigned v) { return __hip_atomic_fetch_add(p, v, __ATOMIC_RELAXED, __HIP_MEMORY_SCOPE_AGENT); }
__device__ __forceinline__ unsigned xb_xcc_id() { return (unsigned)__builtin_amdgcn_s_getreg((3 << 11) | 20) & 0xFu; }
#define XB_SPIN(cond, bar) do { unsigned _sp = 0; while (cond) { __builtin_amdgcn_s_sleep(1); \
    if ((++_sp & 255u) == 0u) { if (xb_ld(&(bar)[XB_TMO])) break; if (_sp > XB_SPIN_CAP) { atomicAdd(&(bar)[XB_TMO], 1u); break; } } } } while (0)

struct XcdBarrier { unsigned* bar; unsigned x; volatile LAS unsigned* st; };

__device__ __forceinline__ XcdBarrier xcd_barrier_post(unsigned* bar, volatile LAS unsigned* st) {
    XcdBarrier b; b.bar = bar; b.x = xb_xcc_id(); b.st = st;
    if (threadIdx.x == 0) (void)xb_add(&bar[XB_XCNT(b.x)], 1u);
    return b;
}
__device__ __forceinline__ void xcd_barrier_complete(unsigned* bar, unsigned x, unsigned& nloc, unsigned& nx) {
    const unsigned G = gridDim.x * gridDim.y * gridDim.z;
    unsigned sum, cnt, mine, sp = 0u;
    for (;;) {
        sum = 0u; cnt = 0u; mine = 0u;
#pragma unroll
        for (unsigned j = 0; j < 16; ++j) { const unsigned c = xb_ld(&bar[XB_XCNT(j)]); sum += c; cnt += (c > 0u) ? 1u : 0u; mine = (j == x) ? c : mine; }
        if (sum == G) break;
        __builtin_amdgcn_s_sleep(1);
        if ((++sp & 255u) == 0u) { if (xb_ld(&bar[XB_TMO])) break; if (sp > XB_SPIN_CAP) { atomicAdd(&bar[XB_TMO], 1u); break; } }
    }
    nloc = mine > 0u ? mine : 1u; nx = cnt > 0u ? cnt : 1u;
}
__device__ __forceinline__ void xcd_barrier(const XcdBarrier& b) {
    asm volatile("s_waitcnt vmcnt(0)" ::: "memory");
    __syncthreads();
    if (threadIdx.x == 0) {
        unsigned* bar = b.bar;
        __builtin_amdgcn_s_waitcnt(0);
        unsigned nloc = b.st[0], nx = b.st[1];
        if (nloc == 0u) { xcd_barrier_complete(bar, b.x, nloc, nx); b.st[0] = nloc; b.st[1] = nx; }
        const unsigned old = xb_add(&bar[XB_XSUB(b.x)], 1u);
        const unsigned gen = old / nloc;
        if (old + 1u == (gen + 1u) * nloc) {
            __builtin_amdgcn_fence(__ATOMIC_RELEASE, "agent");
            asm volatile("s_waitcnt vmcnt(0)" ::: "memory");
            const unsigned og = xb_add(&bar[XB_TOP], 1u);
            const unsigned tg = og / nx;
            if (og + 1u == (tg + 1u) * nx) xb_add(&bar[XB_TOPGEN], 1u);
            else XB_SPIN(xb_ld(&bar[XB_TOPGEN]) == tg, bar);
            __builtin_amdgcn_fence(__ATOMIC_ACQUIRE, "agent");
            xb_add(&bar[XB_XGEN(b.x)], 1u);
            asm volatile("s_waitcnt vmcnt(0)" ::: "memory");
        } else {
            XB_SPIN(xb_ld(&bar[XB_XGEN(b.x)]) == gen, bar);
            __builtin_amdgcn_fence(__ATOMIC_ACQUIRE, "agent");
            asm volatile("s_waitcnt vmcnt(0)" ::: "memory");
        }
    }
    __syncthreads();
}
#define N_LAUNCH_MODE 0
#define ENABLE_RET 1
#define ENABLE_ATT 1
#define ENABLE_GLA 1
#define ENABLE_MLS 1
#define ENABLE_MOE 1
#define MOE_FP8 1
#define S2_ABL 0
#define OUT_FP8 1
#define YP_FP8 1
#define MOE_NULL 0
#define MOE_WHICH 3
#define MOE_HOT 0
#define WNT 1
#define CVT_HOST 2
#define S2X 1
#define S2M 1
#define GFP8_RET 0
#define GFP8_GLA 0
#define GFP8_MLS 0
#define MOE_PRO_LAYERS 1
#define MLS_S2MODE 2
#define IFP8_RET 0
#define IFP8_GLA 0
#define IFP8_MLS 0
#define IFP8_ATT 1
#define REP_PRO 1
#define REP_MOE 1
#define REP_INPROJ 1
#define REP_S1 1
#define REP_S2 1
#define REP_S2M 1
#define REP_S2R 1
#define REP_PRE 1
#define REP_HN 1
#define REP_ATT 1
#define REP_NORM 1
#define REP_OUT 1
#define REP_BAR 1
struct CvtJob { const float* wp; unsigned char* op; int ld; int lane; };
namespace pg8 {
constexpr int BM = 256, BK = 64, HALF = 128, HTB = HALF * BK * 2, STAGE_BYTES = 8 * HTB, NXCD = 8, WGM = 8;
__host__ __device__ __forceinline__ int lds_byte(int r, int c) { const int st = (r >> 4) * 2 + (c >> 5), rr = r & 15, cc = c & 31, ob = rr * 64 + cc * 2; return st * 1024 + (ob ^ (((ob >> 9) & 1) << 5)); }
__host__ __device__ __forceinline__ void stage_rc(int b, int& R, int& C) { const int st = b / 1024, sb = b % 1024, swz = sb ^ (((sb >> 9) & 1) << 5); R = (st >> 1) * 16 + swz / 64; C = (st & 1) * 32 + (swz % 64) / 2; }
__host__ __device__ __forceinline__ int perm32(int rho) { const int n = rho >> 4, i = rho & 15; return 8 * (i >> 2) + 4 * n + (i & 3); }

struct Unit { int pm, pn; };
struct Gemm { const bf16_t* A; const bf16_t* Bt; int M, N, K; };

struct StaticOrder {
    int nM, nN, nwg, G, c;
    __device__ void init(int M, int N, int G_, int c_) { nM = M / BM; nN = N / BM; nwg = nM * nN; G = G_; c = c_; }
    __device__ bool next(int i, Unit& u) const {
        const long L = (long)i * G + c; if (L >= nwg) return false;
        int wgid = (int)L; { const int q = nwg / NXCD, r = nwg % NXCD, xcd = wgid % NXCD, off = wgid / NXCD; wgid = (xcd < r ? xcd * (q + 1) : r * (q + 1) + (xcd - r) * q) + off; }
        const int nig = WGM * nN, gid = wgid / nig, fm = gid * WGM, gsz = (nM - fm) < WGM ? (nM - fm) : WGM;
        u.pm = fm + ((wgid % nig) % gsz); u.pn = (wgid % nig) / gsz; return true;
    }
    __device__ __forceinline__ unsigned rowtok(int, int) const { return 0u; }
};
struct MoeOrder {
    const LAS int* utab;
    const LAS unsigned short* idx;
    int nmy;
    __device__ __forceinline__ bool next(int i, Unit& u) const { if (i >= nmy) return false; u.pm = utab[2 * i]; u.pn = utab[2 * i + 1]; return true; }
    __device__ __forceinline__ unsigned rowtok(int i, int r) const { return (unsigned)idx[i * 256 + r]; }
};

struct NoBg { static constexpr bool ON = false; };
template <class Epi, class Sched, bool GATHER, bool FP8, class Bg>
__device__ __forceinline__ void gemm_phase_bg(LAS unsigned char* lds, const Gemm g, const Sched& S, const Epi& E, Bg& bg) {
    const int tid = threadIdx.x, wid = __builtin_amdgcn_readfirstlane(tid >> 6), lane = tid & 63, wr = wid >> 2, wc = wid & 3, fr = lane & 15, fq = lane >> 4;
    const int K = g.K, nt = K / BK;
    unsigned voffA[2], voffB[2]; int rowA[2];
#pragma unroll
    for (int i = 0; i < 2; ++i) { int R, C; stage_rc(tid * 16 + i * 8192, R, C); const int Rb = Epi::PERM2 ? ((R >> 5) * 64 + ((R >> 2) & 3) * 16 + ((R >> 4) & 1) * 4 + (R & 3)) : (Epi::PERM ? ((R & ~31) + perm32(R & 31)) : R);
        rowA[i] = R; voffA[i] = GATHER ? (unsigned)(C * 2) : (unsigned)(R * K + C) * 2u; voffB[i] = (unsigned)(Rb * K + C) * 2u; }
    const size_t kstep = (size_t)(BK * 2);
    const size_t hstep = (size_t)HALF * K * 2;
    const size_t bhstep = Epi::PERM2 ? (size_t)8 * K * 2 : hstep;
    const size_t tstep = 2 * hstep;
    const unsigned ldsw = (unsigned)wid * 1024u;
    const int aoff = FP8 ? lds_byte(wr * 64 + fr, fq * 16) : lds_byte(wr * 64 + fr, fq * 8), boff = FP8 ? lds_byte(wc * 32 + fr, fq * 16) : lds_byte(wc * 32 + fr, fq * 8);
    const int fo1 = (fq & 1) ? 16 : 0, fo2 = 16 - fo1;
    const int aoff1 = aoff + fo1, aoff2 = aoff + fo2, boff1 = boff + fo1, boff2 = boff + fo2;
    const unsigned rowbytes = (unsigned)K * 2u;
#define PG8_SA(b, h) (((b) * 2 + (h)) * HTB)
#define PG8_SB(b, h) ((4 + (b) * 2 + (h)) * HTB)
#define PG8_STAGE(bufoff, gbase, voff) do { _Pragma("unroll") for (int _i = 0; _i < 2; ++_i) \
        __builtin_amdgcn_global_load_lds((const unsigned*)((const char*)(gbase) + (voff)[_i]), (LAS unsigned*)(lds + (bufoff) + ldsw + _i * 8192), 16, 0, 0); } while (0)
#define PG8_STAGE_A(bufoff, tptr, half, vg) do { if constexpr (GATHER) { PG8_STAGE(bufoff, tptr, (vg)[half]); } else { PG8_STAGE(bufoff, (tptr) + (half) * hstep, voffA); } } while (0)
#define PG8_LDA8(dst, b, h) do { _Pragma("unroll") for (int m = 0; m < 4; ++m) { const i32x4 lo_ = *(const LAS i32x4*)(lds + PG8_SA(b, h) + aoff1 + m * 2048), hi_ = *(const LAS i32x4*)(lds + PG8_SA(b, h) + aoff2 + m * 2048); \
        dst[m] = (i32x8){lo_.x, lo_.y, lo_.z, lo_.w, hi_.x, hi_.y, hi_.z, hi_.w}; } } while (0)
#define PG8_LDB8(dst, b, h) do { _Pragma("unroll") for (int n = 0; n < 2; ++n) { const i32x4 lo_ = *(const LAS i32x4*)(lds + PG8_SB(b, h) + boff1 + n * 2048), hi_ = *(const LAS i32x4*)(lds + PG8_SB(b, h) + boff2 + n * 2048); \
        dst[n] = (i32x8){lo_.x, lo_.y, lo_.z, lo_.w, hi_.x, hi_.y, hi_.z, hi_.w}; } } while (0)
#define PG8_MMA8(ai, bj, At, Bt) do { __builtin_amdgcn_s_setprio(1); _Pragma("unroll") for (int m = 0; m < 4; ++m) _Pragma("unroll") for (int n = 0; n < 2; ++n) \
        asm volatile("v_mfma_scale_f32_16x16x128_f8f6f4 %0, %1, %2, %0, %3, %3 op_sel_hi:[0,0,0]" : "+v"(acc[ai][bj][m][n]) : "v"(Bt[n]), "v"(At[m]), "v"(sc7f)); __builtin_amdgcn_s_setprio(0); } while (0)
#define PG8_LDA(dst, b, h) do { _Pragma("unroll") for (int m = 0; m < 4; ++m) _Pragma("unroll") for (int k = 0; k < 2; ++k) dst[m][k] = *(const LAS bf16x8*)(lds + PG8_SA(b, h) + aoff + m * 2048 + k * 1024); } while (0)
#define PG8_LDB(dst, b, h) do { _Pragma("unroll") for (int n = 0; n < 2; ++n) _Pragma("unroll") for (int k = 0; k < 2; ++k) dst[n][k] = *(const LAS bf16x8*)(lds + PG8_SB(b, h) + boff + n * 2048 + k * 1024); } while (0)
#define PG8_MMA(ai, bj, At, Bt) do { __builtin_amdgcn_s_setprio(1); _Pragma("unroll") for (int m = 0; m < 4; ++m) _Pragma("unroll") for (int n = 0; n < 2; ++n) _Pragma("unroll") for (int k = 0; k < 2; ++k) \
        acc[ai][bj][m][n] = __builtin_amdgcn_mfma_f32_16x16x32_bf16(Bt[n][k], At[m][k], acc[ai][bj][m][n], 0, 0, 0); __builtin_amdgcn_s_setprio(0); } while (0)
#define PG8_WAIT_V(n) asm volatile("s_waitcnt vmcnt(" #n ")" ::: "memory")
#define PG8_WAIT_L(n) asm volatile("s_waitcnt lgkmcnt(" #n ")" ::: "memory")
#define PG8_BAR __builtin_amdgcn_s_barrier()
#define PG8_SCHED __builtin_amdgcn_sched_barrier(0)
#define XLDA(b, h) do { if constexpr (FP8) { PG8_LDA8(At8, b, h); } else { PG8_LDA(At, b, h); } } while (0)
#define XLDB(w_, b, h) do { if constexpr (FP8) { if (w_) { PG8_LDB8(B18, b, h); } else { PG8_LDB8(B08, b, h); } } else { if (w_) { PG8_LDB(B1, b, h); } else { PG8_LDB(B0, b, h); } } } while (0)
#define XMMA(ai, bj, w_) do { if constexpr (FP8) { if (w_) { PG8_MMA8(ai, bj, At8, B18); } else { PG8_MMA8(ai, bj, At8, B08); } } else { if (w_) { PG8_MMA(ai, bj, At, B1); } else { PG8_MMA(ai, bj, At, B0); } } } while (0)
    Unit cur, nxt; int ui = 0;
    if (!S.next(0, cur)) return;
    f32x4 acc[2][2][4][2];
#pragma unroll
    for (int a = 0; a < 2; ++a)
#pragma unroll
        for (int b = 0; b < 2; ++b)
#pragma unroll
            for (int m = 0; m < 4; ++m)
#pragma unroll
                for (int n = 0; n < 2; ++n) acc[a][b][m][n] = (f32x4){0.f, 0.f, 0.f, 0.f};
    bf16x8 At[4][2], B0[2][2], B1[2][2];
    i32x8 At8[4], B08[2], B18[2]; const int sc7f = 0x7f7f7f7f;
    unsigned vgc[2][2], vgn[2][2];
    if constexpr (GATHER) {
#pragma unroll
        for (int h = 0; h < 2; ++h)
#pragma unroll
            for (int i = 0; i < 2; ++i) { vgc[h][i] = S.rowtok(0, h * HALF + rowA[i]) * rowbytes + voffA[i]; vgn[h][i] = vgc[h][i]; }
    }
    const char* cA = GATHER ? (const char*)g.A : (const char*)g.A + (size_t)cur.pm * tstep; const char* cB = (const char*)g.Bt + (size_t)cur.pn * tstep;
    PG8_STAGE(PG8_SB(0, 0), cB, voffB); PG8_STAGE_A(PG8_SA(0, 0), cA, 0, vgc); PG8_STAGE(PG8_SB(0, 1), cB + bhstep, voffB); PG8_STAGE_A(PG8_SA(0, 1), cA, 1, vgc);
    if (wr == 1) PG8_BAR;
    PG8_WAIT_V(4); PG8_BAR;
    PG8_STAGE(PG8_SB(1, 0), cB + kstep, voffB); PG8_STAGE_A(PG8_SA(1, 0), cA + kstep, 0, vgc); PG8_STAGE(PG8_SB(1, 1), cB + bhstep + kstep, voffB);
    PG8_WAIT_V(6); PG8_BAR;
    for (;;) {
        const bool has_next = S.next(ui + 1, nxt);
        if constexpr (GATHER) {
            if (has_next) {
#pragma unroll
                for (int h = 0; h < 2; ++h)
#pragma unroll
                    for (int i = 0; i < 2; ++i) vgn[h][i] = S.rowtok(ui + 1, h * HALF + rowA[i]) * rowbytes + voffA[i];
            } else {
#pragma unroll
                for (int h = 0; h < 2; ++h)
#pragma unroll
                    for (int i = 0; i < 2; ++i) vgn[h][i] = vgc[h][i];
            }
        }
        const char* nA = GATHER ? cA : (has_next ? (const char*)g.A + (size_t)nxt.pm * tstep : cA); const char* nB = has_next ? (const char*)g.Bt + (size_t)nxt.pn * tstep : cB;
        for (int t = 0; t < nt; t += 2) {
            const bool last = (t == nt - 2);
            const char* a1 = cA + (size_t)(t + 1) * kstep;
            const char* a2 = last ? nA : cA + (size_t)(t + 2) * kstep; const char* b2 = last ? nB : cB + (size_t)(t + 2) * kstep;
            const char* a3 = a2 + kstep; const char* b3 = b2 + kstep;
            unsigned vg2[2][2];
            if constexpr (GATHER) {
#pragma unroll
                for (int h = 0; h < 2; ++h)
#pragma unroll
                    for (int i = 0; i < 2; ++i) vg2[h][i] = last ? vgn[h][i] : vgc[h][i];
            }
            XLDB(0, 0, 0); PG8_SCHED; XLDA(0, 0); PG8_STAGE_A(PG8_SA(1, 1), a1, 1, vgc);
            PG8_WAIT_L(8); PG8_BAR; PG8_WAIT_L(0); XMMA(0, 0, 0); PG8_BAR; PG8_SCHED;
            XLDB(1, 0, 1); PG8_STAGE(PG8_SB(0, 0), b2, voffB);
            PG8_BAR; PG8_WAIT_L(0); XMMA(0, 1, 1); PG8_BAR;
            XLDA(0, 1); PG8_STAGE_A(PG8_SA(0, 0), a2, 0, vg2);
            PG8_BAR; PG8_WAIT_L(0); XMMA(1, 0, 0); PG8_BAR; PG8_SCHED;
            PG8_STAGE(PG8_SB(0, 1), b2 + bhstep, voffB);
            PG8_WAIT_V(6); PG8_BAR; XMMA(1, 1, 1); PG8_BAR;
            XLDB(0, 1, 0); PG8_SCHED; XLDA(1, 0); PG8_STAGE_A(PG8_SA(0, 1), a2, 1, vg2);
            PG8_WAIT_L(8); PG8_BAR; PG8_WAIT_L(0); XMMA(0, 0, 0); PG8_BAR; PG8_SCHED;
            XLDB(1, 1, 1); PG8_STAGE(PG8_SB(1, 0), b3, voffB);
            PG8_BAR; PG8_WAIT_L(0); XMMA(0, 1, 1); PG8_BAR;
            XLDA(1, 1); PG8_STAGE_A(PG8_SA(1, 0), a3, 0, vg2);
            PG8_BAR; PG8_WAIT_L(0); XMMA(1, 0, 0); PG8_BAR; PG8_SCHED;
            PG8_STAGE(PG8_SB(1, 1), b3 + bhstep, voffB);
            PG8_WAIT_V(6); PG8_BAR; XMMA(1, 1, 1); PG8_BAR;
        }
        if constexpr (FP8) { asm volatile("s_nop 15\n\ts_nop 15" ::: "memory"); }
        if constexpr (Bg::ON) E.run(acc, cur, wr, wc, fr, fq, bg); else E(acc, cur, wr, wc, fr, fq);
        if (!has_next) break;
#pragma unroll
        for (int a = 0; a < 2; ++a)
#pragma unroll
            for (int b = 0; b < 2; ++b)
#pragma unroll
                for (int m = 0; m < 4; ++m)
#pragma unroll
                    for (int n = 0; n < 2; ++n) acc[a][b][m][n] = (f32x4){0.f, 0.f, 0.f, 0.f};
        cur = nxt; cA = nA; cB = nB; ++ui;
        if constexpr (GATHER) {
#pragma unroll
            for (int h = 0; h < 2; ++h)
#pragma unroll
                for (int i = 0; i < 2; ++i) vgc[h][i] = vgn[h][i];
        }
    }
    PG8_WAIT_V(0);
    if (wr == 0) PG8_BAR;
    PG8_BAR;
#undef PG8_SA
#undef PG8_SB
#undef PG8_STAGE
#undef PG8_STAGE_A
#undef PG8_LDA
#undef PG8_LDA8
#undef PG8_LDB8
#undef PG8_MMA8
#undef XLDA
#undef XLDB
#undef XMMA
#undef PG8_LDB
#undef PG8_MMA
#undef PG8_WAIT_V
#undef PG8_WAIT_L
#undef PG8_BAR
#undef PG8_SCHED
}
template <class Epi, class Sched, bool GATHER, bool FP8 = false>
__device__ __forceinline__ void gemm_phase(LAS unsigned char* lds, const Gemm g, const Sched& S, const Epi& E) { NoBg nb; gemm_phase_bg<Epi, Sched, GATHER, FP8, NoBg>(lds, g, S, E, nb); }


template <bool XBF> struct EpiResid {
    static constexpr bool PERM = true, PERM2 = false;
    const void* xin; bf16_t* xout; const float* gate; float gs;
    __device__ __forceinline__ void operator()(const f32x4 (&acc)[2][2][4][2], const Unit& u, int wr, int wc, int fr, int fq) const {
        const int row0 = u.pm * BM + wr * 64 + fr, col0 = u.pn * BM + wc * 32 + 8 * fq;
        const int b = (u.pm * BM) >> 12;
        f32x4 gv[2][2];
#pragma unroll
        for (int bj = 0; bj < 2; ++bj)
#pragma unroll
            for (int n = 0; n < 2; ++n) gv[bj][n] = *(const f32x4*)(gate + (size_t)b * 6144 + col0 + bj * HALF + 4 * n) * gs;
#pragma unroll
        for (int ai = 0; ai < 2; ++ai)
#pragma unroll
            for (int m = 0; m < 4; ++m) { const size_t ro = (size_t)(row0 + ai * HALF + m * 16) * DM + col0;
#pragma unroll
                for (int bj = 0; bj < 2; ++bj) { f32x4 x0, x1;
                    if (XBF) { const u32x4 p = *(const u32x4*)((const bf16_t*)xin + ro + bj * HALF); x0 = (f32x4){bflo(p.x), bfhi(p.x), bflo(p.y), bfhi(p.y)}; x1 = (f32x4){bflo(p.z), bfhi(p.z), bflo(p.w), bfhi(p.w)}; }
                    else { x0 = *(const f32x4*)((const float*)xin + ro + bj * HALF); x1 = *(const f32x4*)((const float*)xin + ro + bj * HALF + 4); }
                    const f32x4 o0 = x0 + gv[bj][0] * acc[ai][bj][m][0], o1 = x1 + gv[bj][1] * acc[ai][bj][m][1];
                    u32x4 q; q.x = pk2(o0[0], o0[1]); q.y = pk2(o0[2], o0[3]); q.z = pk2(o1[0], o1[1]); q.w = pk2(o1[2], o1[3]);
                    *(u32x4*)(xout + ro + bj * HALF) = q; } }
    }
};
struct EpiBf16S {
    static constexpr bool PERM = true, PERM2 = false;
    bf16_t* O; int ldc; int nscaled; float scale; float gs;
    __device__ __forceinline__ void operator()(const f32x4 (&acc)[2][2][4][2], const Unit& u, int wr, int wc, int fr, int fq) const {
        const int row0 = u.pm * BM + wr * 64 + fr; const int col0 = u.pn * BM + wc * 32 + 8 * fq;
        const float sc = ((u.pn < nscaled) ? scale : 1.0f) * gs;
#pragma unroll
        for (int ai = 0; ai < 2; ++ai)
#pragma unroll
            for (int m = 0; m < 4; ++m) { bf16_t* rowp = O + (size_t)(row0 + ai * HALF + m * 16) * ldc + col0;
#pragma unroll
                for (int bj = 0; bj < 2; ++bj) { const f32x4 v0 = acc[ai][bj][m][0] * sc, v1 = acc[ai][bj][m][1] * sc;
                    u32x4 w; w.x = cvt_pk_bf16(v0[0], v0[1]); w.y = cvt_pk_bf16(v0[2], v0[3]); w.z = cvt_pk_bf16(v1[0], v1[1]); w.w = cvt_pk_bf16(v1[2], v1[3]);
                    *(u32x4*)(rowp + bj * HALF) = w; } }
    }
};
struct EpiRet {
    static constexpr bool PERM = true, PERM2 = false;
    bf16_t* O; const f32x2* rope; float gs;
    __device__ __forceinline__ void operator()(const f32x4 (&acc)[2][2][4][2], const Unit& u, int wr, int wc, int fr, int fq) const { NoBg nb; run(acc, u, wr, wc, fr, fq, nb); }
    template <class Bg> __device__ __forceinline__ void run(const f32x4 (&acc)[2][2][4][2], const Unit& u, int wr, int wc, int fr, int fq, Bg& hook) const {
        const int row0 = u.pm * BM + wr * 64 + fr; const int col0 = u.pn * BM + wc * 32 + 8 * fq;
        const float sc = ((u.pn >= 4 && u.pn < 8) ? 0.0625f : 1.0f) * gs;
        if (u.pn < 8) { NoBg nb; rows<true>(acc, row0, col0, sc, wc, fq, nb); } else rows<false>(acc, row0, col0, sc, wc, fq, hook);
    }
    template <bool ROT, class Bg> __device__ __forceinline__ void rows(const f32x4 (&acc)[2][2][4][2], int row0, int col0, float sc, int wc, int fq, Bg& hook) const {
        float cv[64]; CvtJob cj; bool cp = false;
        if constexpr (Bg::ON) { cp = hook.begin(cj); if (cp) Bg::load1(cj, cv); __builtin_amdgcn_sched_barrier(0); }
#pragma unroll
        for (int ai = 0; ai < 2; ++ai)
#pragma unroll
            for (int m = 0; m < 4; ++m) { const int row = row0 + ai * HALF + m * 16; bf16_t* rowp = O + (size_t)row * 6144 + col0;
                f32x4 a0 = acc[ai][0][m][0], a1 = acc[ai][0][m][1], b0 = acc[ai][1][m][0], b1 = acc[ai][1][m][1];
                if constexpr (!ROT) { a0 = a0 * gs; a1 = a1 * gs; b0 = b0 * gs; b1 = b1 * gs; }
                else {
                    const f32x2* cs = rope + (size_t)(row & (SEQ - 1)) * 128 + wc * 32 + 8 * fq;
                    f32x4 o0, o1, p0, p1;
#pragma unroll
                    for (int j = 0; j < 4; ++j) { const f32x2 c0 = cs[j], c1 = cs[4 + j];
                        o0[j] = (a0[j] * c0.x - b0[j] * c0.y) * sc; p0[j] = (a0[j] * c0.y + b0[j] * c0.x) * sc;
                        o1[j] = (a1[j] * c1.x - b1[j] * c1.y) * sc; p1[j] = (a1[j] * c1.y + b1[j] * c1.x) * sc; }
                    a0 = o0; a1 = o1; b0 = p0; b1 = p1;
                }
                u32x4 w; w.x = cvt_pk_bf16(a0[0], a0[1]); w.y = cvt_pk_bf16(a0[2], a0[3]); w.z = cvt_pk_bf16(a1[0], a1[1]); w.w = cvt_pk_bf16(a1[2], a1[3]);
                *(u32x4*)(rowp) = w;
                w.x = cvt_pk_bf16(b0[0], b0[1]); w.y = cvt_pk_bf16(b0[2], b0[3]); w.z = cvt_pk_bf16(b1[0], b1[1]); w.w = cvt_pk_bf16(b1[2], b1[3]);
                *(u32x4*)(rowp + HALF) = w;
                if constexpr (Bg::ON) { if (ai == 0 && m == 3) { __builtin_amdgcn_sched_barrier(0); if (cp) Bg::load2(cj, cv); } } }
        if constexpr (Bg::ON) { __builtin_amdgcn_sched_barrier(0); if (cp) Bg::store(cj, cv); }
    }
};
struct EpiSwiglu {
    static constexpr bool PERM = true, PERM2 = false;
    bf16_t* O; const float* b1;
    __device__ __forceinline__ void operator()(const f32x4 (&acc)[2][2][4][2], const Unit& u, int wr, int wc, int fr, int fq) const {
        const int e = u.pn >> 3, pl = u.pn & 7;
        const int row0 = u.pm * BM + wr * 64 + fr; const int c0 = pl * 128 + wc * 32 + 8 * fq;
        const float* bg = b1 + (size_t)e * 2048 + c0; const float* bl = bg + 1024;
        const f32x4 bg0 = *(const f32x4*)bg, bg1 = *(const f32x4*)(bg + 4), bl0 = *(const f32x4*)bl, bl1 = *(const f32x4*)(bl + 4);
#pragma unroll
        for (int ai = 0; ai < 2; ++ai)
#pragma unroll
            for (int m = 0; m < 4; ++m) { bf16_t* rowp = O + (size_t)(row0 + ai * HALF + m * 16) * 1024 + c0;
                const f32x4 g0 = acc[ai][0][m][0] + bg0, g1 = acc[ai][0][m][1] + bg1, l0 = acc[ai][1][m][0] + bl0, l1 = acc[ai][1][m][1] + bl1;
                float r[8];
#pragma unroll
                for (int j = 0; j < 4; ++j) {
                    const float ga = fminf(g0[j], 7.0f), la = fminf(fmaxf(l0[j], -7.0f), 7.0f);
                    r[j] = ga * __builtin_amdgcn_rcpf(1.0f + __builtin_amdgcn_exp2f(-2.4554669595930157f * ga)) * (la + 1.0f);
                    const float gb = fminf(g1[j], 7.0f), lb = fminf(fmaxf(l1[j], -7.0f), 7.0f);
                    r[4 + j] = gb * __builtin_amdgcn_rcpf(1.0f + __builtin_amdgcn_exp2f(-2.4554669595930157f * gb)) * (lb + 1.0f); }
                u32x4 w; w.x = cvt_pk_bf16(r[0], r[1]); w.y = cvt_pk_bf16(r[2], r[3]); w.z = cvt_pk_bf16(r[4], r[5]); w.w = cvt_pk_bf16(r[6], r[7]);
                *(u32x4*)(rowp) = w; }
    }
};
struct EpiSwiglu8 {
    static constexpr bool PERM = true, PERM2 = false;
    unsigned char* O; const float* b1;
    static __device__ __forceinline__ f32x2 act2(f32x2 accg, f32x2 accl, f32x2 bg, f32x2 bl) {
        const f32x2 ws2 = {0.03125f, 0.03125f};
        f32x2 gg = accg * ws2 + bg, ll = accl * ws2 + bl;
        gg.x = fminf(gg.x, 7.0f); gg.y = fminf(gg.y, 7.0f);
        ll.x = fminf(fmaxf(ll.x, -7.0f), 7.0f); ll.y = fminf(fmaxf(ll.y, -7.0f), 7.0f);
        const f32x2 ea = gg * (f32x2){-2.4554669595930157f, -2.4554669595930157f};
        f32x2 den; den.x = __builtin_amdgcn_exp2f(ea.x); den.y = __builtin_amdgcn_exp2f(ea.y);
        den = den + (f32x2){1.0f, 1.0f};
        f32x2 rc; rc.x = __builtin_amdgcn_rcpf(den.x); rc.y = __builtin_amdgcn_rcpf(den.y);
        return (gg * rc) * (ll + (f32x2){1.0f, 1.0f});
    }
    __device__ __forceinline__ void operator()(const f32x4 (&acc)[2][2][4][2], const Unit& u, int wr, int wc, int fr, int fq) const { NoBg nb; run(acc, u, wr, wc, fr, fq, nb); }
    template <class Bg> __device__ __forceinline__ void run(const f32x4 (&acc)[2][2][4][2], const Unit& u, int wr, int wc, int fr, int fq, Bg& hook) const {
        const int e = u.pn >> 3, pl = u.pn & 7;
        const int row0 = u.pm * BM + wr * 64 + fr; const int c0 = pl * 128 + wc * 32 + 8 * fq;
        const float* bg = b1 + (size_t)e * 2048 + c0; const float* bl = bg + 1024;
        const f32x4 bg0 = *(const f32x4*)bg, bg1 = *(const f32x4*)(bg + 4), bl0 = *(const f32x4*)bl, bl1 = *(const f32x4*)(bl + 4);
        float cv[64]; CvtJob cj; bool cp = false;
        if constexpr (Bg::ON) { __builtin_amdgcn_sched_barrier(0); cp = hook.begin(cj); if (cp) Bg::load1(cj, cv); __builtin_amdgcn_sched_barrier(0); }
#pragma unroll
        for (int ai = 0; ai < 2; ++ai)
#pragma unroll
            for (int m = 0; m < 4; ++m) { __builtin_amdgcn_sched_barrier(0); unsigned char* rowp = O + (size_t)(row0 + ai * HALF + m * 16) * 1024 + c0;
                const f32x4 g0 = acc[ai][0][m][0], g1 = acc[ai][0][m][1], l0 = acc[ai][1][m][0], l1 = acc[ai][1][m][1];
                const f32x2 r0 = act2((f32x2){g0[0], g0[1]}, (f32x2){l0[0], l0[1]}, (f32x2){bg0[0], bg0[1]}, (f32x2){bl0[0], bl0[1]});
                const f32x2 r1 = act2((f32x2){g0[2], g0[3]}, (f32x2){l0[2], l0[3]}, (f32x2){bg0[2], bg0[3]}, (f32x2){bl0[2], bl0[3]});
                const f32x2 r2 = act2((f32x2){g1[0], g1[1]}, (f32x2){l1[0], l1[1]}, (f32x2){bg1[0], bg1[1]}, (f32x2){bl1[0], bl1[1]});
                const f32x2 r3 = act2((f32x2){g1[2], g1[3]}, (f32x2){l1[2], l1[3]}, (f32x2){bg1[2], bg1[3]}, (f32x2){bl1[2], bl1[3]});
                u32x2 w; w.x = pk4_fp8(r0.x, r0.y, r1.x, r1.y); w.y = pk4_fp8(r2.x, r2.y, r3.x, r3.y);
                *(u32x2*)(rowp) = w;
                if constexpr (Bg::ON) { if (ai == 0 && m == 3) { __builtin_amdgcn_sched_barrier(0); if (cp) Bg::load2(cj, cv); } } }
        if constexpr (Bg::ON) { __builtin_amdgcn_sched_barrier(0); if (cp) Bg::store(cj, cv); }
    }
};
struct EpiNull {
    static constexpr bool PERM = true, PERM2 = false;
    float* sink;
    __device__ __forceinline__ void operator()(const f32x4 (&acc)[2][2][4][2], const Unit& u, int wr, int wc, int fr, int fq) const {
        float s = 0.f;
#pragma unroll
        for (int ai = 0; ai < 2; ++ai)
#pragma unroll
            for (int bj = 0; bj < 2; ++bj)
#pragma unroll
                for (int m = 0; m < 4; ++m)
#pragma unroll
                    for (int n = 0; n < 2; ++n) s += acc[ai][bj][m][n][0];
        if (s == 123.456f) sink[0] = s;
    }
};
struct EpiMoe2 {
    static constexpr bool PERM = true, PERM2 = (YP_FP8 != 0);
    bf16_t* O; const float* b2; float ws_;
    __device__ __forceinline__ void operator()(const f32x4 (&acc)[2][2][4][2], const Unit& u, int wr, int wc, int fr, int fq) const {
        const int e = u.pn >> 2, pl = u.pn & 3;
        const int row0 = u.pm * BM + wr * 64 + fr;
        if constexpr (PERM2) {
            const int c0 = pl * 256 + wc * 64 + 16 * fq;
            const float* bp = b2 + (size_t)e * 1024 + c0;
            f32x4 bv[2][2];
#pragma unroll
            for (int bj = 0; bj < 2; ++bj)
#pragma unroll
                for (int n = 0; n < 2; ++n) bv[bj][n] = *(const f32x4*)(bp + 8 * bj + 4 * n);
#pragma unroll
            for (int ai = 0; ai < 2; ++ai)
#pragma unroll
                for (int m = 0; m < 4; ++m) { __builtin_amdgcn_sched_barrier(0);
                    const f32x4 v00 = acc[ai][0][m][0] * ws_ + bv[0][0], v01 = acc[ai][0][m][1] * ws_ + bv[0][1], v10 = acc[ai][1][m][0] * ws_ + bv[1][0], v11 = acc[ai][1][m][1] * ws_ + bv[1][1];
                    u32x4 w; w.x = pk4_fp8(v00[0], v00[1], v00[2], v00[3]); w.y = pk4_fp8(v01[0], v01[1], v01[2], v01[3]); w.z = pk4_fp8(v10[0], v10[1], v10[2], v10[3]); w.w = pk4_fp8(v11[0], v11[1], v11[2], v11[3]);
                    *(u32x4*)((unsigned char*)O + (size_t)(row0 + ai * HALF + m * 16) * 1024 + c0) = w; }
        } else {
            const int c0 = pl * 256 + wc * 32 + 8 * fq;
            const float* bp = b2 + (size_t)e * 1024 + c0;
            f32x4 bv[2][2];
#pragma unroll
            for (int bj = 0; bj < 2; ++bj)
#pragma unroll
                for (int n = 0; n < 2; ++n) bv[bj][n] = *(const f32x4*)(bp + bj * HALF + 4 * n);
#pragma unroll
            for (int ai = 0; ai < 2; ++ai)
#pragma unroll
                for (int m = 0; m < 4; ++m) { __builtin_amdgcn_sched_barrier(0); bf16_t* rowp = O + (size_t)(row0 + ai * HALF + m * 16) * 1024 + c0;
#pragma unroll
                    for (int bj = 0; bj < 2; ++bj) { const f32x4 v0 = acc[ai][bj][m][0] * ws_ + bv[bj][0], v1 = acc[ai][bj][m][1] * ws_ + bv[bj][1];
                        u32x4 w; w.x = cvt_pk_bf16(v0[0], v0[1]); w.y = cvt_pk_bf16(v0[2], v0[3]); w.z = cvt_pk_bf16(v1[0], v1[1]); w.w = cvt_pk_bf16(v1[2], v1[3]);
                        *(u32x4*)(rowp + bj * HALF) = w; } }
        }
    }
};
}
struct Frame {
    LAS unsigned char* lds;
    unsigned* ctl;
    unsigned char* ws;
    const float* const* in;
    float* out;
    int tid, lane, wave, G, bid;
};

__device__ __forceinline__ void transpose_item(const float* W, int ld, int K, bf16_t* WT, int drow0, LAS float* scr, int k0, int n0, int lane) {
    f32x4 v[16];
#pragma unroll
    for (int i = 0; i < 16; ++i) v[i] = *(const f32x4*)(W + (size_t)(k0 + 4 * i + (lane >> 4)) * ld + n0 + 4 * (lane & 15));
#pragma unroll
    for (int i = 0; i < 16; ++i) { LAS float* s = scr + (4 * i + (lane >> 4)) * 65 + 4 * (lane & 15); s[0] = v[i].x; s[1] = v[i].y; s[2] = v[i].z; s[3] = v[i].w; }
    LDS_WAIT(); asm volatile("" ::: "memory");
    const int c = lane & 7;
#pragma unroll
    for (int j = 0; j < 8; ++j) { const int n = (lane >> 3) + 8 * j; const LAS float* s = scr + (8 * c) * 65 + n;
        u32x4 o; o.x = pk2(s[0 * 65], s[1 * 65]); o.y = pk2(s[2 * 65], s[3 * 65]); o.z = pk2(s[4 * 65], s[5 * 65]); o.w = pk2(s[6 * 65], s[7 * 65]);
        *(u32x4*)(WT + (size_t)(drow0 + n) * K + k0 + 8 * c) = o; }
    LDS_WAIT(); asm volatile("" ::: "memory");
}
__device__ __forceinline__ void transpose_item8(const float* W, int ld, int K, unsigned char* WT, int drow0, LAS float* scr, int k0, int n0, int lane) {
    f32x4 v[16];
#pragma unroll
    for (int i = 0; i < 16; ++i) v[i] = *(const f32x4*)(W + (size_t)(k0 + 4 * i + (lane >> 4)) * ld + n0 + 4 * (lane & 15));
#pragma unroll
    for (int i = 0; i < 16; ++i) { LAS float* s = scr + (4 * i + (lane >> 4)) * 65 + 4 * (lane & 15); s[0] = v[i].x * 32.0f; s[1] = v[i].y * 32.0f; s[2] = v[i].z * 32.0f; s[3] = v[i].w * 32.0f; }
    LDS_WAIT(); asm volatile("" ::: "memory");
    const int c = lane & 3;
#pragma unroll
    for (int j = 0; j < 4; ++j) { const int n = (lane >> 2) + 16 * j; const LAS float* s = scr + (16 * c) * 65 + n;
        u32x4 o; o.x = pk4_fp8(s[0 * 65], s[1 * 65], s[2 * 65], s[3 * 65]); o.y = pk4_fp8(s[4 * 65], s[5 * 65], s[6 * 65], s[7 * 65]);
        o.z = pk4_fp8(s[8 * 65], s[9 * 65], s[10 * 65], s[11 * 65]); o.w = pk4_fp8(s[12 * 65], s[13 * 65], s[14 * 65], s[15 * 65]);
        *(u32x4*)(WT + (size_t)(drow0 + n) * K + k0 + 16 * c) = o; }
    LDS_WAIT(); asm volatile("" ::: "memory");
}
__device__ __forceinline__ void cvt_item_regs(const float* W, int ld, int K, unsigned char* WT, int drow0, int k0, int n0, int lane) {
    const float* wp = W + (size_t)k0 * ld + n0 + lane;
    float v[64];
#pragma unroll
    for (int i = 0; i < 64; ++i) v[i] = WNT ? __builtin_nontemporal_load(wp + (size_t)i * ld) : wp[(size_t)i * ld];
    unsigned char* op = WT + (size_t)(drow0 + lane) * K + k0;
#pragma unroll
    for (int c = 0; c < 4; ++c) { u32x4 o;
        o.x = pk4_fp8(v[16 * c + 0] * 32.0f, v[16 * c + 1] * 32.0f, v[16 * c + 2] * 32.0f, v[16 * c + 3] * 32.0f);
        o.y = pk4_fp8(v[16 * c + 4] * 32.0f, v[16 * c + 5] * 32.0f, v[16 * c + 6] * 32.0f, v[16 * c + 7] * 32.0f);
        o.z = pk4_fp8(v[16 * c + 8] * 32.0f, v[16 * c + 9] * 32.0f, v[16 * c + 10] * 32.0f, v[16 * c + 11] * 32.0f);
        o.w = pk4_fp8(v[16 * c + 12] * 32.0f, v[16 * c + 13] * 32.0f, v[16 * c + 14] * 32.0f, v[16 * c + 15] * 32.0f);
        *(u32x4*)(op + 16 * c) = o; }
}
__device__ __forceinline__ float cvt_ld(const CvtJob& j, __amdgpu_buffer_rsrc_t r, int i) { return __builtin_bit_cast(float, __builtin_amdgcn_raw_buffer_load_b32(r, j.lane * 4, i * j.ld * 4, 0)); }
__device__ __forceinline__ __amdgpu_buffer_rsrc_t cvt_rsrc(const CvtJob& j) { return __builtin_amdgcn_make_buffer_rsrc((void*)j.wp, 0, 0x7fffffff, 0x00020000); }
__device__ __forceinline__ CvtJob moe_cvt_job(const float* const* in, unsigned char* ws, int l, int gi_, int lane) {
    CvtJob j; j.lane = lane;
    const int gi = __builtin_amdgcn_readfirstlane(gi_);
    if (gi < 32 * 512) { const int e = gi >> 9, q = gi & 511, kb = q >> 5, n0 = (q & 31) * 64, mat = l * 32 + e;
        const int drow = (n0 < 1024) ? ((n0 >> 7) * 256 + (n0 & 127)) : (((n0 - 1024) >> 7) * 256 + 128 + ((n0 - 1024) & 127));
        j.ld = 2048; j.wp = in[31] + (size_t)mat * 1024 * 2048 + (size_t)(kb * 64) * 2048 + n0; j.op = ws + WS_W1T + (size_t)mat * 2048 * 1024 + (size_t)drow * 1024 + kb * 64; }
    else { const int r = gi - 32 * 512, e = r >> 8, q = r & 255, kb = q >> 4, n0 = (q & 15) * 64, mat = l * 32 + e;
        j.ld = 1024; j.wp = in[33] + (size_t)mat * 1024 * 1024 + (size_t)(kb * 64) * 1024 + n0; j.op = ws + WS_W2T + (size_t)mat * 1024 * 1024 + (size_t)n0 * 1024 + kb * 64; }
    return j;
}
__device__ __forceinline__ void cvt_job_load(const CvtJob& j, float (&v)[64]) {
    const __amdgpu_buffer_rsrc_t r = cvt_rsrc(j);
#pragma unroll
    for (int i = 0; i < 64; ++i) v[i] = cvt_ld(j, r, i);
}
__device__ __forceinline__ void cvt_job_store(const CvtJob& j, const float (&v)[64]) {
    unsigned char* op = j.op + (unsigned)j.lane * 1024u;
#pragma unroll
    for (int c = 0; c < 4; ++c) { u32x4 o;
        o.x = pk4_fp8(v[16 * c + 0] * 32.0f, v[16 * c + 1] * 32.0f, v[16 * c + 2] * 32.0f, v[16 * c + 3] * 32.0f);
        o.y = pk4_fp8(v[16 * c + 4] * 32.0f, v[16 * c + 5] * 32.0f, v[16 * c + 6] * 32.0f, v[16 * c + 7] * 32.0f);
        o.z = pk4_fp8(v[16 * c + 8] * 32.0f, v[16 * c + 9] * 32.0f, v[16 * c + 10] * 32.0f, v[16 * c + 11] * 32.0f);
        o.w = pk4_fp8(v[16 * c + 12] * 32.0f, v[16 * c + 13] * 32.0f, v[16 * c + 14] * 32.0f, v[16 * c + 15] * 32.0f);
        *(u32x4*)(op + 16 * c) = o; }
}
__device__ __forceinline__ void cvt_half_load(const CvtJob& j, int hf, float (&v)[32]) {
#pragma unroll
    for (int i = 0; i < 32; ++i) v[i] = j.wp[(size_t)(32 * hf + i) * j.ld + j.lane];
}
__device__ __forceinline__ void cvt_half_store(const CvtJob& j, int hf, const float (&v)[32]) {
    unsigned char* op = j.op + (unsigned)j.lane * 1024u;
#pragma unroll
    for (int c = 0; c < 2; ++c) { u32x4 o;
        o.x = pk4_fp8(v[16 * c + 0] * 32.0f, v[16 * c + 1] * 32.0f, v[16 * c + 2] * 32.0f, v[16 * c + 3] * 32.0f);
        o.y = pk4_fp8(v[16 * c + 4] * 32.0f, v[16 * c + 5] * 32.0f, v[16 * c + 6] * 32.0f, v[16 * c + 7] * 32.0f);
        o.z = pk4_fp8(v[16 * c + 8] * 32.0f, v[16 * c + 9] * 32.0f, v[16 * c + 10] * 32.0f, v[16 * c + 11] * 32.0f);
        o.w = pk4_fp8(v[16 * c + 12] * 32.0f, v[16 * c + 13] * 32.0f, v[16 * c + 14] * 32.0f, v[16 * c + 15] * 32.0f);
        *(u32x4*)(op + 32 * hf + 16 * c) = o; }
}
__device__ __forceinline__ void bg_convert(const float* const* in, unsigned char* ws, int layer, int slot0, int count, int gw, int NGW, int lane) {
    for (int s = 0; s < count; s += 2) {
        const int ga = (slot0 + s) * NGW + gw, gb = (slot0 + s + 1) * NGW + gw;
        const bool va = ga < 24576, vb = (s + 1 < count) && gb < 24576;
        float xa[64], xb[64]; CvtJob ja, jb;
        if (va) { ja = moe_cvt_job(in, ws, layer, ga, lane); cvt_job_load(ja, xa); }
        if (vb) { jb = moe_cvt_job(in, ws, layer, gb, lane); cvt_job_load(jb, xb); }
        if (va) cvt_job_store(ja, xa);
        if (vb) cvt_job_store(jb, xb);
    }
}
template <int NB1> struct BgCvtT {
    static constexpr bool ON = true;
    const float* const* in; unsigned char* ws; int layerA, giA, limA, nA, layerB, limB, slot, nslot, gw, NGW, lane;
    __device__ __forceinline__ void init(const float* const* in_, unsigned char* ws_, int gw_, int NGW_, int lane_, int layerA_, int giA_, int limA_, int layerB_, int limB_) {
        in = in_; ws = ws_; gw = gw_; NGW = NGW_; lane = lane_; layerA = layerA_; giA = giA_; limA = limA_; layerB = layerB_; limB = limB_;
        nA = layerA_ >= 0 ? (limA_ - giA_ + NGW_ - 1) / NGW_ : 0; nslot = nA + (layerB_ >= 0 ? (limB_ + NGW_ - 1) / NGW_ : 0); slot = 0; }
    __device__ __forceinline__ bool sel(int s, int& layer, int& gi) const {
        if (s >= nslot) return false;
        if (s < nA) { layer = layerA; gi = giA + s * NGW + gw; return gi < limA; }
        layer = layerB; gi = (s - nA) * NGW + gw; return gi < limB; }
    __device__ __forceinline__ bool begin(CvtJob& j) { int layer = 0, gi = 0; const bool ok = sel(slot, layer, gi); ++slot; if (ok) j = moe_cvt_job(in, ws, layer, gi, lane); return ok; }
    static __device__ __forceinline__ void load1(const CvtJob& j, float (&v)[64]) { const __amdgpu_buffer_rsrc_t r = cvt_rsrc(j);
#pragma unroll
        for (int i = 0; i < NB1; ++i) v[i] = cvt_ld(j, r, i); }
    static __device__ __forceinline__ void load2(const CvtJob& j, float (&v)[64]) { const __amdgpu_buffer_rsrc_t r = cvt_rsrc(j);
#pragma unroll
        for (int i = NB1; i < 64; ++i) v[i] = cvt_ld(j, r, i); }
    static __device__ __forceinline__ void store(const CvtJob& j, const float (&v)[64]) { cvt_job_store(j, v); }
    __device__ __forceinline__ void finish() {
        for (; slot < nslot; ++slot) { int layer = 0, gi = 0; if (sel(slot, layer, gi)) { const CvtJob jj = moe_cvt_job(in, ws, layer, gi, lane); float x[64]; cvt_job_load(jj, x); cvt_job_store(jj, x); } } }
};
typedef BgCvtT<48> BgCvt;
typedef BgCvtT<40> BgCvtR;
__device__ __forceinline__ void moe_cvt_item(const float* const* in, unsigned char* ws, int l, int gi, int lane) {
    if (gi < 32 * 512) { const int e = gi >> 9, q = gi & 511, kb = q >> 5, n0 = (q & 31) * 64, mat = l * 32 + e;
        const int drow = (n0 < 1024) ? ((n0 >> 7) * 256 + (n0 & 127)) : (((n0 - 1024) >> 7) * 256 + 128 + ((n0 - 1024) & 127));
        cvt_item_regs(in[31] + (size_t)mat * 1024 * 2048, 2048, 1024, ws + WS_W1T + (size_t)mat * 2048 * 1024, drow, kb * 64, n0, lane); }
    else { const int r = gi - 32 * 512, e = r >> 8, q = r & 255, kb = q >> 4, n0 = (q & 15) * 64, mat = l * 32 + e;
        cvt_item_regs(in[33] + (size_t)mat * 1024 * 1024, 1024, 1024, ws + WS_W2T + (size_t)mat * 1024 * 1024, n0, kb * 64, n0, lane); }
}
__device__ __forceinline__ bool tr_job(int& r, const float* W, int ld, int K, int N, bf16_t* WT, LAS float* scr, int lane) {
    const int nb = N / 64, items = (K / 64) * nb;
    if (r >= items) { r -= items; return false; }
    const int kb = r / nb, nn = r % nb;
    transpose_item(W, ld, K, WT, nn * 64, scr, kb * 64, nn * 64, lane);
    return true;
}

__device__ __forceinline__ bool tr_job8(int& r, const float* W, int ld, int K, int N, unsigned char* WT, LAS float* scr, int lane) {
    const int nb = N / 64, items = (K / 64) * nb;
    if (r >= items) { r -= items; return false; }
    const int kb = r / nb, nn = r % nb;
    transpose_item8(W, ld, K, WT, nn * 64, scr, kb * 64, nn * 64, lane);
    return true;
}
__device__ __forceinline__ void prologue_phase(Frame& F) {
    const float* const* in = F.in; unsigned char* ws = F.ws;
    {
        LAS float* sc = (LAS float*)F.lds;
        LAS float* red = (LAS float*)(F.lds + 32768);
        const float* c = in[1];
        for (int i = F.tid; i < NB * DM; i += NTHR) sc[i] = siluf_(c[i]);
        __syncthreads();
        float* mod = (float*)(ws + WS_MOD);
        for (int it = F.bid; it < 4 * 96; it += F.G) {
            const int l = it / 96, cb = it % 96, col = cb * 64 + F.lane;
            const __amdgpu_buffer_rsrc_t wr = __builtin_amdgcn_make_buffer_rsrc((void*)(in[2] + (size_t)l * DM * 6144), 0, 0x7fffffff, 0x00020000);
            float acc[8];
#pragma unroll
            for (int b = 0; b < 8; ++b) acc[b] = 0.f;
            const int k0 = F.wave * 128;
            const LAS float* scp = sc + k0;
#pragma unroll 1
            for (int kk = 0; kk < 128; kk += 64) {
                float wv[64];
#pragma unroll
                for (int j = 0; j < 64; ++j) wv[j] = __builtin_bit_cast(float, __builtin_amdgcn_raw_buffer_load_b32(wr, col * 4, (k0 + kk + j) * 6144 * 4, 0));
#pragma unroll
                for (int j = 0; j < 64; j += 4)
#pragma unroll
                    for (int b = 0; b < 8; ++b) { const f32x4 s4 = *(const LAS f32x4*)(scp + b * DM + kk + j);
                        acc[b] += s4.x * wv[j] + s4.y * wv[j + 1] + s4.z * wv[j + 2] + s4.w * wv[j + 3]; }
            }
#pragma unroll
            for (int b = 0; b < 8; ++b) red[(F.wave * 8 + b) * 64 + F.lane] = acc[b];
            __syncthreads();
            {
                float s = 0.f;
#pragma unroll
                for (int w8 = 0; w8 < 8; ++w8) s += red[(w8 * 8 + F.wave) * 64 + F.lane];
                mod[((size_t)l * NB + F.wave) * 6144 + col] = s + in[3][(size_t)l * 6144 + col];
            }
            __syncthreads();
        }
    }
    const int gw = F.bid * NWAVES + F.wave, NGW = F.G * NWAVES, gt = F.bid * NTHR + F.tid, NGT = F.G * NTHR;
    {
        f32x2* rope = (f32x2*)(ws + WS_ROPE);
        const float inv_t = (float)exp(-(double)(gt & 127) * (9.210340371976184 / 128.0));
        const bool inv_same = (NGT & 127) == 0;
        for (int i = gt; i < SEQ * 128; i += NGT) {
            const int pos = i >> 7, j = i & 127;
            const float inv = inv_same ? inv_t : (float)exp(-(double)j * (9.210340371976184 / 128.0));
            const float ang = (float)pos * inv;
            const double rev = (double)ang * 0.15915494309189535;
            const float fr = (float)(rev - floor(rev));
            rope[i] = (f32x2){__builtin_amdgcn_cosf(fr), __builtin_amdgcn_sinf(fr)};
        }
    }
    {
        bf16_t* wrt = (bf16_t*)(ws + WS_WRT);
        for (int i = gt; i < 4 * 32 * 1024; i += NGT) {
            const int l = i >> 15, e = (i >> 10) & 31, k = i & 1023;
            const float w = in[29][((size_t)l * 1024 + k) * 32 + e];
            const unsigned hi = f2bf(w); const float lo = w - bf2f((unsigned short)hi);
            wrt[((size_t)(l * 2 + 0) * 32 + e) * 1024 + k] = (bf16_t)hi; wrt[((size_t)(l * 2 + 1) * 32 + e) * 1024 + k] = (bf16_t)f2bf(lo);
        }
        bf16_t* wgl = (bf16_t*)(ws + WS_WGL);
        for (int i = gt; i < 16 * 1024; i += NGT) {
            const int e = i >> 10, k = i & 1023;
            const float w = in[13][(size_t)k * 3088 + 2048 + e];
            const unsigned hi = f2bf(w); const float lo = w - bf2f((unsigned short)hi);
            wgl[(size_t)(0 * 16 + e) * 1024 + k] = (bf16_t)hi; wgl[(size_t)(1 * 16 + e) * 1024 + k] = (bf16_t)f2bf(lo);
        }
    }
    {
        bf16_t* wmg = (bf16_t*)(ws + WS_WMG);
        for (int i = gt; i < 16 * 6144; i += NGT) {
            const int e = i / 6144, k = i % 6144;
            const float w = (e < 8) ? in[24][(size_t)k * 8 + e] : 0.f;
            const unsigned hi = f2bf(w); const float lo = w - bf2f((unsigned short)hi);
            wmg[(size_t)e * 6144 + k] = (bf16_t)hi; wmg[(size_t)(16 + e) * 6144 + k] = (bf16_t)f2bf(lo);
        }
    }
    {
        LAS float* scr = (LAS float*)(F.lds + F.wave * 16640);
        constexpr int I_RET_IN = 16 * 96, I_RET_OUT = 32 * 16, I_ATT_IN = 16 * 48, I_ATT_OUT = 16 * 16, I_GLA_A = 16 * 32, I_GLA_B = 16 * 16, I_GLA_OUT = 16 * 16,
                      I_MLS_IN = 16 * 64, I_MLS_OUT = 32 * 16;
        constexpr int I_DENSE = I_RET_IN + I_RET_OUT + I_ATT_IN + I_ATT_OUT + I_GLA_A + I_GLA_B + I_GLA_OUT + I_MLS_IN + I_MLS_OUT;
        constexpr int I_W1 = 16 * 32, I_W2 = 16 * 16;
        constexpr int NITEMS = I_DENSE + (MOE_FP8 ? (CVT_HOST == 2 ? 0 : MOE_PRO_LAYERS) * 24576 : 128 * I_W1 + 128 * I_W2);
        for (int it = gw; it < NITEMS; it += NGW) {
            int r = it;
            if (r < I_DENSE) {
                if (GFP8_RET) { if (tr_job(r, in[7], 6144, 1024, 4096, (bf16_t*)(ws + WS_W_RET_IN), scr, F.lane)) continue;
                    if (tr_job8(r, in[7] + 4096, 6144, 1024, 2048, (unsigned char*)(ws + WS_W_RET_IN + 8 * MiB), scr, F.lane)) continue; }
                else if (IFP8_RET ? tr_job8(r, in[7], 6144, 1024, 6144, (unsigned char*)(ws + WS_W_RET_IN), scr, F.lane) : tr_job(r, in[7], 6144, 1024, 6144, (bf16_t*)(ws + WS_W_RET_IN), scr, F.lane)) continue;
                if (OUT_FP8 ? tr_job8(r, in[9], 1024, 2048, 1024, (unsigned char*)(ws + WS_W_RET_OUT), scr, F.lane) : tr_job(r, in[9], 1024, 2048, 1024, (bf16_t*)(ws + WS_W_RET_OUT), scr, F.lane)) continue;
                if (IFP8_ATT ? tr_job8(r, in[10], 3072, 1024, 3072, (unsigned char*)(ws + WS_W_ATT_IN), scr, F.lane) : tr_job(r, in[10], 3072, 1024, 3072, (bf16_t*)(ws + WS_W_ATT_IN), scr, F.lane)) continue;
                if (OUT_FP8 ? tr_job8(r, in[12], 1024, 1024, 1024, (unsigned char*)(ws + WS_W_ATT_OUT), scr, F.lane) : tr_job(r, in[12], 1024, 1024, 1024, (bf16_t*)(ws + WS_W_ATT_OUT), scr, F.lane)) continue;
                if (IFP8_GLA ? tr_job8(r, in[13], 3088, 1024, 2048, (unsigned char*)(ws + WS_W_GLA_IN), scr, F.lane) : tr_job(r, in[13], 3088, 1024, 2048, (bf16_t*)(ws + WS_W_GLA_IN), scr, F.lane)) continue;
                if (GFP8_GLA) { if (tr_job8(r, in[13] + 2064, 3088, 1024, 1024, (unsigned char*)(ws + WS_W_GLA_IN + 4 * MiB), scr, F.lane)) continue; }
                else if (IFP8_GLA ? tr_job8(r, in[13] + 2064, 3088, 1024, 1024, (unsigned char*)(ws + WS_W_GLA_IN) + (size_t)2048 * 1024, scr, F.lane) : tr_job(r, in[13] + 2064, 3088, 1024, 1024, (bf16_t*)(ws + WS_W_GLA_IN) + (size_t)2048 * 1024, scr, F.lane)) continue;
                if (OUT_FP8 ? tr_job8(r, in[17], 1024, 1024, 1024, (unsigned char*)(ws + WS_W_GLA_OUT), scr, F.lane) : tr_job(r, in[17], 1024, 1024, 1024, (bf16_t*)(ws + WS_W_GLA_OUT), scr, F.lane)) continue;
                if (GFP8_MLS) { if (tr_job(r, in[18], 4096, 1024, 2048, (bf16_t*)(ws + WS_W_MLS_IN), scr, F.lane)) continue;
                    if (tr_job8(r, in[18] + 2048, 4096, 1024, 2048, (unsigned char*)(ws + WS_W_MLS_IN + 4 * MiB), scr, F.lane)) continue; }
                else if (IFP8_MLS ? tr_job8(r, in[18], 4096, 1024, 4096, (unsigned char*)(ws + WS_W_MLS_IN), scr, F.lane) : tr_job(r, in[18], 4096, 1024, 4096, (bf16_t*)(ws + WS_W_MLS_IN), scr, F.lane)) continue;
                if (OUT_FP8) tr_job8(r, in[28], 1024, 2048, 1024, (unsigned char*)(ws + WS_W_MLS_OUT), scr, F.lane); else tr_job(r, in[28], 1024, 2048, 1024, (bf16_t*)(ws + WS_W_MLS_OUT), scr, F.lane);
                continue;
            }
            r -= I_DENSE;
            if (MOE_FP8) { moe_cvt_item(in, ws, r / 24576, r % 24576, F.lane); continue; }
            if (r < 128 * I_W1) {
                const int mat = r / I_W1, q = r % I_W1, kb = q / 32, nn = q % 32, n0 = nn * 64;
                const int drow = (n0 < 1024) ? ((n0 >> 7) * 256 + (n0 & 127)) : (((n0 - 1024) >> 7) * 256 + 128 + ((n0 - 1024) & 127));
                transpose_item(in[31] + (size_t)mat * 1024 * 2048, 2048, 1024, (bf16_t*)(ws + WS_W1T) + (size_t)mat * 2048 * 1024, drow, scr, kb * 64, n0, F.lane);
                continue;
            }
            r -= 128 * I_W1;
            { const int mat = r / I_W2, q = r % I_W2, kb = q / 16, nn = q % 16;
              transpose_item(in[33] + (size_t)mat * 1024 * 1024, 1024, 1024, (bf16_t*)(ws + WS_W2T) + (size_t)mat * 1024 * 1024, nn * 64, scr, kb * 64, nn * 64, F.lane); }
        }
    }
}

struct NormArgs {
    const void* xin; bf16_t* xout;
    const float* gain;
    const float* sc; const float* sh;
    bf16_t* h;
    unsigned char* h8;
    const bf16_t* yp; const int* tokes_c; const float* tokw_c; const float* gf; const unsigned* cnt_prev;
    const bf16_t* wt;
    const float* rb;
    unsigned* cnt; unsigned short* list; int* tokes; float* tokw;
    float* glow;
    float* out;
};
template <bool COMBINE, int PROJ  , bool FINAL, bool XBF = true, int HOUT = 3>
__device__ __forceinline__ void norm_phase(Frame& F, const NormArgs& a) {
    constexpr bool WANT_H8 = !FINAL && (HOUT & 2), WANT_H16 = !FINAL && ((HOUT & 1) || PROJ != 0);
    LAS unsigned* sbase = (LAS unsigned*)(F.lds + LDS_MISC + 256);
    LAS float* lg = (LAS float*)(F.lds + F.wave * 2176);
    if (COMBINE) {
        if (F.wave == 0) {
            const unsigned t = F.lane < NEXP ? ((a.cnt_prev[F.lane * 64] + 255u) >> 8) << 8 : 0u;
            unsigned incl = t;
#pragma unroll
            for (int d = 1; d < NEXP; d <<= 1) { const unsigned v = __shfl_up(incl, d); if (F.lane >= d) incl += v; }
            if (F.lane < NEXP) sbase[F.lane] = incl - t;
        }
        LDS_WAIT();
        __syncthreads();
    }
    const int gw = F.bid * NWAVES + F.wave, NGW = F.G * NWAVES, lane = F.lane;
    LAS unsigned* hist = (LAS unsigned*)(F.lds + LDS_MISC + 1024);
    LAS unsigned* gbase = (LAS unsigned*)(F.lds + LDS_MISC + 1280);
    if (PROJ == 1) { if (F.tid < 32) hist[F.tid] = 0u; __syncthreads(); }
    const int niter = (T / 16 + NGW - 1) / NGW;
    for (int it = 0; it < niter; ++it) {
        const int tile_ = it * NGW + gw; const bool active = tile_ < T / 16; const int tile = active ? tile_ : 0;
        const int t0 = tile * 16, b = t0 >> 12;
        f32x4 gm[4], shv[4], gfv[4];
        if (active) {
#pragma unroll
        for (int j = 0; j < 4; ++j) {
            const int d = 512 * (j >> 1) + 8 * lane + 4 * (j & 1);
            const f32x4 g = *(const f32x4*)(a.gain + d);
            if (!FINAL) { const f32x4 s = *(const f32x4*)(a.sc + (size_t)b * 6144 + d); gm[j] = g * (s + 1.0f); shv[j] = *(const f32x4*)(a.sh + (size_t)b * 6144 + d); }
            else { gm[j] = g; shv[j] = (f32x4){0.f, 0.f, 0.f, 0.f}; }
            if (COMBINE) gfv[j] = *(const f32x4*)(a.gf + (size_t)b * 6144 + d);
        }
        int es_all = 0; float w_all = 0.f;
        if (COMBINE) { es_all = a.tokes_c[t0 * 4 + lane]; w_all = a.tokw_c[t0 * 4 + lane]; }
        f32x4 xa[4], xb[4]; u32x2 ya[4][4], yb[4][4];
#define NP_LOAD(r, X, Y) do { const int t_ = t0 + (r); \
            _Pragma("unroll") for (int jj = 0; jj < 2; ++jj) { if (XBF) { const u32x4 p_ = *(const u32x4*)((const bf16_t*)a.xin + (size_t)t_ * DM + 512 * jj + 8 * lane); \
                    X[2 * jj] = (f32x4){bflo(p_.x), bfhi(p_.x), bflo(p_.y), bfhi(p_.y)}; X[2 * jj + 1] = (f32x4){bflo(p_.z), bfhi(p_.z), bflo(p_.w), bfhi(p_.w)}; } \
                else { X[2 * jj] = *(const f32x4*)((const float*)a.xin + (size_t)t_ * DM + 512 * jj + 8 * lane); X[2 * jj + 1] = *(const f32x4*)((const float*)a.xin + (size_t)t_ * DM + 512 * jj + 8 * lane + 4); } } \
            if (COMBINE) { _Pragma("unroll") for (int k = 0; k < TOPK; ++k) { const int es = __builtin_amdgcn_readlane(es_all, 4 * (r) + k); \
                const size_t row = (size_t)sbase[es >> 16] + (unsigned)(es & 0xffff); \
                _Pragma("unroll") for (int jj = 0; jj < 2; ++jj) { if (YP_FP8) { const u32x2 y_ = *(const u32x2*)((const unsigned char*)a.yp + row * 1024 + 512 * jj + 8 * lane); Y[k][2 * jj].x = y_.x; Y[k][2 * jj + 1].x = y_.y; } \
                    else { const u32x4 y_ = *(const u32x4*)(a.yp + row * 1024 + 512 * jj + 8 * lane); Y[k][2 * jj] = (u32x2){y_.x, y_.y}; Y[k][2 * jj + 1] = (u32x2){y_.z, y_.w}; } } } } } while (0)
#define NP_PROC(r, X, Y) do { const int t_ = t0 + (r); f32x4 v[4]; \
            _Pragma("unroll") for (int j = 0; j < 4; ++j) v[j] = X[j]; \
            if (COMBINE) { f32x4 y[4]; \
                _Pragma("unroll") for (int j = 0; j < 4; ++j) y[j] = (f32x4){0.f, 0.f, 0.f, 0.f}; \
                _Pragma("unroll") for (int k = 0; k < TOPK; ++k) { const float w = __builtin_bit_cast(float, __builtin_amdgcn_readlane(__builtin_bit_cast(int, w_all), 4 * (r) + k)); \
                    _Pragma("unroll") for (int j = 0; j < 4; ++j) { const u32x2 p = Y[k][j]; \
                        if (YP_FP8) { const f32x2 lo_ = __builtin_amdgcn_cvt_pk_f32_fp8((int)p.x, false), hi_ = __builtin_amdgcn_cvt_pk_f32_fp8((int)p.x, true); y[j] += (f32x4){lo_.x, lo_.y, hi_.x, hi_.y} * w; } \
                        else y[j] += (f32x4){bflo(p.x), bfhi(p.x), bflo(p.y), bfhi(p.y)} * w; } } \
                _Pragma("unroll") for (int j = 0; j < 4; ++j) v[j] += gfv[j] * y[j]; \
                _Pragma("unroll") for (int jj = 0; jj < 2; ++jj) { u32x4 q_; q_.x = pk2(v[2 * jj].x, v[2 * jj].y); q_.y = pk2(v[2 * jj].z, v[2 * jj].w); q_.z = pk2(v[2 * jj + 1].x, v[2 * jj + 1].y); q_.w = pk2(v[2 * jj + 1].z, v[2 * jj + 1].w); \
                    *(u32x4*)(a.xout + (size_t)t_ * DM + 512 * jj + 8 * lane) = q_; } } \
            float ss = 0.f; \
            _Pragma("unroll") for (int j = 0; j < 4; ++j) ss += (v[j].x * v[j].x + v[j].y * v[j].y) + (v[j].z * v[j].z + v[j].w * v[j].w); \
            const float rstd = rsqrtf(wave_sum(ss) * (1.0f / DM) + EPS); \
            _Pragma("unroll") for (int jj = 0; jj < 2; ++jj) { const f32x4 h0 = v[2 * jj] * rstd * gm[2 * jj] + shv[2 * jj], h1 = v[2 * jj + 1] * rstd * gm[2 * jj + 1] + shv[2 * jj + 1]; \
                if (FINAL) { *(f32x4*)(a.out + (size_t)t_ * DM + 512 * jj + 8 * lane) = h0; *(f32x4*)(a.out + (size_t)t_ * DM + 512 * jj + 8 * lane + 4) = h1; } \
                else { if (WANT_H16) { u32x4 p; p.x = pk2(h0.x, h0.y); p.y = pk2(h0.z, h0.w); p.z = pk2(h1.x, h1.y); p.w = pk2(h1.z, h1.w); *(u32x4*)(a.h + (size_t)t_ * DM + 512 * jj + 8 * lane) = p; } \
                    if (WANT_H8) { u32x2 p8; p8.x = pk4_fp8(h0.x, h0.y, h0.z, h0.w); p8.y = pk4_fp8(h1.x, h1.y, h1.z, h1.w); *(u32x2*)(a.h8 + (size_t)t_ * DM + 512 * jj + 8 * lane) = p8; } } } } while (0)
        f32x4 xc[4]; u32x2 yc[4][4];
        NP_LOAD(0, xa, ya); NP_LOAD(1, xb, yb);
#pragma unroll 1
        for (int r = 0; r < 15; r += 3) {
            NP_LOAD(r + 2, xc, yc);
            NP_PROC(r, xa, ya);
            NP_LOAD(r + 3, xa, ya);
            NP_PROC(r + 1, xb, yb);
            if (r + 4 < 16) NP_LOAD(r + 4, xb, yb);
            NP_PROC(r + 2, xc, yc);
        }
        NP_PROC(15, xa, ya);
#undef NP_LOAD
#undef NP_PROC
        }
        if (PROJ != 0) {
            constexpr int NT = (PROJ == 1) ? 2 : 1;
            VM_WAIT();
            f32x4 acc[NT];
#pragma unroll
            for (int n = 0; n < NT; ++n) acc[n] = (f32x4){0.f, 0.f, 0.f, 0.f};
            const bf16_t* ap = a.h + (size_t)(t0 + (lane & 15)) * DM + 8 * (lane >> 4);
            const bf16_t* bp = a.wt + (size_t)(lane & 15) * DM + 8 * (lane >> 4);
#pragma unroll 4
            for (int ks = 0; ks < 32; ++ks) {
                const bf16x8 av = *(const bf16x8*)(ap + 32 * ks);
#pragma unroll
                for (int n = 0; n < NT; ++n) {
                    const bf16x8 bh = *(const bf16x8*)(bp + (size_t)(16 * n) * DM + 32 * ks);
                    const bf16x8 bl = *(const bf16x8*)(bp + (size_t)(NT * 16 + 16 * n) * DM + 32 * ks);
                    acc[n] = __builtin_amdgcn_mfma_f32_16x16x32_bf16(av, bh, acc[n], 0, 0, 0);
                    acc[n] = __builtin_amdgcn_mfma_f32_16x16x32_bf16(av, bl, acc[n], 0, 0, 0);
                }
            }
            if (PROJ == 2) {
                if (active)
#pragma unroll
                for (int i = 0; i < 4; ++i) a.glow[(size_t)(t0 + 4 * (lane >> 4) + i) * 16 + (lane & 15)] = acc[0][i];
            } else {
#pragma unroll
                for (int n = 0; n < NT; ++n)
#pragma unroll
                    for (int i = 0; i < 4; ++i) lg[(4 * (lane >> 4) + i) * 34 + 16 * n + (lane & 15)] = acc[n][i];
                LDS_WAIT(); asm volatile("" ::: "memory");
                float tv[4]; int ti[4]; unsigned lr[4];
                const bool picker = active && lane < 16;
#pragma unroll
                for (int k = 0; k < 4; ++k) { tv[k] = 0.f; ti[k] = 0; lr[k] = 0u; }
                if (picker) {
                    float v[32];
#pragma unroll
                    for (int e = 0; e < 32; ++e) v[e] = lg[lane * 34 + e] + a.rb[e];
#pragma unroll
                    for (int k = 0; k < 4; ++k) {
                        float best = -3.0e38f; int bi = 0;
#pragma unroll
                        for (int e = 0; e < 32; ++e) { const bool gt = v[e] > best; best = gt ? v[e] : best; bi = gt ? e : bi; }
#pragma unroll
                        for (int e = 0; e < 32; ++e) v[e] = (e == bi) ? -3.0e38f : v[e];
                        tv[k] = best; ti[k] = bi;
                    }
#pragma unroll
                    for (int k = 0; k < 4; ++k) lr[k] = __hip_atomic_fetch_add(hist + ti[k], 1u, __ATOMIC_RELAXED, __HIP_MEMORY_SCOPE_WORKGROUP);
                }
                LDS_WAIT();
                __syncthreads();
                if (F.tid < 32) { const unsigned hc = hist[F.tid]; gbase[F.tid] = hc ? atomicAdd(a.cnt + F.tid * 64, hc) : 0u; hist[F.tid] = 0u; }
                LDS_WAIT();
                __syncthreads();
                if (picker) {
                    const int t = t0 + lane;
                    const float e1 = __expf(tv[1] - tv[0]), e2 = __expf(tv[2] - tv[0]), e3 = __expf(tv[3] - tv[0]);
                    const float inv = 1.0f / (1.0f + e1 + e2 + e3);
                    const float wk[4] = {inv, e1 * inv, e2 * inv, e3 * inv};
#pragma unroll
                    for (int k = 0; k < 4; ++k) {
                        const unsigned slot = gbase[ti[k]] + lr[k];
                        a.list[(size_t)ti[k] * T + slot] = (unsigned short)t;
                        a.tokes[t * 4 + k] = (ti[k] << 16) | (int)slot;
                        a.tokw[t * 4 + k] = wk[k];
                    }
                }
                LDS_WAIT();
                __syncthreads();
            }
        }
    }
}

template <int NPN, bool GATHER, bool FP8, class Epi, bool HOT = false, bool HOSTCVT = false>
__device__ __forceinline__ void moe_gemm_phase(Frame& F, const bf16_t* A, const bf16_t* Bt, const unsigned* cnt, const unsigned short* list, const Epi& E, const float* const* in = nullptr, unsigned char* ws = nullptr, int cvt_layer = -1, int w2_layer = -1) {
    BgCvt bgc; if constexpr (HOSTCVT) bgc.init(in, ws, F.bid * NWAVES + F.wave, F.G * NWAVES, F.lane, w2_layer, 16384, 24576, cvt_layer, 24576);
    LAS int* tb = (LAS int*)(F.lds + LDS_MISC + 512);
    LAS int* cn = (LAS int*)(F.lds + LDS_MISC + 768);
    LAS unsigned short* idx = (LAS unsigned short*)(F.lds + LDS_IDX);
    LAS int* utab = (LAS int*)(F.lds + LDS_IDX + 18 * 512);
    if (F.wave == 0) {
        const int c = F.lane < NEXP ? (int)cnt[F.lane * 64] : 0, t = (c + 255) >> 8;
        int incl = t;
#pragma unroll
        for (int d = 1; d < NEXP; d <<= 1) { const int v = __shfl_up(incl, d); if (F.lane >= d) incl += v; }
        if (F.lane < NEXP) { cn[F.lane] = c; tb[F.lane] = incl - t; }
        if (F.lane == NEXP - 1) tb[NEXP] = incl;
    }
    LDS_WAIT();
    __syncthreads();
    const int NT = tb[NEXP];
    const bool xcd_deal = (F.G % 8 == 0);
    const int ncls = xcd_deal ? 8 : 1, cls = xcd_deal ? (F.bid & 7) : 0, rank = xcd_deal ? (F.bid >> 3) : F.bid, W = F.G / ncls;
    const int r0 = (int)(((long)cls * NT) / ncls), r1 = (int)(((long)(cls + 1) * NT) / ncls);
    const int U = (r1 - r0) * NPN;
    int e = GATHER ? 0 : NEXP - 1;
    for (int i0 = 0; i0 * W + rank < U; i0 += 18) {
        if (i0 > 0) __syncthreads();
        int nmy = 0;
        int goff[18];
#pragma unroll
        for (int i = 0; i < 18; ++i) {
            goff[i] = 0;
            const int L = (i0 + i) * W + rank;
            if (L < U) {
                const int rt = GATHER ? (r0 + L / NPN) : (r1 - 1 - L / NPN), pl = L % NPN;
                if (GATHER) { while (e < NEXP - 1 && rt >= tb[e + 1]) ++e; } else { while (e > 0 && rt < tb[e]) --e; }
                if (F.tid == 0) { utab[2 * i] = HOT ? 0 : rt; utab[2 * i + 1] = HOT ? 0 : (e * NPN + pl); }
                if (GATHER) { int j = (rt - tb[e]) * 256 + (F.tid & 255); const int c = cn[e]; j = j < c ? j : c - 1; goff[i] = e * T + j; }
                nmy = i + 1;
            }
        }
        if (GATHER && F.tid < 256) {
            unsigned short lv[18];
#pragma unroll
            for (int i = 0; i < 18; ++i) lv[i] = (i < nmy) ? list[goff[i]] : (unsigned short)0;
#pragma unroll
            for (int i = 0; i < 18; ++i) if (i < nmy) idx[i * 256 + F.tid] = HOT ? (unsigned short)F.tid : lv[i];
        }
        VM_WAIT(); LDS_WAIT();
        __syncthreads();
        pg8::MoeOrder S; S.utab = utab; S.idx = idx; S.nmy = nmy;
        pg8::Gemm g{A, Bt, 0, 0, FP8 ? 512 : 1024};
        if constexpr (HOSTCVT) pg8::gemm_phase_bg<Epi, pg8::MoeOrder, GATHER, FP8, BgCvt>(F.lds, g, S, E, bgc);
        else pg8::gemm_phase<Epi, pg8::MoeOrder, GATHER, FP8>(F.lds, g, S, E);
    }
    if constexpr (HOSTCVT) bgc.finish();
}
template <int MODE, int ABL = 0>
__device__ __forceinline__ void s2_phase(Frame& F, const bf16_t* Q, const bf16_t* PT, const bf16_t* KT, const bf16_t* VT, const float* REC, bf16_t* mix,
                                         const float* const* in = nullptr, unsigned char* ws = nullptr, int cvt_layer = -1) {
    constexpr bool ML = (MODE == 2 || MODE == 3);
    constexpr int DK = MODE == 0 ? 256 : (MODE == 1 ? 128 : 512);
    constexpr int NER = (MODE == 1 || MODE == 3) ? 2 : 4;
    constexpr int NE = ML ? NER + 1 : NER;
    constexpr int NEB = (MODE == 3) ? 16 : 8;
    constexpr int EW = 16 * NER, MT = DK / 128, KS = DK / 32, NJ = (NE + 1) / 2;
    constexpr int KSE = (MODE == 2) ? KS / 2 : KS;
    constexpr int LDQ = MODE == 0 ? 6144 : (MODE == 1 ? 512 : 2048);
    constexpr int QH = MODE == 0 ? 256 : (MODE == 1 ? 128 : 512);
    constexpr int VH = MODE == 1 ? 256 : 512;
    constexpr int LDM = MODE == 1 ? 1024 : 2048;
    constexpr int LDS_ST = DK * 2 + 16, LDO = EW * 2 + 16;
    constexpr int VCOLS = ML ? EW + 16 : EW, LDV = VCOLS * 2 + 16;
    constexpr int LDVS = MODE == 0 ? 6144 : (MODE == 1 ? 3072 : 2048);
    constexpr int NROWS = ML ? EW + 2 : EW;
    constexpr int ST_BYTES = NROWS * LDS_ST, VT_BYTES = 64 * LDV;
    constexpr bool QLDS = (MODE == 2);
    constexpr int LDQL = 528;
    LAS unsigned char* ST = F.lds;
    LAS unsigned char* VTs = F.lds + ST_BYTES;
    LAS unsigned char* Os = VTs + 2 * VT_BYTES;
    LAS float* QN = (LAS float*)(Os + 64 * LDO);
    LAS float* RS = QN + 64;
    LAS float* NL = RS + 64;
    LAS float* BLA = NL + 512;
    LAS unsigned char* QL = (LAS unsigned char*)(BLA + 256);
    const int lane = F.lane, l15 = lane & 15, g = lane >> 4, w = F.wave, lt = w >> 1, eh = w & 1;
    const int nrow = EW + (l15 == 0 ? 0 : 1);
    constexpr int VPR = EW / 8;
    const int se = F.tid / VPR, sq = F.tid % VPR;
    const int tq = l15 >> 2, tp = l15 & 3;
    const bool stager = F.tid < 64 * VPR;
    const unsigned qs_lo = (unsigned)((F.tid >> 5) * LDQ + 8 * (F.tid & 31)) * 2u;
    const unsigned q_lo = (unsigned)((16 * lt + l15) * LDQ + 8 * g) * 2u, p_lo = (unsigned)((16 * lt + l15) * 64 + 8 * g) * 2u, v_lo = (unsigned)(se * LDVS + 8 * sq) * 2u, k_lo = (unsigned)lane * 16u;
    constexpr bool BG = (MODE == 0 || MODE == 1) && ABL == 0;
    const int gw_ = F.bid * NWAVES + F.wave, NGW_ = F.G * NWAVES;
    const int bg_n = (BG && cvt_layer >= 0) ? 2 * ((24576 + NGW_ - 1) / NGW_) : 0;
    const int bg_period = bg_n > 0 ? ((NCHUNK / bg_n) > 2 ? (NCHUNK / bg_n) : 2) : 1;
    int bg_done = 0;
    float bgx[32]; CvtJob bgj; bgj.wp = nullptr; bgj.op = nullptr; bgj.ld = 0; bool bg_pending = false;
    for (int u0 = F.bid; u0 < NB * 4 * NEB; u0 += F.G) {
        int eb, bh;
        if (F.G == 256) { const int x = u0 & 7, j = (u0 >> 3) & 31, r = u0 >> 8; bh = x * 4 + (j >> 3); eb = (j & 7) + 8 * r; }
        else { eb = u0 % NEB; bh = u0 / NEB; }
        const int h = bh & 3, b = bh >> 2;
        const size_t ubase = ((size_t)(b * 4 + h)) * NCHUNK;
        f32x4 S[MT][NER];
#pragma unroll
        for (int mt = 0; mt < MT; ++mt)
#pragma unroll
            for (int nt = 0; nt < NER; ++nt) S[mt][nt] = (f32x4){0.f, 0.f, 0.f, 0.f};
        if (ML) { NL[F.tid] = 0.f; }
        for (int i = F.tid; i < ST_BYTES / 4; i += NTHR) ((LAS unsigned*)ST)[i] = 0u;
        float vsc[8], rsi[4], rso[4], dec64 = 1.f;
        if (MODE == 0) {
            const float lg = log1pf(-exp2f(-5.0f - (float)h));
#pragma unroll
            for (int j = 0; j < 8; ++j) vsc[j] = __expf((float)(63 - se) * lg);
#pragma unroll
            for (int r = 0; r < 4; ++r) { const int l = 16 * lt + 4 * g + r; rsi[r] = __expf((float)(l - 63) * lg); rso[r] = __expf((float)(l + 1) * lg); }
            dec64 = __expf(64.0f * lg);
        }
        float m_prev = 0.f;
        bf16x8 qf[KS] = {}, pf[2] = {}, kf[MT][2] = {}; u32x4 qst[4] = {}; float recv = 0.f; u32x4 vraw = (u32x4){0u, 0u, 0u, 0u}; f32x4 z0 = (f32x4){0.f, 0.f, 0.f, 0.f}, z1 = z0, blv = z0, alv = z0, dcv = z0; float Amax = 0.f, blast = 0.f;
#define S2_PREFETCH(cc) do { const size_t uidx_ = ubase + (cc); const size_t t0_ = (size_t)b * SEQ + (size_t)(cc) * 64; \
          \
        if (stager) vraw = *(const u32x4*)((const char*)(VT + t0_ * LDVS + VH * h + EW * eb) + v_lo); \
        if (MODE == 1) dcv = *(const f32x4*)(REC + uidx_ * 128 + 16 * w + 4 * g); \
        if (ML) { const float* rec_ = REC + uidx_ * 192; z0.x = rec_[64 + (se & 63)]; \
            Amax = rec_[128 + 63]; blast = rec_[63]; if (F.tid < 128) recv = rec_[(F.tid < 64) ? F.tid : (64 + F.tid)]; } \
        _Pragma("unroll") for (int ks = 0; ks < 2; ++ks) pf[ks] = *(const bf16x8*)((const char*)(PT + uidx_ * 4096 + 32 * ks) + p_lo); \
        if (QLDS) { _Pragma("unroll") for (int i = 0; i < 4; ++i) qst[i] = *(const u32x4*)((const char*)(Q + (t0_ + 16 * i) * LDQ + QH * h) + qs_lo); } \
        if (ABL < 2 && !QLDS) { _Pragma("unroll") for (int ks = 0; ks < KSE; ++ks) qf[ks] = *(const bf16x8*)((const char*)(Q + t0_ * LDQ + QH * h + 32 * ks) + q_lo); } } while (0)
        S2_PREFETCH(0);
#define S2_VFRAG(dst, c0_, ks_) do { const LAS unsigned char* a_ = vt + (32 * (ks_) + 8 * g + tq) * LDV + 2 * ((c0_) + 4 * tp); \
        const s16x4 lo_ = __builtin_amdgcn_ds_read_tr16_b64_v4i16((LAS s16x4*)a_), hi_ = __builtin_amdgcn_ds_read_tr16_b64_v4i16((LAS s16x4*)(a_ + 4 * LDV)); \
        dst = (bf16x8){lo_.x, lo_.y, lo_.z, lo_.w, hi_.x, hi_.y, hi_.z, hi_.w}; } while (0)
        for (int c = 0; c < NCHUNK; ++c) {
            const size_t t0 = (size_t)b * SEQ + (size_t)c * 64;
            const size_t uidx = ubase + c;
            LAS unsigned char* vt = VTs + (c & 1) * VT_BYTES;
            const float Mx = fmaxf(m_prev, Amax), keep = ML ? __expf(m_prev - Mx) : 1.f, bl_c = blast;
            f32x4 blc = blv, alc = alv; const f32x4 dcc = dcv;
            if (stager) {
                u32x4 o = vraw;
                if (MODE != 1) {
                    float wrow = 1.f;
                    if (MODE == 0) wrow = vsc[0];
                    if (ML) wrow = __expf(z0.x - Mx);
                    o.x = pk2(bflo(vraw.x) * wrow, bfhi(vraw.x) * wrow); o.y = pk2(bflo(vraw.y) * wrow, bfhi(vraw.y) * wrow);
                    o.z = pk2(bflo(vraw.z) * wrow, bfhi(vraw.z) * wrow); o.w = pk2(bflo(vraw.w) * wrow, bfhi(vraw.w) * wrow);
                    if (ML && sq == 0) {
                        *(LAS u32x4*)(vt + se * LDV + 2 * EW) = (u32x4){pk2(wrow, 0.f), 0u, 0u, 0u};
                        *(LAS u32x4*)(vt + se * LDV + 2 * EW + 16) = (u32x4){0u, 0u, 0u, 0u}; }
                }
                *(LAS u32x4*)(vt + se * LDV + 16 * sq) = o;
            }
            asm volatile("" ::: "memory");
            if (QLDS) {
#pragma unroll
                for (int i = 0; i < 4; ++i) { const int p_ = F.tid + i * NTHR; *(LAS u32x4*)(QL + (p_ >> 5) * LDQL + 16 * (p_ & 31)) = qst[i]; }
                asm volatile("" ::: "memory");
#pragma unroll
                for (int ks = KS - KSE; ks < KS; ++ks) { if (ABL < 2) qf[ks] = *(const bf16x8*)((const char*)(Q + t0 * LDQ + QH * h + 32 * ks) + q_lo); }
            }
            if (ML) { if (F.tid < 128) BLA[(c & 1) * 128 + F.tid] = recv; }
            if (MODE != 2) {
#pragma unroll
                for (int mt = 0; mt < MT; ++mt)
#pragma unroll
                    for (int ks = 0; ks < 2; ++ks) if (ABL < 3) kf[mt][ks] = *(const bf16x8*)((const char*)(KT + uidx * (DK * 64) + ((((MT * w + mt) * 2 + ks) * 64) << 3)) + k_lo);
            }
            WG_SYNC_LDS();
            if (c > 0) {
                if (EW == 64) { const int r = F.tid >> 3, q = F.tid & 7; *(u32x4*)(mix + (t0 - 64 + r) * LDM + VH * h + EW * eb + 8 * q) = *(const LAS u32x4*)(Os + r * LDO + 16 * q); }
                else if (F.tid < 256) { const int r = F.tid >> 2, q = F.tid & 3; *(u32x4*)(mix + (t0 - 64 + r) * LDM + VH * h + EW * eb + 8 * q) = *(const LAS u32x4*)(Os + r * LDO + 16 * q); }
            }
            f32x4 oi[NJ], oo[NJ];
#pragma unroll
            for (int j = 0; j < NJ; ++j) { oi[j] = (f32x4){0.f, 0.f, 0.f, 0.f}; oo[j] = (f32x4){0.f, 0.f, 0.f, 0.f}; }
#pragma unroll
            for (int j = 0; j < NJ; ++j) { const int nt = eh + 2 * j;
                if (2 * j + 1 < NE || eh == 0) {
#pragma unroll
                    for (int ks = 0; ks < 2; ++ks) { bf16x8 vf; S2_VFRAG(vf, 16 * nt, ks);
                        if (ABL == 0) oi[j] = __builtin_amdgcn_mfma_f32_16x16x32_bf16(pf[ks], vf, oi[j], 0, 0, 0); else asm volatile("" :: "v"(vf), "v"(pf[ks])); } } }
#pragma unroll
            for (int ks = 0; ks < KS; ++ks) {
                bf16x8 qa;
                if (QLDS && ks < KS - KSE) qa = *(const LAS bf16x8*)(QL + (16 * lt + l15) * LDQL + 64 * ks + 16 * g); else qa = qf[ks];
#pragma unroll
                for (int j = 0; j < NJ; ++j) { const int nt = eh + 2 * j;
                    if ((2 * j + 1 < NE || eh == 0) && ABL < 4) { const bf16x8 sf = *(const LAS bf16x8*)(ST + ((ML && nt == NER) ? nrow : (16 * nt + l15)) * LDS_ST + 64 * ks + 16 * g);
                        if (ABL == 0) oo[j] = __builtin_amdgcn_mfma_f32_16x16x32_bf16(qa, sf, oo[j], 0, 0, 0); else asm volatile("" :: "v"(sf), "v"(qa)); } }
                if (MODE == 2 && (ks & 3) == 3) __builtin_amdgcn_sched_barrier(0);
            }
            if (ML) { if (((NE - 1) & 1) == eh && l15 == 0) {
#pragma unroll
                    for (int r = 0; r < 4; ++r) { QN[16 * lt + 4 * g + r] = oo[NJ - 1][r]; RS[16 * lt + 4 * g + r] = oi[NJ - 1][r]; } } }
            if (MODE == 2) {
#pragma unroll
                for (int mt = 0; mt < MT; ++mt)
#pragma unroll
                    for (int ks = 0; ks < 2; ++ks) if (ABL < 3) kf[mt][ks] = *(const bf16x8*)((const char*)(KT + uidx * (DK * 64) + ((((MT * w + mt) * 2 + ks) * 64) << 3)) + k_lo);
            }
            { const int cn = (c + 1 < NCHUNK) ? c + 1 : c; S2_PREFETCH(cn); }
            WG_SYNC_LDS();
            if (ML) { blc = *(const LAS f32x4*)(BLA + (c & 1) * 128 + 16 * lt + 4 * g); alc = *(const LAS f32x4*)(BLA + (c & 1) * 128 + 64 + 16 * lt + 4 * g); }
#pragma unroll
            for (int r = 0; r < 4; ++r) { const int l = 16 * lt + 4 * g + r;
                float ci = 1.f, co = 1.f;
                if (MODE == 0) { ci = rsi[r]; co = rso[r]; }
                if (ML) { const float Ml = fmaxf(m_prev, alc[r]), rho = __expf(Mx - Ml), wi = __expf(m_prev - Ml);
                    const float den = wi * QN[l] + rho * RS[l];
                    const float inv = 1.0f / fmaxf(fabsf(den), __expf(-(blc[r] + Ml)));
                    ci = rho * inv; co = wi * inv; }
#pragma unroll
                for (int j = 0; j < NER / 2; ++j) { const int nt = eh + 2 * j;
                    *(LAS unsigned short*)(Os + l * LDO + 2 * (16 * nt + l15)) = (unsigned short)f2bf(ci * oi[j][r] + co * oo[j][r]); } }
#pragma unroll
            for (int nt = 0; nt < NER; ++nt) {
                bf16x8 vf[2];
#pragma unroll
                for (int ks = 0; ks < 2; ++ks) S2_VFRAG(vf[ks], 16 * nt, ks);
#pragma unroll
                for (int mt = 0; mt < MT; ++mt) {
                    if (MODE == 0) S[mt][nt] = S[mt][nt] * dec64;
                    if (MODE == 1) S[mt][nt] = S[mt][nt] * dcc;
                    if (ML) S[mt][nt] = S[mt][nt] * keep;
#pragma unroll
                    for (int ks = 0; ks < 2; ++ks) { if (ABL == 0) S[mt][nt] = __builtin_amdgcn_mfma_f32_16x16x32_bf16(kf[mt][ks], vf[ks], S[mt][nt], 0, 0, 0); else asm volatile("" :: "v"(vf[ks]), "v"(kf[mt][ks])); }
                    u32x2 o; o.x = pk2(S[mt][nt][0], S[mt][nt][1]); o.y = pk2(S[mt][nt][2], S[mt][nt][3]);
                    if (ABL < 4) *(LAS u32x2*)(ST + (16 * nt + l15) * LDS_ST + 2 * (DK / 8 * w + 16 * mt + 4 * g)) = o; }
            }
            if (ML) {
                bf16x8 vf[2];
#pragma unroll
                for (int ks = 0; ks < 2; ++ks) S2_VFRAG(vf[ks], EW, ks);
#pragma unroll
                for (int mt = 0; mt < MT; ++mt) { const int d0 = DK / 8 * w + 16 * mt + 4 * g;
                    f32x4 na = (f32x4){0.f, 0.f, 0.f, 0.f};
                    if (l15 == 0) na = *(const LAS f32x4*)(NL + d0) * keep;
#pragma unroll
                    for (int ks = 0; ks < 2; ++ks) { if (ABL == 0) na = __builtin_amdgcn_mfma_f32_16x16x32_bf16(kf[mt][ks], vf[ks], na, 0, 0, 0); else asm volatile("" :: "v"(vf[ks]), "v"(kf[mt][ks])); }
                    if (l15 == 0) { *(LAS f32x4*)(NL + d0) = na; u32x2 o; o.x = pk2(na[0], na[1]); o.y = pk2(na[2], na[3]); *(LAS u32x2*)(ST + EW * LDS_ST + 2 * d0) = o; } }
            }
            if (ML) m_prev = bl_c + Mx;
            if (BG) {
                if (bg_pending) { cvt_half_store(bgj, bg_done & 1, bgx); bg_pending = false; ++bg_done; }
                else if (bg_done < bg_n && (c % bg_period) == 0) { const int gi = (bg_done >> 1) * NGW_ + gw_;
                    if (gi < 24576) { bgj = moe_cvt_job(in, ws, cvt_layer, gi, lane); cvt_half_load(bgj, bg_done & 1, bgx); bg_pending = true; } else ++bg_done; }
            }
        }
#undef S2_PREFETCH
#undef S2_VFRAG
        LDS_WAIT();
        __syncthreads();
        { const size_t t0 = (size_t)b * SEQ + (size_t)(NCHUNK - 1) * 64;
          if (EW == 64) { const int r = F.tid >> 3, q = F.tid & 7; *(u32x4*)(mix + (t0 + r) * LDM + VH * h + EW * eb + 8 * q) = *(const LAS u32x4*)(Os + r * LDO + 16 * q); }
          else if (F.tid < 256) { const int r = F.tid >> 2, q = F.tid & 3; *(u32x4*)(mix + (t0 + r) * LDM + VH * h + EW * eb + 8 * q) = *(const LAS u32x4*)(Os + r * LDO + 16 * q); } }
        LDS_WAIT();
        __syncthreads();
    }
    if (BG) {
        if (bg_pending) { cvt_half_store(bgj, bg_done & 1, bgx); ++bg_done; }
        for (; bg_done < bg_n; ++bg_done) { const int gi = (bg_done >> 1) * NGW_ + gw_;
            if (gi < 24576) { bgj = moe_cvt_job(in, ws, cvt_layer, gi, lane); cvt_half_load(bgj, bg_done & 1, bgx); cvt_half_store(bgj, bg_done & 1, bgx); } }
    }
}

template <int MODE>
__device__ __forceinline__ void s2x_phase(Frame& F, const bf16_t* Q, const bf16_t* PT, const bf16_t* KT, const bf16_t* VT, const float* REC, bf16_t* mix) {
    constexpr int DK = MODE == 0 ? 256 : 128, NER = MODE == 0 ? 4 : 2, EW = 16 * NER, KS = DK / 32, MTY = DK / 64, NEB = 8;
    constexpr int LDQ = MODE == 0 ? 6144 : 512, QH = MODE == 0 ? 256 : 128, VH = MODE == 1 ? 256 : 512, LDM = MODE == 1 ? 1024 : 2048;
    constexpr int LDS_ST = DK * 2 + 16, LDV = EW * 2 + 16, LDVS = MODE == 0 ? 6144 : 3072;
    constexpr int ST_BYTES = EW * LDS_ST, VT_BYTES = 64 * LDV, VPR = EW / 8;
    LAS unsigned char* ST = F.lds;
    LAS unsigned char* VTs = F.lds + 2 * ST_BYTES;
    const int lane = F.lane, l15 = lane & 15, g = lane >> 4, w = F.wave, lt = w & 3, yw = w & 3;
    const bool isX = w < 4;
    const int se = F.tid / VPR, sq = F.tid % VPR, tq = l15 >> 2, tp = l15 & 3;
    const bool stager = F.tid < 64 * VPR;
    unsigned q_lo = (unsigned)((16 * lt + l15) * LDQ + 8 * g) * 2u, p_lo = (unsigned)((16 * lt + l15) * 64 + 8 * g) * 2u, v_lo = (unsigned)(se * LDVS + 8 * sq) * 2u, k_lo = (unsigned)lane * 16u;
    unsigned o_lo = (unsigned)((16 * lt + l15) * LDM + 4 * NER * g) * 2u;
    for (int u0 = F.bid; u0 < NB * 4 * NEB; u0 += F.G) {
        int eb, bh;
        if (F.G == 256) { const int x = u0 & 7, j = (u0 >> 3) & 31, r = u0 >> 8; bh = x * 4 + (j >> 3); eb = (j & 7) + 8 * r; }
        else { eb = u0 % NEB; bh = u0 / NEB; }
        const int h = bh & 3, b = bh >> 2;
        const size_t ubase = ((size_t)(b * 4 + h)) * NCHUNK;
        for (int i = F.tid; i < 2 * ST_BYTES / 4; i += NTHR) ((LAS unsigned*)ST)[i] = 0u;
        float vsc = 1.f, rsi = 1.f, rso = 1.f, dec64 = 1.f;
        if (MODE == 0) {
            const float lg = log1pf(-exp2f(-5.0f - (float)h));
            vsc = __expf((float)(63 - se) * lg);
            { const int l = 16 * lt + l15; rsi = __expf((float)(l - 63) * lg); rso = __expf((float)(l + 1) * lg); }
            dec64 = __expf(64.0f * lg);
        }
#define S2X_CL(cc) ((cc) < NCHUNK ? (cc) : NCHUNK - 1)
#define S2X_LOADX(QF, PF, cc) do { const size_t uidx_ = ubase + (cc); const size_t t0_ = (size_t)b * SEQ + (size_t)(cc) * 64; \
        _Pragma("unroll") for (int ks = 0; ks < 2; ++ks) PF[ks] = *(const bf16x8*)((const char*)(PT + uidx_ * 4096 + 32 * ks) + p_lo); \
        _Pragma("unroll") for (int ks = 0; ks < KS; ++ks) QF[ks] = *(const bf16x8*)((const char*)(Q + t0_ * LDQ + QH * h + 32 * ks) + q_lo); } while (0)
#define S2X_LOADY(KF, DC, cc) do { const size_t uidx_ = ubase + (cc); \
        _Pragma("unroll") for (int mt = 0; mt < MTY; ++mt) { \
            _Pragma("unroll") for (int ks = 0; ks < 2; ++ks) KF[mt][ks] = *(const bf16x8*)((const char*)(KT + uidx_ * (DK * 64) + ((((MTY * yw + mt) * 2 + ks) * 64) << 3)) + k_lo); \
            if (MODE == 1) DC[mt] = *(const f32x4*)(REC + uidx_ * 128 + 16 * (MTY * yw + mt) + 4 * g); } } while (0)
#define S2X_LOADV(VR, cc) do { const size_t t0_ = (size_t)b * SEQ + (size_t)(cc) * 64; if (stager) VR = *(const u32x4*)((const char*)(VT + t0_ * LDVS + VH * h + EW * eb) + v_lo); } while (0)
#define S2X_STAGE(VR, vt_) do { if (stager) { u32x4 o = VR; \
            if (MODE == 0) { o.x = pk2(bflo(VR.x) * vsc, bfhi(VR.x) * vsc); o.y = pk2(bflo(VR.y) * vsc, bfhi(VR.y) * vsc); o.z = pk2(bflo(VR.z) * vsc, bfhi(VR.z) * vsc); o.w = pk2(bflo(VR.w) * vsc, bfhi(VR.w) * vsc); } \
            *(LAS u32x4*)((vt_) + se * LDV + 16 * sq) = o; } } while (0)
#define S2X_VFRAG(dst, nt_, ks_) do { const LAS unsigned char* a_ = vt + (32 * (ks_) + 8 * g + tq) * LDV + 2 * ((4 * NER) * tp + 4 * (nt_)); \
        const s16x4 lo_ = __builtin_amdgcn_ds_read_tr16_b64_v4i16((LAS s16x4*)a_), hi_ = __builtin_amdgcn_ds_read_tr16_b64_v4i16((LAS s16x4*)(a_ + 4 * LDV)); \
        dst = (bf16x8){lo_.x, lo_.y, lo_.z, lo_.w, hi_.x, hi_.y, hi_.z, hi_.w}; } while (0)
        u32x4 vrA = (u32x4){0u, 0u, 0u, 0u}, vrB = vrA;
        S2X_LOADV(vrA, 0);
        if (isX) {
            bf16x8 qfA[KS], pfA[2], qfB[KS], pfB[2];
            S2X_LOADX(qfA, pfA, 0); S2X_LOADV(vrB, 1); S2X_LOADX(qfB, pfB, 1);
            S2X_STAGE(vrA, VTs);
            S2X_LOADV(vrA, 2);
            WG_SYNC_LDS();
#define S2X_XBODY(QF, PF, VRN, c) do { \
                asm volatile("" : "+v"(q_lo), "+v"(p_lo), "+v"(v_lo), "+v"(o_lo)); \
                const size_t t0 = (size_t)b * SEQ + (size_t)(c) * 64; \
                LAS unsigned char* vt = VTs + ((c) & 1) * VT_BYTES; \
                const LAS unsigned char* STr = ST + (((c) + 1) & 1) * ST_BYTES;           \
                f32x4 oi[NER], oo[NER]; \
                _Pragma("unroll") for (int nt = 0; nt < NER; ++nt) { oi[nt] = (f32x4){0.f, 0.f, 0.f, 0.f}; oo[nt] = (f32x4){0.f, 0.f, 0.f, 0.f}; } \
                _Pragma("unroll") for (int nt = 0; nt < NER; ++nt) _Pragma("unroll") for (int ks = 0; ks < 2; ++ks) { bf16x8 vf; S2X_VFRAG(vf, nt, ks); oi[nt] = __builtin_amdgcn_mfma_f32_16x16x32_bf16(vf, PF[ks], oi[nt], 0, 0, 0); } \
                _Pragma("unroll") for (int ks = 0; ks < KS; ++ks) _Pragma("unroll") for (int nt = 0; nt < NER; ++nt) { const bf16x8 sf = *(const LAS bf16x8*)(STr + (16 * nt + l15) * LDS_ST + 64 * ks + 16 * g); \
                        oo[nt] = __builtin_amdgcn_mfma_f32_16x16x32_bf16(sf, QF[ks], oo[nt], 0, 0, 0); } \
                S2X_LOADX(QF, PF, S2X_CL((c) + 2)); \
                  \
                _Pragma("unroll") for (int n2 = 0; n2 < NER; n2 += 2) { const f32x4 ov0 = oi[n2] * rsi + oo[n2] * rso, ov1 = oi[n2 + 1] * rsi + oo[n2 + 1] * rso; \
                    u32x4 o; o.x = pk2(ov0[0], ov0[1]); o.y = pk2(ov0[2], ov0[3]); o.z = pk2(ov1[0], ov1[1]); o.w = pk2(ov1[2], ov1[3]); \
                    *(u32x4*)((char*)(mix + t0 * LDM + VH * h + EW * eb + 4 * n2) + o_lo) = o; } \
                S2X_STAGE(VRN, VTs + (((c) + 1) & 1) * VT_BYTES); \
                S2X_LOADV(VRN, S2X_CL((c) + 3)); \
                WG_SYNC_LDS(); } while (0)
            for (int c = 0; c < NCHUNK; c += 2) { S2X_XBODY(qfA, pfA, vrB, c); S2X_XBODY(qfB, pfB, vrA, c + 1); }
#undef S2X_XBODY
        } else {
            bf16x8 kfA[MTY][2], kfB[MTY][2]; f32x4 dcA[MTY], dcB[MTY]; f32x4 S[MTY][NER];
#pragma unroll
            for (int mt = 0; mt < MTY; ++mt) { dcA[mt] = (f32x4){1.f, 1.f, 1.f, 1.f}; dcB[mt] = dcA[mt];
#pragma unroll
                for (int nt = 0; nt < NER; ++nt) S[mt][nt] = (f32x4){0.f, 0.f, 0.f, 0.f}; }
            S2X_LOADY(kfA, dcA, 0); S2X_LOADV(vrB, 1); S2X_LOADY(kfB, dcB, 1);
            S2X_STAGE(vrA, VTs);
            S2X_LOADV(vrA, 2);
            WG_SYNC_LDS();
#define S2X_YBODY(KF, DC, VRN, c) do { \
                asm volatile("" : "+v"(k_lo), "+v"(v_lo)); \
                LAS unsigned char* vt = VTs + ((c) & 1) * VT_BYTES; \
                LAS unsigned char* STw = ST + ((c) & 1) * ST_BYTES; \
                _Pragma("unroll") for (int nt = 0; nt < NER; ++nt) { \
                    bf16x8 vf[2]; \
                    _Pragma("unroll") for (int ks = 0; ks < 2; ++ks) S2X_VFRAG(vf[ks], nt, ks); \
                    _Pragma("unroll") for (int mt = 0; mt < MTY; ++mt) { \
                        if (MODE == 0) S[mt][nt] = S[mt][nt] * dec64; else S[mt][nt] = S[mt][nt] * DC[mt]; \
                        _Pragma("unroll") for (int ks = 0; ks < 2; ++ks) S[mt][nt] = __builtin_amdgcn_mfma_f32_16x16x32_bf16(KF[mt][ks], vf[ks], S[mt][nt], 0, 0, 0); \
                        u32x2 o; o.x = pk2(S[mt][nt][0], S[mt][nt][1]); o.y = pk2(S[mt][nt][2], S[mt][nt][3]); \
                        *(LAS u32x2*)(STw + (16 * nt + l15) * LDS_ST + 2 * (16 * (MTY * yw + mt) + 4 * g)) = o; } } \
                S2X_LOADY(KF, DC, S2X_CL((c) + 2)); \
                S2X_STAGE(VRN, VTs + (((c) + 1) & 1) * VT_BYTES); \
                S2X_LOADV(VRN, S2X_CL((c) + 3)); \
                WG_SYNC_LDS(); } while (0)
            for (int c = 0; c < NCHUNK; c += 2) { S2X_YBODY(kfA, dcA, vrB, c); S2X_YBODY(kfB, dcB, vrA, c + 1); }
#undef S2X_YBODY
        }
#undef S2X_CL
#undef S2X_LOADX
#undef S2X_LOADY
#undef S2X_LOADV
#undef S2X_STAGE
#undef S2X_VFRAG
    }
}

__device__ __forceinline__ void s2m_phase(Frame& F, const bf16_t* Q, const bf16_t* PT, const bf16_t* KT, const bf16_t* VT, const float* REC, bf16_t* mix) {
    constexpr int DK = 512, NER = 4, NE = 5, EW = 64, KS = 16, MTY = 8, NEB = 8;
    constexpr int LDQ = 2048, QH = 512, VH = 512, LDM = 2048, LDVS = 2048;
    constexpr int LDS_ST = DK * 2 + 16, VCOLS = EW + 16, LDV = VCOLS * 2 + 16, NROWS = EW + 2;
    constexpr int ST_BYTES = NROWS * LDS_ST, VT_BYTES = 64 * LDV;
    LAS unsigned char* ST = F.lds;
    LAS unsigned char* VTs = F.lds + 2 * ST_BYTES;
    LAS float* NL = (LAS float*)(VTs + 2 * VT_BYTES);
    static_assert(2 * ST_BYTES + 2 * VT_BYTES + 2048 <= LDS_MISC, "s2m LDS");
    const int lane = F.lane, l15 = lane & 15, g = lane >> 4, w = F.wave, lt = w & 3, yw = w & 3;
    const bool isX = w < 4;
    const int se = (F.tid & 255) >> 2, sq = 2 * (F.tid & 3), tq = l15 >> 2, tp = l15 & 3;
    const int nrow = EW + (l15 == 0 ? 0 : 1);
    unsigned q_lo = (unsigned)((16 * lt + l15) * LDQ + 8 * g) * 2u, p_lo = (unsigned)((16 * lt + l15) * 64 + 8 * g) * 2u, v_lo = (unsigned)(se * LDVS + 8 * sq) * 2u, k_lo = (unsigned)lane * 16u;
    unsigned o_lo = (unsigned)((16 * lt + l15) * LDM + 4 * g) * 2u;
    unsigned rb_lo = (unsigned)(16 * lt + l15) * 4u, rz_lo = (unsigned)(64 + se) * 4u;
    unsigned st_lo = (unsigned)(l15 * LDS_ST + 2 * (16 * MTY * yw + 4 * g)), nl_lo = (unsigned)(4 * (16 * MTY * yw + 4 * g)), sn_lo = (unsigned)(EW * LDS_ST + 2 * (16 * MTY * yw + 4 * g));
    for (int u0 = F.bid; u0 < NB * 4 * NEB; u0 += F.G) {
        int eb, bh;
        if (F.G == 256) { const int x = u0 & 7, j = (u0 >> 3) & 31, r = u0 >> 8; bh = x * 4 + (j >> 3); eb = (j & 7) + 8 * r; }
        else { eb = u0 % NEB; bh = u0 / NEB; }
        const int h = bh & 3, b = bh >> 2;
        const size_t ubase = ((size_t)(b * 4 + h)) * NCHUNK;
        for (int i = F.tid; i < 2 * ST_BYTES / 4; i += NTHR) ((LAS unsigned*)ST)[i] = 0u;
        NL[F.tid] = 0.f;
        u32x4 vraw[2] = {(u32x4){0u, 0u, 0u, 0u}, (u32x4){0u, 0u, 0u, 0u}}; float z_s = 0.f, Amax_s = 0.f, blast_s = 0.f;
#define S2M_RFL(x) __builtin_bit_cast(float, __builtin_amdgcn_readfirstlane(__builtin_bit_cast(int, (float)(x))))
#define S2M_LOADS(cc) do { const float* rec_ = REC + (ubase + (cc)) * 192; Amax_s = rec_[128 + 63]; blast_s = rec_[63]; } while (0)
#define S2M_LOADV(cc) do { const size_t t0_ = (size_t)b * SEQ + (size_t)(cc) * 64; const float* rec_ = REC + (ubase + (cc)) * 192; \
        vraw[0] = *(const u32x4*)((const char*)(VT + t0_ * LDVS + VH * h + EW * eb) + v_lo); vraw[1] = *(const u32x4*)((const char*)(VT + t0_ * LDVS + VH * h + EW * eb + 8) + v_lo); \
        z_s = *(const float*)((const char*)rec_ + rz_lo); Amax_s = rec_[128 + 63]; blast_s = rec_[63]; } while (0)
#define S2M_STAGE(vt_, Mx_) do { const float wrow = __expf(z_s - (Mx_)); \
        _Pragma("unroll") for (int i_ = 0; i_ < 2; ++i_) { u32x4 o; const u32x4 vr_ = vraw[i_]; \
            o.x = pk2(bflo(vr_.x) * wrow, bfhi(vr_.x) * wrow); o.y = pk2(bflo(vr_.y) * wrow, bfhi(vr_.y) * wrow); o.z = pk2(bflo(vr_.z) * wrow, bfhi(vr_.z) * wrow); o.w = pk2(bflo(vr_.w) * wrow, bfhi(vr_.w) * wrow); \
            *(LAS u32x4*)((vt_) + se * LDV + 16 * (sq + i_)) = o; } \
        if (sq == 0) { *(LAS u32x4*)((vt_) + se * LDV + 2 * EW) = (u32x4){pk2(wrow, 0.f), 0u, 0u, 0u}; *(LAS u32x4*)((vt_) + se * LDV + 2 * EW + 16) = (u32x4){0u, 0u, 0u, 0u}; } } while (0)
#define S2M_VFRAG(dst, c0_, ks_) do { const LAS unsigned char* a_ = vt + (32 * (ks_) + 8 * g + tq) * LDV + 2 * ((c0_) + 4 * tp); \
        const s16x4 lo_ = __builtin_amdgcn_ds_read_tr16_b64_v4i16((LAS s16x4*)a_), hi_ = __builtin_amdgcn_ds_read_tr16_b64_v4i16((LAS s16x4*)(a_ + 4 * LDV)); \
        dst = (bf16x8){lo_.x, lo_.y, lo_.z, lo_.w, hi_.x, hi_.y, hi_.z, hi_.w}; } while (0)
        float m_prev = 0.f, Mx, keep, bl_c;
        if (isX) { S2M_LOADV(0); } else { S2M_LOADS(0); }
        Mx = S2M_RFL(fmaxf(m_prev, Amax_s)); keep = S2M_RFL(__expf(m_prev - Mx)); bl_c = S2M_RFL(blast_s);
        if (isX) { S2M_STAGE(VTs, Mx); S2M_LOADV(1); } else { S2M_LOADS(1); }
#define S2M_ADVANCE(XR) do { const float m_next = S2M_RFL(bl_c + Mx), Mx_next = S2M_RFL(fmaxf(m_next, Amax_s)), bl_next = S2M_RFL(blast_s); \
        if (XR) { S2M_STAGE(VTs + ((c + 1) & 1) * VT_BYTES, Mx_next); S2M_LOADV(cn2); } else { S2M_LOADS(cn2); } \
        m_prev = m_next; Mx = Mx_next; keep = S2M_RFL(__expf(m_prev - Mx)); bl_c = bl_next; } while (0)
        if (isX) {
            bf16x8 qf[KS], pf[2]; float b_l, a_l;
#define S2M_LOADX(cc) do { const size_t uidx_ = ubase + (cc); const size_t t0_ = (size_t)b * SEQ + (size_t)(cc) * 64; const float* rec_ = REC + uidx_ * 192; \
            _Pragma("unroll") for (int ks = 0; ks < 2; ++ks) pf[ks] = *(const bf16x8*)((const char*)(PT + uidx_ * 4096 + 32 * ks) + p_lo); \
            _Pragma("unroll") for (int ks = 0; ks < KS; ++ks) qf[ks] = *(const bf16x8*)((const char*)(Q + t0_ * LDQ + QH * h + 32 * ks) + q_lo); \
            b_l = *(const float*)((const char*)rec_ + rb_lo); a_l = *(const float*)((const char*)(rec_ + 128) + rb_lo); } while (0)
            S2M_LOADX(0);
            WG_SYNC_LDS();
            for (int c = 0; c < NCHUNK; ++c) {
                asm volatile("" : "+v"(q_lo), "+v"(p_lo), "+v"(v_lo), "+v"(rb_lo), "+v"(rz_lo), "+v"(o_lo));
                const size_t t0 = (size_t)b * SEQ + (size_t)c * 64;
                const int cn = (c + 1 < NCHUNK) ? c + 1 : c, cn2 = (c + 2 < NCHUNK) ? c + 2 : NCHUNK - 1;
                LAS unsigned char* vt = VTs + (c & 1) * VT_BYTES;
                const LAS unsigned char* STr = ST + ((c + 1) & 1) * ST_BYTES;
                f32x4 oi[NE], oo[NE];
#pragma unroll
                for (int nt = 0; nt < NE; ++nt) { oi[nt] = (f32x4){0.f, 0.f, 0.f, 0.f}; oo[nt] = (f32x4){0.f, 0.f, 0.f, 0.f}; }
#pragma unroll
                for (int nt = 0; nt < NE; ++nt)
#pragma unroll
                    for (int ks = 0; ks < 2; ++ks) { bf16x8 vf; S2M_VFRAG(vf, 16 * nt, ks); oi[nt] = __builtin_amdgcn_mfma_f32_16x16x32_bf16(vf, pf[ks], oi[nt], 0, 0, 0); }
#pragma unroll
                for (int ks = 0; ks < KS; ++ks) {
#pragma unroll
                    for (int nt = 0; nt < NE; ++nt) { const bf16x8 sf = *(const LAS bf16x8*)(STr + ((nt == NER) ? nrow : (16 * nt + l15)) * LDS_ST + 64 * ks + 16 * g);
                        oo[nt] = __builtin_amdgcn_mfma_f32_16x16x32_bf16(sf, qf[ks], oo[nt], 0, 0, 0); }
                    if ((ks & 3) == 3) __builtin_amdgcn_sched_barrier(0);
                }
                const float QNl = __shfl(oo[NER][0], l15), RSl = __shfl(oi[NER][0], l15);
                const float Ml = fmaxf(m_prev, a_l), rho = __expf(Mx - Ml), wi = __expf(m_prev - Ml);
                const float den = wi * QNl + rho * RSl;
                const float inv = 1.0f / fmaxf(fabsf(den), __expf(-(b_l + Ml)));
                const float ci = rho * inv, co = wi * inv;
#pragma unroll
                for (int nt = 0; nt < NER; ++nt) { const f32x4 ov = oi[nt] * ci + oo[nt] * co;
                    u32x2 o; o.x = pk2(ov[0], ov[1]); o.y = pk2(ov[2], ov[3]);
                    *(u32x2*)((char*)(mix + t0 * LDM + VH * h + EW * eb + 16 * nt) + o_lo) = o; }
                S2M_LOADX(cn);
                S2M_ADVANCE(true);
                WG_SYNC_LDS();
            }
#undef S2M_LOADX
        } else {
            bf16x8 kf[MTY][2]; f32x4 S[MTY][NER];
#pragma unroll
            for (int mt = 0; mt < MTY; ++mt)
#pragma unroll
                for (int nt = 0; nt < NER; ++nt) S[mt][nt] = (f32x4){0.f, 0.f, 0.f, 0.f};
#define S2M_LOADY(cc) do { const size_t uidx_ = ubase + (cc); \
            _Pragma("unroll") for (int mt = 0; mt < MTY; ++mt) _Pragma("unroll") for (int ks = 0; ks < 2; ++ks) \
                kf[mt][ks] = *(const bf16x8*)((const char*)(KT + uidx_ * (DK * 64) + ((((MTY * yw + mt) * 2 + ks) * 64) << 3)) + k_lo); } while (0)
            S2M_LOADY(0);
            WG_SYNC_LDS();
            for (int c = 0; c < NCHUNK; ++c) {
                asm volatile("" : "+v"(k_lo), "+v"(st_lo), "+v"(nl_lo), "+v"(sn_lo));
                const int cn = (c + 1 < NCHUNK) ? c + 1 : c, cn2 = (c + 2 < NCHUNK) ? c + 2 : NCHUNK - 1;
                LAS unsigned char* vt = VTs + (c & 1) * VT_BYTES;
                LAS unsigned char* STw = ST + (c & 1) * ST_BYTES;
#pragma unroll
                for (int nt = 0; nt < NER; ++nt) {
                    bf16x8 vf[2];
#pragma unroll
                    for (int ks = 0; ks < 2; ++ks) S2M_VFRAG(vf[ks], 16 * nt, ks);
#pragma unroll
                    for (int mt = 0; mt < MTY; ++mt) {
                        S[mt][nt] = S[mt][nt] * keep;
#pragma unroll
                        for (int ks = 0; ks < 2; ++ks) S[mt][nt] = __builtin_amdgcn_mfma_f32_16x16x32_bf16(kf[mt][ks], vf[ks], S[mt][nt], 0, 0, 0);
                        u32x2 o; o.x = pk2(S[mt][nt][0], S[mt][nt][1]); o.y = pk2(S[mt][nt][2], S[mt][nt][3]);
                        *(LAS u32x2*)(STw + st_lo + (16 * nt * LDS_ST + 32 * mt)) = o; }
                }
                {
                    bf16x8 vf[2];
#pragma unroll
                    for (int ks = 0; ks < 2; ++ks) S2M_VFRAG(vf[ks], EW, ks);
#pragma unroll
                    for (int mt = 0; mt < MTY; ++mt) {
                        f32x4 na = (f32x4){0.f, 0.f, 0.f, 0.f};
                        if (l15 == 0) na = *(const LAS f32x4*)((LAS unsigned char*)NL + nl_lo + 64 * mt) * keep;
#pragma unroll
                        for (int ks = 0; ks < 2; ++ks) na = __builtin_amdgcn_mfma_f32_16x16x32_bf16(kf[mt][ks], vf[ks], na, 0, 0, 0);
                        if (l15 == 0) { *(LAS f32x4*)((LAS unsigned char*)NL + nl_lo + 64 * mt) = na; u32x2 o; o.x = pk2(na[0], na[1]); o.y = pk2(na[2], na[3]); *(LAS u32x2*)(STw + sn_lo + 32 * mt) = o; } }
                }
                S2M_LOADY(cn);
                S2M_ADVANCE(false);
                WG_SYNC_LDS();
            }
#undef S2M_LOADY
        }
#undef S2M_ADVANCE
#undef S2M_LOADV
#undef S2M_LOADS
#undef S2M_RFL
#undef S2M_STAGE
#undef S2M_VFRAG
    }
}
template <int MODE>
__device__ __forceinline__ void hn_phase(Frame& F, const bf16_t* mix, const bf16_t* gate, const bf16_t* xc, const float* gn, const float* skip, bf16_t* amix) {
    constexpr int HD = MODE == 1 ? 256 : 512, NV = HD / 64;
    constexpr int LDM = 4 * HD;
    constexpr int LDG = MODE == 0 ? 6144 : (MODE == 1 ? 3072 : 4096), GOFF = MODE == 0 ? 4096 : 2048;
    const int gw = F.bid * NWAVES + F.wave, NGW = F.G * NWAVES, lane = F.lane;
    for (int t = gw; t < T; t += NGW) {
        float v[4][NV], gv[4][NV], xv[4][NV];
#pragma unroll
        for (int h = 0; h < 4; ++h) {
            if (NV == 8) {
                const u32x4 a = *(const u32x4*)(mix + (size_t)t * LDM + HD * h + 8 * lane), b = *(const u32x4*)(gate + (size_t)t * LDG + GOFF + HD * h + 8 * lane);
                v[h][0] = bflo(a.x); v[h][1] = bfhi(a.x); v[h][2] = bflo(a.y); v[h][3] = bfhi(a.y); v[h][4 % NV] = bflo(a.z); v[h][5 % NV] = bfhi(a.z); v[h][6 % NV] = bflo(a.w); v[h][7 % NV] = bfhi(a.w);
                gv[h][0] = bflo(b.x); gv[h][1] = bfhi(b.x); gv[h][2] = bflo(b.y); gv[h][3] = bfhi(b.y); gv[h][4 % NV] = bflo(b.z); gv[h][5 % NV] = bfhi(b.z); gv[h][6 % NV] = bflo(b.w); gv[h][7 % NV] = bfhi(b.w);
                if (MODE == 2) { const u32x4 c = *(const u32x4*)(xc + (size_t)t * LDM + HD * h + 8 * lane);
                    xv[h][0] = bflo(c.x); xv[h][1] = bfhi(c.x); xv[h][2] = bflo(c.y); xv[h][3] = bfhi(c.y); xv[h][4 % NV] = bflo(c.z); xv[h][5 % NV] = bfhi(c.z); xv[h][6 % NV] = bflo(c.w); xv[h][7 % NV] = bfhi(c.w); }
            } else {
                const u32x2 a = *(const u32x2*)(mix + (size_t)t * LDM + HD * h + 4 * lane), b = *(const u32x2*)(gate + (size_t)t * LDG + GOFF + HD * h + 4 * lane);
                v[h][0] = bflo(a.x); v[h][1] = bfhi(a.x); v[h][2] = bflo(a.y); v[h][3] = bfhi(a.y);
                gv[h][0] = bflo(b.x); gv[h][1] = bfhi(b.x); gv[h][2] = bflo(b.y); gv[h][3] = bfhi(b.y);
            }
        }
#pragma unroll
        for (int h = 0; h < 4; ++h) {
            if (MODE != 1) { float s = 0.f;
#pragma unroll
                for (int j = 0; j < NV; ++j) s += v[h][j];
                const float mean = wave_sum(s) * (1.0f / HD);
#pragma unroll
                for (int j = 0; j < NV; ++j) v[h][j] -= mean; }
            float q = 0.f;
#pragma unroll
            for (int j = 0; j < NV; ++j) q += v[h][j] * v[h][j];
            const float rstd = rsqrtf(wave_sum(q) * (1.0f / HD) + EPS);
            float o[NV];
#pragma unroll
            for (int j = 0; j < NV; ++j) { const int ch = HD * h + NV * lane + j;
                float y = v[h][j] * rstd * gn[ch];
                if (MODE == 2) y += skip[ch] * xv[h][j];
                o[j] = y * siluf_(gv[h][j]); }
            if (OUT_FP8) { unsigned char* a8 = (unsigned char*)amix;
                if (NV == 8) { u32x2 ow; ow.x = pk4_fp8(o[0], o[1], o[2], o[3]); ow.y = pk4_fp8(o[4 % NV], o[5 % NV], o[6 % NV], o[7 % NV]); *(u32x2*)(a8 + (size_t)t * LDM + HD * h + 8 * lane) = ow; }
                else *(unsigned*)(a8 + (size_t)t * LDM + HD * h + 4 * lane) = pk4_fp8(o[0], o[1], o[2], o[3]); }
            else if (NV == 8) { u32x4 ow; ow.x = pk2(o[0], o[1]); ow.y = pk2(o[2], o[3]); ow.z = pk2(o[4 % NV], o[5 % NV]); ow.w = pk2(o[6 % NV], o[7 % NV]);
                *(u32x4*)(amix + (size_t)t * LDM + HD * h + 8 * lane) = ow; }
            else { u32x2 ow; ow.x = pk2(o[0], o[1]); ow.y = pk2(o[2], o[3]); *(u32x2*)(amix + (size_t)t * LDM + HD * h + 4 * lane) = ow; }
        }
    }
}
__device__ __forceinline__ int kt_off(int d, int m) { return ((((d >> 4) * 2 + (m >> 5)) * 64 + 16 * ((m >> 3) & 3) + (d & 15)) << 3) + (m & 7); }

template <int NC, bool FRAG>
__device__ __forceinline__ void s1_write_transposed(const LAS unsigned char* src, int ldb, bf16_t* dst, int tid) {
    for (int p = tid; p < NC * 8; p += NTHR) {
        const int col = p % NC, mc = p / NC;
        unsigned short v[8];
#pragma unroll
        for (int e = 0; e < 8; ++e) v[e] = *(const LAS unsigned short*)(src + (size_t)(8 * mc + e) * ldb + 2 * col);
        u32x4 w; w.x = v[0] | ((unsigned)v[1] << 16); w.y = v[2] | ((unsigned)v[3] << 16); w.z = v[4] | ((unsigned)v[5] << 16); w.w = v[6] | ((unsigned)v[7] << 16);
        const int off = FRAG ? kt_off(col, 8 * mc) : (col * 64 + 8 * mc);
        *(u32x4*)(dst + off) = w;
    }
}
template <int DK>
__device__ __forceinline__ void s1_write_kt_tr(const LAS unsigned char* src, int ldb, bf16_t* dst, int wave, int lane) {
    const int l15 = lane & 15, g = lane >> 4, q = l15 >> 2, p = l15 & 3;
#pragma unroll
    for (int f = wave; f < (DK / 16) * 2; f += NWAVES) {
        const int dt = f >> 1, ks = f & 1;
        const LAS unsigned char* a = src + (32 * ks + 8 * g + q) * ldb + 2 * (16 * dt + 4 * p);
        const s16x4 lo = __builtin_amdgcn_ds_read_tr16_b64_v4i16((LAS s16x4*)a), hi = __builtin_amdgcn_ds_read_tr16_b64_v4i16((LAS s16x4*)(a + 4 * ldb));
        const bf16x8 v = (bf16x8){lo.x, lo.y, lo.z, lo.w, hi.x, hi.y, hi.z, hi.w};
        *(bf16x8*)(dst + ((size_t)f * 64 + lane) * 8) = v;
    }
}
template <int NC>
__device__ __forceinline__ void s1_load_tile(const bf16_t* src, int ld, LAS unsigned char* dst, int ldb, int tid) {
    constexpr int PPR = NC / 8;
    for (int p = tid; p < 64 * PPR; p += NTHR) { const int r = p / PPR, q = p % PPR;
        *(LAS u32x4*)(dst + (size_t)r * ldb + 16 * q) = *(const u32x4*)(src + (size_t)r * ld + 8 * q); }
}

template <int NC>
__device__ __forceinline__ void s1_gload(const bf16_t* src, int ld, u32x4 (&r)[64 * NC / 8 / NTHR], int tid) {
    constexpr int PPR = NC / 8;
#pragma unroll
    for (int i = 0; i < 64 * NC / 8 / NTHR; ++i) { const int p = tid + i * NTHR, row = p / PPR, q = p % PPR; r[i] = *(const u32x4*)(src + (size_t)row * ld + 8 * q); }
}
template <int NC>
__device__ __forceinline__ void s1_lstore(const u32x4 (&r)[64 * NC / 8 / NTHR], LAS unsigned char* dst, int ldb, int tid) {
    constexpr int PPR = NC / 8;
#pragma unroll
    for (int i = 0; i < 64 * NC / 8 / NTHR; ++i) { const int p = tid + i * NTHR, row = p / PPR, q = p % PPR; *(LAS u32x4*)(dst + (size_t)row * ldb + 16 * q) = r[i]; }
}
__device__ __forceinline__ void ret_s1_phase(Frame& F, const bf16_t* proj, bf16_t* PT, bf16_t* KT, bf16_t* VT) {
    constexpr int LDK = 528, LDV = 1040, LDP = 144;
    LAS unsigned char* Ks = F.lds;
    LAS unsigned char* Vs = F.lds + 33792;
    LAS unsigned char* Ps = F.lds + 33792 + 66560;
    const int lane = F.lane, l15 = lane & 15, g = lane >> 4, w = F.wave, lt = w >> 1, mh = w & 1;
    u32x4 kr[4]; bf16x8 qf[8];
#define RS1_LOAD(uu) do { const int c_ = (uu) % NCHUNK, h_ = ((uu) / NCHUNK) % 4, b_ = (uu) / (NCHUNK * 4); const size_t t0_ = (size_t)b_ * SEQ + (size_t)c_ * 64; \
        s1_gload<256>(proj + t0_ * 6144 + 1024 + 256 * h_, 6144, kr, F.tid); \
        _Pragma("unroll") for (int ks = 0; ks < 8; ++ks) qf[ks] = *(const bf16x8*)(proj + (t0_ + 16 * lt + l15) * 6144 + 256 * h_ + 32 * ks + 8 * g); } while (0)
    if (F.bid < NB * 4 * NCHUNK) RS1_LOAD(F.bid);
    for (int u = F.bid; u < NB * 4 * NCHUNK; u += F.G) {
        s1_lstore<256>(kr, Ks, LDK, F.tid);
        WG_SYNC_LDS();
        f32x4 acc[2];
#pragma unroll
        for (int nt = 0; nt < 2; ++nt) { acc[nt] = (f32x4){0.f, 0.f, 0.f, 0.f};
#pragma unroll
            for (int ks = 0; ks < 8; ++ks) { const bf16x8 kf = *(const LAS bf16x8*)(Ks + (size_t)(32 * mh + 16 * nt + l15) * LDK + 64 * ks + 16 * g);
                acc[nt] = __builtin_amdgcn_mfma_f32_16x16x32_bf16(qf[ks], kf, acc[nt], 0, 0, 0); } }
#pragma unroll
        for (int nt = 0; nt < 2; ++nt)
#pragma unroll
            for (int r = 0; r < 4; ++r) { const int l = 16 * lt + 4 * g + r, m = 32 * mh + 16 * nt + l15;
                *(LAS unsigned short*)(Ps + l * LDP + 2 * m) = (unsigned short)f2bf(m <= l ? acc[nt][r] : 0.f); }
        { const int un = u + F.G; if (un < NB * 4 * NCHUNK) RS1_LOAD(un); }
        WG_SYNC_LDS();
        { const int r = F.tid >> 3, q = F.tid & 7; *(u32x4*)(PT + (size_t)u * 4096 + r * 64 + 8 * q) = *(const LAS u32x4*)(Ps + r * LDP + 16 * q); }
        s1_write_kt_tr<256>(Ks, LDK, KT + (size_t)u * 256 * 64, F.wave, lane);
        WG_SYNC_LDS();
    }
#undef RS1_LOAD
}

__device__ __forceinline__ void ret_s2_phase(Frame& F, const bf16_t* proj, const bf16_t* PT, const bf16_t* KT, const bf16_t* VT, bf16_t* mix) {
    constexpr int LDS_ST = 528, LDV = 144, LDO = 144;
    LAS unsigned char* ST = F.lds;
    LAS unsigned char* VTs = F.lds + 33792;
    LAS unsigned char* Os = F.lds + 33792 + 18432;
    const int lane = F.lane, l15 = lane & 15, g = lane >> 4, w = F.wave, lt = w >> 1, eh = w & 1;
    for (int u = F.bid; u < NB * 4 * 8; u += F.G) {
        const int eb = u & 7, h = (u >> 3) & 3, b = u >> 5;
        const float lg = log1pf(-exp2f(-5.0f - (float)h));
        f32x4 S[2][4];
#pragma unroll
        for (int mt = 0; mt < 2; ++mt)
#pragma unroll
            for (int nt = 0; nt < 4; ++nt) S[mt][nt] = (f32x4){0.f, 0.f, 0.f, 0.f};
        for (int i = F.tid; i < 33792 / 4; i += NTHR) ((LAS unsigned*)ST)[i] = 0u;
        const float dec64 = __expf(64.0f * lg);
        for (int c = 0; c < NCHUNK; ++c) {
            const size_t t0 = (size_t)b * SEQ + (size_t)c * 64;
            const size_t uidx = ((size_t)(b * 4 + h)) * NCHUNK + c;
            LAS unsigned char* vt = VTs + (c & 1) * 9216;
            bf16x8 kf[2][2], qf[8], pf[2];
#pragma unroll
            for (int mt = 0; mt < 2; ++mt)
#pragma unroll
                for (int ks = 0; ks < 2; ++ks) kf[mt][ks] = *(const bf16x8*)(KT + uidx * (256 * 64) + ((((2 * w + mt) * 2 + ks) * 64 + lane) << 3));
#pragma unroll
            for (int ks = 0; ks < 8; ++ks) qf[ks] = *(const bf16x8*)(proj + (t0 + 16 * lt + l15) * 6144 + 256 * h + 32 * ks + 8 * g);
#pragma unroll
            for (int ks = 0; ks < 2; ++ks) pf[ks] = *(const bf16x8*)(PT + uidx * 4096 + (16 * lt + l15) * 64 + 32 * ks + 8 * g);
            {
                const int e = F.tid >> 3, q = F.tid & 7;
                const u32x4 raw = *(const u32x4*)(VT + uidx * (512 * 64) + (size_t)(64 * eb + e) * 64 + 8 * q);
                float f[8] = {bflo(raw.x), bfhi(raw.x), bflo(raw.y), bfhi(raw.y), bflo(raw.z), bfhi(raw.z), bflo(raw.w), bfhi(raw.w)};
#pragma unroll
                for (int j = 0; j < 8; ++j) f[j] *= __expf((float)(63 - (8 * q + j)) * lg);
                u32x4 o; o.x = pk2(f[0], f[1]); o.y = pk2(f[2], f[3]); o.z = pk2(f[4], f[5]); o.w = pk2(f[6], f[7]);
                *(LAS u32x4*)(vt + e * LDV + 16 * q) = o;
            }
            LDS_WAIT();
            __syncthreads();
            f32x4 oi[2], oo[2];
#pragma unroll
            for (int nt = 0; nt < 2; ++nt) {
                const int e = 32 * eh + 16 * nt + l15;
                oi[nt] = (f32x4){0.f, 0.f, 0.f, 0.f}; oo[nt] = (f32x4){0.f, 0.f, 0.f, 0.f};
#pragma unroll
                for (int ks = 0; ks < 2; ++ks) { const bf16x8 vf = *(const LAS bf16x8*)(vt + e * LDV + 64 * ks + 16 * g);
                    oi[nt] = __builtin_amdgcn_mfma_f32_16x16x32_bf16(pf[ks], vf, oi[nt], 0, 0, 0); }
#pragma unroll
                for (int ks = 0; ks < 8; ++ks) { const bf16x8 sf = *(const LAS bf16x8*)(ST + e * LDS_ST + 64 * ks + 16 * g);
                    oo[nt] = __builtin_amdgcn_mfma_f32_16x16x32_bf16(qf[ks], sf, oo[nt], 0, 0, 0); }
            }
#pragma unroll
            for (int r = 0; r < 4; ++r) { const int l = 16 * lt + 4 * g + r;
                const float si = __expf((float)(l - 63) * lg), so = __expf((float)(l + 1) * lg);
#pragma unroll
                for (int nt = 0; nt < 2; ++nt) *(LAS unsigned short*)(Os + l * LDO + 2 * (32 * eh + 16 * nt + l15)) = (unsigned short)f2bf(si * oi[nt][r] + so * oo[nt][r]); }
            LDS_WAIT();
            __syncthreads();
            { const int r = F.tid >> 3, q = F.tid & 7; *(u32x4*)(mix + (t0 + r) * 2048 + 512 * h + 64 * eb + 8 * q) = *(const LAS u32x4*)(Os + r * LDO + 16 * q); }
#pragma unroll
            for (int mt = 0; mt < 2; ++mt)
#pragma unroll
                for (int nt = 0; nt < 4; ++nt) { S[mt][nt] = S[mt][nt] * dec64;
#pragma unroll
                    for (int ks = 0; ks < 2; ++ks) { const bf16x8 vf = *(const LAS bf16x8*)(vt + (16 * nt + l15) * LDV + 64 * ks + 16 * g);
                        S[mt][nt] = __builtin_amdgcn_mfma_f32_16x16x32_bf16(kf[mt][ks], vf, S[mt][nt], 0, 0, 0); }
                    u32x2 o; o.x = pk2(S[mt][nt][0], S[mt][nt][1]); o.y = pk2(S[mt][nt][2], S[mt][nt][3]);
                    *(LAS u32x2*)(ST + (16 * nt + l15) * LDS_ST + 2 * (32 * w + 16 * mt + 4 * g)) = o; }
        }
        LDS_WAIT();
        __syncthreads();
    }
}

__device__ __forceinline__ void ret_norm_phase(Frame& F, const bf16_t* mix, const bf16_t* proj, const float* gn, bf16_t* amix) {
    const int gw = F.bid * NWAVES + F.wave, NGW = F.G * NWAVES, lane = F.lane;
    for (int i = gw; i < T * 4; i += NGW) {
        const int t = i >> 2, h = i & 3;
        const u32x4 raw = *(const u32x4*)(mix + (size_t)t * 2048 + 512 * h + 8 * lane);
        const u32x4 gr = *(const u32x4*)(proj + (size_t)t * 6144 + 4096 + 512 * h + 8 * lane);
        float v[8] = {bflo(raw.x), bfhi(raw.x), bflo(raw.y), bfhi(raw.y), bflo(raw.z), bfhi(raw.z), bflo(raw.w), bfhi(raw.w)};
        const float gv[8] = {bflo(gr.x), bfhi(gr.x), bflo(gr.y), bfhi(gr.y), bflo(gr.z), bfhi(gr.z), bflo(gr.w), bfhi(gr.w)};
        float s = 0.f;
#pragma unroll
        for (int j = 0; j < 8; ++j) s += v[j];
        const float mean = wave_sum(s) * (1.0f / 512.0f);
        float q = 0.f;
#pragma unroll
        for (int j = 0; j < 8; ++j) { v[j] -= mean; q += v[j] * v[j]; }
        const float rstd = rsqrtf(wave_sum(q) * (1.0f / 512.0f) + EPS);
        const f32x4 g0 = *(const f32x4*)(gn + 512 * h + 8 * lane), g1 = *(const f32x4*)(gn + 512 * h + 8 * lane + 4);
        const float gg[8] = {g0.x, g0.y, g0.z, g0.w, g1.x, g1.y, g1.z, g1.w};
        float o[8];
#pragma unroll
        for (int j = 0; j < 8; ++j) o[j] = v[j] * rstd * gg[j] * siluf_(gv[j]);
        u32x4 ow; ow.x = pk2(o[0], o[1]); ow.y = pk2(o[2], o[3]); ow.z = pk2(o[4], o[5]); ow.w = pk2(o[6], o[7]);
        *(u32x4*)(amix + (size_t)t * 2048 + 512 * h + 8 * lane) = ow;
    }
}
#define NPH_RET 5
#define LAYER_RET() do { \
        { pg8::Gemm g{IFP8_RET ? (const bf16_t*)(ws + WS_H8) : hbuf, (const bf16_t*)(ws + WS_W_RET_IN), T, GFP8_RET ? 4096 : 6144, IFP8_RET ? 512 : 1024}; pg8::EpiRet E{proj, (const f32x2*)(ws + WS_ROPE), IFP8_RET ? 0.03125f : 1.0f}; \
          pg8::Gemm g2{(const bf16_t*)(ws + WS_H8), (const bf16_t*)(ws + WS_W_RET_IN + 8 * MiB), T, 2048, 512}; pg8::EpiBf16S E2{proj + 4096, 6144, 0, 1.0f, 0.03125f}; \
          RUN_PHASE({ pg8::StaticOrder S; S.init(T, GFP8_RET ? 4096 : 6144, F.G, F.bid); \
            if (CVT_HOST == 2 && MOE_FP8) { BgCvtR bgc; bgc.init(in, ws, F.bid * NWAVES + F.wave, F.G * NWAVES, F.lane, -1, 0, 0, 0, 16384);       \
              pg8::gemm_phase_bg<pg8::EpiRet, pg8::StaticOrder, false, (IFP8_RET != 0), BgCvtR>(F.lds, g, S, E, bgc); bgc.finish(); } \
            else pg8::gemm_phase<pg8::EpiRet, pg8::StaticOrder, false, (IFP8_RET != 0)>(F.lds, g, S, E); \
            if (GFP8_RET) { pg8::StaticOrder S2; S2.init(T, 2048, F.G, F.bid); pg8::gemm_phase<pg8::EpiBf16S, pg8::StaticOrder, false, true>(F.lds, g2, S2, E2); } }); } \
        RUN_PHASE_N(REP_S1, ret_s1_phase(F, proj, (bf16_t*)(ws + WS_PT), (bf16_t*)(ws + WS_KT), (bf16_t*)(ws + WS_VT))); \
        RUN_PHASE({ if (S2X) s2x_phase<0>(F, proj, (const bf16_t*)(ws + WS_PT), (const bf16_t*)(ws + WS_KT), proj + 2048, nullptr, (bf16_t*)(ws + WS_MIX)); else s2_phase<0>(F, proj, (const bf16_t*)(ws + WS_PT), (const bf16_t*)(ws + WS_KT), proj + 2048, nullptr, (bf16_t*)(ws + WS_MIX), in, ws, -1); \
            if (REP_S2R > 1) { VM_WAIT(); __syncthreads(); s2_phase<0, S2_ABL>(F, proj, (const bf16_t*)(ws + WS_PT), (const bf16_t*)(ws + WS_KT), proj + 2048, nullptr, (bf16_t*)(ws + WS_AMIX)); } }); \
        RUN_PHASE_N(REP_HN, hn_phase<0>(F, (const bf16_t*)(ws + WS_MIX), proj, nullptr, in[8], nullptr, amix)); \
        OUTPROJ(0, WS_W_RET_OUT, 2048); \
    } while (0)
__device__ __forceinline__ void attn_phase(Frame& F, const bf16_t* qkv, const float* relb, bf16_t* o, const float* const* in, unsigned char* ws) {
    const int gw_ = F.bid * NWAVES + F.wave, NGW_ = F.G * NWAVES;
    const int n_it = 2 * ((NB * NCHUNK + F.G - 1) / F.G);
    constexpr int NLY = CVT_HOST ? 0 : 4 - MOE_PRO_LAYERS;
    const int per_ly = (MOE_FP8 && NLY > 0) ? ((24576 + NGW_ * n_it - 1) / (NGW_ * n_it)) : 0, per_it = per_ly * NLY;
    int it_ = 0;
    LAS unsigned char* wl = F.lds + F.wave * 8192;
    LAS float* rb = (LAS float*)(wl + 5120);
    const int lane = F.lane, l15 = lane & 15, g = lane >> 4;
    const __amdgpu_buffer_rsrc_t qrs = __builtin_amdgcn_make_buffer_rsrc((void*)qkv, 0, 0x7fffffff, 0x00020000);
    const unsigned kofs = (unsigned)(l15 * 3072 + 8 * g) * 2u, vofs = (unsigned)((lane >> 3) * 3072 + 8 * (lane & 7)) * 2u;
    for (int u0 = F.bid; u0 < NB * NCHUNK; u0 += F.G) {
        int u = u0;
        if (F.G == 256) { const int x = u0 & 7, j = (u0 >> 3) & 31, r = u0 >> 8; u = x * NCHUNK + r * 32 + j; }
        const int b = u / NCHUNK, c = u % NCHUNK;
        const size_t t0 = (size_t)b * SEQ + (size_t)c * 64;
        for (int hh = 0; hh < 2; ++hh) {
            const int h = F.wave * 2 + hh;
            if (per_it) { for (int ly = 0; ly < NLY; ++ly) bg_convert(in, ws, MOE_PRO_LAYERS + ly, it_ * per_ly, per_ly, gw_, NGW_, lane); }
            ++it_;
            for (int i = lane; i < 320; i += 64) rb[i] = relb[h * 320 + i] * 1.4426950408889634f;
            bf16x8 qf[4][2];
#pragma unroll
            for (int nt = 0; nt < 4; ++nt)
#pragma unroll
                for (int ks = 0; ks < 2; ++ks) qf[nt][ks] = *(const bf16x8*)(qkv + (t0 + 16 * nt + l15) * 3072 + 64 * h + 32 * ks + 8 * g);
            f32x4 oacc[4][4];
#pragma unroll
            for (int dt = 0; dt < 4; ++dt)
#pragma unroll
                for (int nt = 0; nt < 4; ++nt) oacc[dt][nt] = (f32x4){0.f, 0.f, 0.f, 0.f};
            float mrun[4], lsum[4];
#pragma unroll
            for (int nt = 0; nt < 4; ++nt) { mrun[nt] = -1.0e30f; lsum[nt] = 0.f; }
            const int kt0 = (16 - 2 * c) > 0 ? (16 - 2 * c) : 0;
            bf16x8 kf[2][2]; u32x4 vv[4];
#define ATT_GLOAD(KF, VV, kt_) do { const unsigned sb_ = (unsigned)((t0 - 512 + 32 * (kt_)) * 3072 + 64 * h) * 2u;        \
                _Pragma("unroll") for (int mt = 0; mt < 2; ++mt) _Pragma("unroll") for (int ks = 0; ks < 2; ++ks) \
                    KF[mt][ks] = __builtin_bit_cast(bf16x8, __builtin_amdgcn_raw_buffer_load_b128(qrs, kofs, sb_ + (unsigned)((16 * mt * 3072 + 1024 + 32 * ks) * 2), 0)); \
                _Pragma("unroll") for (int i = 0; i < 4; ++i) VV[i] = __builtin_bit_cast(u32x4, __builtin_amdgcn_raw_buffer_load_b128(qrs, vofs, sb_ + (unsigned)((8 * i * 3072 + 2048) * 2), 0)); } while (0)
            ATT_GLOAD(kf, vv, kt0);
            for (int kt = kt0; kt < 18; ++kt) {
                bf16x8 kfn[2][2]; u32x4 vvn[4];
                { const int ktn = kt + 1 < 18 ? kt + 1 : kt; ATT_GLOAD(kfn, vvn, ktn); }
                f32x4 sacc[2][4];
#pragma unroll
                for (int mt = 0; mt < 2; ++mt)
#pragma unroll
                    for (int nt = 0; nt < 4; ++nt) { sacc[mt][nt] = (f32x4){0.f, 0.f, 0.f, 0.f};
#pragma unroll
                        for (int ks = 0; ks < 2; ++ks) sacc[mt][nt] = __builtin_amdgcn_mfma_f32_16x16x32_bf16(kf[mt][ks], qf[nt][ks], sacc[mt][nt], 0, 0, 0); }
#pragma unroll
                for (int i = 0; i < 4; ++i) *(LAS u32x4*)(wl + ((lane >> 3) + 8 * i) * 144 + 16 * (lane & 7)) = vv[i];
                bf16x8 pf[4];
#pragma unroll
                for (int nt = 0; nt < 4; ++nt) {
                    float tmax = -1.0e30f;
                    if (kt <= 7) {
                        const float cb = rb[256 + 63];
#pragma unroll
                        for (int mt = 0; mt < 2; ++mt)
#pragma unroll
                            for (int r = 0; r < 4; ++r) { const float s = sacc[mt][nt][r] + cb; sacc[mt][nt][r] = s; tmax = fmaxf(tmax, s); }
                    } else {
#pragma unroll
                        for (int mt = 0; mt < 2; ++mt)
#pragma unroll
                            for (int r = 0; r < 4; ++r) {
                                int dist = (16 * nt + l15) - (32 * kt + 16 * mt + 4 * g + r) + 512;
                                dist = dist < -63 ? -63 : (dist > 256 ? 256 : dist);
                                const float s = sacc[mt][nt][r] + rb[dist + 63];
                                sacc[mt][nt][r] = s; tmax = fmaxf(tmax, s);
                            }
                    }
                    tmax = fmaxf(tmax, __shfl_xor(tmax, 16)); tmax = fmaxf(tmax, __shfl_xor(tmax, 32));
                    const float mnew = fmaxf(mrun[nt], tmax);
                    const float alpha = __builtin_amdgcn_exp2f(mrun[nt] - mnew);
                    mrun[nt] = mnew;
                    float ps = 0.f; float p[8];
#pragma unroll
                    for (int mt = 0; mt < 2; ++mt)
#pragma unroll
                        for (int r = 0; r < 4; ++r) { const float e = __builtin_amdgcn_exp2f(sacc[mt][nt][r] - mnew); p[4 * mt + r] = e; ps += e; }
                    lsum[nt] = lsum[nt] * alpha + ps;
                    if (__builtin_amdgcn_ballot_w64(alpha != 1.0f) != 0) {
#pragma unroll
                        for (int dt = 0; dt < 4; ++dt) oacc[dt][nt] = oacc[dt][nt] * alpha; }
                    u32x4 pw; pw.x = cvt_pk_bf16(p[0], p[1]); pw.y = cvt_pk_bf16(p[2], p[3]); pw.z = cvt_pk_bf16(p[4], p[5]); pw.w = cvt_pk_bf16(p[6], p[7]);
                    pf[nt] = __builtin_bit_cast(bf16x8, pw);
                }
#pragma unroll
                for (int dt = 0; dt < 4; ++dt) {
                    const LAS unsigned char* ta = wl + (4 * g + (l15 >> 2)) * 144 + 2 * (16 * dt + 4 * (l15 & 3));
                    const s16x4 lo = __builtin_amdgcn_ds_read_tr16_b64_v4i16((LAS s16x4*)ta), hi = __builtin_amdgcn_ds_read_tr16_b64_v4i16((LAS s16x4*)(ta + 16 * 144));
                    const bf16x8 vf = (bf16x8){lo.x, lo.y, lo.z, lo.w, hi.x, hi.y, hi.z, hi.w};
#pragma unroll
                    for (int nt = 0; nt < 4; ++nt) oacc[dt][nt] = __builtin_amdgcn_mfma_f32_16x16x32_bf16(vf, pf[nt], oacc[dt][nt], 0, 0, 0);
                }
#pragma unroll
                for (int mt = 0; mt < 2; ++mt)
#pragma unroll
                    for (int ks = 0; ks < 2; ++ks) kf[mt][ks] = kfn[mt][ks];
#pragma unroll
                for (int i = 0; i < 4; ++i) vv[i] = vvn[i];
            }
#undef ATT_GLOAD
#pragma unroll
            for (int nt = 0; nt < 4; ++nt) {
                float l = lsum[nt]; l += __shfl_xor(l, 16); l += __shfl_xor(l, 32);
                const float inv = 1.0f / l;
#pragma unroll
                for (int dt = 0; dt < 4; ++dt) { const f32x4 v = oacc[dt][nt] * inv;
                    if (OUT_FP8) *(unsigned*)((unsigned char*)o + (t0 + 16 * nt + l15) * 1024 + 64 * h + 16 * dt + 4 * g) = pk4_fp8(v[0], v[1], v[2], v[3]);
                    else { u32x2 w; w.x = cvt_pk_bf16(v[0], v[1]); w.y = cvt_pk_bf16(v[2], v[3]);
                    *(u32x2*)(o + (t0 + 16 * nt + l15) * 1024 + 64 * h + 16 * dt + 4 * g) = w; } }
            }
        }
    }
    for (; it_ < n_it; ++it_) { if (per_it) for (int ly = 0; ly < NLY; ++ly) bg_convert(in, ws, MOE_PRO_LAYERS + ly, it_ * per_ly, per_ly, gw_, NGW_, lane); }
}
#define NPH_ATT 3
#define LAYER_ATT() do { \
        { pg8::Gemm g{IFP8_ATT ? (const bf16_t*)(ws + WS_H8) : hbuf, (const bf16_t*)(ws + WS_W_ATT_IN), T, 3072, IFP8_ATT ? 512 : 1024}; pg8::EpiBf16S E{proj, 3072, 4, 0.125f * 1.4426950408889634f, IFP8_ATT ? 0.03125f : 1.0f};       \
          RUN_PHASE_DUP(REP_INPROJ, { pg8::StaticOrder S; S.init(T, 3072, F.G, F.bid); pg8::gemm_phase<pg8::EpiBf16S, pg8::StaticOrder, false, (IFP8_ATT != 0)>(F.lds, g, S, E); }); } \
        RUN_PHASE_N(REP_ATT, attn_phase(F, proj, in[11], amix, in, ws)); \
        OUTPROJ(1, WS_W_ATT_OUT, 1024); \
    } while (0)
__device__ __forceinline__ void gla_s1_phase(Frame& F, const bf16_t* proj, const float* glow, const float* wgate, const float* bgate,
                                             bf16_t* PT, bf16_t* KT, bf16_t* VT, bf16_t* QS, float* REC) {
    constexpr int LDQ = 272, LDV = 528, LDP = 144;
    LAS float* Bc = (LAS float*)F.lds;
    LAS float* Gl = (LAS float*)(F.lds + 32768);
    LAS float* Wg = (LAS float*)(F.lds + 36864);
    LAS unsigned char* Qi = F.lds + 45056;
    LAS unsigned char* Ki = F.lds + 45056 + 17408;
    LAS unsigned char* Kst = F.lds + 45056 + 2 * 17408;
    LAS unsigned char* Vs = F.lds + 45056 + 3 * 17408;
    LAS unsigned char* Ps = F.lds + 45056 + 3 * 17408 + 33792;
    const int lane = F.lane, l15 = lane & 15, g = lane >> 4, w = F.wave, lt = w >> 1, mh = w & 1;
    float glr[2], wgr[4], bgr = 0.f; u32x4 qrr[2], krr[2];
#define GS1_LOAD(uu) do { const int c_ = (uu) % NCHUNK, h_ = ((uu) / NCHUNK) % 4, b_ = (uu) / (NCHUNK * 4); const size_t t0_ = (size_t)b_ * SEQ + (size_t)c_ * 64; \
        _Pragma("unroll") for (int i = 0; i < 2; ++i) glr[i] = glow[t0_ * 16 + F.tid + NTHR * i]; \
        _Pragma("unroll") for (int i = 0; i < 4; ++i) { const int x_ = F.tid + NTHR * i; wgr[i] = wgate[(size_t)(x_ >> 7) * 512 + 128 * h_ + (x_ & 127)]; } \
        bgr = bgate[128 * h_ + (F.tid & 127)]; \
        _Pragma("unroll") for (int i = 0; i < 2; ++i) { const int p_ = F.tid + NTHR * i, l_ = p_ >> 4, q8_ = p_ & 15; \
            qrr[i] = *(const u32x4*)(proj + (t0_ + l_) * 3072 + 128 * h_ + 8 * q8_); krr[i] = *(const u32x4*)(proj + (t0_ + l_) * 3072 + 512 + 128 * h_ + 8 * q8_); } } while (0)
    if (F.bid < NB * 4 * NCHUNK) GS1_LOAD(F.bid);
    for (int u = F.bid; u < NB * 4 * NCHUNK; u += F.G) {
        const int c = u % NCHUNK, h = (u / NCHUNK) % 4, b = u / (NCHUNK * 4);
        const size_t t0 = (size_t)b * SEQ + (size_t)c * 64;
#pragma unroll
        for (int i = 0; i < 2; ++i) Gl[F.tid + NTHR * i] = glr[i];
#pragma unroll
        for (int i = 0; i < 4; ++i) Wg[F.tid + NTHR * i] = wgr[i];
        const float bg_cur = bgr; const u32x4 qc[2] = {qrr[0], qrr[1]}, kc[2] = {krr[0], krr[1]};
        if (u + F.G < NB * 4 * NCHUNK) GS1_LOAD(u + F.G);
        WG_SYNC_LDS();
        { const int d = F.tid & 127; const float bg = bg_cur;
          float wg[16];
#pragma unroll
          for (int k = 0; k < 16; ++k) wg[k] = Wg[k * 128 + d];
          for (int i = 0; i < 16; ++i) { const int l = (F.tid >> 7) + 4 * i; float z = bg;
#pragma unroll
              for (int k = 0; k < 16; ++k) z += Gl[l * 16 + k] * wg[k];
              Bc[l * 128 + d] = logsigmoidf_(z) * (1.0f / 16.0f); } }
        WG_SYNC_LDS();
        if (F.tid < 128) { float a = 0.f; for (int l = 0; l < 64; ++l) { a += Bc[l * 128 + F.tid]; Bc[l * 128 + F.tid] = a; } REC[(size_t)u * 128 + F.tid] = __expf(a); }
        WG_SYNC_LDS();
#pragma unroll
        for (int pi = 0; pi < 2; ++pi) { const int p = F.tid + NTHR * pi;
            const int l = p >> 4, q8 = p & 15;
            const u32x4 qr = qc[pi], kr = kc[pi];
            const float qv[8] = {bflo(qr.x), bfhi(qr.x), bflo(qr.y), bfhi(qr.y), bflo(qr.z), bfhi(qr.z), bflo(qr.w), bfhi(qr.w)};
            const float kv[8] = {bflo(kr.x), bfhi(kr.x), bflo(kr.y), bfhi(kr.y), bflo(kr.z), bfhi(kr.z), bflo(kr.w), bfhi(kr.w)};
            float qi[8], ki[8], ks[8];
#pragma unroll
            for (int j = 0; j < 8; ++j) { const float bb = Bc[l * 128 + 8 * q8 + j], bl = Bc[63 * 128 + 8 * q8 + j];
                qi[j] = qv[j] * __expf(bb); ki[j] = kv[j] * __expf(-bb); ks[j] = kv[j] * __expf(bl - bb); }
            u32x4 o; o.x = pk2(qi[0], qi[1]); o.y = pk2(qi[2], qi[3]); o.z = pk2(qi[4], qi[5]); o.w = pk2(qi[6], qi[7]);
            *(LAS u32x4*)(Qi + l * LDQ + 16 * q8) = o; *(u32x4*)(QS + (t0 + l) * 512 + 128 * h + 8 * q8) = o;
            o.x = pk2(ki[0], ki[1]); o.y = pk2(ki[2], ki[3]); o.z = pk2(ki[4], ki[5]); o.w = pk2(ki[6], ki[7]);
            *(LAS u32x4*)(Ki + l * LDQ + 16 * q8) = o;
            o.x = pk2(ks[0], ks[1]); o.y = pk2(ks[2], ks[3]); o.z = pk2(ks[4], ks[5]); o.w = pk2(ks[6], ks[7]);
            *(LAS u32x4*)(Kst + l * LDQ + 16 * q8) = o;
        }
        WG_SYNC_LDS();
        f32x4 acc[2];
#pragma unroll
        for (int nt = 0; nt < 2; ++nt) { acc[nt] = (f32x4){0.f, 0.f, 0.f, 0.f};
#pragma unroll
            for (int ks = 0; ks < 4; ++ks) { const bf16x8 qf = *(const LAS bf16x8*)(Qi + (16 * lt + l15) * LDQ + 64 * ks + 16 * g);
                const bf16x8 kf = *(const LAS bf16x8*)(Ki + (32 * mh + 16 * nt + l15) * LDQ + 64 * ks + 16 * g);
                acc[nt] = __builtin_amdgcn_mfma_f32_16x16x32_bf16(qf, kf, acc[nt], 0, 0, 0); } }
#pragma unroll
        for (int nt = 0; nt < 2; ++nt)
#pragma unroll
            for (int r = 0; r < 4; ++r) { const int l = 16 * lt + 4 * g + r, m = 32 * mh + 16 * nt + l15;
                *(LAS unsigned short*)(Ps + l * LDP + 2 * m) = (unsigned short)f2bf(m <= l ? acc[nt][r] : 0.f); }
        WG_SYNC_LDS();
        { const int r = F.tid >> 3, q = F.tid & 7; *(u32x4*)(PT + (size_t)u * 4096 + r * 64 + 8 * q) = *(const LAS u32x4*)(Ps + r * LDP + 16 * q); }
        s1_write_kt_tr<128>(Kst, LDQ, KT + (size_t)u * 128 * 64, F.wave, lane);
        WG_SYNC_LDS();
    }
#undef GS1_LOAD
}

__device__ __forceinline__ void gla_s2_phase(Frame& F, const bf16_t* QS, const bf16_t* PT, const bf16_t* KT, const bf16_t* VT, const float* REC, bf16_t* mix) {
    constexpr int LDS_ST = 272, LDV = 144, LDO = 80;
    LAS unsigned char* ST = F.lds;
    LAS unsigned char* VTs = F.lds + 8704;
    LAS unsigned char* Os = F.lds + 8704 + 9216;
    const int lane = F.lane, l15 = lane & 15, g = lane >> 4, w = F.wave, lt = w >> 1, eh = w & 1;
    for (int u = F.bid; u < NB * 4 * 8; u += F.G) {
        const int eb = u & 7, h = (u >> 3) & 3, b = u >> 5;
        f32x4 S[2];
#pragma unroll
        for (int nt = 0; nt < 2; ++nt) S[nt] = (f32x4){0.f, 0.f, 0.f, 0.f};
        for (int i = F.tid; i < 8704 / 4; i += NTHR) ((LAS unsigned*)ST)[i] = 0u;
        for (int c = 0; c < NCHUNK; ++c) {
            const size_t t0 = (size_t)b * SEQ + (size_t)c * 64;
            const size_t uidx = ((size_t)(b * 4 + h)) * NCHUNK + c;
            LAS unsigned char* vt = VTs + (c & 1) * 4608;
            bf16x8 kf[2], qf[4], pf[2];
#pragma unroll
            for (int ks = 0; ks < 2; ++ks) kf[ks] = *(const bf16x8*)(KT + uidx * (128 * 64) + (((w * 2 + ks) * 64 + lane) << 3));
#pragma unroll
            for (int ks = 0; ks < 4; ++ks) qf[ks] = *(const bf16x8*)(QS + (t0 + 16 * lt + l15) * 512 + 128 * h + 32 * ks + 8 * g);
#pragma unroll
            for (int ks = 0; ks < 2; ++ks) pf[ks] = *(const bf16x8*)(PT + uidx * 4096 + (16 * lt + l15) * 64 + 32 * ks + 8 * g);
            f32x4 dec;
#pragma unroll
            for (int r = 0; r < 4; ++r) dec[r] = REC[uidx * 128 + 16 * w + 4 * g + r];
            if (F.tid < 256) { const int e = F.tid >> 3, q = F.tid & 7;
                *(LAS u32x4*)(vt + e * LDV + 16 * q) = *(const u32x4*)(VT + uidx * (256 * 64) + (size_t)(32 * eb + e) * 64 + 8 * q); }
            LDS_WAIT();
            __syncthreads();
            f32x4 oo = (f32x4){0.f, 0.f, 0.f, 0.f};
            { const int e = 16 * eh + l15;
#pragma unroll
              for (int ks = 0; ks < 2; ++ks) { const bf16x8 vf = *(const LAS bf16x8*)(vt + e * LDV + 64 * ks + 16 * g);
                  oo = __builtin_amdgcn_mfma_f32_16x16x32_bf16(pf[ks], vf, oo, 0, 0, 0); }
#pragma unroll
              for (int ks = 0; ks < 4; ++ks) { const bf16x8 sf = *(const LAS bf16x8*)(ST + e * LDS_ST + 64 * ks + 16 * g);
                  oo = __builtin_amdgcn_mfma_f32_16x16x32_bf16(qf[ks], sf, oo, 0, 0, 0); } }
#pragma unroll
            for (int r = 0; r < 4; ++r) *(LAS unsigned short*)(Os + (16 * lt + 4 * g + r) * LDO + 2 * (16 * eh + l15)) = (unsigned short)f2bf(oo[r]);
            LDS_WAIT();
            __syncthreads();
            if (F.tid < 256) { const int r = F.tid >> 2, q = F.tid & 3; *(u32x4*)(mix + (t0 + r) * 1024 + 256 * h + 32 * eb + 8 * q) = *(const LAS u32x4*)(Os + r * LDO + 16 * q); }
#pragma unroll
            for (int nt = 0; nt < 2; ++nt) { S[nt] = S[nt] * dec;
#pragma unroll
                for (int ks = 0; ks < 2; ++ks) { const bf16x8 vf = *(const LAS bf16x8*)(vt + (16 * nt + l15) * LDV + 64 * ks + 16 * g);
                    S[nt] = __builtin_amdgcn_mfma_f32_16x16x32_bf16(kf[ks], vf, S[nt], 0, 0, 0); }
                u32x2 o; o.x = pk2(S[nt][0], S[nt][1]); o.y = pk2(S[nt][2], S[nt][3]);
                *(LAS u32x2*)(ST + (16 * nt + l15) * LDS_ST + 2 * (16 * w + 4 * g)) = o; }
        }
        LDS_WAIT();
        __syncthreads();
    }
}

__device__ __forceinline__ void gla_norm_phase(Frame& F, const bf16_t* mix, const bf16_t* proj, const float* gn, bf16_t* amix) {
    const int gw = F.bid * NWAVES + F.wave, NGW = F.G * NWAVES, lane = F.lane;
    for (int i = gw; i < T * 4; i += NGW) {
        const int t = i >> 2, h = i & 3;
        const u32x2 raw = *(const u32x2*)(mix + (size_t)t * 1024 + 256 * h + 4 * lane);
        const u32x2 rr = *(const u32x2*)(proj + (size_t)t * 3072 + 2048 + 256 * h + 4 * lane);
        const float v[4] = {bflo(raw.x), bfhi(raw.x), bflo(raw.y), bfhi(raw.y)};
        const float rv[4] = {bflo(rr.x), bfhi(rr.x), bflo(rr.y), bfhi(rr.y)};
        float q = 0.f;
#pragma unroll
        for (int j = 0; j < 4; ++j) q += v[j] * v[j];
        const float rstd = rsqrtf(wave_sum(q) * (1.0f / 256.0f) + EPS);
        const f32x4 g0 = *(const f32x4*)(gn + 256 * h + 4 * lane);
        const float gg[4] = {g0.x, g0.y, g0.z, g0.w};
        float o[4];
#pragma unroll
        for (int j = 0; j < 4; ++j) o[j] = v[j] * rstd * gg[j] * siluf_(rv[j]);
        u32x2 ow; ow.x = pk2(o[0], o[1]); ow.y = pk2(o[2], o[3]);
        *(u32x2*)(amix + (size_t)t * 1024 + 256 * h + 4 * lane) = ow;
    }
}
#define NPH_GLA 5
#define LAYER_GLA() do { \
        { pg8::Gemm g{IFP8_GLA ? (const bf16_t*)(ws + WS_H8) : hbuf, (const bf16_t*)(ws + WS_W_GLA_IN), T, GFP8_GLA ? 2048 : 3072, IFP8_GLA ? 512 : 1024}; pg8::EpiBf16S E{proj, 3072, 2, 0.08838834764831845f, IFP8_GLA ? 0.03125f : 1.0f}; \
          pg8::Gemm g2{(const bf16_t*)(ws + WS_H8), (const bf16_t*)(ws + WS_W_GLA_IN + 4 * MiB), T, 1024, 512}; pg8::EpiBf16S E2{proj + 2048, 3072, 0, 1.0f, 0.03125f}; \
          RUN_PHASE({ pg8::StaticOrder S; S.init(T, GFP8_GLA ? 2048 : 3072, F.G, F.bid); pg8::gemm_phase<pg8::EpiBf16S, pg8::StaticOrder, false, (IFP8_GLA != 0)>(F.lds, g, S, E); \
            if (GFP8_GLA) { pg8::StaticOrder S2; S2.init(T, 1024, F.G, F.bid); pg8::gemm_phase<pg8::EpiBf16S, pg8::StaticOrder, false, true>(F.lds, g2, S2, E2); } }); } \
        RUN_PHASE_N(REP_S1, gla_s1_phase(F, proj, (const float*)(ws + WS_GLOW), in[14], in[15], (bf16_t*)(ws + WS_PT), (bf16_t*)(ws + WS_KT), (bf16_t*)(ws + WS_VT), (bf16_t*)(ws + WS_QS), (float*)(ws + WS_REC))); \
        RUN_PHASE_N(REP_S2, { if (S2X) s2x_phase<1>(F, (const bf16_t*)(ws + WS_QS), (const bf16_t*)(ws + WS_PT), (const bf16_t*)(ws + WS_KT), proj + 1024, (const float*)(ws + WS_REC), (bf16_t*)(ws + WS_MIX)); else s2_phase<1>(F, (const bf16_t*)(ws + WS_QS), (const bf16_t*)(ws + WS_PT), (const bf16_t*)(ws + WS_KT), proj + 1024, (const float*)(ws + WS_REC), (bf16_t*)(ws + WS_MIX), in, ws, -1); }); \
        RUN_PHASE_N(REP_HN, hn_phase<1>(F, (const bf16_t*)(ws + WS_MIX), proj, nullptr, in[16], nullptr, amix)); \
        OUTPROJ(2, WS_W_GLA_OUT, 1024); \
    } while (0)
__device__ __forceinline__ void mls_pre_phase(Frame& F, const bf16_t* proj, const float* conv_w, const float* conv_b, const float* w_q, const float* w_k, const float* w_v,
                                              const bf16_t* wmg, const float* b_gates, bf16_t* MQ, bf16_t* MK, bf16_t* MV, bf16_t* MXC, float* GATES) {
    LAS float* red = (LAS float*)F.lds;
    const int n = F.tid, lane = F.lane, l15 = lane & 15, g = lane >> 4, w = F.wave;
    f32x2 cw2[4][2], cb2[2], wq2[4][2], wk2[4][2], wv2[4][2];
#pragma unroll
    for (int j = 0; j < 4; ++j) { const f32x4 t4 = *(const f32x4*)(conv_w + (size_t)j * 2048 + 4 * n); cw2[j][0] = (f32x2){t4.x, t4.y}; cw2[j][1] = (f32x2){t4.z, t4.w}; }
    { const f32x4 t4 = *(const f32x4*)(conv_b + 4 * n); cb2[0] = (f32x2){t4.x, t4.y}; cb2[1] = (f32x2){t4.z, t4.w}; }
    const float kscale = 0.044194173824159216f;
#pragma unroll
    for (int c4 = 0; c4 < 4; ++c4) { const f32x4 a = *(const f32x4*)(w_q + (size_t)n * 16 + 4 * c4), bb = *(const f32x4*)(w_k + (size_t)n * 16 + 4 * c4), cc = *(const f32x4*)(w_v + (size_t)n * 16 + 4 * c4);
        wq2[c4][0] = (f32x2){a.x, a.y}; wq2[c4][1] = (f32x2){a.z, a.w};
        wk2[c4][0] = (f32x2){bb.x, bb.y} * kscale; wk2[c4][1] = (f32x2){bb.z, bb.w} * kscale;
        wv2[c4][0] = (f32x2){cc.x, cc.y}; wv2[c4][1] = (f32x2){cc.z, cc.w}; }
    for (int u = F.bid; u < NB * NCHUNK; u += F.G) {
        const int b = u / NCHUNK, c = u % NCHUNK;
        const size_t t0 = (size_t)b * SEQ + (size_t)c * 64;
        f32x2 x3[2], x2[2], x1[2];
        if (c > 0) {
            const u32x2 r3 = *(const u32x2*)(proj + (t0 - 3) * 4096 + 4 * n), r2 = *(const u32x2*)(proj + (t0 - 2) * 4096 + 4 * n), r1 = *(const u32x2*)(proj + (t0 - 1) * 4096 + 4 * n);
            x3[0] = (f32x2){bflo(r3.x), bfhi(r3.x)}; x3[1] = (f32x2){bflo(r3.y), bfhi(r3.y)};
            x2[0] = (f32x2){bflo(r2.x), bfhi(r2.x)}; x2[1] = (f32x2){bflo(r2.y), bfhi(r2.y)};
            x1[0] = (f32x2){bflo(r1.x), bfhi(r1.x)}; x1[1] = (f32x2){bflo(r1.y), bfhi(r1.y)};
        } else {
#pragma unroll
            for (int p = 0; p < 2; ++p) { x3[p] = (f32x2){0.f, 0.f}; x2[p] = x3[p]; x1[p] = x3[p]; }
        }
        for (int l0 = 0; l0 < 64; l0 += 8) {
            u32x2 xr[8];
#pragma unroll
            for (int j = 0; j < 8; ++j) xr[j] = *(const u32x2*)(proj + (t0 + l0 + j) * 4096 + 4 * n);
#pragma unroll
            for (int j = 0; j < 8; ++j) {
                const f32x2 x0[2] = {(f32x2){bflo(xr[j].x), bfhi(xr[j].x)}, (f32x2){bflo(xr[j].y), bfhi(xr[j].y)}};
                f32x2 xc[2];
#pragma unroll
                for (int p = 0; p < 2; ++p) { const f32x2 cv = cb2[p] + cw2[0][p] * x3[p] + cw2[1][p] * x2[p] + cw2[2][p] * x1[p] + cw2[3][p] * x0[p];
                    xc[p] = (f32x2){siluf_(cv.x), siluf_(cv.y)}; }
                const float xcs[4] = {xc[0].x, xc[0].y, xc[1].x, xc[1].y}, x0s[4] = {x0[0].x, x0[0].y, x0[1].x, x0[1].y};
                f32x2 q[2], k[2], v[2];
#pragma unroll
                for (int p = 0; p < 2; ++p) {
                    q[p] = wq2[0][p] * xcs[0] + wq2[1][p] * xcs[1] + wq2[2][p] * xcs[2] + wq2[3][p] * xcs[3];
                    k[p] = wk2[0][p] * xcs[0] + wk2[1][p] * xcs[1] + wk2[2][p] * xcs[2] + wk2[3][p] * xcs[3];
                    v[p] = wv2[0][p] * x0s[0] + wv2[1][p] * x0s[1] + wv2[2][p] * x0s[2] + wv2[3][p] * x0s[3];
                }
                const size_t o = (t0 + l0 + j) * 2048 + 4 * n;
                u32x2 pq; pq.x = pk2(q[0].x, q[0].y); pq.y = pk2(q[1].x, q[1].y); *(u32x2*)(MQ + o) = pq;
                pq.x = pk2(k[0].x, k[0].y); pq.y = pk2(k[1].x, k[1].y); *(u32x2*)(MK + o) = pq;
                pq.x = pk2(v[0].x, v[0].y); pq.y = pk2(v[1].x, v[1].y); *(u32x2*)(MV + o) = pq;
                pq.x = pk2(xc[0].x, xc[0].y); pq.y = pk2(xc[1].x, xc[1].y); *(u32x2*)(MXC + o) = pq;
#pragma unroll
                for (int p = 0; p < 2; ++p) { x3[p] = x2[p]; x2[p] = x1[p]; x1[p] = x0[p]; }
            }
        }
        VM_WAIT();
        __syncthreads();
        f32x4 acc[4];
#pragma unroll
        for (int mt = 0; mt < 4; ++mt) acc[mt] = (f32x4){0.f, 0.f, 0.f, 0.f};
        for (int ks0 = 0; ks0 < 24; ks0 += 4) {
            bf16x8 bh[4], bl[4], af[4][4];
#pragma unroll
            for (int u4 = 0; u4 < 4; ++u4) {
                const int kk = 768 * w + 32 * (ks0 + u4), buf = kk >> 11, col = kk & 2047;
                const bf16_t* src = buf == 0 ? MQ : (buf == 1 ? MK : MV);
                bh[u4] = *(const bf16x8*)(wmg + (size_t)l15 * 6144 + kk + 8 * g);
                bl[u4] = *(const bf16x8*)(wmg + (size_t)(16 + l15) * 6144 + kk + 8 * g);
#pragma unroll
                for (int mt = 0; mt < 4; ++mt) af[u4][mt] = *(const bf16x8*)(src + (t0 + 16 * mt + l15) * 2048 + col + 8 * g);
            }
#pragma unroll
            for (int u4 = 0; u4 < 4; ++u4)
#pragma unroll
                for (int mt = 0; mt < 4; ++mt) {
                    acc[mt] = __builtin_amdgcn_mfma_f32_16x16x32_bf16(af[u4][mt], bh[u4], acc[mt], 0, 0, 0);
                    acc[mt] = __builtin_amdgcn_mfma_f32_16x16x32_bf16(af[u4][mt], bl[u4], acc[mt], 0, 0, 0); }
        }
#pragma unroll
        for (int mt = 0; mt < 4; ++mt)
#pragma unroll
            for (int r = 0; r < 4; ++r) red[(w * 64 + 16 * mt + 4 * g + r) * 16 + l15] = acc[mt][r];
        LDS_WAIT();
        __syncthreads();
        { const int tok = F.tid >> 3, j = F.tid & 7; float s = b_gates[j];
#pragma unroll
          for (int ww = 0; ww < 8; ++ww) s += red[(ww * 64 + tok) * 16 + j];
          GATES[(t0 + tok) * 8 + j] = (j < 4) ? s : logsigmoidf_(s); }
        LDS_WAIT();
        __syncthreads();
    }
}

__device__ __forceinline__ void mls_s1_phase(Frame& F, const bf16_t* MQ, const bf16_t* MK, const bf16_t* MV, const float* GATES, bf16_t* PT, bf16_t* KT, bf16_t* VT, float* REC) {
    constexpr int LDK = 1040, LDP = 144;
    LAS unsigned char* Ks = F.lds;
    LAS unsigned char* Vs = F.lds + 66560;
    LAS unsigned char* Ps = F.lds + 133120;
    const int lane = F.lane, l15 = lane & 15, g = lane >> 4, w = F.wave, lt = w >> 1, mh = w & 1;
    u32x4 kr[8]; bf16x8 qf[16]; float g_f = 0.f, g_i = 0.f;
#define MS1_LOAD(uu) do { const int c_ = (uu) % NCHUNK, h_ = ((uu) / NCHUNK) % 4, b_ = (uu) / (NCHUNK * 4); const size_t t0_ = (size_t)b_ * SEQ + (size_t)c_ * 64; \
        s1_gload<512>(MK + t0_ * 2048 + 512 * h_, 2048, kr, F.tid); \
        if (w == 0) { g_f = GATES[(t0_ + lane) * 8 + 4 + h_]; g_i = GATES[(t0_ + lane) * 8 + h_]; } \
        _Pragma("unroll") for (int ks = 0; ks < 16; ++ks) qf[ks] = *(const bf16x8*)(MQ + (t0_ + 16 * lt + l15) * 2048 + 512 * h_ + 32 * ks + 8 * g); } while (0)
    if (F.bid < NB * 4 * NCHUNK) MS1_LOAD(F.bid);
    for (int u = F.bid; u < NB * 4 * NCHUNK; u += F.G) {
        const int c = u % NCHUNK, h = (u / NCHUNK) % 4, b = u / (NCHUNK * 4);
        const size_t t0 = (size_t)b * SEQ + (size_t)c * 64;
        s1_lstore<512>(kr, Ks, LDK, F.tid);
        if (w == 0) {
            float bsum = g_f;
#pragma unroll
            for (int o = 1; o < 64; o <<= 1) { const float t = __shfl_up(bsum, o); if (lane >= o) bsum += t; }
            const float z = g_i - bsum;
            float a = z;
#pragma unroll
            for (int o = 1; o < 64; o <<= 1) { const float t = __shfl_up(a, o); if (lane >= o) a = fmaxf(a, t); }
            REC[(size_t)u * 192 + lane] = bsum; REC[(size_t)u * 192 + 64 + lane] = z; REC[(size_t)u * 192 + 128 + lane] = a;
        }
        WG_SYNC_LDS();
        f32x4 acc[2];
#pragma unroll
        for (int nt = 0; nt < 2; ++nt) acc[nt] = (f32x4){0.f, 0.f, 0.f, 0.f};
#pragma unroll
        for (int ks = 0; ks < 16; ++ks) {
#pragma unroll
            for (int nt = 0; nt < 2; ++nt) { const bf16x8 kf = *(const LAS bf16x8*)(Ks + (size_t)(32 * mh + 16 * nt + l15) * LDK + 64 * ks + 16 * g);
                acc[nt] = __builtin_amdgcn_mfma_f32_16x16x32_bf16(qf[ks], kf, acc[nt], 0, 0, 0); }
        }
#pragma unroll
        for (int nt = 0; nt < 2; ++nt)
#pragma unroll
            for (int r = 0; r < 4; ++r) { const int l = 16 * lt + 4 * g + r, m = 32 * mh + 16 * nt + l15;
                *(LAS unsigned short*)(Ps + l * LDP + 2 * m) = (unsigned short)f2bf(m <= l ? acc[nt][r] : 0.f); }
        { const int un = u + F.G; if (un < NB * 4 * NCHUNK) MS1_LOAD(un); }
        WG_SYNC_LDS();
        { const int r = F.tid >> 3, q = F.tid & 7; *(u32x4*)(PT + (size_t)u * 4096 + r * 64 + 8 * q) = *(const LAS u32x4*)(Ps + r * LDP + 16 * q); }
        s1_write_kt_tr<512>(Ks, LDK, KT + (size_t)u * 512 * 64, F.wave, lane);
        WG_SYNC_LDS();
    }
#undef MS1_LOAD
}

__device__ __forceinline__ void mls_s2_phase(Frame& F, const bf16_t* MQ, const bf16_t* PT, const bf16_t* KT, const bf16_t* VT, const float* REC, bf16_t* mix) {
    constexpr int LDS_ST = 1040, LDV = 144, LDO = 144;
    LAS unsigned char* ST = F.lds;
    LAS unsigned char* VTs = F.lds + 83200;
    LAS unsigned char* Os = F.lds + 83200 + 23040;
    LAS float* QN = (LAS float*)(F.lds + 83200 + 23040 + 9216);
    LAS float* RS = QN + 64;
    const int lane = F.lane, l15 = lane & 15, g = lane >> 4, w = F.wave, lt = w >> 1, eh = w & 1;
    for (int u = F.bid; u < NB * 4 * 8; u += F.G) {
        const int eb = u & 7, h = (u >> 3) & 3, b = u >> 5;
        f32x4 S[4][5];
#pragma unroll
        for (int mt = 0; mt < 4; ++mt)
#pragma unroll
            for (int nt = 0; nt < 5; ++nt) S[mt][nt] = (f32x4){0.f, 0.f, 0.f, 0.f};
        for (int i = F.tid; i < 83200 / 4; i += NTHR) ((LAS unsigned*)ST)[i] = 0u;
        float m_prev = 0.f;
        for (int c = 0; c < NCHUNK; ++c) {
            const size_t t0 = (size_t)b * SEQ + (size_t)c * 64;
            const size_t uidx = ((size_t)(b * 4 + h)) * NCHUNK + c;
            const float* rec = REC + uidx * 192;
            LAS unsigned char* vt = VTs + (c & 1) * 11520;
            const float Amax = rec[128 + 63], blast = rec[63];
            const float Mx = fmaxf(m_prev, Amax), keep = __expf(m_prev - Mx);
            {
                const int e = F.tid >> 3, q = F.tid & 7;
                const f32x4 z0 = *(const f32x4*)(rec + 64 + 8 * q), z1 = *(const f32x4*)(rec + 64 + 8 * q + 4);
                const float wm[8] = {__expf(z0.x - Mx), __expf(z0.y - Mx), __expf(z0.z - Mx), __expf(z0.w - Mx), __expf(z1.x - Mx), __expf(z1.y - Mx), __expf(z1.z - Mx), __expf(z1.w - Mx)};
                const u32x4 raw = *(const u32x4*)(VT + uidx * (512 * 64) + (size_t)(64 * eb + e) * 64 + 8 * q);
                const float f[8] = {bflo(raw.x) * wm[0], bfhi(raw.x) * wm[1], bflo(raw.y) * wm[2], bfhi(raw.y) * wm[3], bflo(raw.z) * wm[4], bfhi(raw.z) * wm[5], bflo(raw.w) * wm[6], bfhi(raw.w) * wm[7]};
                u32x4 o; o.x = pk2(f[0], f[1]); o.y = pk2(f[2], f[3]); o.z = pk2(f[4], f[5]); o.w = pk2(f[6], f[7]);
                *(LAS u32x4*)(vt + e * LDV + 16 * q) = o;
                if (F.tid < 128) { u32x4 o2 = (u32x4){0u, 0u, 0u, 0u};
                    if (e == 0) { o2.x = pk2(wm[0], wm[1]); o2.y = pk2(wm[2], wm[3]); o2.z = pk2(wm[4], wm[5]); o2.w = pk2(wm[6], wm[7]); }
                    *(LAS u32x4*)(vt + (64 + e) * LDV + 16 * q) = o2; }
            }
            bf16x8 pf[2];
#pragma unroll
            for (int ks = 0; ks < 2; ++ks) pf[ks] = *(const bf16x8*)(PT + uidx * 4096 + (16 * lt + l15) * 64 + 32 * ks + 8 * g);
            LDS_WAIT();
            __syncthreads();
            if (c > 0) { const int r = F.tid >> 3, q = F.tid & 7; *(u32x4*)(mix + (t0 - 64 + r) * 2048 + 512 * h + 64 * eb + 8 * q) = *(const LAS u32x4*)(Os + r * LDO + 16 * q); }
            f32x4 oi[3], oo[3];
#pragma unroll
            for (int j = 0; j < 3; ++j) { oi[j] = (f32x4){0.f, 0.f, 0.f, 0.f}; oo[j] = (f32x4){0.f, 0.f, 0.f, 0.f}; }
#pragma unroll
            for (int j = 0; j < 3; ++j) { const int nt = eh + 2 * j;
                if (nt < 5) {
#pragma unroll
                    for (int ks = 0; ks < 2; ++ks) { const bf16x8 vf = *(const LAS bf16x8*)(vt + (16 * nt + l15) * LDV + 64 * ks + 16 * g);
                        oi[j] = __builtin_amdgcn_mfma_f32_16x16x32_bf16(pf[ks], vf, oi[j], 0, 0, 0); } } }
#pragma unroll 4
            for (int ks = 0; ks < 16; ++ks) {
                const bf16x8 qf = *(const bf16x8*)(MQ + (t0 + 16 * lt + l15) * 2048 + 512 * h + 32 * ks + 8 * g);
#pragma unroll
                for (int j = 0; j < 3; ++j) { const int nt = eh + 2 * j;
                    if (nt < 5) { const bf16x8 sf = *(const LAS bf16x8*)(ST + (16 * nt + l15) * LDS_ST + 64 * ks + 16 * g);
                        oo[j] = __builtin_amdgcn_mfma_f32_16x16x32_bf16(qf, sf, oo[j], 0, 0, 0); } }
            }
            if (eh == 0 && l15 == 0) {
#pragma unroll
                for (int r = 0; r < 4; ++r) { QN[16 * lt + 4 * g + r] = oo[2][r]; RS[16 * lt + 4 * g + r] = oi[2][r]; }
            }
            LDS_WAIT();
            __syncthreads();
#pragma unroll
            for (int r = 0; r < 4; ++r) { const int l = 16 * lt + 4 * g + r;
                const float bl = rec[l], al = rec[128 + l];
                const float Ml = fmaxf(m_prev, al), rho = __expf(Mx - Ml), wi = __expf(m_prev - Ml);
                const float den = wi * QN[l] + rho * RS[l];
                const float dn = fmaxf(fabsf(den), __expf(-(bl + Ml)));
                const float inv = 1.0f / dn;
#pragma unroll
                for (int j = 0; j < 2; ++j) { const int nt = eh + 2 * j;
                    *(LAS unsigned short*)(Os + l * LDO + 2 * (16 * nt + l15)) = (unsigned short)f2bf((wi * oo[j][r] + rho * oi[j][r]) * inv); } }
            bf16x8 kf[4][2];
#pragma unroll
            for (int mt = 0; mt < 4; ++mt)
#pragma unroll
                for (int ks = 0; ks < 2; ++ks) kf[mt][ks] = *(const bf16x8*)(KT + uidx * (512 * 64) + ((((4 * w + mt) * 2 + ks) * 64 + lane) << 3));
#pragma unroll
            for (int nt = 0; nt < 5; ++nt) {
                bf16x8 vf[2];
#pragma unroll
                for (int ks = 0; ks < 2; ++ks) vf[ks] = *(const LAS bf16x8*)(vt + (16 * nt + l15) * LDV + 64 * ks + 16 * g);
#pragma unroll
                for (int mt = 0; mt < 4; ++mt) { S[mt][nt] = S[mt][nt] * keep;
#pragma unroll
                    for (int ks = 0; ks < 2; ++ks) S[mt][nt] = __builtin_amdgcn_mfma_f32_16x16x32_bf16(kf[mt][ks], vf[ks], S[mt][nt], 0, 0, 0);
                    u32x2 o; o.x = pk2(S[mt][nt][0], S[mt][nt][1]); o.y = pk2(S[mt][nt][2], S[mt][nt][3]);
                    *(LAS u32x2*)(ST + (16 * nt + l15) * LDS_ST + 2 * (64 * w + 16 * mt + 4 * g)) = o; }
            }
            m_prev = blast + Mx;
        }
        LDS_WAIT();
        __syncthreads();
        { const size_t t0 = (size_t)b * SEQ + (size_t)(NCHUNK - 1) * 64; const int r = F.tid >> 3, q = F.tid & 7;
          *(u32x4*)(mix + (t0 + r) * 2048 + 512 * h + 64 * eb + 8 * q) = *(const LAS u32x4*)(Os + r * LDO + 16 * q); }
        LDS_WAIT();
        __syncthreads();
    }
}

__device__ __forceinline__ void mls_norm_phase(Frame& F, const bf16_t* mix, const bf16_t* proj, const bf16_t* MXC, const float* gn, const float* skip, bf16_t* amix) {
    const int gw = F.bid * NWAVES + F.wave, NGW = F.G * NWAVES, lane = F.lane;
    for (int i = gw; i < T * 4; i += NGW) {
        const int t = i >> 2, h = i & 3, ch = 512 * h + 8 * lane;
        const u32x4 raw = *(const u32x4*)(mix + (size_t)t * 2048 + ch);
        const u32x4 zr = *(const u32x4*)(proj + (size_t)t * 4096 + 2048 + ch);
        const u32x4 xr = *(const u32x4*)(MXC + (size_t)t * 2048 + ch);
        float v[8] = {bflo(raw.x), bfhi(raw.x), bflo(raw.y), bfhi(raw.y), bflo(raw.z), bfhi(raw.z), bflo(raw.w), bfhi(raw.w)};
        const float zv[8] = {bflo(zr.x), bfhi(zr.x), bflo(zr.y), bfhi(zr.y), bflo(zr.z), bfhi(zr.z), bflo(zr.w), bfhi(zr.w)};
        const float xv[8] = {bflo(xr.x), bfhi(xr.x), bflo(xr.y), bfhi(xr.y), bflo(xr.z), bfhi(xr.z), bflo(xr.w), bfhi(xr.w)};
        float s = 0.f;
#pragma unroll
        for (int j = 0; j < 8; ++j) s += v[j];
        const float mean = wave_sum(s) * (1.0f / 512.0f);
        float q = 0.f;
#pragma unroll
        for (int j = 0; j < 8; ++j) { v[j] -= mean; q += v[j] * v[j]; }
        const float rstd = rsqrtf(wave_sum(q) * (1.0f / 512.0f) + EPS);
        const f32x4 g0 = *(const f32x4*)(gn + ch), g1 = *(const f32x4*)(gn + ch + 4), s0 = *(const f32x4*)(skip + ch), s1 = *(const f32x4*)(skip + ch + 4);
        const float gg[8] = {g0.x, g0.y, g0.z, g0.w, g1.x, g1.y, g1.z, g1.w};
        const float sk[8] = {s0.x, s0.y, s0.z, s0.w, s1.x, s1.y, s1.z, s1.w};
        float o[8];
#pragma unroll
        for (int j = 0; j < 8; ++j) o[j] = (v[j] * rstd * gg[j] + sk[j] * xv[j]) * siluf_(zv[j]);
        u32x4 ow; ow.x = pk2(o[0], o[1]); ow.y = pk2(o[2], o[3]); ow.z = pk2(o[4], o[5]); ow.w = pk2(o[6], o[7]);
        *(u32x4*)(amix + (size_t)t * 2048 + ch) = ow;
    }
}
#define NPH_MLS 6
#define LAYER_MLS() do { \
        { pg8::Gemm g{IFP8_MLS ? (const bf16_t*)(ws + WS_H8) : hbuf, (const bf16_t*)(ws + WS_W_MLS_IN), T, GFP8_MLS ? 2048 : 4096, IFP8_MLS ? 512 : 1024}; pg8::EpiBf16S E{proj, 4096, 0, 1.0f, IFP8_MLS ? 0.03125f : 1.0f}; \
          pg8::Gemm g2{(const bf16_t*)(ws + WS_H8), (const bf16_t*)(ws + WS_W_MLS_IN + 4 * MiB), T, 2048, 512}; pg8::EpiBf16S E2{proj + 2048, 4096, 0, 1.0f, 0.03125f}; \
          RUN_PHASE({ pg8::StaticOrder S; S.init(T, GFP8_MLS ? 2048 : 4096, F.G, F.bid); pg8::gemm_phase<pg8::EpiBf16S, pg8::StaticOrder, false, (IFP8_MLS != 0)>(F.lds, g, S, E); \
            if (GFP8_MLS) { pg8::StaticOrder S2; S2.init(T, 2048, F.G, F.bid); pg8::gemm_phase<pg8::EpiBf16S, pg8::StaticOrder, false, true>(F.lds, g2, S2, E2); } }); } \
        RUN_PHASE_N(REP_PRE, mls_pre_phase(F, proj, in[19], in[20], in[21], in[22], in[23], (const bf16_t*)(ws + WS_WMG), in[25], (bf16_t*)(ws + WS_MQ), (bf16_t*)(ws + WS_MK), (bf16_t*)(ws + WS_MV), (bf16_t*)(ws + WS_MXC), (float*)(ws + WS_GATES))); \
        RUN_PHASE_N(REP_S1, mls_s1_phase(F, (const bf16_t*)(ws + WS_MQ), (const bf16_t*)(ws + WS_MK), (const bf16_t*)(ws + WS_MV), (const float*)(ws + WS_GATES), (bf16_t*)(ws + WS_PT), (bf16_t*)(ws + WS_KT), (bf16_t*)(ws + WS_VT), (float*)(ws + WS_REC))); \
        RUN_PHASE({ if (S2M) s2m_phase(F, (const bf16_t*)(ws + WS_MQ), (const bf16_t*)(ws + WS_PT), (const bf16_t*)(ws + WS_KT), (const bf16_t*)(ws + WS_MV), (const float*)(ws + WS_REC), (bf16_t*)(ws + WS_MIX)); else s2_phase<MLS_S2MODE>(F, (const bf16_t*)(ws + WS_MQ), (const bf16_t*)(ws + WS_PT), (const bf16_t*)(ws + WS_KT), (const bf16_t*)(ws + WS_MV), (const float*)(ws + WS_REC), (bf16_t*)(ws + WS_MIX)); \
            if (REP_S2M > 1) { VM_WAIT(); __syncthreads(); if (S2M) s2m_phase(F, (const bf16_t*)(ws + WS_MQ), (const bf16_t*)(ws + WS_PT), (const bf16_t*)(ws + WS_KT), (const bf16_t*)(ws + WS_MV), (const float*)(ws + WS_REC), (bf16_t*)(ws + WS_AMIX)); else s2_phase<2, S2_ABL>(F, (const bf16_t*)(ws + WS_MQ), (const bf16_t*)(ws + WS_PT), (const bf16_t*)(ws + WS_KT), (const bf16_t*)(ws + WS_MV), (const float*)(ws + WS_REC), (bf16_t*)(ws + WS_AMIX)); } }); \
        RUN_PHASE_N(REP_HN, hn_phase<2>(F, (const bf16_t*)(ws + WS_MIX), proj, (const bf16_t*)(ws + WS_MXC), in[26], in[27], amix)); \
        OUTPROJ(3, WS_W_MLS_OUT, 2048); \
    } while (0)
#ifndef N_LAUNCH_MODE
#define N_LAUNCH_MODE 0
#endif
struct Args { const float* in[35]; float* out; unsigned char* ws; int ph_lo, ph_hi; };

__global__ void __launch_bounds__(NTHR, 2) trunk_fwd(Args args) {
    extern __shared__ __attribute__((aligned(16))) unsigned char lds_raw[];
    Frame F;
    F.lds = (LAS unsigned char*)lds_raw;
    F.tid = threadIdx.x; F.lane = F.tid & 63; F.wave = __builtin_amdgcn_readfirstlane(F.tid >> 6);
    F.G = gridDim.x; F.bid = blockIdx.x;
    F.ws = args.ws; F.in = args.in; F.out = args.out; F.ctl = (unsigned*)(args.ws + WS_CTL);
    unsigned char* ws = args.ws; const float* const* in = args.in;
    const int lo = args.ph_lo, hi = args.ph_hi;
    volatile LAS unsigned* xbw = (volatile LAS unsigned*)(F.lds + LDS_MISC);
    if (F.tid < 4) xbw[F.tid] = 0u;
    __syncthreads();
    XcdBarrier bar; bar.bar = F.ctl + CW_BAR; bar.x = 0; bar.st = xbw;
    if (hi - lo > 1) bar = xcd_barrier_post(F.ctl + CW_BAR, xbw);
    int ph = 0;
#define RUN_PHASE(...) do { if (ph >= lo && ph < hi) { __VA_ARGS__; if (ph + 1 < hi) { xcd_barrier(bar); if (REP_BAR > 1) xcd_barrier(bar); } } ++ph; } while (0)
#define RUN_PHASE_DUP(NREP, ...) do { if (ph >= lo && ph < hi) { __VA_ARGS__; if ((NREP) > 1) { VM_WAIT(); __syncthreads(); __VA_ARGS__; } if (ph + 1 < hi) xcd_barrier(bar); } ++ph; } while (0)
#define RUN_PHASE_N(NREP, ...) do { if (ph >= lo && ph < hi) { for (int rep_ = 0; rep_ < (NREP); ++rep_) { if (rep_) { VM_WAIT(); __syncthreads(); } __VA_ARGS__; } if (ph + 1 < hi) xcd_barrier(bar); } ++ph; } while (0)

    float* mod = (float*)(ws + WS_MOD);
    bf16_t* xres = (bf16_t*)(ws + WS_XRES);
    bf16_t* hbuf = (bf16_t*)(ws + WS_H);
    bf16_t* proj = (bf16_t*)(ws + WS_PROJ);
    bf16_t* amix = (bf16_t*)(ws + WS_AMIX);
    bf16_t* act = (bf16_t*)(ws + WS_ACT);
    bf16_t* yp = (bf16_t*)(ws + WS_YP);
    int* tokes = (int*)(ws + WS_TOKES); float* tokw = (float*)(ws + WS_TOKW);
    unsigned short* list = (unsigned short*)(ws + WS_LIST);
    const void* xcur = in[0];

    RUN_PHASE_N(REP_PRO, prologue_phase(F));

#define MOD(l, k) (mod + (size_t)(l) * NB * 6144 + (k) * 1024)
#define CNT(l) (F.ctl + CW_CNT + (l) * 32 * 64)
#define NORM1(l, PROJ) do { constexpr bool CMB = ((l) > 0) && ENABLE_MOE; NormArgs a{}; a.xin = xcur; a.xout = xres; a.gain = in[4] + (l) * 1024; a.sc = MOD(l, 1); a.sh = MOD(l, 0); a.h = hbuf; \
        if (CMB) { a.yp = yp; a.tokes_c = tokes; a.tokw_c = tokw; a.gf = MOD((l) - 1, 5); a.cnt_prev = CNT((l) - 1); } \
        a.wt = (const bf16_t*)(ws + WS_WGL); a.glow = (float*)(ws + WS_GLOW); a.h8 = (unsigned char*)(ws + WS_H8); \
        constexpr int IF8 = (l) == 0 ? IFP8_RET : ((l) == 1 ? IFP8_ATT : ((l) == 2 ? IFP8_GLA : IFP8_MLS)); \
        constexpr int GF8 = (l) == 0 ? GFP8_RET : ((l) == 2 ? GFP8_GLA : ((l) == 3 ? GFP8_MLS : 0)); \
        RUN_PHASE({ norm_phase<CMB, PROJ, false, ((l) > 0), (IF8 ? 2 : (GF8 ? 3 : 1))>(F, a); \
            if (REP_NORM > 1) { VM_WAIT(); __syncthreads(); NormArgs a2 = a; a2.xout = (bf16_t*)(ws + WS_PT); a2.h = (bf16_t*)(ws + WS_MIX); a2.h8 = (unsigned char*)(ws + WS_AMIX); norm_phase<CMB, 0, false, ((l) > 0), (IF8 ? 2 : (GF8 ? 3 : 1))>(F, a2); } }); if (CMB) xcur = xres; } while (0)
#define OUTPROJ(l, WOFF, KK) do { pg8::Gemm g{amix, (const bf16_t*)(ws + (WOFF)), T, DM, OUT_FP8 ? (KK) / 2 : (KK)}; pg8::EpiResid<((l) > 0)> E{xcur, xres, MOD(l, 2), OUT_FP8 ? 0.03125f : 1.0f}; \
        RUN_PHASE({ pg8::StaticOrder S; S.init(T, DM, F.G, F.bid); pg8::gemm_phase<pg8::EpiResid<((l) > 0)>, pg8::StaticOrder, false, (OUT_FP8 != 0)>(F.lds, g, S, E); \
            if (REP_OUT > 1) { VM_WAIT(); __syncthreads(); pg8::EpiResid<((l) > 0)> E2{(l) > 0 ? (const void*)(ws + WS_PT) : xcur, (bf16_t*)(ws + WS_PT), MOD(l, 2), 1.0f}; pg8::gemm_phase<pg8::EpiResid<((l) > 0)>, pg8::StaticOrder, false, (OUT_FP8 != 0)>(F.lds, g, S, E2); } }); xcur = xres; } while (0)
#define MOE(l) do { if (!ENABLE_MOE) break; \
        { NormArgs a{}; a.xin = xcur; a.gain = in[5] + (l) * 1024; a.sc = MOD(l, 4); a.sh = MOD(l, 3); a.h = hbuf; \
          a.wt = (const bf16_t*)(ws + WS_WRT) + (size_t)(l) * 2 * 32 * 1024; a.rb = in[30] + (l) * 32; a.cnt = CNT(l); a.list = list; a.tokes = tokes; a.tokw = tokw; a.h8 = (unsigned char*)(ws + WS_H8); \
          RUN_PHASE({ norm_phase<false, 1, false, true, (MOE_FP8 ? 3 : 1)>(F, a); \
            if (REP_NORM > 1) { VM_WAIT(); __syncthreads(); NormArgs a2 = a; a2.h = (bf16_t*)(ws + WS_MIX); a2.h8 = (unsigned char*)(ws + WS_AMIX); norm_phase<false, 0, false, true, (MOE_FP8 ? 3 : 1)>(F, a2); } }); } \
        if (MOE_FP8) { \
          { pg8::EpiSwiglu8 E{(unsigned char*)act, in[32] + (size_t)(l) * 32 * 2048}; pg8::EpiNull EN{(float*)(ws + WS_GLOW)}; \
            RUN_PHASE({ if (CVT_HOST && (l) >= MOE_PRO_LAYERS - 1 && (l) < 3) moe_gemm_phase<8, true, true, pg8::EpiSwiglu8, false, true>(F, (const bf16_t*)(ws + WS_H8), (const bf16_t*)(ws + WS_W1T + (size_t)(l) * 32 * 2048 * 1024), CNT(l), list, E, in, ws, (l) + 1, (CVT_HOST == 2 && (l) == 0) ? 0 : -1); \
              else moe_gemm_phase<8, true, true, pg8::EpiSwiglu8>(F, (const bf16_t*)(ws + WS_H8), (const bf16_t*)(ws + WS_W1T + (size_t)(l) * 32 * 2048 * 1024), CNT(l), list, E); \
              if (REP_MOE > 1 && (MOE_WHICH & 1)) { VM_WAIT(); __syncthreads(); if (MOE_NULL) moe_gemm_phase<8, true, true, pg8::EpiNull, (MOE_HOT != 0)>(F, (const bf16_t*)(ws + WS_H8), (const bf16_t*)(ws + WS_W1T + (size_t)(l) * 32 * 2048 * 1024), CNT(l), list, EN); \
                else moe_gemm_phase<8, true, true, pg8::EpiSwiglu8>(F, (const bf16_t*)(ws + WS_H8), (const bf16_t*)(ws + WS_W1T + (size_t)(l) * 32 * 2048 * 1024), CNT(l), list, E); } }); } \
          { pg8::EpiMoe2 E{yp, in[34] + (size_t)(l) * 32 * 1024, 0.03125f}; pg8::EpiNull EN{(float*)(ws + WS_GLOW)}; \
            RUN_PHASE({ moe_gemm_phase<4, false, true, pg8::EpiMoe2>(F, act, (const bf16_t*)(ws + WS_W2T + (size_t)(l) * 32 * 1024 * 1024), CNT(l), list, E); \
              if (REP_MOE > 1 && (MOE_WHICH & 2)) { VM_WAIT(); __syncthreads(); if (MOE_NULL) moe_gemm_phase<4, false, true, pg8::EpiNull, (MOE_HOT != 0)>(F, act, (const bf16_t*)(ws + WS_W2T + (size_t)(l) * 32 * 1024 * 1024), CNT(l), list, EN); \
                else moe_gemm_phase<4, false, true, pg8::EpiMoe2>(F, act, (const bf16_t*)(ws + WS_W2T + (size_t)(l) * 32 * 1024 * 1024), CNT(l), list, E); } }); } \
        } else { \
          { pg8::EpiSwiglu E{act, in[32] + (size_t)(l) * 32 * 2048}; \
            RUN_PHASE_N(REP_MOE, moe_gemm_phase<8, true, false, pg8::EpiSwiglu>(F, hbuf, (const bf16_t*)(ws + WS_W1T) + (size_t)(l) * 32 * 2048 * 1024, CNT(l), list, E)); } \
          { pg8::EpiMoe2 E{yp, in[34] + (size_t)(l) * 32 * 1024, 1.0f}; \
            RUN_PHASE_N(REP_MOE, moe_gemm_phase<4, false, false, pg8::EpiMoe2>(F, act, (const bf16_t*)(ws + WS_W2T) + (size_t)(l) * 32 * 1024 * 1024, CNT(l), list, E)); } \
        } \
    } while (0)

    NORM1(0, 0);
#if ENABLE_RET
    LAYER_RET();
#endif
    MOE(0);
    NORM1(1, 0);
#if ENABLE_ATT
    LAYER_ATT();
#endif
    MOE(1);
    NORM1(2, 2);
#if ENABLE_GLA
    LAYER_GLA();
#endif
    MOE(2);
    NORM1(3, 0);
#if ENABLE_MLS
    LAYER_MLS();
#endif
    MOE(3);
    { NormArgs a{}; a.xin = xcur; a.xout = xres; a.gain = in[6]; a.yp = yp; a.tokes_c = tokes; a.tokw_c = tokw; a.gf = MOD(3, 5); a.cnt_prev = CNT(3); a.out = F.out;
      RUN_PHASE({ norm_phase<(ENABLE_MOE != 0), 0, true, true>(F, a); if (REP_NORM > 1) { VM_WAIT(); __syncthreads(); NormArgs a2 = a; a2.xout = (bf16_t*)(ws + WS_PT); a2.out = (float*)(ws + WS_MIX); norm_phase<(ENABLE_MOE != 0), 0, true, true>(F, a2); } }); }
#undef RUN_PHASE
}

static int count_phases() {
    int n = 1;
    const int mixer[4] = {ENABLE_RET ? NPH_RET : 0, ENABLE_ATT ? NPH_ATT : 0, ENABLE_GLA ? NPH_GLA : 0, ENABLE_MLS ? NPH_MLS : 0};
    for (int l = 0; l < 4; ++l) n += 1 + mixer[l] + (ENABLE_MOE ? 3 : 0);
    return n + 1;
}

extern "C" void kernel_launch(void* const* d_in, const int* in_sizes, int n_in, void* d_out, int out_size, void* d_ws, size_t ws_size, hipStream_t stream) {
    static int grid = 0;
    if (grid == 0) {
        if (n_in != 35 || out_size != T * DM || ws_size < WS_END) { fprintf(stderr, "kernel_launch: unexpected shapes (n_in %d out %d ws %zu)\n", n_in, out_size, ws_size); grid = -1; return; }
        int dev = 0, cus = 0, per_cu = 0;
        if (hipGetDevice(&dev) != hipSuccess || hipDeviceGetAttribute(&cus, hipDeviceAttributeMultiprocessorCount, dev) != hipSuccess) { grid = -1; return; }
        if (hipFuncSetAttribute((const void*)trunk_fwd, hipFuncAttributeMaxDynamicSharedMemorySize, LDS_BYTES) != hipSuccess) { fprintf(stderr, "kernel_launch: hipFuncSetAttribute failed\n"); grid = -1; return; }
        if (hipOccupancyMaxActiveBlocksPerMultiprocessor(&per_cu, (const void*)trunk_fwd, NTHR, LDS_BYTES) != hipSuccess || per_cu < 1) { fprintf(stderr, "kernel_launch: occupancy query says %d\n", per_cu); grid = -1; return; }
        grid = cus;
    }
    if (grid <= 0) return;
    hipMemsetAsync((char*)d_ws + WS_CTL, 0, CTL_ZERO_BYTES, stream);
    Args a{};
    for (int i = 0; i < 35; ++i) a.in[i] = (const float*)d_in[i];
    a.out = (float*)d_out; a.ws = (unsigned char*)d_ws;
    const int nph = count_phases();
#if N_LAUNCH_MODE == 1
    for (int p = 0; p < nph; ++p) { a.ph_lo = p; a.ph_hi = p + 1; hipLaunchKernelGGL(trunk_fwd, dim3(grid), dim3(NTHR), LDS_BYTES, stream, a); }
#else
    a.ph_lo = 0; a.ph_hi = nph;
    hipLaunchKernelGGL(trunk_fwd, dim3(grid), dim3(NTHR), LDS_BYTES, stream, a);
#endif
    hipError_t le = hipGetLastError();
    if (le != hipSuccess) fprintf(stderr, "kernel_launch: launch failed: %s\n", hipGetErrorName(le));
}
```

```cpp
#include <hip/hip_runtime.h>
#include <stdint.h>
#include <stdio.h>

#define GAS __attribute__((address_space(1)))
#define LAS __attribute__((address_space(3)))
typedef unsigned short bf16_t;
typedef short bf16x8 __attribute__((ext_vector_type(8)));
typedef float f32x4 __attribute__((ext_vector_type(4)));
typedef float f32x2 __attribute__((ext_vector_type(2)));
typedef unsigned u32x4 __attribute__((ext_vector_type(4)));
typedef unsigned u32x2 __attribute__((ext_vector_type(2)));
typedef short s16x4 __attribute__((ext_vector_type(4)));
typedef int i32x8 __attribute__((ext_vector_type(8)));
typedef int i32x4 __attribute__((ext_vector_type(4)));

constexpr int NB = 8, SEQ = 4096, DM = 1024, T = NB * SEQ;
constexpr int NCHUNK = SEQ / 64;
constexpr int NEXP = 32, TOPK = 4;
constexpr int NWAVES = 8, NTHR = NWAVES * 64;
constexpr float EPS = 1e-6f;

constexpr size_t MiB = 1u << 20;
constexpr size_t WS_CTL = 0, CTL_ZERO_BYTES = 1 * MiB;
constexpr size_t WS_MOD = 1 * MiB;
constexpr size_t WS_ROPE = 2 * MiB;
constexpr size_t WS_WRT = 6 * MiB;
constexpr size_t WS_WGL = 7 * MiB;
constexpr size_t WS_WMG = 7 * MiB + 131072;
constexpr size_t WS_W_RET_IN = 8 * MiB, WS_W_RET_OUT = 20 * MiB, WS_W_ATT_IN = 24 * MiB, WS_W_ATT_OUT = 30 * MiB;
constexpr size_t WS_W_GLA_IN = 32 * MiB, WS_W_GLA_OUT = 38 * MiB, WS_W_MLS_IN = 40 * MiB, WS_W_MLS_OUT = 48 * MiB;
constexpr size_t WS_W1T = 64 * MiB;
constexpr size_t WS_W2T = 576 * MiB;
constexpr size_t WS_XRES = 832 * MiB;
constexpr size_t WS_H = 960 * MiB;
constexpr size_t WS_PROJ = 1024 * MiB;
constexpr size_t WS_MIX = 1408 * MiB;
constexpr size_t WS_AMIX = 1536 * MiB;
constexpr size_t WS_PT = 1664 * MiB;
constexpr size_t WS_KT = 1680 * MiB;
constexpr size_t WS_VT = 1808 * MiB;
constexpr size_t WS_QS = 1936 * MiB;
constexpr size_t WS_REC = 1968 * MiB;
constexpr size_t WS_MQ = WS_PROJ + 256 * MiB;
constexpr size_t WS_MK = 1984 * MiB, WS_MV = 2112 * MiB, WS_MXC = 2240 * MiB;
constexpr size_t WS_ACT = 2368 * MiB;
constexpr size_t WS_YP = 2640 * MiB;
constexpr size_t WS_TOKES = 2912 * MiB;
constexpr size_t WS_TOKW = 2913 * MiB;
constexpr size_t WS_LIST = 2914 * MiB;
constexpr size_t WS_GLOW = 2918 * MiB;
constexpr size_t WS_GATES = 2920 * MiB;
constexpr size_t WS_H8 = 2928 * MiB;
constexpr size_t WS_END = 2960 * MiB;
constexpr int CW_BAR = 4096;
constexpr int CW_CNT = 16384;

constexpr int LDS_BYTES = 163840;
constexpr int LDS_MISC = 163840 - 1536;
constexpr int LDS_IDX = 131072;

#define LDS_WAIT() asm volatile("s_waitcnt lgkmcnt(0)" ::: "memory")
#define VM_WAIT() asm volatile("s_waitcnt vmcnt(0)" ::: "memory")
#define WG_SYNC_LDS() do { asm volatile("s_waitcnt lgkmcnt(0)" ::: "memory"); __builtin_amdgcn_s_barrier(); asm volatile("" ::: "memory"); } while (0)
typedef __bf16 bf16n2 __attribute__((ext_vector_type(2)));
__device__ __forceinline__ unsigned pk2(float lo, float hi) { const f32x2 v = {lo, hi}; return __builtin_bit_cast(unsigned, __builtin_convertvector(v, bf16n2)); }
__device__ __forceinline__ unsigned f2bf(float f) { return pk2(f, 0.f) & 0xffffu; }
__device__ __forceinline__ float bf2f(unsigned short b) { return __builtin_bit_cast(float, ((unsigned)b) << 16); }
__device__ __forceinline__ float bflo(unsigned u) { return __builtin_bit_cast(float, u << 16); }
__device__ __forceinline__ float bfhi(unsigned u) { return __builtin_bit_cast(float, u & 0xffff0000u); }
__device__ __forceinline__ unsigned cvt_pk_bf16(float lo, float hi) { return pk2(lo, hi); }
__device__ __forceinline__ unsigned pk4_fp8(float a, float b, float c, float d) { int r = 0; r = __builtin_amdgcn_cvt_pk_fp8_f32(a, b, r, false); r = __builtin_amdgcn_cvt_pk_fp8_f32(c, d, r, true); return (unsigned)r; }
__device__ __forceinline__ float wave_sum(float v) {
#pragma unroll
    for (int o = 1; o < 64; o <<= 1) v += __shfl_xor(v, o);
    return v;
}
__device__ __forceinline__ float wave_max(float v) {
#pragma unroll
    for (int o = 1; o < 64; o <<= 1) v = fmaxf(v, __shfl_xor(v, o));
    return v;
}
__device__ __forceinline__ float sigmoidf_(float x) { return __builtin_amdgcn_rcpf(1.0f + __builtin_amdgcn_exp2f(-1.4426950408889634f * x)); }
__device__ __forceinline__ float siluf_(float x) { return x * __builtin_amdgcn_rcpf(1.0f + __builtin_amdgcn_exp2f(-1.4426950408889634f * x)); }
__device__ __forceinline__ float logsigmoidf_(float x) { return fminf(x, 0.f) - log1pf(__expf(-fabsf(x))); }

#define XB_TMO      128
#define XB_XCNT(j)  (256  + 64 * (j))
#define XB_XSUB(j)  (1280 + 64 * (j))
#define XB_XGEN(j)  (2304 + 64 * (j))
#define XB_TOP      3328
#define XB_TOPGEN   3392
#define XCD_BAR_WORDS 3456
#define XB_SPIN_CAP (1u << 20)

__device__ __forceinline__ unsigned xb_ld(unsigned* p)              { return __hip_atomic_load(p, __ATOMIC_RELAXED, __HIP_MEMORY_SCOPE_AGENT); }
__device__ __forceinline__ unsigned xb_add(unsigned* p, unsigned v) { return __hip_atomic_fetch_add(p, v, __ATOMIC_RELAXED, __HIP_MEMORY_SCOPE_AGENT); }
__device__ __forceinline__ unsigned xb_xcc_id() { return (unsigned)__builtin_amdgcn_s_getreg((3 << 11) | 20) & 0xFu; }
#define XB_SPIN(cond, bar) do { unsigned _sp = 0; while (cond) { __builtin_amdgcn_s_sleep(1); \
    if ((++_sp & 255u) == 0u) { if (xb_ld(&(bar)[XB_TMO])) break; if (_sp > XB_SPIN_CAP) { atomicAdd(&(bar)[XB_TMO], 1u); break; } } } } while (0)

struct XcdBarrier { unsigned* bar; unsigned x; volatile LAS unsigned* st; };

__device__ __forceinline__ XcdBarrier xcd_barrier_post(unsigned* bar, volatile LAS unsigned* st) {
    XcdBarrier b; b.bar = bar; b.x = xb_xcc_id(); b.st = st;
    if (threadIdx.x == 0) (void)xb_add(&bar[XB_XCNT(b.x)], 1u);
    return b;
}
__device__ __forceinline__ void xcd_barrier_complete(unsigned* bar, unsigned x, unsigned& nloc, unsigned& nx) {
    const unsigned G = gridDim.x * gridDim.y * gridDim.z;
    unsigned sum, cnt, mine, sp = 0u;
    for (;;) {
        sum = 0u; cnt = 0u; mine = 0u;
#pragma unroll
        for (unsigned j = 0; j < 16; ++j) { const unsigned c = xb_ld(&bar[XB_XCNT(j)]); sum += c; cnt += (c > 0u) ? 1u : 0u; mine = (j == x) ? c : mine; }
        if (sum == G) break;
        __builtin_amdgcn_s_sleep(1);
        if ((++sp & 255u) == 0u) { if (xb_ld(&bar[XB_TMO])) break; if (sp > XB_SPIN_CAP) { atomicAdd(&bar[XB_TMO], 1u); break; } }
    }
    nloc = mine > 0u ? mine : 1u; nx = cnt > 0u ? cnt : 1u;
}
__device__ __forceinline__ void xcd_barrier(const XcdBarrier& b) {
    asm volatile("s_waitcnt vmcnt(0)" ::: "memory");
    __syncthreads();
    if (threadIdx.x == 0) {
        unsigned* bar = b.bar;
        __builtin_amdgcn_s_waitcnt(0);
        unsigned nloc = b.st[0], nx = b.st[1];
        if (nloc == 0u) { xcd_barrier_complete(bar, b.x, nloc, nx); b.st[0] = nloc; b.st[1] = nx; }
        const unsigned old = xb_add(&bar[XB_XSUB(b.x)], 1u);
        const unsigned gen = old / nloc;
        if (old + 1u == (gen + 1u) * nloc) {
            __builtin_amdgcn_fence(__ATOMIC_RELEASE, "agent");
            asm volatile("s_waitcnt vmcnt(0)" ::: "memory");
            const unsigned og = xb_add(&bar[XB_TOP], 1u);
            const unsigned tg = og / nx;
            if (og + 1u == (tg + 1u) * nx) xb_add(&bar[XB_TOPGEN], 1u);
            else XB_SPIN(xb_ld(&bar[XB_TOPGEN]) == tg, bar);
            __builtin_amdgcn_fence(__ATOMIC_ACQUIRE, "agent");
            xb_add(&bar[XB_XGEN(b.x)], 1u);
            asm volatile("s_waitcnt vmcnt(0)" ::: "memory");
        } else {
            XB_SPIN(xb_ld(&bar[XB_XGEN(b.x)]) == gen, bar);
            __builtin_amdgcn_fence(__ATOMIC_ACQUIRE, "agent");
            asm volatile("s_waitcnt vmcnt(0)" ::: "memory");
        }
    }
    __syncthreads();
}
#define N_LAUNCH_MODE 0
#define ENABLE_RET 1
#define ENABLE_ATT 1
#define ENABLE_GLA 1
#define ENABLE_MLS 1
#define ENABLE_MOE 1
#define MOE_FP8 1
#define S2_ABL 0
#define OUT_FP8 1
#define YP_FP8 1
#define MOE_NULL 0
#define MOE_WHICH 3
#define MOE_HOT 0
#define WNT 1
#define CVT_HOST 2
#define S2X 1
#define S2M 1
#define GFP8_RET 0
#define GFP8_GLA 0
#define GFP8_MLS 0
#define MOE_PRO_LAYERS 1
#define MLS_S2MODE 2
#define IFP8_RET 0
#define IFP8_GLA 0
#define IFP8_MLS 0
#define IFP8_ATT 1
#define REP_PRO 1
#define REP_MOE 1
#define REP_INPROJ 1
#define REP_S1 1
#define REP_S2 1
#define REP_S2M 1
#define REP_S2R 1
#define REP_PRE 1
#define REP_HN 1
#define REP_ATT 1
#define REP_NORM 1
#define REP_OUT 1
#define REP_BAR 1
struct CvtJob { const float* wp; unsigned char* op; int ld; int lane; };
namespace pg8 {
constexpr int BM = 256, BK = 64, HALF = 128, HTB = HALF * BK * 2, STAGE_BYTES = 8 * HTB, NXCD = 8, WGM = 8;
__host__ __device__ __forceinline__ int lds_byte(int r, int c) { const int st = (r >> 4) * 2 + (c >> 5), rr = r & 15, cc = c & 31, ob = rr * 64 + cc * 2; return st * 1024 + (ob ^ (((ob >> 9) & 1) << 5)); }
__host__ __device__ __forceinline__ void stage_rc(int b, int& R, int& C) { const int st = b / 1024, sb = b % 1024, swz = sb ^ (((sb >> 9) & 1) << 5); R = (st >> 1) * 16 + swz / 64; C = (st & 1) * 32 + (swz % 64) / 2; }
__host__ __device__ __forceinline__ int perm32(int rho) { const int n = rho >> 4, i = rho & 15; return 8 * (i >> 2) + 4 * n + (i & 3); }

struct Unit { int pm, pn; };
struct Gemm { const bf16_t* A; const bf16_t* Bt; int M, N, K; };

struct StaticOrder {
    int nM, nN, nwg, G, c;
    __device__ void init(int M, int N, int G_, int c_) { nM = M / BM; nN = N / BM; nwg = nM * nN; G = G_; c = c_; }
    __device__ bool next(int i, Unit& u) const {
        const long L = (long)i * G + c; if (L >= nwg) return false;
        int wgid = (int)L; { const int q = nwg / NXCD, r = nwg % NXCD, xcd = wgid % NXCD, off = wgid / NXCD; wgid = (xcd < r ? xcd * (q + 1) : r * (q + 1) + (xcd - r) * q) + off; }
        const int nig = WGM * nN, gid = wgid / nig, fm = gid * WGM, gsz = (nM - fm) < WGM ? (nM - fm) : WGM;
        u.pm = fm + ((wgid % nig) % gsz); u.pn = (wgid % nig) / gsz; return true;
    }
    __device__ __forceinline__ unsigned rowtok(int, int) const { return 0u; }
};
struct MoeOrder {
    const LAS int* utab;
    const LAS unsigned short* idx;
    int nmy;
    __device__ __forceinline__ bool next(int i, Unit& u) const { if (i >= nmy) return false; u.pm = utab[2 * i]; u.pn = utab[2 * i + 1]; return true; }
    __device__ __forceinline__ unsigned rowtok(int i, int r) const { return (unsigned)idx[i * 256 + r]; }
};

struct NoBg { static constexpr bool ON = false; };
template <class Epi, class Sched, bool GATHER, bool FP8, class Bg>
__device__ __forceinline__ void gemm_phase_bg(LAS unsigned char* lds, const Gemm g, const Sched& S, const Epi& E, Bg& bg) {
    const int tid = threadIdx.x, wid = __builtin_amdgcn_readfirstlane(tid >> 6), lane = tid & 63, wr = wid >> 2, wc = wid & 3, fr = lane & 15, fq = lane >> 4;
    const int K = g.K, nt = K / BK;
    unsigned voffA[2], voffB[2]; int rowA[2];
#pragma unroll
    for (int i = 0; i < 2; ++i) { int R, C; stage_rc(tid * 16 + i * 8192, R, C); const int Rb = Epi::PERM2 ? ((R >> 5) * 64 + ((R >> 2) & 3) * 16 + ((R >> 4) & 1) * 4 + (R & 3)) : (Epi::PERM ? ((R & ~31) + perm32(R & 31)) : R);
        rowA[i] = R; voffA[i] = GATHER ? (unsigned)(C * 2) : (unsigned)(R * K + C) * 2u; voffB[i] = (unsigned)(Rb * K + C) * 2u; }
    const size_t kstep = (size_t)(BK * 2);
    const size_t hstep = (size_t)HALF * K * 2;
    const size_t bhstep = Epi::PERM2 ? (size_t)8 * K * 2 : hstep;
    const size_t tstep = 2 * hstep;
    const unsigned ldsw = (unsigned)wid * 1024u;
    const int aoff = FP8 ? lds_byte(wr * 64 + fr, fq * 16) : lds_byte(wr * 64 + fr, fq * 8), boff = FP8 ? lds_byte(wc * 32 + fr, fq * 16) : lds_byte(wc * 32 + fr, fq * 8);
    const int fo1 = (fq & 1) ? 16 : 0, fo2 = 16 - fo1;
    const int aoff1 = aoff + fo1, aoff2 = aoff + fo2, boff1 = boff + fo1, boff2 = boff + fo2;
    const unsigned rowbytes = (unsigned)K * 2u;
#define PG8_SA(b, h) (((b) * 2 + (h)) * HTB)
#define PG8_SB(b, h) ((4 + (b) * 2 + (h)) * HTB)
#define PG8_STAGE(bufoff, gbase, voff) do { _Pragma("unroll") for (int _i = 0; _i < 2; ++_i) \
        __builtin_amdgcn_global_load_lds((const unsigned*)((const char*)(gbase) + (voff)[_i]), (LAS unsigned*)(lds + (bufoff) + ldsw + _i * 8192), 16, 0, 0); } while (0)
#define PG8_STAGE_A(bufoff, tptr, half, vg) do { if constexpr (GATHER) { PG8_STAGE(bufoff, tptr, (vg)[half]); } else { PG8_STAGE(bufoff, (tptr) + (half) * hstep, voffA); } } while (0)
#define PG8_LDA8(dst, b, h) do { _Pragma("unroll") for (int m = 0; m < 4; ++m) { const i32x4 lo_ = *(const LAS i32x4*)(lds + PG8_SA(b, h) + aoff1 + m * 2048), hi_ = *(const LAS i32x4*)(lds + PG8_SA(b, h) + aoff2 + m * 2048); \
        dst[m] = (i32x8){lo_.x, lo_.y, lo_.z, lo_.w, hi_.x, hi_.y, hi_.z, hi_.w}; } } while (0)
#define PG8_LDB8(dst, b, h) do { _Pragma("unroll") for (int n = 0; n < 2; ++n) { const i32x4 lo_ = *(const LAS i32x4*)(lds + PG8_SB(b, h) + boff1 + n * 2048), hi_ = *(const LAS i32x4*)(lds + PG8_SB(b, h) + boff2 + n * 2048); \
        dst[n] = (i32x8){lo_.x, lo_.y, lo_.z, lo_.w, hi_.x, hi_.y, hi_.z, hi_.w}; } } while (0)
#define PG8_MMA8(ai, bj, At, Bt) do { __builtin_amdgcn_s_setprio(1); _Pragma("unroll") for (int m = 0; m < 4; ++m) _Pragma("unroll") for (int n = 0; n < 2; ++n) \
        asm volatile("v_mfma_scale_f32_16x16x128_f8f6f4 %0, %1, %2, %0, %3, %3 op_sel_hi:[0,0,0]" : "+v"(acc[ai][bj][m][n]) : "v"(Bt[n]), "v"(At[m]), "v"(sc7f)); __builtin_amdgcn_s_setprio(0); } while (0)
#define PG8_LDA(dst, b, h) do { _Pragma("unroll") for (int m = 0; m < 4; ++m) _Pragma("unroll") for (int k = 0; k < 2; ++k) dst[m][k] = *(const LAS bf16x8*)(lds + PG8_SA(b, h) + aoff + m * 2048 + k * 1024); } while (0)
#define PG8_LDB(dst, b, h) do { _Pragma("unroll") for (int n = 0; n < 2; ++n) _Pragma("unroll") for (int k = 0; k < 2; ++k) dst[n][k] = *(const LAS bf16x8*)(lds + PG8_SB(b, h) + boff + n * 2048 + k * 1024); } while (0)
#define PG8_MMA(ai, bj, At, Bt) do { __builtin_amdgcn_s_setprio(1); _Pragma("unroll") for (int m = 0; m < 4; ++m) _Pragma("unroll") for (int n = 0; n < 2; ++n) _Pragma("unroll") for (int k = 0; k < 2; ++k) \
        acc[ai][bj][m][n] = __builtin_amdgcn_mfma_f32_16x16x32_bf16(Bt[n][k], At[m][k], acc[ai][bj][m][n], 0, 0, 0); __builtin_amdgcn_s_setprio(0); } while (0)
#define PG8_WAIT_V(n) asm volatile("s_waitcnt vmcnt(" #n ")" ::: "memory")
#define PG8_WAIT_L(n) asm volatile("s_waitcnt lgkmcnt(" #n ")" ::: "memory")
#define PG8_BAR __builtin_amdgcn_s_barrier()
#define PG8_SCHED __builtin_amdgcn_sched_barrier(0)
#define XLDA(b, h) do { if constexpr (FP8) { PG8_LDA8(At8, b, h); } else { PG8_LDA(At, b, h); } } while (0)
#define XLDB(w_, b, h) do { if constexpr (FP8) { if (w_) { PG8_LDB8(B18, b, h); } else { PG8_LDB8(B08, b, h); } } else { if (w_) { PG8_LDB(B1, b, h); } else { PG8_LDB(B0, b, h); } } } while (0)
#define XMMA(ai, bj, w_) do { if constexpr (FP8) { if (w_) { PG8_MMA8(ai, bj, At8, B18); } else { PG8_MMA8(ai, bj, At8, B08); } } else { if (w_) { PG8_MMA(ai, bj, At, B1); } else { PG8_MMA(ai, bj, At, B0); } } } while (0)
    Unit cur, nxt; int ui = 0;
    if (!S.next(0, cur)) return;
    f32x4 acc[2][2][4][2];
#pragma unroll
    for (int a = 0; a < 2; ++a)
#pragma unroll
        for (int b = 0; b < 2; ++b)
#pragma unroll
            for (int m = 0; m < 4; ++m)
#pragma unroll
                for (int n = 0; n < 2; ++n) acc[a][b][m][n] = (f32x4){0.f, 0.f, 0.f, 0.f};
    bf16x8 At[4][2], B0[2][2], B1[2][2];
    i32x8 At8[4], B08[2], B18[2]; const int sc7f = 0x7f7f7f7f;
    unsigned vgc[2][2], vgn[2][2];
    if constexpr (GATHER) {
#pragma unroll
        for (int h = 0; h < 2; ++h)
#pragma unroll
            for (int i = 0; i < 2; ++i) { vgc[h][i] = S.rowtok(0, h * HALF + rowA[i]) * rowbytes + voffA[i]; vgn[h][i] = vgc[h][i]; }
    }
    const char* cA = GATHER ? (const char*)g.A : (const char*)g.A + (size_t)cur.pm * tstep; const char* cB = (const char*)g.Bt + (size_t)cur.pn * tstep;
    PG8_STAGE(PG8_SB(0, 0), cB, voffB); PG8_STAGE_A(PG8_SA(0, 0), cA, 0, vgc); PG8_STAGE(PG8_SB(0, 1), cB + bhstep, voffB); PG8_STAGE_A(PG8_SA(0, 1), cA, 1, vgc);
    if (wr == 1) PG8_BAR;
    PG8_WAIT_V(4); PG8_BAR;
    PG8_STAGE(PG8_SB(1, 0), cB + kstep, voffB); PG8_STAGE_A(PG8_SA(1, 0), cA + kstep, 0, vgc); PG8_STAGE(PG8_SB(1, 1), cB + bhstep + kstep, voffB);
    PG8_WAIT_V(6); PG8_BAR;
    for (;;) {
        const bool has_next = S.next(ui + 1, nxt);
        if constexpr (GATHER) {
            if (has_next) {
#pragma unroll
                for (int h = 0; h < 2; ++h)
#pragma unroll
                    for (int i = 0; i < 2; ++i) vgn[h][i] = S.rowtok(ui + 1, h * HALF + rowA[i]) * rowbytes + voffA[i];
            } else {
#pragma unroll
                for (int h = 0; h < 2; ++h)
#pragma unroll
                    for (int i = 0; i < 2; ++i) vgn[h][i] = vgc[h][i];
            }
        }
        const char* nA = GATHER ? cA : (has_next ? (const char*)g.A + (size_t)nxt.pm * tstep : cA); const char* nB = has_next ? (const char*)g.Bt + (size_t)nxt.pn * tstep : cB;
        for (int t = 0; t < nt; t += 2) {
            const bool last = (t == nt - 2);
            const char* a1 = cA + (size_t)(t + 1) * kstep;
            const char* a2 = last ? nA : cA + (size_t)(t + 2) * kstep; const char* b2 = last ? nB : cB + (size_t)(t + 2) * kstep;
            const char* a3 = a2 + kstep; const char* b3 = b2 + kstep;
            unsigned vg2[2][2];
            if constexpr (GATHER) {
#pragma unroll
                for (int h = 0; h < 2; ++h)
#pragma unroll
                    for (int i = 0; i < 2; ++i) vg2[h][i] = last ? vgn[h][i] : vgc[h][i];
            }
            XLDB(0, 0, 0); PG8_SCHED; XLDA(0, 0); PG8_STAGE_A(PG8_SA(1, 1), a1, 1, vgc);
            PG8_WAIT_L(8); PG8_BAR; PG8_WAIT_L(0); XMMA(0, 0, 0); PG8_BAR; PG8_SCHED;
            XLDB(1, 0, 1); PG8_STAGE(PG8_SB(0, 0), b2, voffB);
            PG8_BAR; PG8_WAIT_L(0); XMMA(0, 1, 1); PG8_BAR;
            XLDA(0, 1); PG8_STAGE_A(PG8_SA(0, 0), a2, 0, vg2);
            PG8_BAR; PG8_WAIT_L(0); XMMA(1, 0, 0); PG8_BAR; PG8_SCHED;
            PG8_STAGE(PG8_SB(0, 1), b2 + bhstep, voffB);
            PG8_WAIT_V(6); PG8_BAR; XMMA(1, 1, 1); PG8_BAR;
            XLDB(0, 1, 0); PG8_SCHED; XLDA(1, 0); PG8_STAGE_A(PG8_SA(0, 1), a2, 1, vg2);
            PG8_WAIT_L(8); PG8_BAR; PG8_WAIT_L(0); XMMA(0, 0, 0); PG8_BAR; PG8_SCHED;
            XLDB(1, 1, 1); PG8_STAGE(PG8_SB(1, 0), b3, voffB);
            PG8_BAR; PG8_WAIT_L(0); XMMA(0, 1, 1); PG8_BAR;
            XLDA(1, 1); PG8_STAGE_A(PG8_SA(1, 0), a3, 0, vg2);
            PG8_BAR; PG8_WAIT_L(0); XMMA(1, 0, 0); PG8_BAR; PG8_SCHED;
            PG8_STAGE(PG8_SB(1, 1), b3 + bhstep, voffB);
            PG8_WAIT_V(6); PG8_BAR; XMMA(1, 1, 1); PG8_BAR;
        }
        if constexpr (FP8) { asm volatile("s_nop 15\n\ts_nop 15" ::: "memory"); }
        if constexpr (Bg::ON) E.run(acc, cur, wr, wc, fr, fq, bg); else E(acc, cur, wr, wc, fr, fq);
        if (!has_next) break;
#pragma unroll
        for (int a = 0; a < 2; ++a)
#pragma unroll
            for (int b = 0; b < 2; ++b)
#pragma unroll
                for (int m = 0; m < 4; ++m)
#pragma unroll
                    for (int n = 0; n < 2; ++n) acc[a][b][m][n] = (f32x4){0.f, 0.f, 0.f, 0.f};
        cur = nxt; cA = nA; cB = nB; ++ui;
        if constexpr (GATHER) {
#pragma unroll
            for (int h = 0; h < 2; ++h)
#pragma unroll
                for (int i = 0; i < 2; ++i) vgc[h][i] = vgn[h][i];
        }
    }
    PG8_WAIT_V(0);
    if (wr == 0) PG8_BAR;
    PG8_BAR;
#undef PG8_SA
#undef PG8_SB
#undef PG8_STAGE
#undef PG8_STAGE_A
#undef PG8_LDA
#undef PG8_LDA8
#undef PG8_LDB8
#undef PG8_MMA8
#undef XLDA
#undef XLDB
#undef XMMA
#undef PG8_LDB
#undef PG8_MMA
#undef PG8_WAIT_V
#undef PG8_WAIT_L
#undef PG8_BAR
#undef PG8_SCHED
}
template <class Epi, class Sched, bool GATHER, bool FP8 = false>
__device__ __forceinline__ void gemm_phase(LAS unsigned char* lds, const Gemm g, const Sched& S, const Epi& E) { NoBg nb; gemm_phase_bg<Epi, Sched, GATHER, FP8, NoBg>(lds, g, S, E, nb); }


template <bool XBF> struct EpiResid {
    static constexpr bool PERM = true, PERM2 = false;
    const void* xin; bf16_t* xout; const float* gate; float gs;
    __device__ __forceinline__ void operator()(const f32x4 (&acc)[2][2][4][2], const Unit& u, int wr, int wc, int fr, int fq) const {
        const int row0 = u.pm * BM + wr * 64 + fr, col0 = u.pn * BM + wc * 32 + 8 * fq;
        const int b = (u.pm * BM) >> 12;
        f32x4 gv[2][2];
#pragma unroll
        for (int bj = 0; bj < 2; ++bj)
#pragma unroll
            for (int n = 0; n < 2; ++n) gv[bj][n] = *(const f32x4*)(gate + (size_t)b * 6144 + col0 + bj * HALF + 4 * n) * gs;
#pragma unroll
        for (int ai = 0; ai < 2; ++ai)
#pragma unroll
            for (int m = 0; m < 4; ++m) { const size_t ro = (size_t)(row0 + ai * HALF + m * 16) * DM + col0;
#pragma unroll
                for (int bj = 0; bj < 2; ++bj) { f32x4 x0, x1;
                    if (XBF) { const u32x4 p = *(const u32x4*)((const bf16_t*)xin + ro + bj * HALF); x0 = (f32x4){bflo(p.x), bfhi(p.x), bflo(p.y), bfhi(p.y)}; x1 = (f32x4){bflo(p.z), bfhi(p.z), bflo(p.w), bfhi(p.w)}; }
                    else { x0 = *(const f32x4*)((const float*)xin + ro + bj * HALF); x1 = *(const f32x4*)((const float*)xin + ro + bj * HALF + 4); }
                    const f32x4 o0 = x0 + gv[bj][0] * acc[ai][bj][m][0], o1 = x1 + gv[bj][1] * acc[ai][bj][m][1];
                    u32x4 q; q.x = pk2(o0[0], o0[1]); q.y = pk2(o0[2], o0[3]); q.z = pk2(o1[0], o1[1]); q.w = pk2(o1[2], o1[3]);
                    *(u32x4*)(xout + ro + bj * HALF) = q; } }
    }
};
struct EpiBf16S {
    static constexpr bool PERM = true, PERM2 = false;
    bf16_t* O; int ldc; int nscaled; float scale; float gs;
    __device__ __forceinline__ void operator()(const f32x4 (&acc)[2][2][4][2], const Unit& u, int wr, int wc, int fr, int fq) const {
        const int row0 = u.pm * BM + wr * 64 + fr; const int col0 = u.pn * BM + wc * 32 + 8 * fq;
        const float sc = ((u.pn < nscaled) ? scale : 1.0f) * gs;
#pragma unroll
        for (int ai = 0; ai < 2; ++ai)
#pragma unroll
            for (int m = 0; m < 4; ++m) { bf16_t* rowp = O + (size_t)(row0 + ai * HALF + m * 16) * ldc + col0;
#pragma unroll
                for (int bj = 0; bj < 2; ++bj) { const f32x4 v0 = acc[ai][bj][m][0] * sc, v1 = acc[ai][bj][m][1] * sc;
                    u32x4 w; w.x = cvt_pk_bf16(v0[0], v0[1]); w.y = cvt_pk_bf16(v0[2], v0[3]); w.z = cvt_pk_bf16(v1[0], v1[1]); w.w = cvt_pk_bf16(v1[2], v1[3]);
                    *(u32x4*)(rowp + bj * HALF) = w; } }
    }
};
struct EpiRet {
    static constexpr bool PERM = true, PERM2 = false;
    bf16_t* O; const f32x2* rope; float gs;
    __device__ __forceinline__ void operator()(const f32x4 (&acc)[2][2][4][2], const Unit& u, int wr, int wc, int fr, int fq) const { NoBg nb; run(acc, u, wr, wc, fr, fq, nb); }
    template <class Bg> __device__ __forceinline__ void run(const f32x4 (&acc)[2][2][4][2], const Unit& u, int wr, int wc, int fr, int fq, Bg& hook) const {
        const int row0 = u.pm * BM + wr * 64 + fr; const int col0 = u.pn * BM + wc * 32 + 8 * fq;
        const float sc = ((u.pn >= 4 && u.pn < 8) ? 0.0625f : 1.0f) * gs;
        if (u.pn < 8) { NoBg nb; rows<true>(acc, row0, col0, sc, wc, fq, nb); } else rows<false>(acc, row0, col0, sc, wc, fq, hook);
    }
    template <bool ROT, class Bg> __device__ __forceinline__ void rows(const f32x4 (&acc)[2][2][4][2], int row0, int col0, float sc, int wc, int fq, Bg& hook) const {
        float cv[64]; CvtJob cj; bool cp = false;
        if constexpr (Bg::ON) { cp = hook.begin(cj); if (cp) Bg::load1(cj, cv); __builtin_amdgcn_sched_barrier(0); }
#pragma unroll
        for (int ai = 0; ai < 2; ++ai)
#pragma unroll
            for (int m = 0; m < 4; ++m) { const int row = row0 + ai * HALF + m * 16; bf16_t* rowp = O + (size_t)row * 6144 + col0;
                f32x4 a0 = acc[ai][0][m][0], a1 = acc[ai][0][m][1], b0 = acc[ai][1][m][0], b1 = acc[ai][1][m][1];
                if constexpr (!ROT) { a0 = a0 * gs; a1 = a1 * gs; b0 = b0 * gs; b1 = b1 * gs; }
                else {
                    const f32x2* cs = rope + (size_t)(row & (SEQ - 1)) * 128 + wc * 32 + 8 * fq;
                    f32x4 o0, o1, p0, p1;
#pragma unroll
                    for (int j = 0; j < 4; ++j) { const f32x2 c0 = cs[j], c1 = cs[4 + j];
                        o0[j] = (a0[j] * c0.x - b0[j] * c0.y) * sc; p0[j] = (a0[j] * c0.y + b0[j] * c0.x) * sc;
                        o1[j] = (a1[j] * c1.x - b1[j] * c1.y) * sc; p1[j] = (a1[j] * c1.y + b1[j] * c1.x) * sc; }
                    a0 = o0; a1 = o1; b0 = p0; b1 = p1;
                }
                u32x4 w; w.x = cvt_pk_bf16(a0[0], a0[1]); w.y = cvt_pk_bf16(a0[2], a0[3]); w.z = cvt_pk_bf16(a1[0], a1[1]); w.w = cvt_pk_bf16(a1[2], a1[3]);
                *(u32x4*)(rowp) = w;
                w.x = cvt_pk_bf16(b0[0], b0[1]); w.y = cvt_pk_bf16(b0[2], b0[3]); w.z = cvt_pk_bf16(b1[0], b1[1]); w.w = cvt_pk_bf16(b1[2], b1[3]);
                *(u32x4*)(rowp + HALF) = w;
                if constexpr (Bg::ON) { if (ai == 0 && m == 3) { __builtin_amdgcn_sched_barrier(0); if (cp) Bg::load2(cj, cv); } } }
        if constexpr (Bg::ON) { __builtin_amdgcn_sched_barrier(0); if (cp) Bg::store(cj, cv); }
    }
};
struct EpiSwiglu {
    static constexpr bool PERM = true, PERM2 = false;
    bf16_t* O; const float* b1;
    __device__ __forceinline__ void operator()(const f32x4 (&acc)[2][2][4][2], const Unit& u, int wr, int wc, int fr, int fq) const {
        const int e = u.pn >> 3, pl = u.pn & 7;
        const int row0 = u.pm * BM + wr * 64 + fr; const int c0 = pl * 128 + wc * 32 + 8 * fq;
        const float* bg = b1 + (size_t)e * 2048 + c0; const float* bl = bg + 1024;
        const f32x4 bg0 = *(const f32x4*)bg, bg1 = *(const f32x4*)(bg + 4), bl0 = *(const f32x4*)bl, bl1 = *(const f32x4*)(bl + 4);
#pragma unroll
        for (int ai = 0; ai < 2; ++ai)
#pragma unroll
            for (int m = 0; m < 4; ++m) { bf16_t* rowp = O + (size_t)(row0 + ai * HALF + m * 16) * 1024 + c0;
                const f32x4 g0 = acc[ai][0][m][0] + bg0, g1 = acc[ai][0][m][1] + bg1, l0 = acc[ai][1][m][0] + bl0, l1 = acc[ai][1][m][1] + bl1;
                float r[8];
#pragma unroll
                for (int j = 0; j < 4; ++j) {
                    const float ga = fminf(g0[j], 7.0f), la = fminf(fmaxf(l0[j], -7.0f), 7.0f);
                    r[j] = ga * __builtin_amdgcn_rcpf(1.0f + __builtin_amdgcn_exp2f(-2.4554669595930157f * ga)) * (la + 1.0f);
                    const float gb = fminf(g1[j], 7.0f), lb = fminf(fmaxf(l1[j], -7.0f), 7.0f);
                    r[4 + j] = gb * __builtin_amdgcn_rcpf(1.0f + __builtin_amdgcn_exp2f(-2.4554669595930157f * gb)) * (lb + 1.0f); }
                u32x4 w; w.x = cvt_pk_bf16(r[0], r[1]); w.y = cvt_pk_bf16(r[2], r[3]); w.z = cvt_pk_bf16(r[4], r[5]); w.w = cvt_pk_bf16(r[6], r[7]);
                *(u32x4*)(rowp) = w; }
    }
};
struct EpiSwiglu8 {
    static constexpr bool PERM = true, PERM2 = false;
    unsigned char* O; const float* b1;
    static __device__ __forceinline__ f32x2 act2(f32x2 accg, f32x2 accl, f32x2 bg, f32x2 bl) {
        const f32x2 ws2 = {0.03125f, 0.03125f};
        f32x2 gg = accg * ws2 + bg, ll = accl * ws2 + bl;
        gg.x = fminf(gg.x, 7.0f); gg.y = fminf(gg.y, 7.0f);
        ll.x = fminf(fmaxf(ll.x, -7.0f), 7.0f); ll.y = fminf(fmaxf(ll.y, -7.0f), 7.0f);
        const f32x2 ea = gg * (f32x2){-2.4554669595930157f, -2.4554669595930157f};
        f32x2 den; den.x = __builtin_amdgcn_exp2f(ea.x); den.y = __builtin_amdgcn_exp2f(ea.y);
        den = den + (f32x2){1.0f, 1.0f};
        f32x2 rc; rc.x = __builtin_amdgcn_rcpf(den.x); rc.y = __builtin_amdgcn_rcpf(den.y);
        return (gg * rc) * (ll + (f32x2){1.0f, 1.0f});
    }
    __device__ __forceinline__ void operator()(const f32x4 (&acc)[2][2][4][2], const Unit& u, int wr, int wc, int fr, int fq) const { NoBg nb; run(acc, u, wr, wc, fr, fq, nb); }
    template <class Bg> __device__ __forceinline__ void run(const f32x4 (&acc)[2][2][4][2], const Unit& u, int wr, int wc, int fr, int fq, Bg& hook) const {
        const int e = u.pn >> 3, pl = u.pn & 7;
        const int row0 = u.pm * BM + wr * 64 + fr; const int c0 = pl * 128 + wc * 32 + 8 * fq;
        const float* bg = b1 + (size_t)e * 2048 + c0; const float* bl = bg + 1024;
        const f32x4 bg0 = *(const f32x4*)bg, bg1 = *(const f32x4*)(bg + 4), bl0 = *(const f32x4*)bl, bl1 = *(const f32x4*)(bl + 4);
        float cv[64]; CvtJob cj; bool cp = false;
        if constexpr (Bg::ON) { __builtin_amdgcn_sched_barrier(0); cp = hook.begin(cj); if (cp) Bg::load1(cj, cv); __builtin_amdgcn_sched_barrier(0); }
#pragma unroll
        for (int ai = 0; ai < 2; ++ai)
#pragma unroll
            for (int m = 0; m < 4; ++m) { __builtin_amdgcn_sched_barrier(0); unsigned char* rowp = O + (size_t)(row0 + ai * HALF + m * 16) * 1024 + c0;
                const f32x4 g0 = acc[ai][0][m][0], g1 = acc[ai][0][m][1], l0 = acc[ai][1][m][0], l1 = acc[ai][1][m][1];
                const f32x2 r0 = act2((f32x2){g0[0], g0[1]}, (f32x2){l0[0], l0[1]}, (f32x2){bg0[0], bg0[1]}, (f32x2){bl0[0], bl0[1]});
                const f32x2 r1 = act2((f32x2){g0[2], g0[3]}, (f32x2){l0[2], l0[3]}, (f32x2){bg0[2], bg0[3]}, (f32x2){bl0[2], bl0[3]});
                const f32x2 r2 = act2((f32x2){g1[0], g1[1]}, (f32x2){l1[0], l1[1]}, (f32x2){bg1[0], bg1[1]}, (f32x2){bl1[0], bl1[1]});
                const f32x2 r3 = act2((f32x2){g1[2], g1[3]}, (f32x2){l1[2], l1[3]}, (f32x2){bg1[2], bg1[3]}, (f32x2){bl1[2], bl1[3]});
                u32x2 w; w.x = pk4_fp8(r0.x, r0.y, r1.x, r1.y); w.y = pk4_fp8(r2.x, r2.y, r3.x, r3.y);
                *(u32x2*)(rowp) = w;
                if constexpr (Bg::ON) { if (ai == 0 && m == 3) { __builtin_amdgcn_sched_barrier(0); if (cp) Bg::load2(cj, cv); } } }
        if constexpr (Bg::ON) { __builtin_amdgcn_sched_barrier(0); if (cp) Bg::store(cj, cv); }
    }
};
struct EpiNull {
    static constexpr bool PERM = true, PERM2 = false;
    float* sink;
    __device__ __forceinline__ void operator()(const f32x4 (&acc)[2][2][4][2], const Unit& u, int wr, int wc, int fr, int fq) const {
        float s = 0.f;
#pragma unroll
        for (int ai = 0; ai < 2; ++ai)
#pragma unroll
            for (int bj = 0; bj < 2; ++bj)
#pragma unroll
                for (int m = 0; m < 4; ++m)
#pragma unroll
                    for (int n = 0; n < 2; ++n) s += acc[ai][bj][m][n][0];
        if (s == 123.456f) sink[0] = s;
    }
};
struct EpiMoe2 {
    static constexpr bool PERM = true, PERM2 = (YP_FP8 != 0);
    bf16_t* O; const float* b2; float ws_;
    __device__ __forceinline__ void operator()(const f32x4 (&acc)[2][2][4][2], const Unit& u, int wr, int wc, int fr, int fq) const {
        const int e = u.pn >> 2, pl = u.pn & 3;
        const int row0 = u.pm * BM + wr * 64 + fr;
        if constexpr (PERM2) {
            const int c0 = pl * 256 + wc * 64 + 16 * fq;
            const float* bp = b2 + (size_t)e * 1024 + c0;
            f32x4 bv[2][2];
#pragma unroll
            for (int bj = 0; bj < 2; ++bj)
#pragma unroll
                for (int n = 0; n < 2; ++n) bv[bj][n] = *(const f32x4*)(bp + 8 * bj + 4 * n);
#pragma unroll
            for (int ai = 0; ai < 2; ++ai)
#pragma unroll
                for (int m = 0; m < 4; ++m) { __builtin_amdgcn_sched_barrier(0);
                    const f32x4 v00 = acc[ai][0][m][0] * ws_ + bv[0][0], v01 = acc[ai][0][m][1] * ws_ + bv[0][1], v10 = acc[ai][1][m][0] * ws_ + bv[1][0], v11 = acc[ai][1][m][1] * ws_ + bv[1][1];
                    u32x4 w; w.x = pk4_fp8(v00[0], v00[1], v00[2], v00[3]); w.y = pk4_fp8(v01[0], v01[1], v01[2], v01[3]); w.z = pk4_fp8(v10[0], v10[1], v10[2], v10[3]); w.w = pk4_fp8(v11[0], v11[1], v11[2], v11[3]);
                    *(u32x4*)((unsigned char*)O + (size_t)(row0 + ai * HALF + m * 16) * 1024 + c0) = w; }
        } else {
            const int c0 = pl * 256 + wc * 32 + 8 * fq;
            const float* bp = b2 + (size_t)e * 1024 + c0;
            f32x4 bv[2][2];
#pragma unroll
            for (int bj = 0; bj < 2; ++bj)
#pragma unroll
                for (int n = 0; n < 2; ++n) bv[bj][n] = *(const f32x4*)(bp + bj * HALF + 4 * n);
#pragma unroll
            for (int ai = 0; ai < 2; ++ai)
#pragma unroll
                for (int m = 0; m < 4; ++m) { __builtin_amdgcn_sched_barrier(0); bf16_t* rowp = O + (size_t)(row0 + ai * HALF + m * 16) * 1024 + c0;
#pragma unroll
                    for (int bj = 0; bj < 2; ++bj) { const f32x4 v0 = acc[ai][bj][m][0] * ws_ + bv[bj][0], v1 = acc[ai][bj][m][1] * ws_ + bv[bj][1];
                        u32x4 w; w.x = cvt_pk_bf16(v0[0], v0[1]); w.y = cvt_pk_bf16(v0[2], v0[3]); w.z = cvt_pk_bf16(v1[0], v1[1]); w.w = cvt_pk_bf16(v1[2], v1[3]);
                        *(u32x4*)(rowp + bj * HALF) = w; } }
        }
    }
};
}
struct Frame {
    LAS unsigned char* lds;
    unsigned* ctl;
    unsigned char* ws;
    const float* const* in;
    float* out;
    int tid, lane, wave, G, bid;
};

__device__ __forceinline__ void transpose_item(const float* W, int ld, int K, bf16_t* WT, int drow0, LAS float* scr, int k0, int n0, int lane) {
    f32x4 v[16];
#pragma unroll
    for (int i = 0; i < 16; ++i) v[i] = *(const f32x4*)(W + (size_t)(k0 + 4 * i + (lane >> 4)) * ld + n0 + 4 * (lane & 15));
#pragma unroll
    for (int i = 0; i < 16; ++i) { LAS float* s = scr + (4 * i + (lane >> 4)) * 65 + 4 * (lane & 15); s[0] = v[i].x; s[1] = v[i].y; s[2] = v[i].z; s[3] = v[i].w; }
    LDS_WAIT(); asm volatile("" ::: "memory");
    const int c = lane & 7;
#pragma unroll
    for (int j = 0; j < 8; ++j) { const int n = (lane >> 3) + 8 * j; const LAS float* s = scr + (8 * c) * 65 + n;
        u32x4 o; o.x = pk2(s[0 * 65], s[1 * 65]); o.y = pk2(s[2 * 65], s[3 * 65]); o.z = pk2(s[4 * 65], s[5 * 65]); o.w = pk2(s[6 * 65], s[7 * 65]);
        *(u32x4*)(WT + (size_t)(drow0 + n) * K + k0 + 8 * c) = o; }
    LDS_WAIT(); asm volatile("" ::: "memory");
}
__device__ __forceinline__ void transpose_item8(const float* W, int ld, int K, unsigned char* WT, int drow0, LAS float* scr, int k0, int n0, int lane) {
    f32x4 v[16];
#pragma unroll
    for (int i = 0; i < 16; ++i) v[i] = *(const f32x4*)(W + (size_t)(k0 + 4 * i + (lane >> 4)) * ld + n0 + 4 * (lane & 15));
#pragma unroll
    for (int i = 0; i < 16; ++i) { LAS float* s = scr + (4 * i + (lane >> 4)) * 65 + 4 * (lane & 15); s[0] = v[i].x * 32.0f; s[1] = v[i].y * 32.0f; s[2] = v[i].z * 32.0f; s[3] = v[i].w * 32.0f; }
    LDS_WAIT(); asm volatile("" ::: "memory");
    const int c = lane & 3;
#pragma unroll
    for (int j = 0; j < 4; ++j) { const int n = (lane >> 2) + 16 * j; const LAS float* s = scr + (16 * c) * 65 + n;
        u32x4 o; o.x = pk4_fp8(s[0 * 65], s[1 * 65], s[2 * 65], s[3 * 65]); o.y = pk4_fp8(s[4 * 65], s[5 * 65], s[6 * 65], s[7 * 65]);
        o.z = pk4_fp8(s[8 * 65], s[9 * 65], s[10 * 65], s[11 * 65]); o.w = pk4_fp8(s[12 * 65], s[13 * 65], s[14 * 65], s[15 * 65]);
        *(u32x4*)(WT + (size_t)(drow0 + n) * K + k0 + 16 * c) = o; }
    LDS_WAIT(); asm volatile("" ::: "memory");
}
__device__ __forceinline__ void cvt_item_regs(const float* W, int ld, int K, unsigned char* WT, int drow0, int k0, int n0, int lane) {
    const float* wp = W + (size_t)k0 * ld + n0 + lane;
    float v[64];
#pragma unroll
    for (int i = 0; i < 64; ++i) v[i] = WNT ? __builtin_nontemporal_load(wp + (size_t)i * ld) : wp[(size_t)i * ld];
    unsigned char* op = WT + (size_t)(drow0 + lane) * K + k0;
#pragma unroll
    for (int c = 0; c < 4; ++c) { u32x4 o;
        o.x = pk4_fp8(v[16 * c + 0] * 32.0f, v[16 * c + 1] * 32.0f, v[16 * c + 2] * 32.0f, v[16 * c + 3] * 32.0f);
        o.y = pk4_fp8(v[16 * c + 4] * 32.0f, v[16 * c + 5] * 32.0f, v[16 * c + 6] * 32.0f, v[16 * c + 7] * 32.0f);
        o.z = pk4_fp8(v[16 * c + 8] * 32.0f, v[16 * c + 9] * 32.0f, v[16 * c + 10] * 32.0f, v[16 * c + 11] * 32.0f);
        o.w = pk4_fp8(v[16 * c + 12] * 32.0f, v[16 * c + 13] * 32.0f, v[16 * c + 14] * 32.0f, v[16 * c + 15] * 32.0f);
        *(u32x4*)(op + 16 * c) = o; }
}
__device__ __forceinline__ float cvt_ld(const CvtJob& j, __amdgpu_buffer_rsrc_t r, int i) { return __builtin_bit_cast(float, __builtin_amdgcn_raw_buffer_load_b32(r, j.lane * 4, i * j.ld * 4, 0)); }
__device__ __forceinline__ __amdgpu_buffer_rsrc_t cvt_rsrc(const CvtJob& j) { return __builtin_amdgcn_make_buffer_rsrc((void*)j.wp, 0, 0x7fffffff, 0x00020000); }
__device__ __forceinline__ CvtJob moe_cvt_job(const float* const* in, unsigned char* ws, int l, int gi_, int lane) {
    CvtJob j; j.lane = lane;
    const int gi = __builtin_amdgcn_readfirstlane(gi_);
    if (gi < 32 * 512) { const int e = gi >> 9, q = gi & 511, kb = q >> 5, n0 = (q & 31) * 64, mat = l * 32 + e;
        const int drow = (n0 < 1024) ? ((n0 >> 7) * 256 + (n0 & 127)) : (((n0 - 1024) >> 7) * 256 + 128 + ((n0 - 1024) & 127));
        j.ld = 2048; j.wp = in[31] + (size_t)mat * 1024 * 2048 + (size_t)(kb * 64) * 2048 + n0; j.op = ws + WS_W1T + (size_t)mat * 2048 * 1024 + (size_t)drow * 1024 + kb * 64; }
    else { const int r = gi - 32 * 512, e = r >> 8, q = r & 255, kb = q >> 4, n0 = (q & 15) * 64, mat = l * 32 + e;
        j.ld = 1024; j.wp = in[33] + (size_t)mat * 1024 * 1024 + (size_t)(kb * 64) * 1024 + n0; j.op = ws + WS_W2T + (size_t)mat * 1024 * 1024 + (size_t)n0 * 1024 + kb * 64; }
    return j;
}
__device__ __forceinline__ void cvt_job_load(const CvtJob& j, float (&v)[64]) {
    const __amdgpu_buffer_rsrc_t r = cvt_rsrc(j);
#pragma unroll
    for (int i = 0; i < 64; ++i) v[i] = cvt_ld(j, r, i);
}
__device__ __forceinline__ void cvt_job_store(const CvtJob& j, const float (&v)[64]) {
    unsigned char* op = j.op + (unsigned)j.lane * 1024u;
#pragma unroll
    for (int c = 0; c < 4; ++c) { u32x4 o;
        o.x = pk4_fp8(v[16 * c + 0] * 32.0f, v[16 * c + 1] * 32.0f, v[16 * c + 2] * 32.0f, v[16 * c + 3] * 32.0f);
        o.y = pk4_fp8(v[16 * c + 4] * 32.0f, v[16 * c + 5] * 32.0f, v[16 * c + 6] * 32.0f, v[16 * c + 7] * 32.0f);
        o.z = pk4_fp8(v[16 * c + 8] * 32.0f, v[16 * c + 9] * 32.0f, v[16 * c + 10] * 32.0f, v[16 * c + 11] * 32.0f);
        o.w = pk4_fp8(v[16 * c + 12] * 32.0f, v[16 * c + 13] * 32.0f, v[16 * c + 14] * 32.0f, v[16 * c + 15] * 32.0f);
        *(u32x4*)(op + 16 * c) = o; }
}
__device__ __forceinline__ void cvt_half_load(const CvtJob& j, int hf, float (&v)[32]) {
#pragma unroll
    for (int i = 0; i < 32; ++i) v[i] = j.wp[(size_t)(32 * hf + i) * j.ld + j.lane];
}
__device__ __forceinline__ void cvt_half_store(const CvtJob& j, int hf, const float (&v)[32]) {
    unsigned char* op = j.op + (unsigned)j.lane * 1024u;
#pragma unroll
    for (int c = 0; c < 2; ++c) { u32x4 o;
        o.x = pk4_fp8(v[16 * c + 0] * 32.0f, v[16 * c + 1] * 32.0f, v[16 * c + 2] * 32.0f, v[16 * c + 3] * 32.0f);
        o.y = pk4_fp8(v[16 * c + 4] * 32.0f, v[16 * c + 5] * 32.0f, v[16 * c + 6] * 32.0f, v[16 * c + 7] * 32.0f);
        o.z = pk4_fp8(v[16 * c + 8] * 32.0f, v[16 * c + 9] * 32.0f, v[16 * c + 10] * 32.0f, v[16 * c + 11] * 32.0f);
        o.w = pk4_fp8(v[16 * c + 12] * 32.0f, v[16 * c + 13] * 32.0f, v[16 * c + 14] * 32.0f, v[16 * c + 15] * 32.0f);
        *(u32x4*)(op + 32 * hf + 16 * c) = o; }
}
__device__ __forceinline__ void bg_convert(const float* const* in, unsigned char* ws, int layer, int slot0, int count, int gw, int NGW, int lane) {
    for (int s = 0; s < count; s += 2) {
        const int ga = (slot0 + s) * NGW + gw, gb = (slot0 + s + 1) * NGW + gw;
        const bool va = ga < 24576, vb = (s + 1 < count) && gb < 24576;
        float xa[64], xb[64]; CvtJob ja, jb;
        if (va) { ja = moe_cvt_job(in, ws, layer, ga, lane); cvt_job_load(ja, xa); }
        if (vb) { jb = moe_cvt_job(in, ws, layer, gb, lane); cvt_job_load(jb, xb); }
        if (va) cvt_job_store(ja, xa);
        if (vb) cvt_job_store(jb, xb);
    }
}
template <int NB1> struct BgCvtT {
    static constexpr bool ON = true;
    const float* const* in; unsigned char* ws; int layerA, giA, limA, nA, layerB, limB, slot, nslot, gw, NGW, lane;
    __device__ __forceinline__ void init(const float* const* in_, unsigned char* ws_, int gw_, int NGW_, int lane_, int layerA_, int giA_, int limA_, int layerB_, int limB_) {
        in = in_; ws = ws_; gw = gw_; NGW = NGW_; lane = lane_; layerA = layerA_; giA = giA_; limA = limA_; layerB = layerB_; limB = limB_;
        nA = layerA_ >= 0 ? (limA_ - giA_ + NGW_ - 1) / NGW_ : 0; nslot = nA + (layerB_ >= 0 ? (limB_ + NGW_ - 1) / NGW_ : 0); slot = 0; }
    __device__ __forceinline__ bool sel(int s, int& layer, int& gi) const {
        if (s >= nslot) return false;
        if (s < nA) { layer = layerA; gi = giA + s * NGW + gw; return gi < limA; }
        layer = layerB; gi = (s - nA) * NGW + gw; return gi < limB; }
    __device__ __forceinline__ bool begin(CvtJob& j) { int layer = 0, gi = 0; const bool ok = sel(slot, layer, gi); ++slot; if (ok) j = moe_cvt_job(in, ws, layer, gi, lane); return ok; }
    static __device__ __forceinline__ void load1(const CvtJob& j, float (&v)[64]) { const __amdgpu_buffer_rsrc_t r = cvt_rsrc(j);
#pragma unroll
        for (int i = 0; i < NB1; ++i) v[i] = cvt_ld(j, r, i); }
    static __device__ __forceinline__ void load2(const CvtJob& j, float (&v)[64]) { const __amdgpu_buffer_rsrc_t r = cvt_rsrc(j);
#pragma unroll
        for (int i = NB1; i < 64; ++i) v[i] = cvt_ld(j, r, i); }
    static __device__ __forceinline__ void store(const CvtJob& j, const float (&v)[64]) { cvt_job_store(j, v); }
    __device__ __forceinline__ void finish() {
        for (; slot < nslot; ++slot) { int layer = 0, gi = 0; if (sel(slot, layer, gi)) { const CvtJob jj = moe_cvt_job(in, ws, layer, gi, lane); float x[64]; cvt_job_load(jj, x); cvt_job_store(jj, x); } } }
};
typedef BgCvtT<48> BgCvt;
typedef BgCvtT<40> BgCvtR;
__device__ __forceinline__ void moe_cvt_item(const float* const* in, unsigned char* ws, int l, int gi, int lane) {
    if (gi < 32 * 512) { const int e = gi >> 9, q = gi & 511, kb = q >> 5, n0 = (q & 31) * 64, mat = l * 32 + e;
        const int drow = (n0 < 1024) ? ((n0 >> 7) * 256 + (n0 & 127)) : (((n0 - 1024) >> 7) * 256 + 128 + ((n0 - 1024) & 127));
        cvt_item_regs(in[31] + (size_t)mat * 1024 * 2048, 2048, 1024, ws + WS_W1T + (size_t)mat * 2048 * 1024, drow, kb * 64, n0, lane); }
    else { const int r = gi - 32 * 512, e = r >> 8, q = r & 255, kb = q >> 4, n0 = (q & 15) * 64, mat = l * 32 + e;
        cvt_item_regs(in[33] + (size_t)mat * 1024 * 1024, 1024, 1024, ws + WS_W2T + (size_t)mat * 1024 * 1024, n0, kb * 64, n0, lane); }
}
__device__ __forceinline__ bool tr_job(int& r, const float* W, int ld, int K, int N, bf16_t* WT, LAS float* scr, int lane) {
    const int nb = N / 64, items = (K / 64) * nb;
    if (r >= items) { r -= items; return false; }
    const int kb = r / nb, nn = r % nb;
    transpose_item(W, ld, K, WT, nn * 64, scr, kb * 64, nn * 64, lane);
    return true;
}

__device__ __forceinline__ bool tr_job8(int& r, const float* W, int ld, int K, int N, unsigned char* WT, LAS float* scr, int lane) {
    const int nb = N / 64, items = (K / 64) * nb;
    if (r >= items) { r -= items; return false; }
    const int kb = r / nb, nn = r % nb;
    transpose_item8(W, ld, K, WT, nn * 64, scr, kb * 64, nn * 64, lane);
    return true;
}
__device__ __forceinline__ void prologue_phase(Frame& F) {
    const float* const* in = F.in; unsigned char* ws = F.ws;
    {
        LAS float* sc = (LAS float*)F.lds;
        LAS float* red = (LAS float*)(F.lds + 32768);
        const float* c = in[1];
        for (int i = F.tid; i < NB * DM; i += NTHR) sc[i] = siluf_(c[i]);
        __syncthreads();
        float* mod = (float*)(ws + WS_MOD);
        for (int it = F.bid; it < 4 * 96; it += F.G) {
            const int l = it / 96, cb = it % 96, col = cb * 64 + F.lane;
            const __amdgpu_buffer_rsrc_t wr = __builtin_amdgcn_make_buffer_rsrc((void*)(in[2] + (size_t)l * DM * 6144), 0, 0x7fffffff, 0x00020000);
            float acc[8];
#pragma unroll
            for (int b = 0; b < 8; ++b) acc[b] = 0.f;
            const int k0 = F.wave * 128;
            const LAS float* scp = sc + k0;
#pragma unroll 1
            for (int kk = 0; kk < 128; kk += 64) {
                float wv[64];
#pragma unroll
                for (int j = 0; j < 64; ++j) wv[j] = __builtin_bit_cast(float, __builtin_amdgcn_raw_buffer_load_b32(wr, col * 4, (k0 + kk + j) * 6144 * 4, 0));
#pragma unroll
                for (int j = 0; j < 64; j += 4)
#pragma unroll
                    for (int b = 0; b < 8; ++b) { const f32x4 s4 = *(const LAS f32x4*)(scp + b * DM + kk + j);
                        acc[b] += s4.x * wv[j] + s4.y * wv[j + 1] + s4.z * wv[j + 2] + s4.w * wv[j + 3]; }
            }
#pragma unroll
            for (int b = 0; b < 8; ++b) red[(F.wave * 8 + b) * 64 + F.lane] = acc[b];
            __syncthreads();
            {
                float s = 0.f;
#pragma unroll
                for (int w8 = 0; w8 < 8; ++w8) s += red[(w8 * 8 + F.wave) * 64 + F.lane];
                mod[((size_t)l * NB + F.wave) * 6144 + col] = s + in[3][(size_t)l * 6144 + col];
            }
            __syncthreads();
        }
    }
    const int gw = F.bid * NWAVES + F.wave, NGW = F.G * NWAVES, gt = F.bid * NTHR + F.tid, NGT = F.G * NTHR;
    {
        f32x2* rope = (f32x2*)(ws + WS_ROPE);
        const float inv_t = (float)exp(-(double)(gt & 127) * (9.210340371976184 / 128.0));
        const bool inv_same = (NGT & 127) == 0;
        for (int i = gt; i < SEQ * 128; i += NGT) {
            const int pos = i >> 7, j = i & 127;
            const float inv = inv_same ? inv_t : (float)exp(-(double)j * (9.210340371976184 / 128.0));
            const float ang = (float)pos * inv;
            const double rev = (double)ang * 0.15915494309189535;
            const float fr = (float)(rev - floor(rev));
            rope[i] = (f32x2){__builtin_amdgcn_cosf(fr), __builtin_amdgcn_sinf(fr)};
        }
    }
    {
        bf16_t* wrt = (bf16_t*)(ws + WS_WRT);
        for (int i = gt; i < 4 * 32 * 1024; i += NGT) {
            const int l = i >> 15, e = (i >> 10) & 31, k = i & 1023;
            const float w = in[29][((size_t)l * 1024 + k) * 32 + e];
            const unsigned hi = f2bf(w); const float lo = w - bf2f((unsigned short)hi);
            wrt[((size_t)(l * 2 + 0) * 32 + e) * 1024 + k] = (bf16_t)hi; wrt[((size_t)(l * 2 + 1) * 32 + e) * 1024 + k] = (bf16_t)f2bf(lo);
        }
        bf16_t* wgl = (bf16_t*)(ws + WS_WGL);
        for (int i = gt; i < 16 * 1024; i += NGT) {
            const int e = i >> 10, k = i & 1023;
            const float w = in[13][(size_t)k * 3088 + 2048 + e];
            const unsigned hi = f2bf(w); const float lo = w - bf2f((unsigned short)hi);
            wgl[(size_t)(0 * 16 + e) * 1024 + k] = (bf16_t)hi; wgl[(size_t)(1 * 16 + e) * 1024 + k] = (bf16_t)f2bf(lo);
        }
    }
    {
        bf16_t* wmg = (bf16_t*)(ws + WS_WMG);
        for (int i = gt; i < 16 * 6144; i += NGT) {
            const int e = i / 6144, k = i % 6144;
            const float w = (e < 8) ? in[24][(size_t)k * 8 + e] : 0.f;
            const unsigned hi = f2bf(w); const float lo = w - bf2f((unsigned short)hi);
            wmg[(size_t)e * 6144 + k] = (bf16_t)hi; wmg[(size_t)(16 + e) * 6144 + k] = (bf16_t)f2bf(lo);
        }
    }
    {
        LAS float* scr = (LAS float*)(F.lds + F.wave * 16640);
        constexpr int I_RET_IN = 16 * 96, I_RET_OUT = 32 * 16, I_ATT_IN = 16 * 48, I_ATT_OUT = 16 * 16, I_GLA_A = 16 * 32, I_GLA_B = 16 * 16, I_GLA_OUT = 16 * 16,
                      I_MLS_IN = 16 * 64, I_MLS_OUT = 32 * 16;
        constexpr int I_DENSE = I_RET_IN + I_RET_OUT + I_ATT_IN + I_ATT_OUT + I_GLA_A + I_GLA_B + I_GLA_OUT + I_MLS_IN + I_MLS_OUT;
        constexpr int I_W1 = 16 * 32, I_W2 = 16 * 16;
        constexpr int NITEMS = I_DENSE + (MOE_FP8 ? (CVT_HOST == 2 ? 0 : MOE_PRO_LAYERS) * 24576 : 128 * I_W1 + 128 * I_W2);
        for (int it = gw; it < NITEMS; it += NGW) {
            int r = it;
            if (r < I_DENSE) {
                if (GFP8_RET) { if (tr_job(r, in[7], 6144, 1024, 4096, (bf16_t*)(ws + WS_W_RET_IN), scr, F.lane)) continue;
                    if (tr_job8(r, in[7] + 4096, 6144, 1024, 2048, (unsigned char*)(ws + WS_W_RET_IN + 8 * MiB), scr, F.lane)) continue; }
                else if (IFP8_RET ? tr_job8(r, in[7], 6144, 1024, 6144, (unsigned char*)(ws + WS_W_RET_IN), scr, F.lane) : tr_job(r, in[7], 6144, 1024, 6144, (bf16_t*)(ws + WS_W_RET_IN), scr, F.lane)) continue;
                if (OUT_FP8 ? tr_job8(r, in[9], 1024, 2048, 1024, (unsigned char*)(ws + WS_W_RET_OUT), scr, F.lane) : tr_job(r, in[9], 1024, 2048, 1024, (bf16_t*)(ws + WS_W_RET_OUT), scr, F.lane)) continue;
                if (IFP8_ATT ? tr_job8(r, in[10], 3072, 1024, 3072, (unsigned char*)(ws + WS_W_ATT_IN), scr, F.lane) : tr_job(r, in[10], 3072, 1024, 3072, (bf16_t*)(ws + WS_W_ATT_IN), scr, F.lane)) continue;
                if (OUT_FP8 ? tr_job8(r, in[12], 1024, 1024, 1024, (unsigned char*)(ws + WS_W_ATT_OUT), scr, F.lane) : tr_job(r, in[12], 1024, 1024, 1024, (bf16_t*)(ws + WS_W_ATT_OUT), scr, F.lane)) continue;
                if (IFP8_GLA ? tr_job8(r, in[13], 3088, 1024, 2048, (unsigned char*)(ws + WS_W_GLA_IN), scr, F.lane) : tr_job(r, in[13], 3088, 1024, 2048, (bf16_t*)(ws + WS_W_GLA_IN), scr, F.lane)) continue;
                if (GFP8_GLA) { if (tr_job8(r, in[13] + 2064, 3088, 1024, 1024, (unsigned char*)(ws + WS_W_GLA_IN + 4 * MiB), scr, F.lane)) continue; }
                else if (IFP8_GLA ? tr_job8(r, in[13] + 2064, 3088, 1024, 1024, (unsigned char*)(ws + WS_W_GLA_IN) + (size_t)2048 * 1024, scr, F.lane) : tr_job(r, in[13] + 2064, 3088, 1024, 1024, (bf16_t*)(ws + WS_W_GLA_IN) + (size_t)2048 * 1024, scr, F.lane)) continue;
                if (OUT_FP8 ? tr_job8(r, in[17], 1024, 1024, 1024, (unsigned char*)(ws + WS_W_GLA_OUT), scr, F.lane) : tr_job(r, in[17], 1024, 1024, 1024, (bf16_t*)(ws + WS_W_GLA_OUT), scr, F.lane)) continue;
                if (GFP8_MLS) { if (tr_job(r, in[18], 4096, 1024, 2048, (bf16_t*)(ws + WS_W_MLS_IN), scr, F.lane)) continue;
                    if (tr_job8(r, in[18] + 2048, 4096, 1024, 2048, (unsigned char*)(ws + WS_W_MLS_IN + 4 * MiB), scr, F.lane)) continue; }
                else if (IFP8_MLS ? tr_job8(r, in[18], 4096, 1024, 4096, (unsigned char*)(ws + WS_W_MLS_IN), scr, F.lane) : tr_job(r, in[18], 4096, 1024, 4096, (bf16_t*)(ws + WS_W_MLS_IN), scr, F.lane)) continue;
                if (OUT_FP8) tr_job8(r, in[28], 1024, 2048, 1024, (unsigned char*)(ws + WS_W_MLS_OUT), scr, F.lane); else tr_job(r, in[28], 1024, 2048, 1024, (bf16_t*)(ws + WS_W_MLS_OUT), scr, F.lane);
                continue;
            }
            r -= I_DENSE;
            if (MOE_FP8) { moe_cvt_item(in, ws, r / 24576, r % 24576, F.lane); continue; }
            if (r < 128 * I_W1) {
                const int mat = r / I_W1, q = r % I_W1, kb = q / 32, nn = q % 32, n0 = nn * 64;
                const int drow = (n0 < 1024) ? ((n0 >> 7) * 256 + (n0 & 127)) : (((n0 - 1024) >> 7) * 256 + 128 + ((n0 - 1024) & 127));
                transpose_item(in[31] + (size_t)mat * 1024 * 2048, 2048, 1024, (bf16_t*)(ws + WS_W1T) + (size_t)mat * 2048 * 1024, drow, scr, kb * 64, n0, F.lane);
                continue;
            }
            r -= 128 * I_W1;
            { const int mat = r / I_W2, q = r % I_W2, kb = q / 16, nn = q % 16;
              transpose_item(in[33] + (size_t)mat * 1024 * 1024, 1024, 1024, (bf16_t*)(ws + WS_W2T) + (size_t)mat * 1024 * 1024, nn * 64, scr, kb * 64, nn * 64, F.lane); }
        }
    }
}

struct NormArgs {
    const void* xin; bf16_t* xout;
    const float* gain;
    const float* sc; const float* sh;
    bf16_t* h;
    unsigned char* h8;
    const bf16_t* yp; const int* tokes_c; const float* tokw_c; const float* gf; const unsigned* cnt_prev;
    const bf16_t* wt;
    const float* rb;
    unsigned* cnt; unsigned short* list; int* tokes; float* tokw;
    float* glow;
    float* out;
};
template <bool COMBINE, int PROJ  , bool FINAL, bool XBF = true, int HOUT = 3>
__device__ __forceinline__ void norm_phase(Frame& F, const NormArgs& a) {
    constexpr bool WANT_H8 = !FINAL && (HOUT & 2), WANT_H16 = !FINAL && ((HOUT & 1) || PROJ != 0);
    LAS unsigned* sbase = (LAS unsigned*)(F.lds + LDS_MISC + 256);
    LAS float* lg = (LAS float*)(F.lds + F.wave * 2176);
    if (COMBINE) {
        if (F.wave == 0) {
            const unsigned t = F.lane < NEXP ? ((a.cnt_prev[F.lane * 64] + 255u) >> 8) << 8 : 0u;
            unsigned incl = t;
#pragma unroll
            for (int d = 1; d < NEXP; d <<= 1) { const unsigned v = __shfl_up(incl, d); if (F.lane >= d) incl += v; }
            if (F.lane < NEXP) sbase[F.lane] = incl - t;
        }
        LDS_WAIT();
        __syncthreads();
    }
    const int gw = F.bid * NWAVES + F.wave, NGW = F.G * NWAVES, lane = F.lane;
    LAS unsigned* hist = (LAS unsigned*)(F.lds + LDS_MISC + 1024);
    LAS unsigned* gbase = (LAS unsigned*)(F.lds + LDS_MISC + 1280);
    if (PROJ == 1) { if (F.tid < 32) hist[F.tid] = 0u; __syncthreads(); }
    const int niter = (T / 16 + NGW - 1) / NGW;
    for (int it = 0; it < niter; ++it) {
        const int tile_ = it * NGW + gw; const bool active = tile_ < T / 16; const int tile = active ? tile_ : 0;
        const int t0 = tile * 16, b = t0 >> 12;
        f32x4 gm[4], shv[4], gfv[4];
        if (active) {
#pragma unroll
        for (int j = 0; j < 4; ++j) {
            const int d = 512 * (j >> 1) + 8 * lane + 4 * (j & 1);
            const f32x4 g = *(const f32x4*)(a.gain + d);
            if (!FINAL) { const f32x4 s = *(const f32x4*)(a.sc + (size_t)b * 6144 + d); gm[j] = g * (s + 1.0f); shv[j] = *(const f32x4*)(a.sh + (size_t)b * 6144 + d); }
            else { gm[j] = g; shv[j] = (f32x4){0.f, 0.f, 0.f, 0.f}; }
            if (COMBINE) gfv[j] = *(const f32x4*)(a.gf + (size_t)b * 6144 + d);
        }
        int es_all = 0; float w_all = 0.f;
        if (COMBINE) { es_all = a.tokes_c[t0 * 4 + lane]; w_all = a.tokw_c[t0 * 4 + lane]; }
        f32x4 xa[4], xb[4]; u32x2 ya[4][4], yb[4][4];
#define NP_LOAD(r, X, Y) do { const int t_ = t0 + (r); \
            _Pragma("unroll") for (int jj = 0; jj < 2; ++jj) { if (XBF) { const u32x4 p_ = *(const u32x4*)((const bf16_t*)a.xin + (size_t)t_ * DM + 512 * jj + 8 * lane); \
                    X[2 * jj] = (f32x4){bflo(p_.x), bfhi(p_.x), bflo(p_.y), bfhi(p_.y)}; X[2 * jj + 1] = (f32x4){bflo(p_.z), bfhi(p_.z), bflo(p_.w), bfhi(p_.w)}; } \
                else { X[2 * jj] = *(const f32x4*)((const float*)a.xin + (size_t)t_ * DM + 512 * jj + 8 * lane); X[2 * jj + 1] = *(const f32x4*)((const float*)a.xin + (size_t)t_ * DM + 512 * jj + 8 * lane + 4); } } \
            if (COMBINE) { _Pragma("unroll") for (int k = 0; k < TOPK; ++k) { const int es = __builtin_amdgcn_readlane(es_all, 4 * (r) + k); \
                const size_t row = (size_t)sbase[es >> 16] + (unsigned)(es & 0xffff); \
                _Pragma("unroll") for (int jj = 0; jj < 2; ++jj) { if (YP_FP8) { const u32x2 y_ = *(const u32x2*)((const unsigned char*)a.yp + row * 1024 + 512 * jj + 8 * lane); Y[k][2 * jj].x = y_.x; Y[k][2 * jj + 1].x = y_.y; } \
                    else { const u32x4 y_ = *(const u32x4*)(a.yp + row * 1024 + 512 * jj + 8 * lane); Y[k][2 * jj] = (u32x2){y_.x, y_.y}; Y[k][2 * jj + 1] = (u32x2){y_.z, y_.w}; } } } } } while (0)
#define NP_PROC(r, X, Y) do { const int t_ = t0 + (r); f32x4 v[4]; \
            _Pragma("unroll") for (int j = 0; j < 4; ++j) v[j] = X[j]; \
            if (COMBINE) { f32x4 y[4]; \
                _Pragma("unroll") for (int j = 0; j < 4; ++j) y[j] = (f32x4){0.f, 0.f, 0.f, 0.f}; \
                _Pragma("unroll") for (int k = 0; k < TOPK; ++k) { const float w = __builtin_bit_cast(float, __builtin_amdgcn_readlane(__builtin_bit_cast(int, w_all), 4 * (r) + k)); \
                    _Pragma("unroll") for (int j = 0; j < 4; ++j) { const u32x2 p = Y[k][j]; \
                        if (YP_FP8) { const f32x2 lo_ = __builtin_amdgcn_cvt_pk_f32_fp8((int)p.x, false), hi_ = __builtin_amdgcn_cvt_pk_f32_fp8((int)p.x, true); y[j] += (f32x4){lo_.x, lo_.y, hi_.x, hi_.y} * w; } \
                        else y[j] += (f32x4){bflo(p.x), bfhi(p.x), bflo(p.y), bfhi(p.y)} * w; } } \
                _Pragma("unroll") for (int j = 0; j < 4; ++j) v[j] += gfv[j] * y[j]; \
                _Pragma("unroll") for (int jj = 0; jj < 2; ++jj) { u32x4 q_; q_.x = pk2(v[2 * jj].x, v[2 * jj].y); q_.y = pk2(v[2 * jj].z, v[2 * jj].w); q_.z = pk2(v[2 * jj + 1].x, v[2 * jj + 1].y); q_.w = pk2(v[2 * jj + 1].z, v[2 * jj + 1].w); \
                    *(u32x4*)(a.xout + (size_t)t_ * DM + 512 * jj + 8 * lane) = q_; } } \
            float ss = 0.f; \
            _Pragma("unroll") for (int j = 0; j < 4; ++j) ss += (v[j].x * v[j].x + v[j].y * v[j].y) + (v[j].z * v[j].z + v[j].w * v[j].w); \
            const float rstd = rsqrtf(wave_sum(ss) * (1.0f / DM) + EPS); \
            _Pragma("unroll") for (int jj = 0; jj < 2; ++jj) { const f32x4 h0 = v[2 * jj] * rstd * gm[2 * jj] + shv[2 * jj], h1 = v[2 * jj + 1] * rstd * gm[2 * jj + 1] + shv[2 * jj + 1]; \
                if (FINAL) { *(f32x4*)(a.out + (size_t)t_ * DM + 512 * jj + 8 * lane) = h0; *(f32x4*)(a.out + (size_t)t_ * DM + 512 * jj + 8 * lane + 4) = h1; } \
                else { if (WANT_H16) { u32x4 p; p.x = pk2(h0.x, h0.y); p.y = pk2(h0.z, h0.w); p.z = pk2(h1.x, h1.y); p.w = pk2(h1.z, h1.w); *(u32x4*)(a.h + (size_t)t_ * DM + 512 * jj + 8 * lane) = p; } \
                    if (WANT_H8) { u32x2 p8; p8.x = pk4_fp8(h0.x, h0.y, h0.z, h0.w); p8.y = pk4_fp8(h1.x, h1.y, h1.z, h1.w); *(u32x2*)(a.h8 + (size_t)t_ * DM + 512 * jj + 8 * lane) = p8; } } } } while (0)
        f32x4 xc[4]; u32x2 yc[4][4];
        NP_LOAD(0, xa, ya); NP_LOAD(1, xb, yb);
#pragma unroll 1
        for (int r = 0; r < 15; r += 3) {
            NP_LOAD(r + 2, xc, yc);
            NP_PROC(r, xa, ya);
            NP_LOAD(r + 3, xa, ya);
            NP_PROC(r + 1, xb, yb);
            if (r + 4 < 16) NP_LOAD(r + 4, xb, yb);
            NP_PROC(r + 2, xc, yc);
        }
        NP_PROC(15, xa, ya);
#undef NP_LOAD
#undef NP_PROC
        }
        if (PROJ != 0) {
            constexpr int NT = (PROJ == 1) ? 2 : 1;
            VM_WAIT();
            f32x4 acc[NT];
#pragma unroll
            for (int n = 0; n < NT; ++n) acc[n] = (f32x4){0.f, 0.f, 0.f, 0.f};
            const bf16_t* ap = a.h + (size_t)(t0 + (lane & 15)) * DM + 8 * (lane >> 4);
            const bf16_t* bp = a.wt + (size_t)(lane & 15) * DM + 8 * (lane >> 4);
#pragma unroll 4
            for (int ks = 0; ks < 32; ++ks) {
                const bf16x8 av = *(const bf16x8*)(ap + 32 * ks);
#pragma unroll
                for (int n = 0; n < NT; ++n) {
                    const bf16x8 bh = *(const bf16x8*)(bp + (size_t)(16 * n) * DM + 32 * ks);
                    const bf16x8 bl = *(const bf16x8*)(bp + (size_t)(NT * 16 + 16 * n) * DM + 32 * ks);
                    acc[n] = __builtin_amdgcn_mfma_f32_16x16x32_bf16(av, bh, acc[n], 0, 0, 0);
                    acc[n] = __builtin_amdgcn_mfma_f32_16x16x32_bf16(av, bl, acc[n], 0, 0, 0);
                }
            }
            if (PROJ == 2) {
                if (active)
#pragma unroll
                for (int i = 0; i < 4; ++i) a.glow[(size_t)(t0 + 4 * (lane >> 4) + i) * 16 + (lane & 15)] = acc[0][i];
            } else {
#pragma unroll
                for (int n = 0; n < NT; ++n)
#pragma unroll
                    for (int i = 0; i < 4; ++i) lg[(4 * (lane >> 4) + i) * 34 + 16 * n + (lane & 15)] = acc[n][i];
                LDS_WAIT(); asm volatile("" ::: "memory");
                float tv[4]; int ti[4]; unsigned lr[4];
                const bool picker = active && lane < 16;
#pragma unroll
                for (int k = 0; k < 4; ++k) { tv[k] = 0.f; ti[k] = 0; lr[k] = 0u; }
                if (picker) {
                    float v[32];
#pragma unroll
                    for (int e = 0; e < 32; ++e) v[e] = lg[lane * 34 + e] + a.rb[e];
#pragma unroll
                    for (int k = 0; k < 4; ++k) {
                        float best = -3.0e38f; int bi = 0;
#pragma unroll
                        for (int e = 0; e < 32; ++e) { const bool gt = v[e] > best; best = gt ? v[e] : best; bi = gt ? e : bi; }
#pragma unroll
                        for (int e = 0; e < 32; ++e) v[e] = (e == bi) ? -3.0e38f : v[e];
                        tv[k] = best; ti[k] = bi;
                    }
#pragma unroll
                    for (int k = 0; k < 4; ++k) lr[k] = __hip_atomic_fetch_add(hist + ti[k], 1u, __ATOMIC_RELAXED, __HIP_MEMORY_SCOPE_WORKGROUP);
                }
                LDS_WAIT();
                __syncthreads();
                if (F.tid < 32) { const unsigned hc = hist[F.tid]; gbase[F.tid] = hc ? atomicAdd(a.cnt + F.tid * 64, hc) : 0u; hist[F.tid] = 0u; }
                LDS_WAIT();
                __syncthreads();
                if (picker) {
                    const int t = t0 + lane;
                    const float e1 = __expf(tv[1] - tv[0]), e2 = __expf(tv[2] - tv[0]), e3 = __expf(tv[3] - tv[0]);
                    const float inv = 1.0f / (1.0f + e1 + e2 + e3);
                    const float wk[4] = {inv, e1 * inv, e2 * inv, e3 * inv};
#pragma unroll
                    for (int k = 0; k < 4; ++k) {
                        const unsigned slot = gbase[ti[k]] + lr[k];
                        a.list[(size_t)ti[k] * T + slot] = (unsigned short)t;
                        a.tokes[t * 4 + k] = (ti[k] << 16) | (int)slot;
                        a.tokw[t * 4 + k] = wk[k];
                    }
                }
                LDS_WAIT();
                __syncthreads();
            }
        }
    }
}

template <int NPN, bool GATHER, bool FP8, class Epi, bool HOT = false, bool HOSTCVT = false>
__device__ __forceinline__ void moe_gemm_phase(Frame& F, const bf16_t* A, const bf16_t* Bt, const unsigned* cnt, const unsigned short* list, const Epi& E, const float* const* in = nullptr, unsigned char* ws = nullptr, int cvt_layer = -1, int w2_layer = -1) {
    BgCvt bgc; if constexpr (HOSTCVT) bgc.init(in, ws, F.bid * NWAVES + F.wave, F.G * NWAVES, F.lane, w2_layer, 16384, 24576, cvt_layer, 24576);
    LAS int* tb = (LAS int*)(F.lds + LDS_MISC + 512);
    LAS int* cn = (LAS int*)(F.lds + LDS_MISC + 768);
    LAS unsigned short* idx = (LAS unsigned short*)(F.lds + LDS_IDX);
    LAS int* utab = (LAS int*)(F.lds + LDS_IDX + 18 * 512);
    if (F.wave == 0) {
        const int c = F.lane < NEXP ? (int)cnt[F.lane * 64] : 0, t = (c + 255) >> 8;
        int incl = t;
#pragma unroll
        for (int d = 1; d < NEXP; d <<= 1) { const int v = __shfl_up(incl, d); if (F.lane >= d) incl += v; }
        if (F.lane < NEXP) { cn[F.lane] = c; tb[F.lane] = incl - t; }
        if (F.lane == NEXP - 1) tb[NEXP] = incl;
    }
    LDS_WAIT();
    __syncthreads();
    const int NT = tb[NEXP];
    const bool xcd_deal = (F.G % 8 == 0);
    const int ncls = xcd_deal ? 8 : 1, cls = xcd_deal ? (F.bid & 7) : 0, rank = xcd_deal ? (F.bid >> 3) : F.bid, W = F.G / ncls;
    const int r0 = (int)(((long)cls * NT) / ncls), r1 = (int)(((long)(cls + 1) * NT) / ncls);
    const int U = (r1 - r0) * NPN;
    int e = GATHER ? 0 : NEXP - 1;
    for (int i0 = 0; i0 * W + rank < U; i0 += 18) {
        if (i0 > 0) __syncthreads();
        int nmy = 0;
        int goff[18];
#pragma unroll
        for (int i = 0; i < 18; ++i) {
            goff[i] = 0;
            const int L = (i0 + i) * W + rank;
            if (L < U) {
                const int rt = GATHER ? (r0 + L / NPN) : (r1 - 1 - L / NPN), pl = L % NPN;
                if (GATHER) { while (e < NEXP - 1 && rt >= tb[e + 1]) ++e; } else { while (e > 0 && rt < tb[e]) --e; }
                if (F.tid == 0) { utab[2 * i] = HOT ? 0 : rt; utab[2 * i + 1] = HOT ? 0 : (e * NPN + pl); }
                if (GATHER) { int j = (rt - tb[e]) * 256 + (F.tid & 255); const int c = cn[e]; j = j < c ? j : c - 1; goff[i] = e * T + j; }
                nmy = i + 1;
            }
        }
        if (GATHER && F.tid < 256) {
            unsigned short lv[18];
#pragma unroll
            for (int i = 0; i < 18; ++i) lv[i] = (i < nmy) ? list[goff[i]] : (unsigned short)0;
#pragma unroll
            for (int i = 0; i < 18; ++i) if (i < nmy) idx[i * 256 + F.tid] = HOT ? (unsigned short)F.tid : lv[i];
        }
        VM_WAIT(); LDS_WAIT();
        __syncthreads();
        pg8::MoeOrder S; S.utab = utab; S.idx = idx; S.nmy = nmy;
        pg8::Gemm g{A, Bt, 0, 0, FP8 ? 512 : 1024};
        if constexpr (HOSTCVT) pg8::gemm_phase_bg<Epi, pg8::MoeOrder, GATHER, FP8, BgCvt>(F.lds, g, S, E, bgc);
        else pg8::gemm_phase<Epi, pg8::MoeOrder, GATHER, FP8>(F.lds, g, S, E);
    }
    if constexpr (HOSTCVT) bgc.finish();
}
template <int MODE, int ABL = 0>
__device__ __forceinline__ void s2_phase(Frame& F, const bf16_t* Q, const bf16_t* PT, const bf16_t* KT, const bf16_t* VT, const float* REC, bf16_t* mix,
                                         const float* const* in = nullptr, unsigned char* ws = nullptr, int cvt_layer = -1) {
    constexpr bool ML = (MODE == 2 || MODE == 3);
    constexpr int DK = MODE == 0 ? 256 : (MODE == 1 ? 128 : 512);
    constexpr int NER = (MODE == 1 || MODE == 3) ? 2 : 4;
    constexpr int NE = ML ? NER + 1 : NER;
    constexpr int NEB = (MODE == 3) ? 16 : 8;
    constexpr int EW = 16 * NER, MT = DK / 128, KS = DK / 32, NJ = (NE + 1) / 2;
    constexpr int KSE = (MODE == 2) ? KS / 2 : KS;
    constexpr int LDQ = MODE == 0 ? 6144 : (MODE == 1 ? 512 : 2048);
    constexpr int QH = MODE == 0 ? 256 : (MODE == 1 ? 128 : 512);
    constexpr int VH = MODE == 1 ? 256 : 512;
    constexpr int LDM = MODE == 1 ? 1024 : 2048;
    constexpr int LDS_ST = DK * 2 + 16, LDO = EW * 2 + 16;
    constexpr int VCOLS = ML ? EW + 16 : EW, LDV = VCOLS * 2 + 16;
    constexpr int LDVS = MODE == 0 ? 6144 : (MODE == 1 ? 3072 : 2048);
    constexpr int NROWS = ML ? EW + 2 : EW;
    constexpr int ST_BYTES = NROWS * LDS_ST, VT_BYTES = 64 * LDV;
    constexpr bool QLDS = (MODE == 2);
    constexpr int LDQL = 528;
    LAS unsigned char* ST = F.lds;
    LAS unsigned char* VTs = F.lds + ST_BYTES;
    LAS unsigned char* Os = VTs + 2 * VT_BYTES;
    LAS float* QN = (LAS float*)(Os + 64 * LDO);
    LAS float* RS = QN + 64;
    LAS float* NL = RS + 64;
    LAS float* BLA = NL + 512;
    LAS unsigned char* QL = (LAS unsigned char*)(BLA + 256);
    const int lane = F.lane, l15 = lane & 15, g = lane >> 4, w = F.wave, lt = w >> 1, eh = w & 1;
    const int nrow = EW + (l15 == 0 ? 0 : 1);
    constexpr int VPR = EW / 8;
    const int se = F.tid / VPR, sq = F.tid % VPR;
    const int tq = l15 >> 2, tp = l15 & 3;
    const bool stager = F.tid < 64 * VPR;
    const unsigned qs_lo = (unsigned)((F.tid >> 5) * LDQ + 8 * (F.tid & 31)) * 2u;
    const unsigned q_lo = (unsigned)((16 * lt + l15) * LDQ + 8 * g) * 2u, p_lo = (unsigned)((16 * lt + l15) * 64 + 8 * g) * 2u, v_lo = (unsigned)(se * LDVS + 8 * sq) * 2u, k_lo = (unsigned)lane * 16u;
    constexpr bool BG = (MODE == 0 || MODE == 1) && ABL == 0;
    const int gw_ = F.bid * NWAVES + F.wave, NGW_ = F.G * NWAVES;
    const int bg_n = (BG && cvt_layer >= 0) ? 2 * ((24576 + NGW_ - 1) / NGW_) : 0;
    const int bg_period = bg_n > 0 ? ((NCHUNK / bg_n) > 2 ? (NCHUNK / bg_n) : 2) : 1;
    int bg_done = 0;
    float bgx[32]; CvtJob bgj; bgj.wp = nullptr; bgj.op = nullptr; bgj.ld = 0; bool bg_pending = false;
    for (int u0 = F.bid; u0 < NB * 4 * NEB; u0 += F.G) {
        int eb, bh;
        if (F.G == 256) { const int x = u0 & 7, j = (u0 >> 3) & 31, r = u0 >> 8; bh = x * 4 + (j >> 3); eb = (j & 7) + 8 * r; }
        else { eb = u0 % NEB; bh = u0 / NEB; }
        const int h = bh & 3, b = bh >> 2;
        const size_t ubase = ((size_t)(b * 4 + h)) * NCHUNK;
        f32x4 S[MT][NER];
#pragma unroll
        for (int mt = 0; mt < MT; ++mt)
#pragma unroll
            for (int nt = 0; nt < NER; ++nt) S[mt][nt] = (f32x4){0.f, 0.f, 0.f, 0.f};
        if (ML) { NL[F.tid] = 0.f; }
        for (int i = F.tid; i < ST_BYTES / 4; i += NTHR) ((LAS unsigned*)ST)[i] = 0u;
        float vsc[8], rsi[4], rso[4], dec64 = 1.f;
        if (MODE == 0) {
            const float lg = log1pf(-exp2f(-5.0f - (float)h));
#pragma unroll
            for (int j = 0; j < 8; ++j) vsc[j] = __expf((float)(63 - se) * lg);
#pragma unroll
            for (int r = 0; r < 4; ++r) { const int l = 16 * lt + 4 * g + r; rsi[r] = __expf((float)(l - 63) * lg); rso[r] = __expf((float)(l + 1) * lg); }
            dec64 = __expf(64.0f * lg);
        }
        float m_prev = 0.f;
        bf16x8 qf[KS] = {}, pf[2] = {}, kf[MT][2] = {}; u32x4 qst[4] = {}; float recv = 0.f; u32x4 vraw = (u32x4){0u, 0u, 0u, 0u}; f32x4 z0 = (f32x4){0.f, 0.f, 0.f, 0.f}, z1 = z0, blv = z0, alv = z0, dcv = z0; float Amax = 0.f, blast = 0.f;
#define S2_PREFETCH(cc) do { const size_t uidx_ = ubase + (cc); const size_t t0_ = (size_t)b * SEQ + (size_t)(cc) * 64; \
          \
        if (stager) vraw = *(const u32x4*)((const char*)(VT + t0_ * LDVS + VH * h + EW * eb) + v_lo); \
        if (MODE == 1) dcv = *(const f32x4*)(REC + uidx_ * 128 + 16 * w + 4 * g); \
        if (ML) { const float* rec_ = REC + uidx_ * 192; z0.x = rec_[64 + (se & 63)]; \
            Amax = rec_[128 + 63]; blast = rec_[63]; if (F.tid < 128) recv = rec_[(F.tid < 64) ? F.tid : (64 + F.tid)]; } \
        _Pragma("unroll") for (int ks = 0; ks < 2; ++ks) pf[ks] = *(const bf16x8*)((const char*)(PT + uidx_ * 4096 + 32 * ks) + p_lo); \
        if (QLDS) { _Pragma("unroll") for (int i = 0; i < 4; ++i) qst[i] = *(const u32x4*)((const char*)(Q + (t0_ + 16 * i) * LDQ + QH * h) + qs_lo); } \
        if (ABL < 2 && !QLDS) { _Pragma("unroll") for (int ks = 0; ks < KSE; ++ks) qf[ks] = *(const bf16x8*)((const char*)(Q + t0_ * LDQ + QH * h + 32 * ks) + q_lo); } } while (0)
        S2_PREFETCH(0);
#define S2_VFRAG(dst, c0_, ks_) do { const LAS unsigned char* a_ = vt + (32 * (ks_) + 8 * g + tq) * LDV + 2 * ((c0_) + 4 * tp); \
        const s16x4 lo_ = __builtin_amdgcn_ds_read_tr16_b64_v4i16((LAS s16x4*)a_), hi_ = __builtin_amdgcn_ds_read_tr16_b64_v4i16((LAS s16x4*)(a_ + 4 * LDV)); \
        dst = (bf16x8){lo_.x, lo_.y, lo_.z, lo_.w, hi_.x, hi_.y, hi_.z, hi_.w}; } while (0)
        for (int c = 0; c < NCHUNK; ++c) {
            const size_t t0 = (size_t)b * SEQ + (size_t)c * 64;
            const size_t uidx = ubase + c;
            LAS unsigned char* vt = VTs + (c & 1) * VT_BYTES;
            const float Mx = fmaxf(m_prev, Amax), keep = ML ? __expf(m_prev - Mx) : 1.f, bl_c = blast;
            f32x4 blc = blv, alc = alv; const f32x4 dcc = dcv;
            if (stager) {
                u32x4 o = vraw;
                if (MODE != 1) {
                    float wrow = 1.f;
                    if (MODE == 0) wrow = vsc[0];
                    if (ML) wrow = __expf(z0.x - Mx);
                    o.x = pk2(bflo(vraw.x) * wrow, bfhi(vraw.x) * wrow); o.y = pk2(bflo(vraw.y) * wrow, bfhi(vraw.y) * wrow);
                    o.z = pk2(bflo(vraw.z) * wrow, bfhi(vraw.z) * wrow); o.w = pk2(bflo(vraw.w) * wrow, bfhi(vraw.w) * wrow);
                    if (ML && sq == 0) {
                        *(LAS u32x4*)(vt + se * LDV + 2 * EW) = (u32x4){pk2(wrow, 0.f), 0u, 0u, 0u};
                        *(LAS u32x4*)(vt + se * LDV + 2 * EW + 16) = (u32x4){0u, 0u, 0u, 0u}; }
                }
                *(LAS u32x4*)(vt + se * LDV + 16 * sq) = o;
            }
            asm volatile("" ::: "memory");
            if (QLDS) {
#pragma unroll
                for (int i = 0; i < 4; ++i) { const int p_ = F.tid + i * NTHR; *(LAS u32x4*)(QL + (p_ >> 5) * LDQL + 16 * (p_ & 31)) = qst[i]; }
                asm volatile("" ::: "memory");
#pragma unroll
                for (int ks = KS - KSE; ks < KS; ++ks) { if (ABL < 2) qf[ks] = *(const bf16x8*)((const char*)(Q + t0 * LDQ + QH * h + 32 * ks) + q_lo); }
            }
            if (ML) { if (F.tid < 128) BLA[(c & 1) * 128 + F.tid] = recv; }
            if (MODE != 2) {
#pragma unroll
                for (int mt = 0; mt < MT; ++mt)
#pragma unroll
                    for (int ks = 0; ks < 2; ++ks) if (ABL < 3) kf[mt][ks] = *(const bf16x8*)((const char*)(KT + uidx * (DK * 64) + ((((MT * w + mt) * 2 + ks) * 64) << 3)) + k_lo);
            }
            WG_SYNC_LDS();
            if (c > 0) {
                if (EW == 64) { const int r = F.tid >> 3, q = F.tid & 7; *(u32x4*)(mix + (t0 - 64 + r) * LDM + VH * h + EW * eb + 8 * q) = *(const LAS u32x4*)(Os + r * LDO + 16 * q); }
                else if (F.tid < 256) { const int r = F.tid >> 2, q = F.tid & 3; *(u32x4*)(mix + (t0 - 64 + r) * LDM + VH * h + EW * eb + 8 * q) = *(const LAS u32x4*)(Os + r * LDO + 16 * q); }
            }
            f32x4 oi[NJ], oo[NJ];
#pragma unroll
            for (int j = 0; j < NJ; ++j) { oi[j] = (f32x4){0.f, 0.f, 0.f, 0.f}; oo[j] = (f32x4){0.f, 0.f, 0.f, 0.f}; }
#pragma unroll
            for (int j = 0; j < NJ; ++j) { const int nt = eh + 2 * j;
                if (2 * j + 1 < NE || eh == 0) {
#pragma unroll
                    for (int ks = 0; ks < 2; ++ks) { bf16x8 vf; S2_VFRAG(vf, 16 * nt, ks);
                        if (ABL == 0) oi[j] = __builtin_amdgcn_mfma_f32_16x16x32_bf16(pf[ks], vf, oi[j], 0, 0, 0); else asm volatile("" :: "v"(vf), "v"(pf[ks])); } } }
#pragma unroll
            for (int ks = 0; ks < KS; ++ks) {
                bf16x8 qa;
                if (QLDS && ks < KS - KSE) qa = *(const LAS bf16x8*)(QL + (16 * lt + l15) * LDQL + 64 * ks + 16 * g); else qa = qf[ks];
#pragma unroll
                for (int j = 0; j < NJ; ++j) { const int nt = eh + 2 * j;
                    if ((2 * j + 1 < NE || eh == 0) && ABL < 4) { const bf16x8 sf = *(const LAS bf16x8*)(ST + ((ML && nt == NER) ? nrow : (16 * nt + l15)) * LDS_ST + 64 * ks + 16 * g);
                        if (ABL == 0) oo[j] = __builtin_amdgcn_mfma_f32_16x16x32_bf16(qa, sf, oo[j], 0, 0, 0); else asm volatile("" :: "v"(sf), "v"(qa)); } }
                if (MODE == 2 && (ks & 3) == 3) __builtin_amdgcn_sched_barrier(0);
            }
            if (ML) { if (((NE - 1) & 1) == eh && l15 == 0) {
#pragma unroll
                    for (int r = 0; r < 4; ++r) { QN[16 * lt + 4 * g + r] = oo[NJ - 1][r]; RS[16 * lt + 4 * g + r] = oi[NJ - 1][r]; } } }
            if (MODE == 2) {
#pragma unroll
                for (int mt = 0; mt < MT; ++mt)
#pragma unroll
                    for (int ks = 0; ks < 2; ++ks) if (ABL < 3) kf[mt][ks] = *(const bf16x8*)((const char*)(KT + uidx * (DK * 64) + ((((MT * w + mt) * 2 + ks) * 64) << 3)) + k_lo);
            }
            { const int cn = (c + 1 < NCHUNK) ? c + 1 : c; S2_PREFETCH(cn); }
            WG_SYNC_LDS();
            if (ML) { blc = *(const LAS f32x4*)(BLA + (c & 1) * 128 + 16 * lt + 4 * g); alc = *(const LAS f32x4*)(BLA + (c & 1) * 128 + 64 + 16 * lt + 4 * g); }
#pragma unroll
            for (int r = 0; r < 4; ++r) { const int l = 16 * lt + 4 * g + r;
                float ci = 1.f, co = 1.f;
                if (MODE == 0) { ci = rsi[r]; co = rso[r]; }
                if (ML) { const float Ml = fmaxf(m_prev, alc[r]), rho = __expf(Mx - Ml), wi = __expf(m_prev - Ml);
                    const float den = wi * QN[l] + rho * RS[l];
                    const float inv = 1.0f / fmaxf(fabsf(den), __expf(-(blc[r] + Ml)));
                    ci = rho * inv; co = wi * inv; }
#pragma unroll
                for (int j = 0; j < NER / 2; ++j) { const int nt = eh + 2 * j;
                    *(LAS unsigned short*)(Os + l * LDO + 2 * (16 * nt + l15)) = (unsigned short)f2bf(ci * oi[j][r] + co * oo[j][r]); } }
#pragma unroll
            for (int nt = 0; nt < NER; ++nt) {
                bf16x8 vf[2];
#pragma unroll
                for (int ks = 0; ks < 2; ++ks) S2_VFRAG(vf[ks], 16 * nt, ks);
#pragma unroll
                for (int mt = 0; mt < MT; ++mt) {
                    if (MODE == 0) S[mt][nt] = S[mt][nt] * dec64;
                    if (MODE == 1) S[mt][nt] = S[mt][nt] * dcc;
                    if (ML) S[mt][nt] = S[mt][nt] * keep;
#pragma unroll
                    for (int ks = 0; ks < 2; ++ks) { if (ABL == 0) S[mt][nt] = __builtin_amdgcn_mfma_f32_16x16x32_bf16(kf[mt][ks], vf[ks], S[mt][nt], 0, 0, 0); else asm volatile("" :: "v"(vf[ks]), "v"(kf[mt][ks])); }
                    u32x2 o; o.x = pk2(S[mt][nt][0], S[mt][nt][1]); o.y = pk2(S[mt][nt][2], S[mt][nt][3]);
                    if (ABL < 4) *(LAS u32x2*)(ST + (16 * nt + l15) * LDS_ST + 2 * (DK / 8 * w + 16 * mt + 4 * g)) = o; }
            }
            if (ML) {
                bf16x8 vf[2];
#pragma unroll
                for (int ks = 0; ks < 2; ++ks) S2_VFRAG(vf[ks], EW, ks);
#pragma unroll
                for (int mt = 0; mt < MT; ++mt) { const int d0 = DK / 8 * w + 16 * mt + 4 * g;
                    f32x4 na = (f32x4){0.f, 0.f, 0.f, 0.f};
                    if (l15 == 0) na = *(const LAS f32x4*)(NL + d0) * keep;
#pragma unroll
                    for (int ks = 0; ks < 2; ++ks) { if (ABL == 0) na = __builtin_amdgcn_mfma_f32_16x16x32_bf16(kf[mt][ks], vf[ks], na, 0, 0, 0); else asm volatile("" :: "v"(vf[ks]), "v"(kf[mt][ks])); }
                    if (l15 == 0) { *(LAS f32x4*)(NL + d0) = na; u32x2 o; o.x = pk2(na[0], na[1]); o.y = pk2(na[2], na[3]); *(LAS u32x2*)(ST + EW * LDS_ST + 2 * d0) = o; } }
            }
            if (ML) m_prev = bl_c + Mx;
            if (BG) {
                if (bg_pending) { cvt_half_store(bgj, bg_done & 1, bgx); bg_pending = false; ++bg_done; }
                else if (bg_done < bg_n && (c % bg_period) == 0) { const int gi = (bg_done >> 1) * NGW_ + gw_;
                    if (gi < 24576) { bgj = moe_cvt_job(in, ws, cvt_layer, gi, lane); cvt_half_load(bgj, bg_done & 1, bgx); bg_pending = true; } else ++bg_done; }
            }
        }
#undef S2_PREFETCH
#undef S2_VFRAG
        LDS_WAIT();
        __syncthreads();
        { const size_t t0 = (size_t)b * SEQ + (size_t)(NCHUNK - 1) * 64;
          if (EW == 64) { const int r = F.tid >> 3, q = F.tid & 7; *(u32x4*)(mix + (t0 + r) * LDM + VH * h + EW * eb + 8 * q) = *(const LAS u32x4*)(Os + r * LDO + 16 * q); }
          else if (F.tid < 256) { const int r = F.tid >> 2, q = F.tid & 3; *(u32x4*)(mix + (t0 + r) * LDM + VH * h + EW * eb + 8 * q) = *(const LAS u32x4*)(Os + r * LDO + 16 * q); } }
        LDS_WAIT();
        __syncthreads();
    }
    if (BG) {
        if (bg_pending) { cvt_half_store(bgj, bg_done & 1, bgx); ++bg_done; }
        for (; bg_done < bg_n; ++bg_done) { const int gi = (bg_done >> 1) * NGW_ + gw_;
            if (gi < 24576) { bgj = moe_cvt_job(in, ws, cvt_layer, gi, lane); cvt_half_load(bgj, bg_done & 1, bgx); cvt_half_store(bgj, bg_done & 1, bgx); } }
    }
}

template <int MODE>
__device__ __forceinline__ void s2x_phase(Frame& F, const bf16_t* Q, const bf16_t* PT, const bf16_t* KT, const bf16_t* VT, const float* REC, bf16_t* mix) {
    constexpr int DK = MODE == 0 ? 256 : 128, NER = MODE == 0 ? 4 : 2, EW = 16 * NER, KS = DK / 32, MTY = DK / 64, NEB = 8;
    constexpr int LDQ = MODE == 0 ? 6144 : 512, QH = MODE == 0 ? 256 : 128, VH = MODE == 1 ? 256 : 512, LDM = MODE == 1 ? 1024 : 2048;
    constexpr int LDS_ST = DK * 2 + 16, LDV = EW * 2 + 16, LDVS = MODE == 0 ? 6144 : 3072;
    constexpr int ST_BYTES = EW * LDS_ST, VT_BYTES = 64 * LDV, VPR = EW / 8;
    LAS unsigned char* ST = F.lds;
    LAS unsigned char* VTs = F.lds + 2 * ST_BYTES;
    const int lane = F.lane, l15 = lane & 15, g = lane >> 4, w = F.wave, lt = w & 3, yw = w & 3;
    const bool isX = w < 4;
    const int se = F.tid / VPR, sq = F.tid % VPR, tq = l15 >> 2, tp = l15 & 3;
    const bool stager = F.tid < 64 * VPR;
    unsigned q_lo = (unsigned)((16 * lt + l15) * LDQ + 8 * g) * 2u, p_lo = (unsigned)((16 * lt + l15) * 64 + 8 * g) * 2u, v_lo = (unsigned)(se * LDVS + 8 * sq) * 2u, k_lo = (unsigned)lane * 16u;
    unsigned o_lo = (unsigned)((16 * lt + l15) * LDM + 4 * NER * g) * 2u;
    for (int u0 = F.bid; u0 < NB * 4 * NEB; u0 += F.G) {
        int eb, bh;
        if (F.G == 256) { const int x = u0 & 7, j = (u0 >> 3) & 31, r = u0 >> 8; bh = x * 4 + (j >> 3); eb = (j & 7) + 8 * r; }
        else { eb = u0 % NEB; bh = u0 / NEB; }
        const int h = bh & 3, b = bh >> 2;
        const size_t ubase = ((size_t)(b * 4 + h)) * NCHUNK;
        for (int i = F.tid; i < 2 * ST_BYTES / 4; i += NTHR) ((LAS unsigned*)ST)[i] = 0u;
        float vsc = 1.f, rsi = 1.f, rso = 1.f, dec64 = 1.f;
        if (MODE == 0) {
            const float lg = log1pf(-exp2f(-5.0f - (float)h));
            vsc = __expf((float)(63 - se) * lg);
            { const int l = 16 * lt + l15; rsi = __expf((float)(l - 63) * lg); rso = __expf((float)(l + 1) * lg); }
            dec64 = __expf(64.0f * lg);
        }
#define S2X_CL(cc) ((cc) < NCHUNK ? (cc) : NCHUNK - 1)
#define S2X_LOADX(QF, PF, cc) do { const size_t uidx_ = ubase + (cc); const size_t t0_ = (size_t)b * SEQ + (size_t)(cc) * 64; \
        _Pragma("unroll") for (int ks = 0; ks < 2; ++ks) PF[ks] = *(const bf16x8*)((const char*)(PT + uidx_ * 4096 + 32 * ks) + p_lo); \
        _Pragma("unroll") for (int ks = 0; ks < KS; ++ks) QF[ks] = *(const bf16x8*)((const char*)(Q + t0_ * LDQ + QH * h + 32 * ks) + q_lo); } while (0)
#define S2X_LOADY(KF, DC, cc) do { const size_t uidx_ = ubase + (cc); \
        _Pragma("unroll") for (int mt = 0; mt < MTY; ++mt) { \
            _Pragma("unroll") for (int ks = 0; ks < 2; ++ks) KF[mt][ks] = *(const bf16x8*)((const char*)(KT + uidx_ * (DK * 64) + ((((MTY * yw + mt) * 2 + ks) * 64) << 3)) + k_lo); \
            if (MODE == 1) DC[mt] = *(const f32x4*)(REC + uidx_ * 128 + 16 * (MTY * yw + mt) + 4 * g); } } while (0)
#define S2X_LOADV(VR, cc) do { const size_t t0_ = (size_t)b * SEQ + (size_t)(cc) * 64; if (stager) VR = *(const u32x4*)((const char*)(VT + t0_ * LDVS + VH * h + EW * eb) + v_lo); } while (0)
#define S2X_STAGE(VR, vt_) do { if (stager) { u32x4 o = VR; \
            if (MODE == 0) { o.x = pk2(bflo(VR.x) * vsc, bfhi(VR.x) * vsc); o.y = pk2(bflo(VR.y) * vsc, bfhi(VR.y) * vsc); o.z = pk2(bflo(VR.z) * vsc, bfhi(VR.z) * vsc); o.w = pk2(bflo(VR.w) * vsc, bfhi(VR.w) * vsc); } \
            *(LAS u32x4*)((vt_) + se * LDV + 16 * sq) = o; } } while (0)
#define S2X_VFRAG(dst, nt_, ks_) do { const LAS unsigned char* a_ = vt + (32 * (ks_) + 8 * g + tq) * LDV + 2 * ((4 * NER) * tp + 4 * (nt_)); \
        const s16x4 lo_ = __builtin_amdgcn_ds_read_tr16_b64_v4i16((LAS s16x4*)a_), hi_ = __builtin_amdgcn_ds_read_tr16_b64_v4i16((LAS s16x4*)(a_ + 4 * LDV)); \
        dst = (bf16x8){lo_.x, lo_.y, lo_.z, lo_.w, hi_.x, hi_.y, hi_.z, hi_.w}; } while (0)
        u32x4 vrA = (u32x4){0u, 0u, 0u, 0u}, vrB = vrA;
        S2X_LOADV(vrA, 0);
        if (isX) {
            bf16x8 qfA[KS], pfA[2], qfB[KS], pfB[2];
            S2X_LOADX(qfA, pfA, 0); S2X_LOADV(vrB, 1); S2X_LOADX(qfB, pfB, 1);
            S2X_STAGE(vrA, VTs);
            S2X_LOADV(vrA, 2);
            WG_SYNC_LDS();
#define S2X_XBODY(QF, PF, VRN, c) do { \
                asm volatile("" : "+v"(q_lo), "+v"(p_lo), "+v"(v_lo), "+v"(o_lo)); \
                const size_t t0 = (size_t)b * SEQ + (size_t)(c) * 64; \
                LAS unsigned char* vt = VTs + ((c) & 1) * VT_BYTES; \
                const LAS unsigned char* STr = ST + (((c) + 1) & 1) * ST_BYTES;           \
                f32x4 oi[NER], oo[NER]; \
                _Pragma("unroll") for (int nt = 0; nt < NER; ++nt) { oi[nt] = (f32x4){0.f, 0.f, 0.f, 0.f}; oo[nt] = (f32x4){0.f, 0.f, 0.f, 0.f}; } \
                _Pragma("unroll") for (int nt = 0; nt < NER; ++nt) _Pragma("unroll") for (int ks = 0; ks < 2; ++ks) { bf16x8 vf; S2X_VFRAG(vf, nt, ks); oi[nt] = __builtin_amdgcn_mfma_f32_16x16x32_bf16(vf, PF[ks], oi[nt], 0, 0, 0); } \
                _Pragma("unroll") for (int ks = 0; ks < KS; ++ks) _Pragma("unroll") for (int nt = 0; nt < NER; ++nt) { const bf16x8 sf = *(const LAS bf16x8*)(STr + (16 * nt + l15) * LDS_ST + 64 * ks + 16 * g); \
                        oo[nt] = __builtin_amdgcn_mfma_f32_16x16x32_bf16(sf, QF[ks], oo[nt], 0, 0, 0); } \
                S2X_LOADX(QF, PF, S2X_CL((c) + 2)); \
                  \
                _Pragma("unroll") for (int n2 = 0; n2 < NER; n2 += 2) { const f32x4 ov0 = oi[n2] * rsi + oo[n2] * rso, ov1 = oi[n2 + 1] * rsi + oo[n2 + 1] * rso; \
                    u32x4 o; o.x = pk2(ov0[0], ov0[1]); o.y = pk2(ov0[2], ov0[3]); o.z = pk2(ov1[0], ov1[1]); o.w = pk2(ov1[2], ov1[3]); \
                    *(u32x4*)((char*)(mix + t0 * LDM + VH * h + EW * eb + 4 * n2) + o_lo) = o; } \
                S2X_STAGE(VRN, VTs + (((c) + 1) & 1) * VT_BYTES); \
                S2X_LOADV(VRN, S2X_CL((c) + 3)); \
                WG_SYNC_LDS(); } while (0)
            for (int c = 0; c < NCHUNK; c += 2) { S2X_XBODY(qfA, pfA, vrB, c); S2X_XBODY(qfB, pfB, vrA, c + 1); }
#undef S2X_XBODY
        } else {
            bf16x8 kfA[MTY][2], kfB[MTY][2]; f32x4 dcA[MTY], dcB[MTY]; f32x4 S[MTY][NER];
#pragma unroll
            for (int mt = 0; mt < MTY; ++mt) { dcA[mt] = (f32x4){1.f, 1.f, 1.f, 1.f}; dcB[mt] = dcA[mt];
#pragma unroll
                for (int nt = 0; nt < NER; ++nt) S[mt][nt] = (f32x4){0.f, 0.f, 0.f, 0.f}; }
            S2X_LOADY(kfA, dcA, 0); S2X_LOADV(vrB, 1); S2X_LOADY(kfB, dcB, 1);
            S2X_STAGE(vrA, VTs);
            S2X_LOADV(vrA, 2);
            WG_SYNC_LDS();
#define S2X_YBODY(KF, DC, VRN, c) do { \
                asm volatile("" : "+v"(k_lo), "+v"(v_lo)); \
                LAS unsigned char* vt = VTs + ((c) & 1) * VT_BYTES; \
                LAS unsigned char* STw = ST + ((c) & 1) * ST_BYTES; \
                _Pragma("unroll") for (int nt = 0; nt < NER; ++nt) { \
                    bf16x8 vf[2]; \
                    _Pragma("unroll") for (int ks = 0; ks < 2; ++ks) S2X_VFRAG(vf[ks], nt, ks); \
                    _Pragma("unroll") for (int mt = 0; mt < MTY; ++mt) { \
                        if (MODE == 0) S[mt][nt] = S[mt][nt] * dec64; else S[mt][nt] = S[mt][nt] * DC[mt]; \
                        _Pragma("unroll") for (int ks = 0; ks < 2; ++ks) S[mt][nt] = __builtin_amdgcn_mfma_f32_16x16x32_bf16(KF[mt][ks], vf[ks], S[mt][nt], 0, 0, 0); \
                        u32x2 o; o.x = pk2(S[mt][nt][0], S[mt][nt][1]); o.y = pk2(S[mt][nt][2], S[mt][nt][3]); \
                        *(LAS u32x2*)(STw + (16 * nt + l15) * LDS_ST + 2 * (16 * (MTY * yw + mt) + 4 * g)) = o; } } \
                S2X_LOADY(KF, DC, S2X_CL((c) + 2)); \
                S2X_STAGE(VRN, VTs + (((c) + 1) & 1) * VT_BYTES); \
                S2X_LOADV(VRN, S2X_CL((c) + 3)); \
                WG_SYNC_LDS(); } while (0)
            for (int c = 0; c < NCHUNK; c += 2) { S2X_YBODY(kfA, dcA, vrB, c); S2X_YBODY(kfB, dcB, vrA, c + 1); }
#undef S2X_YBODY
        }
#undef S2X_CL
#undef S2X_LOADX
#undef S2X_LOADY
#undef S2X_LOADV
#undef S2X_STAGE
#undef S2X_VFRAG
    }
}

__device__ __forceinline__ void s2m_phase(Frame& F, const bf16_t* Q, const bf16_t* PT, const bf16_t* KT, const bf16_t* VT, const float* REC, bf16_t* mix) {
    constexpr int DK = 512, NER = 4, NE = 5, EW = 64, KS = 16, MTY = 8, NEB = 8;
    constexpr int LDQ = 2048, QH = 512, VH = 512, LDM = 2048, LDVS = 2048;
    constexpr int LDS_ST = DK * 2 + 16, VCOLS = EW + 16, LDV = VCOLS * 2 + 16, NROWS = EW + 2;
    constexpr int ST_BYTES = NROWS * LDS_ST, VT_BYTES = 64 * LDV;
    LAS unsigned char* ST = F.lds;
    LAS unsigned char* VTs = F.lds + 2 * ST_BYTES;
    LAS float* NL = (LAS float*)(VTs + 2 * VT_BYTES);
    static_assert(2 * ST_BYTES + 2 * VT_BYTES + 2048 <= LDS_MISC, "s2m LDS");
    const int lane = F.lane, l15 = lane & 15, g = lane >> 4, w = F.wave, lt = w & 3, yw = w & 3;
    const bool isX = w < 4;
    const int se = (F.tid & 255) >> 2, sq = 2 * (F.tid & 3), tq = l15 >> 2, tp = l15 & 3;
    const int nrow = EW + (l15 == 0 ? 0 : 1);
    unsigned q_lo = (unsigned)((16 * lt + l15) * LDQ + 8 * g) * 2u, p_lo = (unsigned)((16 * lt + l15) * 64 + 8 * g) * 2u, v_lo = (unsigned)(se * LDVS + 8 * sq) * 2u, k_lo = (unsigned)lane * 16u;
    unsigned o_lo = (unsigned)((16 * lt + l15) * LDM + 4 * g) * 2u;
    unsigned rb_lo = (unsigned)(16 * lt + l15) * 4u, rz_lo = (unsigned)(64 + se) * 4u;
    unsigned st_lo = (unsigned)(l15 * LDS_ST + 2 * (16 * MTY * yw + 4 * g)), nl_lo = (unsigned)(4 * (16 * MTY * yw + 4 * g)), sn_lo = (unsigned)(EW * LDS_ST + 2 * (16 * MTY * yw + 4 * g));
    for (int u0 = F.bid; u0 < NB * 4 * NEB; u0 += F.G) {
        int eb, bh;
        if (F.G == 256) { const int x = u0 & 7, j = (u0 >> 3) & 31, r = u0 >> 8; bh = x * 4 + (j >> 3); eb = (j & 7) + 8 * r; }
        else { eb = u0 % NEB; bh = u0 / NEB; }
        const int h = bh & 3, b = bh >> 2;
        const size_t ubase = ((size_t)(b * 4 + h)) * NCHUNK;
        for (int i = F.tid; i < 2 * ST_BYTES / 4; i += NTHR) ((LAS unsigned*)ST)[i] = 0u;
        NL[F.tid] = 0.f;
        u32x4 vraw[2] = {(u32x4){0u, 0u, 0u, 0u}, (u32x4){0u, 0u, 0u, 0u}}; float z_s = 0.f, Amax_s = 0.f, blast_s = 0.f;
#define S2M_RFL(x) __builtin_bit_cast(float, __builtin_amdgcn_readfirstlane(__builtin_bit_cast(int, (float)(x))))
#define S2M_LOADS(cc) do { const float* rec_ = REC + (ubase + (cc)) * 192; Amax_s = rec_[128 + 63]; blast_s = rec_[63]; } while (0)
#define S2M_LOADV(cc) do { const size_t t0_ = (size_t)b * SEQ + (size_t)(cc) * 64; const float* rec_ = REC + (ubase + (cc)) * 192; \
        vraw[0] = *(const u32x4*)((const char*)(VT + t0_ * LDVS + VH * h + EW * eb) + v_lo); vraw[1] = *(const u32x4*)((const char*)(VT + t0_ * LDVS + VH * h + EW * eb + 8) + v_lo); \
        z_s = *(const float*)((const char*)rec_ + rz_lo); Amax_s = rec_[128 + 63]; blast_s = rec_[63]; } while (0)
#define S2M_STAGE(vt_, Mx_) do { const float wrow = __expf(z_s - (Mx_)); \
        _Pragma("unroll") for (int i_ = 0; i_ < 2; ++i_) { u32x4 o; const u32x4 vr_ = vraw[i_]; \
            o.x = pk2(bflo(vr_.x) * wrow, bfhi(vr_.x) * wrow); o.y = pk2(bflo(vr_.y) * wrow, bfhi(vr_.y) * wrow); o.z = pk2(bflo(vr_.z) * wrow, bfhi(vr_.z) * wrow); o.w = pk2(bflo(vr_.w) * wrow, bfhi(vr_.w) * wrow); \
            *(LAS u32x4*)((vt_) + se * LDV + 16 * (sq + i_)) = o; } \
        if (sq == 0) { *(LAS u32x4*)((vt_) + se * LDV + 2 * EW) = (u32x4){pk2(wrow, 0.f), 0u, 0u, 0u}; *(LAS u32x4*)((vt_) + se * LDV + 2 * EW + 16) = (u32x4){0u, 0u, 0u, 0u}; } } while (0)
#define S2M_VFRAG(dst, c0_, ks_) do { const LAS unsigned char* a_ = vt + (32 * (ks_) + 8 * g + tq) * LDV + 2 * ((c0_) + 4 * tp); \
        const s16x4 lo_ = __builtin_amdgcn_ds_read_tr16_b64_v4i16((LAS s16x4*)a_), hi_ = __builtin_amdgcn_ds_read_tr16_b64_v4i16((LAS s16x4*)(a_ + 4 * LDV)); \
        dst = (bf16x8){lo_.x, lo_.y, lo_.z, lo_.w, hi_.x, hi_.y, hi_.z, hi_.w}; } while (0)
        float m_prev = 0.f, Mx, keep, bl_c;
        if (isX) { S2M_LOADV(0); } else { S2M_LOADS(0); }
        Mx = S2M_RFL(fmaxf(m_prev, Amax_s)); keep = S2M_RFL(__expf(m_prev - Mx)); bl_c = S2M_RFL(blast_s);
        if (isX) { S2M_STAGE(VTs, Mx); S2M_LOADV(1); } else { S2M_LOADS(1); }
#define S2M_ADVANCE(XR) do { const float m_next = S2M_RFL(bl_c + Mx), Mx_next = S2M_RFL(fmaxf(m_next, Amax_s)), bl_next = S2M_RFL(blast_s); \
        if (XR) { S2M_STAGE(VTs + ((c + 1) & 1) * VT_BYTES, Mx_next); S2M_LOADV(cn2); } else { S2M_LOADS(cn2); } \
        m_prev = m_next; Mx = Mx_next; keep = S2M_RFL(__expf(m_prev - Mx)); bl_c = bl_next; } while (0)
        if (isX) {
            bf16x8 qf[KS], pf[2]; float b_l, a_l;
#define S2M_LOADX(cc) do { const size_t uidx_ = ubase + (cc); const size_t t0_ = (size_t)b * SEQ + (size_t)(cc) * 64; const float* rec_ = REC + uidx_ * 192; \
            _Pragma("unroll") for (int ks = 0; ks < 2; ++ks) pf[ks] = *(const bf16x8*)((const char*)(PT + uidx_ * 4096 + 32 * ks) + p_lo); \
            _Pragma("unroll") for (int ks = 0; ks < KS; ++ks) qf[ks] = *(const bf16x8*)((const char*)(Q + t0_ * LDQ + QH * h + 32 * ks) + q_lo); \
            b_l = *(const float*)((const char*)rec_ + rb_lo); a_l = *(const float*)((const char*)(rec_ + 128) + rb_lo); } while (0)
            S2M_LOADX(0);
            WG_SYNC_LDS();
            for (int c = 0; c < NCHUNK; ++c) {
                asm volatile("" : "+v"(q_lo), "+v"(p_lo), "+v"(v_lo), "+v"(rb_lo), "+v"(rz_lo), "+v"(o_lo));
                const size_t t0 = (size_t)b * SEQ + (size_t)c * 64;
                const int cn = (c + 1 < NCHUNK) ? c + 1 : c, cn2 = (c + 2 < NCHUNK) ? c + 2 : NCHUNK - 1;
                LAS unsigned char* vt = VTs + (c & 1) * VT_BYTES;
                const LAS unsigned char* STr = ST + ((c + 1) & 1) * ST_BYTES;
                f32x4 oi[NE], oo[NE];
#pragma unroll
                for (int nt = 0; nt < NE; ++nt) { oi[nt] = (f32x4){0.f, 0.f, 0.f, 0.f}; oo[nt] = (f32x4){0.f, 0.f, 0.f, 0.f}; }
#pragma unroll
                for (int nt = 0; nt < NE; ++nt)
#pragma unroll
                    for (int ks = 0; ks < 2; ++ks) { bf16x8 vf; S2M_VFRAG(vf, 16 * nt, ks); oi[nt] = __builtin_amdgcn_mfma_f32_16x16x32_bf16(vf, pf[ks], oi[nt], 0, 0, 0); }
#pragma unroll
                for (int ks = 0; ks < KS; ++ks) {
#pragma unroll
                    for (int nt = 0; nt < NE; ++nt) { const bf16x8 sf = *(const LAS bf16x8*)(STr + ((nt == NER) ? nrow : (16 * nt + l15)) * LDS_ST + 64 * ks + 16 * g);
                        oo[nt] = __builtin_amdgcn_mfma_f32_16x16x32_bf16(sf, qf[ks], oo[nt], 0, 0, 0); }
                    if ((ks & 3) == 3) __builtin_amdgcn_sched_barrier(0);
                }
                const float QNl = __shfl(oo[NER][0], l15), RSl = __shfl(oi[NER][0], l15);
                const float Ml = fmaxf(m_prev, a_l), rho = __expf(Mx - Ml), wi = __expf(m_prev - Ml);
                const float den = wi * QNl + rho * RSl;
                const float inv = 1.0f / fmaxf(fabsf(den), __expf(-(b_l + Ml)));
                const float ci = rho * inv, co = wi * inv;
#pragma unroll
                for (int nt = 0; nt < NER; ++nt) { const f32x4 ov = oi[nt] * ci + oo[nt] * co;
                    u32x2 o; o.x = pk2(ov[0], ov[1]); o.y = pk2(ov[2], ov[3]);
                    *(u32x2*)((char*)(mix + t0 * LDM + VH * h + EW * eb + 16 * nt) + o_lo) = o; }
                S2M_LOADX(cn);
                S2M_ADVANCE(true);
                WG_SYNC_LDS();
            }
#undef S2M_LOADX
        } else {
            bf16x8 kf[MTY][2]; f32x4 S[MTY][NER];
#pragma unroll
            for (int mt = 0; mt < MTY; ++mt)
#pragma unroll
                for (int nt = 0; nt < NER; ++nt) S[mt][nt] = (f32x4){0.f, 0.f, 0.f, 0.f};
#define S2M_LOADY(cc) do { const size_t uidx_ = ubase + (cc); \
            _Pragma("unroll") for (int mt = 0; mt < MTY; ++mt) _Pragma("unroll") for (int ks = 0; ks < 2; ++ks) \
                kf[mt][ks] = *(const bf16x8*)((const char*)(KT + uidx_ * (DK * 64) + ((((MTY * yw + mt) * 2 + ks) * 64) << 3)) + k_lo); } while (0)
            S2M_LOADY(0);
            WG_SYNC_LDS();
            for (int c = 0; c < NCHUNK; ++c) {
                asm volatile("" : "+v"(k_lo), "+v"(st_lo), "+v"(nl_lo), "+v"(sn_lo));
                const int cn = (c + 1 < NCHUNK) ? c + 1 : c, cn2 = (c + 2 < NCHUNK) ? c + 2 : NCHUNK - 1;
                LAS unsigned char* vt = VTs + (c & 1) * VT_BYTES;
                LAS unsigned char* STw = ST + (c & 1) * ST_BYTES;
#pragma unroll
                for (int nt = 0; nt < NER; ++nt) {
                    bf16x8 vf[2];
#pragma unroll
                    for (int ks = 0; ks < 2; ++ks) S2M_VFRAG(vf[ks], 16 * nt, ks);
#pragma unroll
                    for (int mt = 0; mt < MTY; ++mt) {
                        S[mt][nt] = S[mt][nt] * keep;
#pragma unroll
                        for (int ks = 0; ks < 2; ++ks) S[mt][nt] = __builtin_amdgcn_mfma_f32_16x16x32_bf16(kf[mt][ks], vf[ks], S[mt][nt], 0, 0, 0);
                        u32x2 o; o.x = pk2(S[mt][nt][0], S[mt][nt][1]); o.y = pk2(S[mt][nt][2], S[mt][nt][3]);
                        *(LAS u32x2*)(STw + st_lo + (16 * nt * LDS_ST + 32 * mt)) = o; }
                }
                {
                    bf16x8 vf[2];
#pragma unroll
                    for (int ks = 0; ks < 2; ++ks) S2M_VFRAG(vf[ks], EW, ks);
#pragma unroll
                    for (int mt = 0; mt < MTY; ++mt) {
                        f32x4 na = (f32x4){0.f, 0.f, 0.f, 0.f};
                        if (l15 == 0) na = *(const LAS f32x4*)((LAS unsigned char*)NL + nl_lo + 64 * mt) * keep;
#pragma unroll
                        for (int ks = 0; ks < 2; ++ks) na = __builtin_amdgcn_mfma_f32_16x16x32_bf16(kf[mt][ks], vf[ks], na, 0, 0, 0);
                        if (l15 == 0) { *(LAS f32x4*)((LAS unsigned char*)NL + nl_lo + 64 * mt) = na; u32x2 o; o.x = pk2(na[0], na[1]); o.y = pk2(na[2], na[3]); *(LAS u32x2*)(STw + sn_lo + 32 * mt) = o; } }
                }
                S2M_LOADY(cn);
                S2M_ADVANCE(false);
                WG_SYNC_LDS();
            }
#undef S2M_LOADY
        }
#undef S2M_ADVANCE
#undef S2M_LOADV
#undef S2M_LOADS
#undef S2M_RFL
#undef S2M_STAGE
#undef S2M_VFRAG
    }
}
template <int MODE>
__device__ __forceinline__ void hn_phase(Frame& F, const bf16_t* mix, const bf16_t* gate, const bf16_t* xc, const float* gn, const float* skip, bf16_t* amix) {
    constexpr int HD = MODE == 1 ? 256 : 512, NV = HD / 64;
    constexpr int LDM = 4 * HD;
    constexpr int LDG = MODE == 0 ? 6144 : (MODE == 1 ? 3072 : 4096), GOFF = MODE == 0 ? 4096 : 2048;
    const int gw = F.bid * NWAVES + F.wave, NGW = F.G * NWAVES, lane = F.lane;
    for (int t = gw; t < T; t += NGW) {
        float v[4][NV], gv[4][NV], xv[4][NV];
#pragma unroll
        for (int h = 0; h < 4; ++h) {
            if (NV == 8) {
                const u32x4 a = *(const u32x4*)(mix + (size_t)t * LDM + HD * h + 8 * lane), b = *(const u32x4*)(gate + (size_t)t * LDG + GOFF + HD * h + 8 * lane);
                v[h][0] = bflo(a.x); v[h][1] = bfhi(a.x); v[h][2] = bflo(a.y); v[h][3] = bfhi(a.y); v[h][4 % NV] = bflo(a.z); v[h][5 % NV] = bfhi(a.z); v[h][6 % NV] = bflo(a.w); v[h][7 % NV] = bfhi(a.w);
                gv[h][0] = bflo(b.x); gv[h][1] = bfhi(b.x); gv[h][2] = bflo(b.y); gv[h][3] = bfhi(b.y); gv[h][4 % NV] = bflo(b.z); gv[h][5 % NV] = bfhi(b.z); gv[h][6 % NV] = bflo(b.w); gv[h][7 % NV] = bfhi(b.w);
                if (MODE == 2) { const u32x4 c = *(const u32x4*)(xc + (size_t)t * LDM + HD * h + 8 * lane);
                    xv[h][0] = bflo(c.x); xv[h][1] = bfhi(c.x); xv[h][2] = bflo(c.y); xv[h][3] = bfhi(c.y); xv[h][4 % NV] = bflo(c.z); xv[h][5 % NV] = bfhi(c.z); xv[h][6 % NV] = bflo(c.w); xv[h][7 % NV] = bfhi(c.w); }
            } else {
                const u32x2 a = *(const u32x2*)(mix + (size_t)t * LDM + HD * h + 4 * lane), b = *(const u32x2*)(gate + (size_t)t * LDG + GOFF + HD * h + 4 * lane);
                v[h][0] = bflo(a.x); v[h][1] = bfhi(a.x); v[h][2] = bflo(a.y); v[h][3] = bfhi(a.y);
                gv[h][0] = bflo(b.x); gv[h][1] = bfhi(b.x); gv[h][2] = bflo(b.y); gv[h][3] = bfhi(b.y);
            }
        }
#pragma unroll
        for (int h = 0; h < 4; ++h) {
            if (MODE != 1) { float s = 0.f;
#pragma unroll
                for (int j = 0; j < NV; ++j) s += v[h][j];
                const float mean = wave_sum(s) * (1.0f / HD);
#pragma unroll
                for (int j = 0; j < NV; ++j) v[h][j] -= mean; }
            float q = 0.f;
#pragma unroll
            for (int j = 0; j < NV; ++j) q += v[h][j] * v[h][j];
            const float rstd = rsqrtf(wave_sum(q) * (1.0f / HD) + EPS);
            float o[NV];
#pragma unroll
            for (int j = 0; j < NV; ++j) { const int ch = HD * h + NV * lane + j;
                float y = v[h][j] * rstd * gn[ch];
                if (MODE == 2) y += skip[ch] * xv[h][j];
                o[j] = y * siluf_(gv[h][j]); }
            if (OUT_FP8) { unsigned char* a8 = (unsigned char*)amix;
                if (NV == 8) { u32x2 ow; ow.x = pk4_fp8(o[0], o[1], o[2], o[3]); ow.y = pk4_fp8(o[4 % NV], o[5 % NV], o[6 % NV], o[7 % NV]); *(u32x2*)(a8 + (size_t)t * LDM + HD * h + 8 * lane) = ow; }
                else *(unsigned*)(a8 + (size_t)t * LDM + HD * h + 4 * lane) = pk4_fp8(o[0], o[1], o[2], o[3]); }
            else if (NV == 8) { u32x4 ow; ow.x = pk2(o[0], o[1]); ow.y = pk2(o[2], o[3]); ow.z = pk2(o[4 % NV], o[5 % NV]); ow.w = pk2(o[6 % NV], o[7 % NV]);
                *(u32x4*)(amix + (size_t)t * LDM + HD * h + 8 * lane) = ow; }
            else { u32x2 ow; ow.x = pk2(o[0], o[1]); ow.y = pk2(o[2], o[3]); *(u32x2*)(amix + (size_t)t * LDM + HD * h + 4 * lane) = ow; }
        }
    }
}
__device__ __forceinline__ int kt_off(int d, int m) { return ((((d >> 4) * 2 + (m >> 5)) * 64 + 16 * ((m >> 3) & 3) + (d & 15)) << 3) + (m & 7); }

template <int NC, bool FRAG>
__device__ __forceinline__ void s1_write_transposed(const LAS unsigned char* src, int ldb, bf16_t* dst, int tid) {
    for (int p = tid; p < NC * 8; p += NTHR) {
        const int col = p % NC, mc = p / NC;
        unsigned short v[8];
#pragma unroll
        for (int e = 0; e < 8; ++e) v[e] = *(const LAS unsigned short*)(src + (size_t)(8 * mc + e) * ldb + 2 * col);
        u32x4 w; w.x = v[0] | ((unsigned)v[1] << 16); w.y = v[2] | ((unsigned)v[3] << 16); w.z = v[4] | ((unsigned)v[5] << 16); w.w = v[6] | ((unsigned)v[7] << 16);
        const int off = FRAG ? kt_off(col, 8 * mc) : (col * 64 + 8 * mc);
        *(u32x4*)(dst + off) = w;
    }
}
template <int DK>
__device__ __forceinline__ void s1_write_kt_tr(const LAS unsigned char* src, int ldb, bf16_t* dst, int wave, int lane) {
    const int l15 = lane & 15, g = lane >> 4, q = l15 >> 2, p = l15 & 3;
#pragma unroll
    for (int f = wave; f < (DK / 16) * 2; f += NWAVES) {
        const int dt = f >> 1, ks = f & 1;
        const LAS unsigned char* a = src + (32 * ks + 8 * g + q) * ldb + 2 * (16 * dt + 4 * p);
        const s16x4 lo = __builtin_amdgcn_ds_read_tr16_b64_v4i16((LAS s16x4*)a), hi = __builtin_amdgcn_ds_read_tr16_b64_v4i16((LAS s16x4*)(a + 4 * ldb));
        const bf16x8 v = (bf16x8){lo.x, lo.y, lo.z, lo.w, hi.x, hi.y, hi.z, hi.w};
        *(bf16x8*)(dst + ((size_t)f * 64 + lane) * 8) = v;
    }
}
template <int NC>
__device__ __forceinline__ void s1_load_tile(const bf16_t* src, int ld, LAS unsigned char* dst, int ldb, int tid) {
    constexpr int PPR = NC / 8;
    for (int p = tid; p < 64 * PPR; p += NTHR) { const int r = p / PPR, q = p % PPR;
        *(LAS u32x4*)(dst + (size_t)r * ldb + 16 * q) = *(const u32x4*)(src + (size_t)r * ld + 8 * q); }
}

template <int NC>
__device__ __forceinline__ void s1_gload(const bf16_t* src, int ld, u32x4 (&r)[64 * NC / 8 / NTHR], int tid) {
    constexpr int PPR = NC / 8;
#pragma unroll
    for (int i = 0; i < 64 * NC / 8 / NTHR; ++i) { const int p = tid + i * NTHR, row = p / PPR, q = p % PPR; r[i] = *(const u32x4*)(src + (size_t)row * ld + 8 * q); }
}
template <int NC>
__device__ __forceinline__ void s1_lstore(const u32x4 (&r)[64 * NC / 8 / NTHR], LAS unsigned char* dst, int ldb, int tid) {
    constexpr int PPR = NC / 8;
#pragma unroll
    for (int i = 0; i < 64 * NC / 8 / NTHR; ++i) { const int p = tid + i * NTHR, row = p / PPR, q = p % PPR; *(LAS u32x4*)(dst + (size_t)row * ldb + 16 * q) = r[i]; }
}
__device__ __forceinline__ void ret_s1_phase(Frame& F, const bf16_t* proj, bf16_t* PT, bf16_t* KT, bf16_t* VT) {
    constexpr int LDK = 528, LDV = 1040, LDP = 144;
    LAS unsigned char* Ks = F.lds;
    LAS unsigned char* Vs = F.lds + 33792;
    LAS unsigned char* Ps = F.lds + 33792 + 66560;
    const int lane = F.lane, l15 = lane & 15, g = lane >> 4, w = F.wave, lt = w >> 1, mh = w & 1;
    u32x4 kr[4]; bf16x8 qf[8];
#define RS1_LOAD(uu) do { const int c_ = (uu) % NCHUNK, h_ = ((uu) / NCHUNK) % 4, b_ = (uu) / (NCHUNK * 4); const size_t t0_ = (size_t)b_ * SEQ + (size_t)c_ * 64; \
        s1_gload<256>(proj + t0_ * 6144 + 1024 + 256 * h_, 6144, kr, F.tid); \
        _Pragma("unroll") for (int ks = 0; ks < 8; ++ks) qf[ks] = *(const bf16x8*)(proj + (t0_ + 16 * lt + l15) * 6144 + 256 * h_ + 32 * ks + 8 * g); } while (0)
    if (F.bid < NB * 4 * NCHUNK) RS1_LOAD(F.bid);
    for (int u = F.bid; u < NB * 4 * NCHUNK; u += F.G) {
        s1_lstore<256>(kr, Ks, LDK, F.tid);
        WG_SYNC_LDS();
        f32x4 acc[2];
#pragma unroll
        for (int nt = 0; nt < 2; ++nt) { acc[nt] = (f32x4){0.f, 0.f, 0.f, 0.f};
#pragma unroll
            for (int ks = 0; ks < 8; ++ks) { const bf16x8 kf = *(const LAS bf16x8*)(Ks + (size_t)(32 * mh + 16 * nt + l15) * LDK + 64 * ks + 16 * g);
                acc[nt] = __builtin_amdgcn_mfma_f32_16x16x32_bf16(qf[ks], kf, acc[nt], 0, 0, 0); } }
#pragma unroll
        for (int nt = 0; nt < 2; ++nt)
#pragma unroll
            for (int r = 0; r < 4; ++r) { const int l = 16 * lt + 4 * g + r, m = 32 * mh + 16 * nt + l15;
                *(LAS unsigned short*)(Ps + l * LDP + 2 * m) = (unsigned short)f2bf(m <= l ? acc[nt][r] : 0.f); }
        { const int un = u + F.G; if (un < NB * 4 * NCHUNK) RS1_LOAD(un); }
        WG_SYNC_LDS();
        { const int r = F.tid >> 3, q = F.tid & 7; *(u32x4*)(PT + (size_t)u * 4096 + r * 64 + 8 * q) = *(const LAS u32x4*)(Ps + r * LDP + 16 * q); }
        s1_write_kt_tr<256>(Ks, LDK, KT + (size_t)u * 256 * 64, F.wave, lane);
        WG_SYNC_LDS();
    }
#undef RS1_LOAD
}

__device__ __forceinline__ void ret_s2_phase(Frame& F, const bf16_t* proj, const bf16_t* PT, const bf16_t* KT, const bf16_t* VT, bf16_t* mix) {
    constexpr int LDS_ST = 528, LDV = 144, LDO = 144;
    LAS unsigned char* ST = F.lds;
    LAS unsigned char* VTs = F.lds + 33792;
    LAS unsigned char* Os = F.lds + 33792 + 18432;
    const int lane = F.lane, l15 = lane & 15, g = lane >> 4, w = F.wave, lt = w >> 1, eh = w & 1;
    for (int u = F.bid; u < NB * 4 * 8; u += F.G) {
        const int eb = u & 7, h = (u >> 3) & 3, b = u >> 5;
        const float lg = log1pf(-exp2f(-5.0f - (float)h));
        f32x4 S[2][4];
#pragma unroll
        for (int mt = 0; mt < 2; ++mt)
#pragma unroll
            for (int nt = 0; nt < 4; ++nt) S[mt][nt] = (f32x4){0.f, 0.f, 0.f, 0.f};
        for (int i = F.tid; i < 33792 / 4; i += NTHR) ((LAS unsigned*)ST)[i] = 0u;
        const float dec64 = __expf(64.0f * lg);
        for (int c = 0; c < NCHUNK; ++c) {
            const size_t t0 = (size_t)b * SEQ + (size_t)c * 64;
            const size_t uidx = ((size_t)(b * 4 + h)) * NCHUNK + c;
            LAS unsigned char* vt = VTs + (c & 1) * 9216;
            bf16x8 kf[2][2], qf[8], pf[2];
#pragma unroll
            for (int mt = 0; mt < 2; ++mt)
#pragma unroll
                for (int ks = 0; ks < 2; ++ks) kf[mt][ks] = *(const bf16x8*)(KT + uidx * (256 * 64) + ((((2 * w + mt) * 2 + ks) * 64 + lane) << 3));
#pragma unroll
            for (int ks = 0; ks < 8; ++ks) qf[ks] = *(const bf16x8*)(proj + (t0 + 16 * lt + l15) * 6144 + 256 * h + 32 * ks + 8 * g);
#pragma unroll
            for (int ks = 0; ks < 2; ++ks) pf[ks] = *(const bf16x8*)(PT + uidx * 4096 + (16 * lt + l15) * 64 + 32 * ks + 8 * g);
            {
                const int e = F.tid >> 3, q = F.tid & 7;
                const u32x4 raw = *(const u32x4*)(VT + uidx * (512 * 64) + (size_t)(64 * eb + e) * 64 + 8 * q);
                float f[8] = {bflo(raw.x), bfhi(raw.x), bflo(raw.y), bfhi(raw.y), bflo(raw.z), bfhi(raw.z), bflo(raw.w), bfhi(raw.w)};
#pragma unroll
                for (int j = 0; j < 8; ++j) f[j] *= __expf((float)(63 - (8 * q + j)) * lg);
                u32x4 o; o.x = pk2(f[0], f[1]); o.y = pk2(f[2], f[3]); o.z = pk2(f[4], f[5]); o.w = pk2(f[6], f[7]);
                *(LAS u32x4*)(vt + e * LDV + 16 * q) = o;
            }
            LDS_WAIT();
            __syncthreads();
            f32x4 oi[2], oo[2];
#pragma unroll
            for (int nt = 0; nt < 2; ++nt) {
                const int e = 32 * eh + 16 * nt + l15;
                oi[nt] = (f32x4){0.f, 0.f, 0.f, 0.f}; oo[nt] = (f32x4){0.f, 0.f, 0.f, 0.f};
#pragma unroll
                for (int ks = 0; ks < 2; ++ks) { const bf16x8 vf = *(const LAS bf16x8*)(vt + e * LDV + 64 * ks + 16 * g);
                    oi[nt] = __builtin_amdgcn_mfma_f32_16x16x32_bf16(pf[ks], vf, oi[nt], 0, 0, 0); }
#pragma unroll
                for (int ks = 0; ks < 8; ++ks) { const bf16x8 sf = *(const LAS bf16x8*)(ST + e * LDS_ST + 64 * ks + 16 * g);
                    oo[nt] = __builtin_amdgcn_mfma_f32_16x16x32_bf16(qf[ks], sf, oo[nt], 0, 0, 0); }
            }
#pragma unroll
            for (int r = 0; r < 4; ++r) { const int l = 16 * lt + 4 * g + r;
                const float si = __expf((float)(l - 63) * lg), so = __expf((float)(l + 1) * lg);
#pragma unroll
                for (int nt = 0; nt < 2; ++nt) *(LAS unsigned short*)(Os + l * LDO + 2 * (32 * eh + 16 * nt + l15)) = (unsigned short)f2bf(si * oi[nt][r] + so * oo[nt][r]); }
            LDS_WAIT();
            __syncthreads();
            { const int r = F.tid >> 3, q = F.tid & 7; *(u32x4*)(mix + (t0 + r) * 2048 + 512 * h + 64 * eb + 8 * q) = *(const LAS u32x4*)(Os + r * LDO + 16 * q); }
#pragma unroll
            for (int mt = 0; mt < 2; ++mt)
#pragma unroll
                for (int nt = 0; nt < 4; ++nt) { S[mt][nt] = S[mt][nt] * dec64;
#pragma unroll
                    for (int ks = 0; ks < 2; ++ks) { const bf16x8 vf = *(const LAS bf16x8*)(vt + (16 * nt + l15) * LDV + 64 * ks + 16 * g);
                        S[mt][nt] = __builtin_amdgcn_mfma_f32_16x16x32_bf16(kf[mt][ks], vf, S[mt][nt], 0, 0, 0); }
                    u32x2 o; o.x = pk2(S[mt][nt][0], S[mt][nt][1]); o.y = pk2(S[mt][nt][2], S[mt][nt][3]);
                    *(LAS u32x2*)(ST + (16 * nt + l15) * LDS_ST + 2 * (32 * w + 16 * mt + 4 * g)) = o; }
        }
        LDS_WAIT();
        __syncthreads();
    }
}

__device__ __forceinline__ void ret_norm_phase(Frame& F, const bf16_t* mix, const bf16_t* proj, const float* gn, bf16_t* amix) {
    const int gw = F.bid * NWAVES + F.wave, NGW = F.G * NWAVES, lane = F.lane;
    for (int i = gw; i < T * 4; i += NGW) {
        const int t = i >> 2, h = i & 3;
        const u32x4 raw = *(const u32x4*)(mix + (size_t)t * 2048 + 512 * h + 8 * lane);
        const u32x4 gr = *(const u32x4*)(proj + (size_t)t * 6144 + 4096 + 512 * h + 8 * lane);
        float v[8] = {bflo(raw.x), bfhi(raw.x), bflo(raw.y), bfhi(raw.y), bflo(raw.z), bfhi(raw.z), bflo(raw.w), bfhi(raw.w)};
        const float gv[8] = {bflo(gr.x), bfhi(gr.x), bflo(gr.y), bfhi(gr.y), bflo(gr.z), bfhi(gr.z), bflo(gr.w), bfhi(gr.w)};
        float s = 0.f;
#pragma unroll
        for (int j = 0; j < 8; ++j) s += v[j];
        const float mean = wave_sum(s) * (1.0f / 512.0f);
        float q = 0.f;
#pragma unroll
        for (int j = 0; j < 8; ++j) { v[j] -= mean; q += v[j] * v[j]; }
        const float rstd = rsqrtf(wave_sum(q) * (1.0f / 512.0f) + EPS);
        const f32x4 g0 = *(const f32x4*)(gn + 512 * h + 8 * lane), g1 = *(const f32x4*)(gn + 512 * h + 8 * lane + 4);
        const float gg[8] = {g0.x, g0.y, g0.z, g0.w, g1.x, g1.y, g1.z, g1.w};
        float o[8];
#pragma unroll
        for (int j = 0; j < 8; ++j) o[j] = v[j] * rstd * gg[j] * siluf_(gv[j]);
        u32x4 ow; ow.x = pk2(o[0], o[1]); ow.y = pk2(o[2], o[3]); ow.z = pk2(o[4], o[5]); ow.w = pk2(o[6], o[7]);
        *(u32x4*)(amix + (size_t)t * 2048 + 512 * h + 8 * lane) = ow;
    }
}
#define NPH_RET 5
#define LAYER_RET() do { \
        { pg8::Gemm g{IFP8_RET ? (const bf16_t*)(ws + WS_H8) : hbuf, (const bf16_t*)(ws + WS_W_RET_IN), T, GFP8_RET ? 4096 : 6144, IFP8_RET ? 512 : 1024}; pg8::EpiRet E{proj, (const f32x2*)(ws + WS_ROPE), IFP8_RET ? 0.03125f : 1.0f}; \
          pg8::Gemm g2{(const bf16_t*)(ws + WS_H8), (const bf16_t*)(ws + WS_W_RET_IN + 8 * MiB), T, 2048, 512}; pg8::EpiBf16S E2{proj + 4096, 6144, 0, 1.0f, 0.03125f}; \
          RUN_PHASE({ pg8::StaticOrder S; S.init(T, GFP8_RET ? 4096 : 6144, F.G, F.bid); \
            if (CVT_HOST == 2 && MOE_FP8) { BgCvtR bgc; bgc.init(in, ws, F.bid * NWAVES + F.wave, F.G * NWAVES, F.lane, -1, 0, 0, 0, 16384);       \
              pg8::gemm_phase_bg<pg8::EpiRet, pg8::StaticOrder, false, (IFP8_RET != 0), BgCvtR>(F.lds, g, S, E, bgc); bgc.finish(); } \
            else pg8::gemm_phase<pg8::EpiRet, pg8::StaticOrder, false, (IFP8_RET != 0)>(F.lds, g, S, E); \
            if (GFP8_RET) { pg8::StaticOrder S2; S2.init(T, 2048, F.G, F.bid); pg8::gemm_phase<pg8::EpiBf16S, pg8::StaticOrder, false, true>(F.lds, g2, S2, E2); } }); } \
        RUN_PHASE_N(REP_S1, ret_s1_phase(F, proj, (bf16_t*)(ws + WS_PT), (bf16_t*)(ws + WS_KT), (bf16_t*)(ws + WS_VT))); \
        RUN_PHASE({ if (S2X) s2x_phase<0>(F, proj, (const bf16_t*)(ws + WS_PT), (const bf16_t*)(ws + WS_KT), proj + 2048, nullptr, (bf16_t*)(ws + WS_MIX)); else s2_phase<0>(F, proj, (const bf16_t*)(ws + WS_PT), (const bf16_t*)(ws + WS_KT), proj + 2048, nullptr, (bf16_t*)(ws + WS_MIX), in, ws, -1); \
            if (REP_S2R > 1) { VM_WAIT(); __syncthreads(); s2_phase<0, S2_ABL>(F, proj, (const bf16_t*)(ws + WS_PT), (const bf16_t*)(ws + WS_KT), proj + 2048, nullptr, (bf16_t*)(ws + WS_AMIX)); } }); \
        RUN_PHASE_N(REP_HN, hn_phase<0>(F, (const bf16_t*)(ws + WS_MIX), proj, nullptr, in[8], nullptr, amix)); \
        OUTPROJ(0, WS_W_RET_OUT, 2048); \
    } while (0)
__device__ __forceinline__ void attn_phase(Frame& F, const bf16_t* qkv, const float* relb, bf16_t* o, const float* const* in, unsigned char* ws) {
    const int gw_ = F.bid * NWAVES + F.wave, NGW_ = F.G * NWAVES;
    const int n_it = 2 * ((NB * NCHUNK + F.G - 1) / F.G);
    constexpr int NLY = CVT_HOST ? 0 : 4 - MOE_PRO_LAYERS;
    const int per_ly = (MOE_FP8 && NLY > 0) ? ((24576 + NGW_ * n_it - 1) / (NGW_ * n_it)) : 0, per_it = per_ly * NLY;
    int it_ = 0;
    LAS unsigned char* wl = F.lds + F.wave * 8192;
    LAS float* rb = (LAS float*)(wl + 5120);
    const int lane = F.lane, l15 = lane & 15, g = lane >> 4;
    const __amdgpu_buffer_rsrc_t qrs = __builtin_amdgcn_make_buffer_rsrc((void*)qkv, 0, 0x7fffffff, 0x00020000);
    const unsigned kofs = (unsigned)(l15 * 3072 + 8 * g) * 2u, vofs = (unsigned)((lane >> 3) * 3072 + 8 * (lane & 7)) * 2u;
    for (int u0 = F.bid; u0 < NB * NCHUNK; u0 += F.G) {
        int u = u0;
        if (F.G == 256) { const int x = u0 & 7, j = (u0 >> 3) & 31, r = u0 >> 8; u = x * NCHUNK + r * 32 + j; }
        const int b = u / NCHUNK, c = u % NCHUNK;
        const size_t t0 = (size_t)b * SEQ + (size_t)c * 64;
        for (int hh = 0; hh < 2; ++hh) {
            const int h = F.wave * 2 + hh;
            if (per_it) { for (int ly = 0; ly < NLY; ++ly) bg_convert(in, ws, MOE_PRO_LAYERS + ly, it_ * per_ly, per_ly, gw_, NGW_, lane); }
            ++it_;
            for (int i = lane; i < 320; i += 64) rb[i] = relb[h * 320 + i] * 1.4426950408889634f;
            bf16x8 qf[4][2];
#pragma unroll
            for (int nt = 0; nt < 4; ++nt)
#pragma unroll
                for (int ks = 0; ks < 2; ++ks) qf[nt][ks] = *(const bf16x8*)(qkv + (t0 + 16 * nt + l15) * 3072 + 64 * h + 32 * ks + 8 * g);
            f32x4 oacc[4][4];
#pragma unroll
            for (int dt = 0; dt < 4; ++dt)
#pragma unroll
                for (int nt = 0; nt < 4; ++nt) oacc[dt][nt] = (f32x4){0.f, 0.f, 0.f, 0.f};
            float mrun[4], lsum[4];
#pragma unroll
            for (int nt = 0; nt < 4; ++nt) { mrun[nt] = -1.0e30f; lsum[nt] = 0.f; }
            const int kt0 = (16 - 2 * c) > 0 ? (16 - 2 * c) : 0;
            bf16x8 kf[2][2]; u32x4 vv[4];
#define ATT_GLOAD(KF, VV, kt_) do { const unsigned sb_ = (unsigned)((t0 - 512 + 32 * (kt_)) * 3072 + 64 * h) * 2u;        \
                _Pragma("unroll") for (int mt = 0; mt < 2; ++mt) _Pragma("unroll") for (int ks = 0; ks < 2; ++ks) \
                    KF[mt][ks] = __builtin_bit_cast(bf16x8, __builtin_amdgcn_raw_buffer_load_b128(qrs, kofs, sb_ + (unsigned)((16 * mt * 3072 + 1024 + 32 * ks) * 2), 0)); \
                _Pragma("unroll") for (int i = 0; i < 4; ++i) VV[i] = __builtin_bit_cast(u32x4, __builtin_amdgcn_raw_buffer_load_b128(qrs, vofs, sb_ + (unsigned)((8 * i * 3072 + 2048) * 2), 0)); } while (0)
            ATT_GLOAD(kf, vv, kt0);
            for (int kt = kt0; kt < 18; ++kt) {
                bf16x8 kfn[2][2]; u32x4 vvn[4];
                { const int ktn = kt + 1 < 18 ? kt + 1 : kt; ATT_GLOAD(kfn, vvn, ktn); }
                f32x4 sacc[2][4];
#pragma unroll
                for (int mt = 0; mt < 2; ++mt)
#pragma unroll
                    for (int nt = 0; nt < 4; ++nt) { sacc[mt][nt] = (f32x4){0.f, 0.f, 0.f, 0.f};
#pragma unroll
                        for (int ks = 0; ks < 2; ++ks) sacc[mt][nt] = __builtin_amdgcn_mfma_f32_16x16x32_bf16(kf[mt][ks], qf[nt][ks], sacc[mt][nt], 0, 0, 0); }
#pragma unroll
                for (int i = 0; i < 4; ++i) *(LAS u32x4*)(wl + ((lane >> 3) + 8 * i) * 144 + 16 * (lane & 7)) = vv[i];
                bf16x8 pf[4];
#pragma unroll
                for (int nt = 0; nt < 4; ++nt) {
                    float tmax = -1.0e30f;
                    if (kt <= 7) {
                        const float cb = rb[256 + 63];
#pragma unroll
                        for (int mt = 0; mt < 2; ++mt)
#pragma unroll
                            for (int r = 0; r < 4; ++r) { const float s = sacc[mt][nt][r] + cb; sacc[mt][nt][r] = s; tmax = fmaxf(tmax, s); }
                    } else {
#pragma unroll
                        for (int mt = 0; mt < 2; ++mt)
#pragma unroll
                            for (int r = 0; r < 4; ++r) {
                                int dist = (16 * nt + l15) - (32 * kt + 16 * mt + 4 * g + r) + 512;
                                dist = dist < -63 ? -63 : (dist > 256 ? 256 : dist);
                                const float s = sacc[mt][nt][r] + rb[dist + 63];
                                sacc[mt][nt][r] = s; tmax = fmaxf(tmax, s);
                            }
                    }
                    tmax = fmaxf(tmax, __shfl_xor(tmax, 16)); tmax = fmaxf(tmax, __shfl_xor(tmax, 32));
                    const float mnew = fmaxf(mrun[nt], tmax);
                    const float alpha = __builtin_amdgcn_exp2f(mrun[nt] - mnew);
                    mrun[nt] = mnew;
                    float ps = 0.f; float p[8];
#pragma unroll
                    for (int mt = 0; mt < 2; ++mt)
#pragma unroll
                        for (int r = 0; r < 4; ++r) { const float e = __builtin_amdgcn_exp2f(sacc[mt][nt][r] - mnew); p[4 * mt + r] = e; ps += e; }
                    lsum[nt] = lsum[nt] * alpha + ps;
                    if (__builtin_amdgcn_ballot_w64(alpha != 1.0f) != 0) {
#pragma unroll
                        for (int dt = 0; dt < 4; ++dt) oacc[dt][nt] = oacc[dt][nt] * alpha; }
                    u32x4 pw; pw.x = cvt_pk_bf16(p[0], p[1]); pw.y = cvt_pk_bf16(p[2], p[3]); pw.z = cvt_pk_bf16(p[4], p[5]); pw.w = cvt_pk_bf16(p[6], p[7]);
                    pf[nt] = __builtin_bit_cast(bf16x8, pw);
                }
#pragma unroll
                for (int dt = 0; dt < 4; ++dt) {
                    const LAS unsigned char* ta = wl + (4 * g + (l15 >> 2)) * 144 + 2 * (16 * (l15 & 3) + 4 * dt);
                    const s16x4 lo = __builtin_amdgcn_ds_read_tr16_b64_v4i16((LAS s16x4*)ta), hi = __builtin_amdgcn_ds_read_tr16_b64_v4i16((LAS s16x4*)(ta + 16 * 144));
                    const bf16x8 vf = (bf16x8){lo.x, lo.y, lo.z, lo.w, hi.x, hi.y, hi.z, hi.w};
#pragma unroll
                    for (int nt = 0; nt < 4; ++nt) oacc[dt][nt] = __builtin_amdgcn_mfma_f32_16x16x32_bf16(vf, pf[nt], oacc[dt][nt], 0, 0, 0);
                }
#pragma unroll
                for (int mt = 0; mt < 2; ++mt)
#pragma unroll
                    for (int ks = 0; ks < 2; ++ks) kf[mt][ks] = kfn[mt][ks];
#pragma unroll
                for (int i = 0; i < 4; ++i) vv[i] = vvn[i];
            }
#undef ATT_GLOAD
#pragma unroll
            for (int nt = 0; nt < 4; ++nt) {
                float l = lsum[nt]; l += __shfl_xor(l, 16); l += __shfl_xor(l, 32);
                const float inv = 1.0f / l;
                if (OUT_FP8) { u32x4 w4; const f32x4 v0 = oacc[0][nt] * inv, v1 = oacc[1][nt] * inv, v2 = oacc[2][nt] * inv, v3 = oacc[3][nt] * inv;
                    w4.x = pk4_fp8(v0[0], v0[1], v0[2], v0[3]); w4.y = pk4_fp8(v1[0], v1[1], v1[2], v1[3]); w4.z = pk4_fp8(v2[0], v2[1], v2[2], v2[3]); w4.w = pk4_fp8(v3[0], v3[1], v3[2], v3[3]);
                    *(u32x4*)((unsigned char*)o + (t0 + 16 * nt + l15) * 1024 + 64 * h + 16 * g) = w4; }
                else {
#pragma unroll
                    for (int d2 = 0; d2 < 4; d2 += 2) { const f32x4 v0 = oacc[d2][nt] * inv, v1 = oacc[d2 + 1][nt] * inv;
                        u32x4 w; w.x = cvt_pk_bf16(v0[0], v0[1]); w.y = cvt_pk_bf16(v0[2], v0[3]); w.z = cvt_pk_bf16(v1[0], v1[1]); w.w = cvt_pk_bf16(v1[2], v1[3]);
                        *(u32x4*)(o + (t0 + 16 * nt + l15) * 1024 + 64 * h + 16 * g + 4 * d2) = w; } }
            }
        }
    }
    for (; it_ < n_it; ++it_) { if (per_it) for (int ly = 0; ly < NLY; ++ly) bg_convert(in, ws, MOE_PRO_LAYERS + ly, it_ * per_ly, per_ly, gw_, NGW_, lane); }
}
#define NPH_ATT 3
#define LAYER_ATT() do { \
        { pg8::Gemm g{IFP8_ATT ? (const bf16_t*)(ws + WS_H8) : hbuf, (const bf16_t*)(ws + WS_W_ATT_IN), T, 3072, IFP8_ATT ? 512 : 1024}; pg8::EpiBf16S E{proj, 3072, 4, 0.125f * 1.4426950408889634f, IFP8_ATT ? 0.03125f : 1.0f};       \
          RUN_PHASE_DUP(REP_INPROJ, { pg8::StaticOrder S; S.init(T, 3072, F.G, F.bid); pg8::gemm_phase<pg8::EpiBf16S, pg8::StaticOrder, false, (IFP8_ATT != 0)>(F.lds, g, S, E); }); } \
        RUN_PHASE_N(REP_ATT, attn_phase(F, proj, in[11], amix, in, ws)); \
        OUTPROJ(1, WS_W_ATT_OUT, 1024); \
    } while (0)
__device__ __forceinline__ void gla_s1_phase(Frame& F, const bf16_t* proj, const float* glow, const float* wgate, const float* bgate,
                                             bf16_t* PT, bf16_t* KT, bf16_t* VT, bf16_t* QS, float* REC) {
    constexpr int LDQ = 272, LDV = 528, LDP = 144;
    LAS float* Bc = (LAS float*)F.lds;
    LAS float* Gl = (LAS float*)(F.lds + 32768);
    LAS float* Wg = (LAS float*)(F.lds + 36864);
    LAS unsigned char* Qi = F.lds + 45056;
    LAS unsigned char* Ki = F.lds + 45056 + 17408;
    LAS unsigned char* Kst = F.lds + 45056 + 2 * 17408;
    LAS unsigned char* Vs = F.lds + 45056 + 3 * 17408;
    LAS unsigned char* Ps = F.lds + 45056 + 3 * 17408 + 33792;
    const int lane = F.lane, l15 = lane & 15, g = lane >> 4, w = F.wave, lt = w >> 1, mh = w & 1;
    float glr[2], wgr[4], bgr = 0.f; u32x4 qrr[2], krr[2];
#define GS1_LOAD(uu) do { const int c_ = (uu) % NCHUNK, h_ = ((uu) / NCHUNK) % 4, b_ = (uu) / (NCHUNK * 4); const size_t t0_ = (size_t)b_ * SEQ + (size_t)c_ * 64; \
        _Pragma("unroll") for (int i = 0; i < 2; ++i) glr[i] = glow[t0_ * 16 + F.tid + NTHR * i]; \
        _Pragma("unroll") for (int i = 0; i < 4; ++i) { const int x_ = F.tid + NTHR * i; wgr[i] = wgate[(size_t)(x_ >> 7) * 512 + 128 * h_ + (x_ & 127)]; } \
        bgr = bgate[128 * h_ + (F.tid & 127)]; \
        _Pragma("unroll") for (int i = 0; i < 2; ++i) { const int p_ = F.tid + NTHR * i, l_ = p_ >> 4, q8_ = p_ & 15; \
            qrr[i] = *(const u32x4*)(proj + (t0_ + l_) * 3072 + 128 * h_ + 8 * q8_); krr[i] = *(const u32x4*)(proj + (t0_ + l_) * 3072 + 512 + 128 * h_ + 8 * q8_); } } while (0)
    if (F.bid < NB * 4 * NCHUNK) GS1_LOAD(F.bid);
    for (int u = F.bid; u < NB * 4 * NCHUNK; u += F.G) {
        const int c = u % NCHUNK, h = (u / NCHUNK) % 4, b = u / (NCHUNK * 4);
        const size_t t0 = (size_t)b * SEQ + (size_t)c * 64;
#pragma unroll
        for (int i = 0; i < 2; ++i) Gl[F.tid + NTHR * i] = glr[i];
#pragma unroll
        for (int i = 0; i < 4; ++i) Wg[F.tid + NTHR * i] = wgr[i];
        const float bg_cur = bgr; const u32x4 qc[2] = {qrr[0], qrr[1]}, kc[2] = {krr[0], krr[1]};
        if (u + F.G < NB * 4 * NCHUNK) GS1_LOAD(u + F.G);
        WG_SYNC_LDS();
        { const int d = F.tid & 127; const float bg = bg_cur;
          float wg[16];
#pragma unroll
          for (int k = 0; k < 16; ++k) wg[k] = Wg[k * 128 + d];
          for (int i = 0; i < 16; ++i) { const int l = (F.tid >> 7) + 4 * i; float z = bg;
#pragma unroll
              for (int k = 0; k < 16; ++k) z += Gl[l * 16 + k] * wg[k];
              Bc[l * 128 + d] = logsigmoidf_(z) * (1.0f / 16.0f); } }
        WG_SYNC_LDS();
        if (F.tid < 128) { float a = 0.f; for (int l = 0; l < 64; ++l) { a += Bc[l * 128 + F.tid]; Bc[l * 128 + F.tid] = a; } REC[(size_t)u * 128 + F.tid] = __expf(a); }
        WG_SYNC_LDS();
#pragma unroll
        for (int pi = 0; pi < 2; ++pi) { const int p = F.tid + NTHR * pi;
            const int l = p >> 4, q8 = p & 15;
            const u32x4 qr = qc[pi], kr = kc[pi];
            const float qv[8] = {bflo(qr.x), bfhi(qr.x), bflo(qr.y), bfhi(qr.y), bflo(qr.z), bfhi(qr.z), bflo(qr.w), bfhi(qr.w)};
            const float kv[8] = {bflo(kr.x), bfhi(kr.x), bflo(kr.y), bfhi(kr.y), bflo(kr.z), bfhi(kr.z), bflo(kr.w), bfhi(kr.w)};
            float qi[8], ki[8], ks[8];
#pragma unroll
            for (int j = 0; j < 8; ++j) { const float bb = Bc[l * 128 + 8 * q8 + j], bl = Bc[63 * 128 + 8 * q8 + j];
                qi[j] = qv[j] * __expf(bb); ki[j] = kv[j] * __expf(-bb); ks[j] = kv[j] * __expf(bl - bb); }
            u32x4 o; o.x = pk2(qi[0], qi[1]); o.y = pk2(qi[2], qi[3]); o.z = pk2(qi[4], qi[5]); o.w = pk2(qi[6], qi[7]);
            *(LAS u32x4*)(Qi + l * LDQ + 16 * q8) = o; *(u32x4*)(QS + (t0 + l) * 512 + 128 * h + 8 * q8) = o;
            o.x = pk2(ki[0], ki[1]); o.y = pk2(ki[2], ki[3]); o.z = pk2(ki[4], ki[5]); o.w = pk2(ki[6], ki[7]);
            *(LAS u32x4*)(Ki + l * LDQ + 16 * q8) = o;
            o.x = pk2(ks[0], ks[1]); o.y = pk2(ks[2], ks[3]); o.z = pk2(ks[4], ks[5]); o.w = pk2(ks[6], ks[7]);
            *(LAS u32x4*)(Kst + l * LDQ + 16 * q8) = o;
        }
        WG_SYNC_LDS();
        f32x4 acc[2];
#pragma unroll
        for (int nt = 0; nt < 2; ++nt) { acc[nt] = (f32x4){0.f, 0.f, 0.f, 0.f};
#pragma unroll
            for (int ks = 0; ks < 4; ++ks) { const bf16x8 qf = *(const LAS bf16x8*)(Qi + (16 * lt + l15) * LDQ + 64 * ks + 16 * g);
                const bf16x8 kf = *(const LAS bf16x8*)(Ki + (32 * mh + 16 * nt + l15) * LDQ + 64 * ks + 16 * g);
                acc[nt] = __builtin_amdgcn_mfma_f32_16x16x32_bf16(qf, kf, acc[nt], 0, 0, 0); } }
#pragma unroll
        for (int nt = 0; nt < 2; ++nt)
#pragma unroll
            for (int r = 0; r < 4; ++r) { const int l = 16 * lt + 4 * g + r, m = 32 * mh + 16 * nt + l15;
                *(LAS unsigned short*)(Ps + l * LDP + 2 * m) = (unsigned short)f2bf(m <= l ? acc[nt][r] : 0.f); }
        WG_SYNC_LDS();
        { const int r = F.tid >> 3, q = F.tid & 7; *(u32x4*)(PT + (size_t)u * 4096 + r * 64 + 8 * q) = *(const LAS u32x4*)(Ps + r * LDP + 16 * q); }
        s1_write_kt_tr<128>(Kst, LDQ, KT + (size_t)u * 128 * 64, F.wave, lane);
        WG_SYNC_LDS();
    }
#undef GS1_LOAD
}

__device__ __forceinline__ void gla_s2_phase(Frame& F, const bf16_t* QS, const bf16_t* PT, const bf16_t* KT, const bf16_t* VT, const float* REC, bf16_t* mix) {
    constexpr int LDS_ST = 272, LDV = 144, LDO = 80;
    LAS unsigned char* ST = F.lds;
    LAS unsigned char* VTs = F.lds + 8704;
    LAS unsigned char* Os = F.lds + 8704 + 9216;
    const int lane = F.lane, l15 = lane & 15, g = lane >> 4, w = F.wave, lt = w >> 1, eh = w & 1;
    for (int u = F.bid; u < NB * 4 * 8; u += F.G) {
        const int eb = u & 7, h = (u >> 3) & 3, b = u >> 5;
        f32x4 S[2];
#pragma unroll
        for (int nt = 0; nt < 2; ++nt) S[nt] = (f32x4){0.f, 0.f, 0.f, 0.f};
        for (int i = F.tid; i < 8704 / 4; i += NTHR) ((LAS unsigned*)ST)[i] = 0u;
        for (int c = 0; c < NCHUNK; ++c) {
            const size_t t0 = (size_t)b * SEQ + (size_t)c * 64;
            const size_t uidx = ((size_t)(b * 4 + h)) * NCHUNK + c;
            LAS unsigned char* vt = VTs + (c & 1) * 4608;
            bf16x8 kf[2], qf[4], pf[2];
#pragma unroll
            for (int ks = 0; ks < 2; ++ks) kf[ks] = *(const bf16x8*)(KT + uidx * (128 * 64) + (((w * 2 + ks) * 64 + lane) << 3));
#pragma unroll
            for (int ks = 0; ks < 4; ++ks) qf[ks] = *(const bf16x8*)(QS + (t0 + 16 * lt + l15) * 512 + 128 * h + 32 * ks + 8 * g);
#pragma unroll
            for (int ks = 0; ks < 2; ++ks) pf[ks] = *(const bf16x8*)(PT + uidx * 4096 + (16 * lt + l15) * 64 + 32 * ks + 8 * g);
            f32x4 dec;
#pragma unroll
            for (int r = 0; r < 4; ++r) dec[r] = REC[uidx * 128 + 16 * w + 4 * g + r];
            if (F.tid < 256) { const int e = F.tid >> 3, q = F.tid & 7;
                *(LAS u32x4*)(vt + e * LDV + 16 * q) = *(const u32x4*)(VT + uidx * (256 * 64) + (size_t)(32 * eb + e) * 64 + 8 * q); }
            LDS_WAIT();
            __syncthreads();
            f32x4 oo = (f32x4){0.f, 0.f, 0.f, 0.f};
            { const int e = 16 * eh + l15;
#pragma unroll
              for (int ks = 0; ks < 2; ++ks) { const bf16x8 vf = *(const LAS bf16x8*)(vt + e * LDV + 64 * ks + 16 * g);
                  oo = __builtin_amdgcn_mfma_f32_16x16x32_bf16(pf[ks], vf, oo, 0, 0, 0); }
#pragma unroll
              for (int ks = 0; ks < 4; ++ks) { const bf16x8 sf = *(const LAS bf16x8*)(ST + e * LDS_ST + 64 * ks + 16 * g);
                  oo = __builtin_amdgcn_mfma_f32_16x16x32_bf16(qf[ks], sf, oo, 0, 0, 0); } }
#pragma unroll
            for (int r = 0; r < 4; ++r) *(LAS unsigned short*)(Os + (16 * lt + 4 * g + r) * LDO + 2 * (16 * eh + l15)) = (unsigned short)f2bf(oo[r]);
            LDS_WAIT();
            __syncthreads();
            if (F.tid < 256) { const int r = F.tid >> 2, q = F.tid & 3; *(u32x4*)(mix + (t0 + r) * 1024 + 256 * h + 32 * eb + 8 * q) = *(const LAS u32x4*)(Os + r * LDO + 16 * q); }
#pragma unroll
            for (int nt = 0; nt < 2; ++nt) { S[nt] = S[nt] * dec;
#pragma unroll
                for (int ks = 0; ks < 2; ++ks) { const bf16x8 vf = *(const LAS bf16x8*)(vt + (16 * nt + l15) * LDV + 64 * ks + 16 * g);
                    S[nt] = __builtin_amdgcn_mfma_f32_16x16x32_bf16(kf[ks], vf, S[nt], 0, 0, 0); }
                u32x2 o; o.x = pk2(S[nt][0], S[nt][1]); o.y = pk2(S[nt][2], S[nt][3]);
                *(LAS u32x2*)(ST + (16 * nt + l15) * LDS_ST + 2 * (16 * w + 4 * g)) = o; }
        }
        LDS_WAIT();
        __syncthreads();
    }
}

__device__ __forceinline__ void gla_norm_phase(Frame& F, const bf16_t* mix, const bf16_t* proj, const float* gn, bf16_t* amix) {
    const int gw = F.bid * NWAVES + F.wave, NGW = F.G * NWAVES, lane = F.lane;
    for (int i = gw; i < T * 4; i += NGW) {
        const int t = i >> 2, h = i & 3;
        const u32x2 raw = *(const u32x2*)(mix + (size_t)t * 1024 + 256 * h + 4 * lane);
        const u32x2 rr = *(const u32x2*)(proj + (size_t)t * 3072 + 2048 + 256 * h + 4 * lane);
        const float v[4] = {bflo(raw.x), bfhi(raw.x), bflo(raw.y), bfhi(raw.y)};
        const float rv[4] = {bflo(rr.x), bfhi(rr.x), bflo(rr.y), bfhi(rr.y)};
        float q = 0.f;
#pragma unroll
        for (int j = 0; j < 4; ++j) q += v[j] * v[j];
        const float rstd = rsqrtf(wave_sum(q) * (1.0f / 256.0f) + EPS);
        const f32x4 g0 = *(const f32x4*)(gn + 256 * h + 4 * lane);
        const float gg[4] = {g0.x, g0.y, g0.z, g0.w};
        float o[4];
#pragma unroll
        for (int j = 0; j < 4; ++j) o[j] = v[j] * rstd * gg[j] * siluf_(rv[j]);
        u32x2 ow; ow.x = pk2(o[0], o[1]); ow.y = pk2(o[2], o[3]);
        *(u32x2*)(amix + (size_t)t * 1024 + 256 * h + 4 * lane) = ow;
    }
}
#define NPH_GLA 5
#define LAYER_GLA() do { \
        { pg8::Gemm g{IFP8_GLA ? (const bf16_t*)(ws + WS_H8) : hbuf, (const bf16_t*)(ws + WS_W_GLA_IN), T, GFP8_GLA ? 2048 : 3072, IFP8_GLA ? 512 : 1024}; pg8::EpiBf16S E{proj, 3072, 2, 0.08838834764831845f, IFP8_GLA ? 0.03125f : 1.0f}; \
          pg8::Gemm g2{(const bf16_t*)(ws + WS_H8), (const bf16_t*)(ws + WS_W_GLA_IN + 4 * MiB), T, 1024, 512}; pg8::EpiBf16S E2{proj + 2048, 3072, 0, 1.0f, 0.03125f}; \
          RUN_PHASE({ pg8::StaticOrder S; S.init(T, GFP8_GLA ? 2048 : 3072, F.G, F.bid); pg8::gemm_phase<pg8::EpiBf16S, pg8::StaticOrder, false, (IFP8_GLA != 0)>(F.lds, g, S, E); \
            if (GFP8_GLA) { pg8::StaticOrder S2; S2.init(T, 1024, F.G, F.bid); pg8::gemm_phase<pg8::EpiBf16S, pg8::StaticOrder, false, true>(F.lds, g2, S2, E2); } }); } \
        RUN_PHASE_N(REP_S1, gla_s1_phase(F, proj, (const float*)(ws + WS_GLOW), in[14], in[15], (bf16_t*)(ws + WS_PT), (bf16_t*)(ws + WS_KT), (bf16_t*)(ws + WS_VT), (bf16_t*)(ws + WS_QS), (float*)(ws + WS_REC))); \
        RUN_PHASE_N(REP_S2, { if (S2X) s2x_phase<1>(F, (const bf16_t*)(ws + WS_QS), (const bf16_t*)(ws + WS_PT), (const bf16_t*)(ws + WS_KT), proj + 1024, (const float*)(ws + WS_REC), (bf16_t*)(ws + WS_MIX)); else s2_phase<1>(F, (const bf16_t*)(ws + WS_QS), (const bf16_t*)(ws + WS_PT), (const bf16_t*)(ws + WS_KT), proj + 1024, (const float*)(ws + WS_REC), (bf16_t*)(ws + WS_MIX), in, ws, -1); }); \
        RUN_PHASE_N(REP_HN, hn_phase<1>(F, (const bf16_t*)(ws + WS_MIX), proj, nullptr, in[16], nullptr, amix)); \
        OUTPROJ(2, WS_W_GLA_OUT, 1024); \
    } while (0)
__device__ __forceinline__ void mls_pre_phase(Frame& F, const bf16_t* proj, const float* conv_w, const float* conv_b, const float* w_q, const float* w_k, const float* w_v,
                                              const bf16_t* wmg, const float* b_gates, bf16_t* MQ, bf16_t* MK, bf16_t* MV, bf16_t* MXC, float* GATES) {
    LAS float* red = (LAS float*)F.lds;
    const int n = F.tid, lane = F.lane, l15 = lane & 15, g = lane >> 4, w = F.wave;
    f32x2 cw2[4][2], cb2[2], wq2[4][2], wk2[4][2], wv2[4][2];
#pragma unroll
    for (int j = 0; j < 4; ++j) { const f32x4 t4 = *(const f32x4*)(conv_w + (size_t)j * 2048 + 4 * n); cw2[j][0] = (f32x2){t4.x, t4.y}; cw2[j][1] = (f32x2){t4.z, t4.w}; }
    { const f32x4 t4 = *(const f32x4*)(conv_b + 4 * n); cb2[0] = (f32x2){t4.x, t4.y}; cb2[1] = (f32x2){t4.z, t4.w}; }
    const float kscale = 0.044194173824159216f;
#pragma unroll
    for (int c4 = 0; c4 < 4; ++c4) { const f32x4 a = *(const f32x4*)(w_q + (size_t)n * 16 + 4 * c4), bb = *(const f32x4*)(w_k + (size_t)n * 16 + 4 * c4), cc = *(const f32x4*)(w_v + (size_t)n * 16 + 4 * c4);
        wq2[c4][0] = (f32x2){a.x, a.y}; wq2[c4][1] = (f32x2){a.z, a.w};
        wk2[c4][0] = (f32x2){bb.x, bb.y} * kscale; wk2[c4][1] = (f32x2){bb.z, bb.w} * kscale;
        wv2[c4][0] = (f32x2){cc.x, cc.y}; wv2[c4][1] = (f32x2){cc.z, cc.w}; }
    for (int u = F.bid; u < NB * NCHUNK; u += F.G) {
        const int b = u / NCHUNK, c = u % NCHUNK;
        const size_t t0 = (size_t)b * SEQ + (size_t)c * 64;
        f32x2 x3[2], x2[2], x1[2];
        if (c > 0) {
            const u32x2 r3 = *(const u32x2*)(proj + (t0 - 3) * 4096 + 4 * n), r2 = *(const u32x2*)(proj + (t0 - 2) * 4096 + 4 * n), r1 = *(const u32x2*)(proj + (t0 - 1) * 4096 + 4 * n);
            x3[0] = (f32x2){bflo(r3.x), bfhi(r3.x)}; x3[1] = (f32x2){bflo(r3.y), bfhi(r3.y)};
            x2[0] = (f32x2){bflo(r2.x), bfhi(r2.x)}; x2[1] = (f32x2){bflo(r2.y), bfhi(r2.y)};
            x1[0] = (f32x2){bflo(r1.x), bfhi(r1.x)}; x1[1] = (f32x2){bflo(r1.y), bfhi(r1.y)};
        } else {
#pragma unroll
            for (int p = 0; p < 2; ++p) { x3[p] = (f32x2){0.f, 0.f}; x2[p] = x3[p]; x1[p] = x3[p]; }
        }
        for (int l0 = 0; l0 < 64; l0 += 8) {
            u32x2 xr[8];
#pragma unroll
            for (int j = 0; j < 8; ++j) xr[j] = *(const u32x2*)(proj + (t0 + l0 + j) * 4096 + 4 * n);
#pragma unroll
            for (int j = 0; j < 8; ++j) {
                const f32x2 x0[2] = {(f32x2){bflo(xr[j].x), bfhi(xr[j].x)}, (f32x2){bflo(xr[j].y), bfhi(xr[j].y)}};
                f32x2 xc[2];
#pragma unroll
                for (int p = 0; p < 2; ++p) { const f32x2 cv = cb2[p] + cw2[0][p] * x3[p] + cw2[1][p] * x2[p] + cw2[2][p] * x1[p] + cw2[3][p] * x0[p];
                    xc[p] = (f32x2){siluf_(cv.x), siluf_(cv.y)}; }
                const float xcs[4] = {xc[0].x, xc[0].y, xc[1].x, xc[1].y}, x0s[4] = {x0[0].x, x0[0].y, x0[1].x, x0[1].y};
                f32x2 q[2], k[2], v[2];
#pragma unroll
                for (int p = 0; p < 2; ++p) {
                    q[p] = wq2[0][p] * xcs[0] + wq2[1][p] * xcs[1] + wq2[2][p] * xcs[2] + wq2[3][p] * xcs[3];
                    k[p] = wk2[0][p] * xcs[0] + wk2[1][p] * xcs[1] + wk2[2][p] * xcs[2] + wk2[3][p] * xcs[3];
                    v[p] = wv2[0][p] * x0s[0] + wv2[1][p] * x0s[1] + wv2[2][p] * x0s[2] + wv2[3][p] * x0s[3];
                }
                const size_t o = (t0 + l0 + j) * 2048 + 4 * n;
                u32x2 pq; pq.x = pk2(q[0].x, q[0].y); pq.y = pk2(q[1].x, q[1].y); *(u32x2*)(MQ + o) = pq;
                pq.x = pk2(k[0].x, k[0].y); pq.y = pk2(k[1].x, k[1].y); *(u32x2*)(MK + o) = pq;
                pq.x = pk2(v[0].x, v[0].y); pq.y = pk2(v[1].x, v[1].y); *(u32x2*)(MV + o) = pq;
                pq.x = pk2(xc[0].x, xc[0].y); pq.y = pk2(xc[1].x, xc[1].y); *(u32x2*)(MXC + o) = pq;
#pragma unroll
                for (int p = 0; p < 2; ++p) { x3[p] = x2[p]; x2[p] = x1[p]; x1[p] = x0[p]; }
            }
        }
        VM_WAIT();
        __syncthreads();
        f32x4 acc[4];
#pragma unroll
        for (int mt = 0; mt < 4; ++mt) acc[mt] = (f32x4){0.f, 0.f, 0.f, 0.f};
        for (int ks0 = 0; ks0 < 24; ks0 += 4) {
            bf16x8 bh[4], bl[4], af[4][4];
#pragma unroll
            for (int u4 = 0; u4 < 4; ++u4) {
                const int kk = 768 * w + 32 * (ks0 + u4), buf = kk >> 11, col = kk & 2047;
                const bf16_t* src = buf == 0 ? MQ : (buf == 1 ? MK : MV);
                bh[u4] = *(const bf16x8*)(wmg + (size_t)l15 * 6144 + kk + 8 * g);
                bl[u4] = *(const bf16x8*)(wmg + (size_t)(16 + l15) * 6144 + kk + 8 * g);
#pragma unroll
                for (int mt = 0; mt < 4; ++mt) af[u4][mt] = *(const bf16x8*)(src + (t0 + 16 * mt + l15) * 2048 + col + 8 * g);
            }
#pragma unroll
            for (int u4 = 0; u4 < 4; ++u4)
#pragma unroll
                for (int mt = 0; mt < 4; ++mt) {
                    acc[mt] = __builtin_amdgcn_mfma_f32_16x16x32_bf16(af[u4][mt], bh[u4], acc[mt], 0, 0, 0);
                    acc[mt] = __builtin_amdgcn_mfma_f32_16x16x32_bf16(af[u4][mt], bl[u4], acc[mt], 0, 0, 0); }
        }
#pragma unroll
        for (int mt = 0; mt < 4; ++mt)
#pragma unroll
            for (int r = 0; r < 4; ++r) red[(w * 64 + 16 * mt + 4 * g + r) * 16 + l15] = acc[mt][r];
        LDS_WAIT();
        __syncthreads();
        { const int tok = F.tid >> 3, j = F.tid & 7; float s = b_gates[j];
#pragma unroll
          for (int ww = 0; ww < 8; ++ww) s += red[(ww * 64 + tok) * 16 + j];
          GATES[(t0 + tok) * 8 + j] = (j < 4) ? s : logsigmoidf_(s); }
        LDS_WAIT();
        __syncthreads();
    }
}

__device__ __forceinline__ void mls_s1_phase(Frame& F, const bf16_t* MQ, const bf16_t* MK, const bf16_t* MV, const float* GATES, bf16_t* PT, bf16_t* KT, bf16_t* VT, float* REC) {
    constexpr int LDK = 1040, LDP = 144;
    LAS unsigned char* Ks = F.lds;
    LAS unsigned char* Vs = F.lds + 66560;
    LAS unsigned char* Ps = F.lds + 133120;
    const int lane = F.lane, l15 = lane & 15, g = lane >> 4, w = F.wave, lt = w >> 1, mh = w & 1;
    u32x4 kr[8]; bf16x8 qf[16]; float g_f = 0.f, g_i = 0.f;
#define MS1_LOAD(uu) do { const int c_ = (uu) % NCHUNK, h_ = ((uu) / NCHUNK) % 4, b_ = (uu) / (NCHUNK * 4); const size_t t0_ = (size_t)b_ * SEQ + (size_t)c_ * 64; \
        s1_gload<512>(MK + t0_ * 2048 + 512 * h_, 2048, kr, F.tid); \
        if (w == 0) { g_f = GATES[(t0_ + lane) * 8 + 4 + h_]; g_i = GATES[(t0_ + lane) * 8 + h_]; } \
        _Pragma("unroll") for (int ks = 0; ks < 16; ++ks) qf[ks] = *(const bf16x8*)(MQ + (t0_ + 16 * lt + l15) * 2048 + 512 * h_ + 32 * ks + 8 * g); } while (0)
    if (F.bid < NB * 4 * NCHUNK) MS1_LOAD(F.bid);
    for (int u = F.bid; u < NB * 4 * NCHUNK; u += F.G) {
        const int c = u % NCHUNK, h = (u / NCHUNK) % 4, b = u / (NCHUNK * 4);
        const size_t t0 = (size_t)b * SEQ + (size_t)c * 64;
        s1_lstore<512>(kr, Ks, LDK, F.tid);
        if (w == 0) {
            float bsum = g_f;
#pragma unroll
            for (int o = 1; o < 64; o <<= 1) { const float t = __shfl_up(bsum, o); if (lane >= o) bsum += t; }
            const float z = g_i - bsum;
            float a = z;
#pragma unroll
            for (int o = 1; o < 64; o <<= 1) { const float t = __shfl_up(a, o); if (lane >= o) a = fmaxf(a, t); }
            REC[(size_t)u * 192 + lane] = bsum; REC[(size_t)u * 192 + 64 + lane] = z; REC[(size_t)u * 192 + 128 + lane] = a;
        }
        WG_SYNC_LDS();
        f32x4 acc[2];
#pragma unroll
        for (int nt = 0; nt < 2; ++nt) acc[nt] = (f32x4){0.f, 0.f, 0.f, 0.f};
#pragma unroll
        for (int ks = 0; ks < 16; ++ks) {
#pragma unroll
            for (int nt = 0; nt < 2; ++nt) { const bf16x8 kf = *(const LAS bf16x8*)(Ks + (size_t)(32 * mh + 16 * nt + l15) * LDK + 64 * ks + 16 * g);
                acc[nt] = __builtin_amdgcn_mfma_f32_16x16x32_bf16(qf[ks], kf, acc[nt], 0, 0, 0); }
        }
#pragma unroll
        for (int nt = 0; nt < 2; ++nt)
#pragma unroll
            for (int r = 0; r < 4; ++r) { const int l = 16 * lt + 4 * g + r, m = 32 * mh + 16 * nt + l15;
                *(LAS unsigned short*)(Ps + l * LDP + 2 * m) = (unsigned short)f2bf(m <= l ? acc[nt][r] : 0.f); }
        { const int un = u + F.G; if (un < NB * 4 * NCHUNK) MS1_LOAD(un); }
        WG_SYNC_LDS();
        { const int r = F.tid >> 3, q = F.tid & 7; *(u32x4*)(PT + (size_t)u * 4096 + r * 64 + 8 * q) = *(const LAS u32x4*)(Ps + r * LDP + 16 * q); }
        s1_write_kt_tr<512>(Ks, LDK, KT + (size_t)u * 512 * 64, F.wave, lane);
        WG_SYNC_LDS();
    }
#undef MS1_LOAD
}

__device__ __forceinline__ void mls_s2_phase(Frame& F, const bf16_t* MQ, const bf16_t* PT, const bf16_t* KT, const bf16_t* VT, const float* REC, bf16_t* mix) {
    constexpr int LDS_ST = 1040, LDV = 144, LDO = 144;
    LAS unsigned char* ST = F.lds;
    LAS unsigned char* VTs = F.lds + 83200;
    LAS unsigned char* Os = F.lds + 83200 + 23040;
    LAS float* QN = (LAS float*)(F.lds + 83200 + 23040 + 9216);
    LAS float* RS = QN + 64;
    const int lane = F.lane, l15 = lane & 15, g = lane >> 4, w = F.wave, lt = w >> 1, eh = w & 1;
    for (int u = F.bid; u < NB * 4 * 8; u += F.G) {
        const int eb = u & 7, h = (u >> 3) & 3, b = u >> 5;
        f32x4 S[4][5];
#pragma unroll
        for (int mt = 0; mt < 4; ++mt)
#pragma unroll
            for (int nt = 0; nt < 5; ++nt) S[mt][nt] = (f32x4){0.f, 0.f, 0.f, 0.f};
        for (int i = F.tid; i < 83200 / 4; i += NTHR) ((LAS unsigned*)ST)[i] = 0u;
        float m_prev = 0.f;
        for (int c = 0; c < NCHUNK; ++c) {
            const size_t t0 = (size_t)b * SEQ + (size_t)c * 64;
            const size_t uidx = ((size_t)(b * 4 + h)) * NCHUNK + c;
            const float* rec = REC + uidx * 192;
            LAS unsigned char* vt = VTs + (c & 1) * 11520;
            const float Amax = rec[128 + 63], blast = rec[63];
            const float Mx = fmaxf(m_prev, Amax), keep = __expf(m_prev - Mx);
            {
                const int e = F.tid >> 3, q = F.tid & 7;
                const f32x4 z0 = *(const f32x4*)(rec + 64 + 8 * q), z1 = *(const f32x4*)(rec + 64 + 8 * q + 4);
                const float wm[8] = {__expf(z0.x - Mx), __expf(z0.y - Mx), __expf(z0.z - Mx), __expf(z0.w - Mx), __expf(z1.x - Mx), __expf(z1.y - Mx), __expf(z1.z - Mx), __expf(z1.w - Mx)};
                const u32x4 raw = *(const u32x4*)(VT + uidx * (512 * 64) + (size_t)(64 * eb + e) * 64 + 8 * q);
                const float f[8] = {bflo(raw.x) * wm[0], bfhi(raw.x) * wm[1], bflo(raw.y) * wm[2], bfhi(raw.y) * wm[3], bflo(raw.z) * wm[4], bfhi(raw.z) * wm[5], bflo(raw.w) * wm[6], bfhi(raw.w) * wm[7]};
                u32x4 o; o.x = pk2(f[0], f[1]); o.y = pk2(f[2], f[3]); o.z = pk2(f[4], f[5]); o.w = pk2(f[6], f[7]);
                *(LAS u32x4*)(vt + e * LDV + 16 * q) = o;
                if (F.tid < 128) { u32x4 o2 = (u32x4){0u, 0u, 0u, 0u};
                    if (e == 0) { o2.x = pk2(wm[0], wm[1]); o2.y = pk2(wm[2], wm[3]); o2.z = pk2(wm[4], wm[5]); o2.w = pk2(wm[6], wm[7]); }
                    *(LAS u32x4*)(vt + (64 + e) * LDV + 16 * q) = o2; }
            }
            bf16x8 pf[2];
#pragma unroll
            for (int ks = 0; ks < 2; ++ks) pf[ks] = *(const bf16x8*)(PT + uidx * 4096 + (16 * lt + l15) * 64 + 32 * ks + 8 * g);
            LDS_WAIT();
            __syncthreads();
            if (c > 0) { const int r = F.tid >> 3, q = F.tid & 7; *(u32x4*)(mix + (t0 - 64 + r) * 2048 + 512 * h + 64 * eb + 8 * q) = *(const LAS u32x4*)(Os + r * LDO + 16 * q); }
            f32x4 oi[3], oo[3];
#pragma unroll
            for (int j = 0; j < 3; ++j) { oi[j] = (f32x4){0.f, 0.f, 0.f, 0.f}; oo[j] = (f32x4){0.f, 0.f, 0.f, 0.f}; }
#pragma unroll
            for (int j = 0; j < 3; ++j) { const int nt = eh + 2 * j;
                if (nt < 5) {
#pragma unroll
                    for (int ks = 0; ks < 2; ++ks) { const bf16x8 vf = *(const LAS bf16x8*)(vt + (16 * nt + l15) * LDV + 64 * ks + 16 * g);
                        oi[j] = __builtin_amdgcn_mfma_f32_16x16x32_bf16(pf[ks], vf, oi[j], 0, 0, 0); } } }
#pragma unroll 4
            for (int ks = 0; ks < 16; ++ks) {
                const bf16x8 qf = *(const bf16x8*)(MQ + (t0 + 16 * lt + l15) * 2048 + 512 * h + 32 * ks + 8 * g);
#pragma unroll
                for (int j = 0; j < 3; ++j) { const int nt = eh + 2 * j;
                    if (nt < 5) { const bf16x8 sf = *(const LAS bf16x8*)(ST + (16 * nt + l15) * LDS_ST + 64 * ks + 16 * g);
                        oo[j] = __builtin_amdgcn_mfma_f32_16x16x32_bf16(qf, sf, oo[j], 0, 0, 0); } }
            }
            if (eh == 0 && l15 == 0) {
#pragma unroll
                for (int r = 0; r < 4; ++r) { QN[16 * lt + 4 * g + r] = oo[2][r]; RS[16 * lt + 4 * g + r] = oi[2][r]; }
            }
            LDS_WAIT();
            __syncthreads();
#pragma unroll
            for (int r = 0; r < 4; ++r) { const int l = 16 * lt + 4 * g + r;
                const float bl = rec[l], al = rec[128 + l];
                const float Ml = fmaxf(m_prev, al), rho = __expf(Mx - Ml), wi = __expf(m_prev - Ml);
                const float den = wi * QN[l] + rho * RS[l];
                const float dn = fmaxf(fabsf(den), __expf(-(bl + Ml)));
                const float inv = 1.0f / dn;
#pragma unroll
                for (int j = 0; j < 2; ++j) { const int nt = eh + 2 * j;
                    *(LAS unsigned short*)(Os + l * LDO + 2 * (16 * nt + l15)) = (unsigned short)f2bf((wi * oo[j][r] + rho * oi[j][r]) * inv); } }
            bf16x8 kf[4][2];
#pragma unroll
            for (int mt = 0; mt < 4; ++mt)
#pragma unroll
                for (int ks = 0; ks < 2; ++ks) kf[mt][ks] = *(const bf16x8*)(KT + uidx * (512 * 64) + ((((4 * w + mt) * 2 + ks) * 64 + lane) << 3));
#pragma unroll
            for (int nt = 0; nt < 5; ++nt) {
                bf16x8 vf[2];
#pragma unroll
                for (int ks = 0; ks < 2; ++ks) vf[ks] = *(const LAS bf16x8*)(vt + (16 * nt + l15) * LDV + 64 * ks + 16 * g);
#pragma unroll
                for (int mt = 0; mt < 4; ++mt) { S[mt][nt] = S[mt][nt] * keep;
#pragma unroll
                    for (int ks = 0; ks < 2; ++ks) S[mt][nt] = __builtin_amdgcn_mfma_f32_16x16x32_bf16(kf[mt][ks], vf[ks], S[mt][nt], 0, 0, 0);
                    u32x2 o; o.x = pk2(S[mt][nt][0], S[mt][nt][1]); o.y = pk2(S[mt][nt][2], S[mt][nt][3]);
                    *(LAS u32x2*)(ST + (16 * nt + l15) * LDS_ST + 2 * (64 * w + 16 * mt + 4 * g)) = o; }
            }
            m_prev = blast + Mx;
        }
        LDS_WAIT();
        __syncthreads();
        { const size_t t0 = (size_t)b * SEQ + (size_t)(NCHUNK - 1) * 64; const int r = F.tid >> 3, q = F.tid & 7;
          *(u32x4*)(mix + (t0 + r) * 2048 + 512 * h + 64 * eb + 8 * q) = *(const LAS u32x4*)(Os + r * LDO + 16 * q); }
        LDS_WAIT();
        __syncthreads();
    }
}

__device__ __forceinline__ void mls_norm_phase(Frame& F, const bf16_t* mix, const bf16_t* proj, const bf16_t* MXC, const float* gn, const float* skip, bf16_t* amix) {
    const int gw = F.bid * NWAVES + F.wave, NGW = F.G * NWAVES, lane = F.lane;
    for (int i = gw; i < T * 4; i += NGW) {
        const int t = i >> 2, h = i & 3, ch = 512 * h + 8 * lane;
        const u32x4 raw = *(const u32x4*)(mix + (size_t)t * 2048 + ch);
        const u32x4 zr = *(const u32x4*)(proj + (size_t)t * 4096 + 2048 + ch);
        const u32x4 xr = *(const u32x4*)(MXC + (size_t)t * 2048 + ch);
        float v[8] = {bflo(raw.x), bfhi(raw.x), bflo(raw.y), bfhi(raw.y), bflo(raw.z), bfhi(raw.z), bflo(raw.w), bfhi(raw.w)};
        const float zv[8] = {bflo(zr.x), bfhi(zr.x), bflo(zr.y), bfhi(zr.y), bflo(zr.z), bfhi(zr.z), bflo(zr.w), bfhi(zr.w)};
        const float xv[8] = {bflo(xr.x), bfhi(xr.x), bflo(xr.y), bfhi(xr.y), bflo(xr.z), bfhi(xr.z), bflo(xr.w), bfhi(xr.w)};
        float s = 0.f;
#pragma unroll
        for (int j = 0; j < 8; ++j) s += v[j];
        const float mean = wave_sum(s) * (1.0f / 512.0f);
        float q = 0.f;
#pragma unroll
        for (int j = 0; j < 8; ++j) { v[j] -= mean; q += v[j] * v[j]; }
        const float rstd = rsqrtf(wave_sum(q) * (1.0f / 512.0f) + EPS);
        const f32x4 g0 = *(const f32x4*)(gn + ch), g1 = *(const f32x4*)(gn + ch + 4), s0 = *(const f32x4*)(skip + ch), s1 = *(const f32x4*)(skip + ch + 4);
        const float gg[8] = {g0.x, g0.y, g0.z, g0.w, g1.x, g1.y, g1.z, g1.w};
        const float sk[8] = {s0.x, s0.y, s0.z, s0.w, s1.x, s1.y, s1.z, s1.w};
        float o[8];
#pragma unroll
        for (int j = 0; j < 8; ++j) o[j] = (v[j] * rstd * gg[j] + sk[j] * xv[j]) * siluf_(zv[j]);
        u32x4 ow; ow.x = pk2(o[0], o[1]); ow.y = pk2(o[2], o[3]); ow.z = pk2(o[4], o[5]); ow.w = pk2(o[6], o[7]);
        *(u32x4*)(amix + (size_t)t * 2048 + ch) = ow;
    }
}
#define NPH_MLS 6
#define LAYER_MLS() do { \
        { pg8::Gemm g{IFP8_MLS ? (const bf16_t*)(ws + WS_H8) : hbuf, (const bf16_t*)(ws + WS_W_MLS_IN), T, GFP8_MLS ? 2048 : 4096, IFP8_MLS ? 512 : 1024}; pg8::EpiBf16S E{proj, 4096, 0, 1.0f, IFP8_MLS ? 0.03125f : 1.0f}; \
          pg8::Gemm g2{(const bf16_t*)(ws + WS_H8), (const bf16_t*)(ws + WS_W_MLS_IN + 4 * MiB), T, 2048, 512}; pg8::EpiBf16S E2{proj + 2048, 4096, 0, 1.0f, 0.03125f}; \
          RUN_PHASE({ pg8::StaticOrder S; S.init(T, GFP8_MLS ? 2048 : 4096, F.G, F.bid); pg8::gemm_phase<pg8::EpiBf16S, pg8::StaticOrder, false, (IFP8_MLS != 0)>(F.lds, g, S, E); \
            if (GFP8_MLS) { pg8::StaticOrder S2; S2.init(T, 2048, F.G, F.bid); pg8::gemm_phase<pg8::EpiBf16S, pg8::StaticOrder, false, true>(F.lds, g2, S2, E2); } }); } \
        RUN_PHASE_N(REP_PRE, mls_pre_phase(F, proj, in[19], in[20], in[21], in[22], in[23], (const bf16_t*)(ws + WS_WMG), in[25], (bf16_t*)(ws + WS_MQ), (bf16_t*)(ws + WS_MK), (bf16_t*)(ws + WS_MV), (bf16_t*)(ws + WS_MXC), (float*)(ws + WS_GATES))); \
        RUN_PHASE_N(REP_S1, mls_s1_phase(F, (const bf16_t*)(ws + WS_MQ), (const bf16_t*)(ws + WS_MK), (const bf16_t*)(ws + WS_MV), (const float*)(ws + WS_GATES), (bf16_t*)(ws + WS_PT), (bf16_t*)(ws + WS_KT), (bf16_t*)(ws + WS_VT), (float*)(ws + WS_REC))); \
        RUN_PHASE({ if (S2M) s2m_phase(F, (const bf16_t*)(ws + WS_MQ), (const bf16_t*)(ws + WS_PT), (const bf16_t*)(ws + WS_KT), (const bf16_t*)(ws + WS_MV), (const float*)(ws + WS_REC), (bf16_t*)(ws + WS_MIX)); else s2_phase<MLS_S2MODE>(F, (const bf16_t*)(ws + WS_MQ), (const bf16_t*)(ws + WS_PT), (const bf16_t*)(ws + WS_KT), (const bf16_t*)(ws + WS_MV), (const float*)(ws + WS_REC), (bf16_t*)(ws + WS_MIX)); \
            if (REP_S2M > 1) { VM_WAIT(); __syncthreads(); if (S2M) s2m_phase(F, (const bf16_t*)(ws + WS_MQ), (const bf16_t*)(ws + WS_PT), (const bf16_t*)(ws + WS_KT), (const bf16_t*)(ws + WS_MV), (const float*)(ws + WS_REC), (bf16_t*)(ws + WS_AMIX)); else s2_phase<2, S2_ABL>(F, (const bf16_t*)(ws + WS_MQ), (const bf16_t*)(ws + WS_PT), (const bf16_t*)(ws + WS_KT), (const bf16_t*)(ws + WS_MV), (const float*)(ws + WS_REC), (bf16_t*)(ws + WS_AMIX)); } }); \
        RUN_PHASE_N(REP_HN, hn_phase<2>(F, (const bf16_t*)(ws + WS_MIX), proj, (const bf16_t*)(ws + WS_MXC), in[26], in[27], amix)); \
        OUTPROJ(3, WS_W_MLS_OUT, 2048); \
    } while (0)
#ifndef N_LAUNCH_MODE
#define N_LAUNCH_MODE 0
#endif
struct Args { const float* in[35]; float* out; unsigned char* ws; int ph_lo, ph_hi; };

__global__ void __launch_bounds__(NTHR, 2) trunk_fwd(Args args) {
    extern __shared__ __attribute__((aligned(16))) unsigned char lds_raw[];
    Frame F;
    F.lds = (LAS unsigned char*)lds_raw;
    F.tid = threadIdx.x; F.lane = F.tid & 63; F.wave = __builtin_amdgcn_readfirstlane(F.tid >> 6);
    F.G = gridDim.x; F.bid = blockIdx.x;
    F.ws = args.ws; F.in = args.in; F.out = args.out; F.ctl = (unsigned*)(args.ws + WS_CTL);
    unsigned char* ws = args.ws; const float* const* in = args.in;
    const int lo = args.ph_lo, hi = args.ph_hi;
    volatile LAS unsigned* xbw = (volatile LAS unsigned*)(F.lds + LDS_MISC);
    if (F.tid < 4) xbw[F.tid] = 0u;
    __syncthreads();
    XcdBarrier bar; bar.bar = F.ctl + CW_BAR; bar.x = 0; bar.st = xbw;
    if (hi - lo > 1) bar = xcd_barrier_post(F.ctl + CW_BAR, xbw);
    int ph = 0;
#define RUN_PHASE(...) do { if (ph >= lo && ph < hi) { __VA_ARGS__; if (ph + 1 < hi) { xcd_barrier(bar); if (REP_BAR > 1) xcd_barrier(bar); } } ++ph; } while (0)
#define RUN_PHASE_DUP(NREP, ...) do { if (ph >= lo && ph < hi) { __VA_ARGS__; if ((NREP) > 1) { VM_WAIT(); __syncthreads(); __VA_ARGS__; } if (ph + 1 < hi) xcd_barrier(bar); } ++ph; } while (0)
#define RUN_PHASE_N(NREP, ...) do { if (ph >= lo && ph < hi) { for (int rep_ = 0; rep_ < (NREP); ++rep_) { if (rep_) { VM_WAIT(); __syncthreads(); } __VA_ARGS__; } if (ph + 1 < hi) xcd_barrier(bar); } ++ph; } while (0)

    float* mod = (float*)(ws + WS_MOD);
    bf16_t* xres = (bf16_t*)(ws + WS_XRES);
    bf16_t* hbuf = (bf16_t*)(ws + WS_H);
    bf16_t* proj = (bf16_t*)(ws + WS_PROJ);
    bf16_t* amix = (bf16_t*)(ws + WS_AMIX);
    bf16_t* act = (bf16_t*)(ws + WS_ACT);
    bf16_t* yp = (bf16_t*)(ws + WS_YP);
    int* tokes = (int*)(ws + WS_TOKES); float* tokw = (float*)(ws + WS_TOKW);
    unsigned short* list = (unsigned short*)(ws + WS_LIST);
    const void* xcur = in[0];

    RUN_PHASE_N(REP_PRO, prologue_phase(F));

#define MOD(l, k) (mod + (size_t)(l) * NB * 6144 + (k) * 1024)
#define CNT(l) (F.ctl + CW_CNT + (l) * 32 * 64)
#define NORM1(l, PROJ) do { constexpr bool CMB = ((l) > 0) && ENABLE_MOE; NormArgs a{}; a.xin = xcur; a.xout = xres; a.gain = in[4] + (l) * 1024; a.sc = MOD(l, 1); a.sh = MOD(l, 0); a.h = hbuf; \
        if (CMB) { a.yp = yp; a.tokes_c = tokes; a.tokw_c = tokw; a.gf = MOD((l) - 1, 5); a.cnt_prev = CNT((l) - 1); } \
        a.wt = (const bf16_t*)(ws + WS_WGL); a.glow = (float*)(ws + WS_GLOW); a.h8 = (unsigned char*)(ws + WS_H8); \
        constexpr int IF8 = (l) == 0 ? IFP8_RET : ((l) == 1 ? IFP8_ATT : ((l) == 2 ? IFP8_GLA : IFP8_MLS)); \
        constexpr int GF8 = (l) == 0 ? GFP8_RET : ((l) == 2 ? GFP8_GLA : ((l) == 3 ? GFP8_MLS : 0)); \
        RUN_PHASE({ norm_phase<CMB, PROJ, false, ((l) > 0), (IF8 ? 2 : (GF8 ? 3 : 1))>(F, a); \
            if (REP_NORM > 1) { VM_WAIT(); __syncthreads(); NormArgs a2 = a; a2.xout = (bf16_t*)(ws + WS_PT); a2.h = (bf16_t*)(ws + WS_MIX); a2.h8 = (unsigned char*)(ws + WS_AMIX); norm_phase<CMB, 0, false, ((l) > 0), (IF8 ? 2 : (GF8 ? 3 : 1))>(F, a2); } }); if (CMB) xcur = xres; } while (0)
#define OUTPROJ(l, WOFF, KK) do { pg8::Gemm g{amix, (const bf16_t*)(ws + (WOFF)), T, DM, OUT_FP8 ? (KK) / 2 : (KK)}; pg8::EpiResid<((l) > 0)> E{xcur, xres, MOD(l, 2), OUT_FP8 ? 0.03125f : 1.0f}; \
        RUN_PHASE({ pg8::StaticOrder S; S.init(T, DM, F.G, F.bid); pg8::gemm_phase<pg8::EpiResid<((l) > 0)>, pg8::StaticOrder, false, (OUT_FP8 != 0)>(F.lds, g, S, E); \
            if (REP_OUT > 1) { VM_WAIT(); __syncthreads(); pg8::EpiResid<((l) > 0)> E2{(l) > 0 ? (const void*)(ws + WS_PT) : xcur, (bf16_t*)(ws + WS_PT), MOD(l, 2), 1.0f}; pg8::gemm_phase<pg8::EpiResid<((l) > 0)>, pg8::StaticOrder, false, (OUT_FP8 != 0)>(F.lds, g, S, E2); } }); xcur = xres; } while (0)
#define MOE(l) do { if (!ENABLE_MOE) break; \
        { NormArgs a{}; a.xin = xcur; a.gain = in[5] + (l) * 1024; a.sc = MOD(l, 4); a.sh = MOD(l, 3); a.h = hbuf; \
          a.wt = (const bf16_t*)(ws + WS_WRT) + (size_t)(l) * 2 * 32 * 1024; a.rb = in[30] + (l) * 32; a.cnt = CNT(l); a.list = list; a.tokes = tokes; a.tokw = tokw; a.h8 = (unsigned char*)(ws + WS_H8); \
          RUN_PHASE({ norm_phase<false, 1, false, true, (MOE_FP8 ? 3 : 1)>(F, a); \
            if (REP_NORM > 1) { VM_WAIT(); __syncthreads(); NormArgs a2 = a; a2.h = (bf16_t*)(ws + WS_MIX); a2.h8 = (unsigned char*)(ws + WS_AMIX); norm_phase<false, 0, false, true, (MOE_FP8 ? 3 : 1)>(F, a2); } }); } \
        if (MOE_FP8) { \
          { pg8::EpiSwiglu8 E{(unsigned char*)act, in[32] + (size_t)(l) * 32 * 2048}; pg8::EpiNull EN{(float*)(ws + WS_GLOW)}; \
            RUN_PHASE({ if (CVT_HOST && (l) >= MOE_PRO_LAYERS - 1 && (l) < 3) moe_gemm_phase<8, true, true, pg8::EpiSwiglu8, false, true>(F, (const bf16_t*)(ws + WS_H8), (const bf16_t*)(ws + WS_W1T + (size_t)(l) * 32 * 2048 * 1024), CNT(l), list, E, in, ws, (l) + 1, (CVT_HOST == 2 && (l) == 0) ? 0 : -1); \
              else moe_gemm_phase<8, true, true, pg8::EpiSwiglu8>(F, (const bf16_t*)(ws + WS_H8), (const bf16_t*)(ws + WS_W1T + (size_t)(l) * 32 * 2048 * 1024), CNT(l), list, E); \
              if (REP_MOE > 1 && (MOE_WHICH & 1)) { VM_WAIT(); __syncthreads(); if (MOE_NULL) moe_gemm_phase<8, true, true, pg8::EpiNull, (MOE_HOT != 0)>(F, (const bf16_t*)(ws + WS_H8), (const bf16_t*)(ws + WS_W1T + (size_t)(l) * 32 * 2048 * 1024), CNT(l), list, EN); \
                else moe_gemm_phase<8, true, true, pg8::EpiSwiglu8>(F, (const bf16_t*)(ws + WS_H8), (const bf16_t*)(ws + WS_W1T + (size_t)(l) * 32 * 2048 * 1024), CNT(l), list, E); } }); } \
          { pg8::EpiMoe2 E{yp, in[34] + (size_t)(l) * 32 * 1024, 0.03125f}; pg8::EpiNull EN{(float*)(ws + WS_GLOW)}; \
            RUN_PHASE({ moe_gemm_phase<4, false, true, pg8::EpiMoe2>(F, act, (const bf16_t*)(ws + WS_W2T + (size_t)(l) * 32 * 1024 * 1024), CNT(l), list, E); \
              if (REP_MOE > 1 && (MOE_WHICH & 2)) { VM_WAIT(); __syncthreads(); if (MOE_NULL) moe_gemm_phase<4, false, true, pg8::EpiNull, (MOE_HOT != 0)>(F, act, (const bf16_t*)(ws + WS_W2T + (size_t)(l) * 32 * 1024 * 1024), CNT(l), list, EN); \
                else moe_gemm_phase<4, false, true, pg8::EpiMoe2>(F, act, (const bf16_t*)(ws + WS_W2T + (size_t)(l) * 32 * 1024 * 1024), CNT(l), list, E); } }); } \
        } else { \
          { pg8::EpiSwiglu E{act, in[32] + (size_t)(l) * 32 * 2048}; \
            RUN_PHASE_N(REP_MOE, moe_gemm_phase<8, true, false, pg8::EpiSwiglu>(F, hbuf, (const bf16_t*)(ws + WS_W1T) + (size_t)(l) * 32 * 2048 * 1024, CNT(l), list, E)); } \
          { pg8::EpiMoe2 E{yp, in[34] + (size_t)(l) * 32 * 1024, 1.0f}; \
            RUN_PHASE_N(REP_MOE, moe_gemm_phase<4, false, false, pg8::EpiMoe2>(F, act, (const bf16_t*)(ws + WS_W2T) + (size_t)(l) * 32 * 1024 * 1024, CNT(l), list, E)); } \
        } \
    } while (0)

    NORM1(0, 0);
#if ENABLE_RET
    LAYER_RET();
#endif
    MOE(0);
    NORM1(1, 0);
#if ENABLE_ATT
    LAYER_ATT();
#endif
    MOE(1);
    NORM1(2, 2);
#if ENABLE_GLA
    LAYER_GLA();
#endif
    MOE(2);
    NORM1(3, 0);
#if ENABLE_MLS
    LAYER_MLS();
#endif
    MOE(3);
    { NormArgs a{}; a.xin = xcur; a.xout = xres; a.gain = in[6]; a.yp = yp; a.tokes_c = tokes; a.tokw_c = tokw; a.gf = MOD(3, 5); a.cnt_prev = CNT(3); a.out = F.out;
      RUN_PHASE({ norm_phase<(ENABLE_MOE != 0), 0, true, true>(F, a); if (REP_NORM > 1) { VM_WAIT(); __syncthreads(); NormArgs a2 = a; a2.xout = (bf16_t*)(ws + WS_PT); a2.out = (float*)(ws + WS_MIX); norm_phase<(ENABLE_MOE != 0), 0, true, true>(F, a2); } }); }
#undef RUN_PHASE
}

static int count_phases() {
    int n = 1;
    const int mixer[4] = {ENABLE_RET ? NPH_RET : 0, ENABLE_ATT ? NPH_ATT : 0, ENABLE_GLA ? NPH_GLA : 0, ENABLE_MLS ? NPH_MLS : 0};
    for (int l = 0; l < 4; ++l) n += 1 + mixer[l] + (ENABLE_MOE ? 3 : 0);
    return n + 1;
}

extern "C" void kernel_launch(void* const* d_in, const int* in_sizes, int n_in, void* d_out, int out_size, void* d_ws, size_t ws_size, hipStream_t stream) {
    static int grid = 0;
    if (grid == 0) {
        if (n_in != 35 || out_size != T * DM || ws_size < WS_END) { fprintf(stderr, "kernel_launch: unexpected shapes (n_in %d out %d ws %zu)\n", n_in, out_size, ws_size); grid = -1; return; }
        int dev = 0, cus = 0, per_cu = 0;
        if (hipGetDevice(&dev) != hipSuccess || hipDeviceGetAttribute(&cus, hipDeviceAttributeMultiprocessorCount, dev) != hipSuccess) { grid = -1; return; }
        if (hipFuncSetAttribute((const void*)trunk_fwd, hipFuncAttributeMaxDynamicSharedMemorySize, LDS_BYTES) != hipSuccess) { fprintf(stderr, "kernel_launch: hipFuncSetAttribute failed\n"); grid = -1; return; }
        if (hipOccupancyMaxActiveBlocksPerMultiprocessor(&per_cu, (const void*)trunk_fwd, NTHR, LDS_BYTES) != hipSuccess || per_cu < 1) { fprintf(stderr, "kernel_launch: occupancy query says %d\n", per_cu); grid = -1; return; }
        grid = cus;
    }
    if (grid <= 0) return;
    hipMemsetAsync((char*)d_ws + WS_CTL, 0, CTL_ZERO_BYTES, stream);
    Args a{};
    for (int i = 0; i < 35; ++i) a.in[i] = (const float*)d_in[i];
    a.out = (float*)d_out; a.ws = (unsigned char*)d_ws;
    const int nph = count_phases();
#if N_LAUNCH_MODE == 1
    for (int p = 0; p < nph; ++p) { a.ph_lo = p; a.ph_hi = p + 1; hipLaunchKernelGGL(trunk_fwd, dim3(grid), dim3(NTHR), LDS_BYTES, stream, a); }
#else
    a.ph_lo = 0; a.ph_hi = nph;
    hipLaunchKernelGGL(trunk_fwd, dim3(grid), dim3(NTHR), LDS_BYTES, stream, a);
#endif
    hipError_t le = hipGetLastError();
    if (le != hipSuccess) fprintf(stderr, "kernel_launch: launch failed: %s\n", hipGetErrorName(le));
}
```
